# Optimizing an MI355X kernel written in HIP

```python
import jax, jax.numpy as jnp
from jax import lax
import numpy as np

D_MODEL = 1024
BATCH = 1
SEQ = 16384
DEPTH = 4

CHUNK = 64
Q_BLOCK = 128
HEAD_DIM = 64
ROPE_THETA = 10000.0
EPS = 1e-6
SB_HEADS = 4
SB_W = SB_HEADS * HEAD_DIM
DSA_HEADS = 4
DSA_W = DSA_HEADS * HEAD_DIM
IDX_HEADS = 4
IDX_DIM = 64
TOPK_MAX = 256
GLA_HEADS = 4
GLA_DK = 32
GLA_DV = 64
GLA_KW = GLA_HEADS * GLA_DK
GLA_VW = GLA_HEADS * GLA_DV
GLA_RANK = 16
GLA_TAU = 16.0
N_BRANCH = 3
N_MEM = 256
X_HEADS = 4
X_DIM = D_MODEL // X_HEADS
D_FF = -(-8 * D_MODEL // (3 * 256)) * 256
SPLIT_SIZES = (SB_W, SB_W, SB_W,
               DSA_W, HEAD_DIM, HEAD_DIM, IDX_HEADS * IDX_DIM, IDX_DIM, IDX_HEADS,
               GLA_KW, GLA_KW, GLA_VW, GLA_RANK, GLA_VW,
               N_BRANCH * D_MODEL)
IN_WIDTH = (3 * SB_W + DSA_W + 2 * HEAD_DIM + IDX_HEADS * IDX_DIM + IDX_DIM + IDX_HEADS
            + 2 * GLA_KW + 2 * GLA_VW + GLA_RANK + N_BRANCH * D_MODEL)

kernel_name = 'hybrid_sb_dsa_gla_streaming_encoder'

F32 = jnp.float32


def rmsnorm(x, g):
    xf = x.astype(F32)
    y = xf * lax.rsqrt(jnp.mean(xf * xf, axis=-1, keepdims=True) + EPS)
    return (y * g.astype(F32)).astype(x.dtype)


def rope(t, pos):
    d = t.shape[-1]
    half = d // 2
    inv = 1.0 / (ROPE_THETA ** (jnp.arange(half, dtype=F32) * (2.0 / d)))
    ang = pos[:, None] * inv[None, :]
    cos = jnp.cos(ang)[None, :, None, :]
    sin = jnp.sin(ang)[None, :, None, :]
    tf = t.astype(F32)
    t1, t2 = tf[..., :half], tf[..., half:]
    return jnp.concatenate([t1 * cos - t2 * sin, t2 * cos + t1 * sin], axis=-1).astype(t.dtype)


def split_columns(z, sizes):
    out, start = [], 0
    for n in sizes:
        out.append(z[..., start:start + n])
        start += n
    return out


def to_blocks(t, nb):
    return jnp.moveaxis(t.reshape((t.shape[0], nb, Q_BLOCK) + t.shape[2:]), 1, 0)


def from_blocks(t):
    t = jnp.moveaxis(t, 0, 1)
    return t.reshape((t.shape[0], t.shape[1] * t.shape[2]) + t.shape[3:])


def stick_breaking_attention(q, k, v):
    B, S, H, dh = q.shape
    nb = S // Q_BLOCK
    scale = dh ** -0.5
    qi = np.repeat(np.arange(nb), np.arange(1, nb + 1))
    start = qi * (qi + 1) // 2
    ki = qi - (np.arange(qi.shape[0]) - start)
    last = np.arange(nb) * (np.arange(nb) + 1) // 2 + np.arange(nb)
    qbl = to_blocks(q.astype(F32) * scale, nb)
    kbl = to_blocks(k.astype(F32), nb)
    vbl = to_blocks(v.astype(F32), nb)
    strict_lower = jnp.tril(jnp.ones((Q_BLOCK, Q_BLOCK), F32), -1)

    def step(carry, idx):
        acc, run = carry
        qb, kb = idx
        first = kb == qb
        acc = jnp.where(first, 0.0, acc)
        run = jnp.where(first, 0.0, run)
        z = jnp.einsum('bqhd,bkhd->bhqk', qbl[qb], kbl[kb])
        valid = (kb < qb) | (strict_lower > 0)
        log_beta = jax.nn.log_sigmoid(z)
        log_keep = jnp.where(valid, log_beta - z, 0.0)
        between = jnp.einsum('bhqj,js->bhqs', log_keep, strict_lower) + run[..., None]
        weight = jnp.where(valid, jnp.exp(log_beta + between), 0.0)
        acc = acc + jnp.einsum('bhqk,bkhd->bhqd', weight, vbl[kb])
        run = run + jnp.sum(log_keep, axis=-1)
        return (acc, run), acc

    init = (jnp.zeros((B, H, Q_BLOCK, dh), F32), jnp.zeros((B, H, Q_BLOCK), F32))
    _, partial = lax.scan(step, init, (jnp.asarray(qi, jnp.int32), jnp.asarray(ki, jnp.int32)))
    out = partial[last]
    out = out.transpose(1, 0, 3, 2, 4).reshape(B, S, H, dh)
    return out.astype(q.dtype)


def dsa_attention(q, k, v, q_idx, k_idx, w_idx):
    B, S, H, dh = q.shape
    nb = S // Q_BLOCK
    n_keep = min(TOPK_MAX, S // 4)
    scale = dh ** -0.5
    kif = k_idx.astype(F32)
    key_chunk = jnp.arange(S) // CHUNK
    gather = jax.vmap(lambda kk, ii: kk[ii])

    def block(args):
        qb, qib, wb, blk = args
        qchunk = (blk * Q_BLOCK + jnp.arange(Q_BLOCK)) // CHUNK
        admissible = key_chunk[None, :] <= qchunk[:, None]
        logits = jnp.einsum('bqhd,bkd->bqhk', qib.astype(F32), kif) * (IDX_DIM ** -0.5)
        iscore = jnp.einsum('bqh,bqhk->bqk', wb.astype(F32), jax.nn.relu(logits))
        iscore = jnp.where(admissible[None], iscore, -jnp.inf)
        _, sel = lax.top_k(iscore, n_keep)
        valid = key_chunk[sel] <= qchunk[None, :, None]
        k_sel = gather(k, sel).astype(F32)
        v_sel = gather(v, sel).astype(F32)
        s = jnp.einsum('bqhd,bqnd->bhqn', qb.astype(F32), k_sel) * scale
        s = jnp.where(valid[:, None], s, -jnp.inf)
        p = jax.nn.softmax(s, axis=-1)
        return jnp.einsum('bhqn,bqnd->bqhd', p, v_sel)

    out = lax.map(block, (to_blocks(q, nb), to_blocks(q_idx, nb), to_blocks(w_idx, nb), jnp.arange(nb)))
    return from_blocks(out).astype(q.dtype)


def gated_linear_attention(q, k, v, log_alpha):
    B, S, H, dk = q.shape
    n = S // CHUNK

    def to_chunks(t):
        return t.astype(F32).reshape(B, n, CHUNK, H, -1).transpose(1, 0, 3, 2, 4)

    qc = to_chunks(q) * (dk ** -0.5)
    kc, vc = to_chunks(k), to_chunks(v)
    bc = jnp.cumsum(to_chunks(log_alpha), axis=3)
    causal = jnp.tril(jnp.ones((CHUNK, CHUNK), bool))[:, :, None]

    def step(state, inp):
        qt, kt, vt, bt = inp
        o_inter = jnp.einsum('bhtd,bhde->bhte', qt * jnp.exp(bt), state)
        diff = bt[:, :, :, None, :] - bt[:, :, None, :, :]
        decay = jnp.exp(jnp.where(causal, diff, -jnp.inf))
        a = jnp.einsum('bhtd,bhjd,bhtjd->bhtj', qt, kt, decay)
        o_intra = jnp.einsum('bhtj,bhje->bhte', a, vt)
        b_last = bt[:, :, -1:, :]
        state = (jnp.exp(b_last[:, :, 0, :])[..., None] * state
                 + jnp.einsum('bhjd,bhje->bhde', kt * jnp.exp(b_last - bt), vt))
        return state, o_inter + o_intra

    state0 = jnp.zeros((B, H, dk, v.shape[-1]), F32)
    _, out = lax.scan(step, state0, (qc, kc, vc, bc))
    return out.transpose(1, 0, 3, 2, 4).reshape(B, S, H, -1).astype(v.dtype)


def hybrid_mixer(h, w_in, gla_w_up, gla_b, gla_norm_g, w_br_a, w_br_b, w_br_c, w_mix_out, pos):
    B, S, _ = h.shape
    z = h @ w_in
    (sb_q, sb_k, sb_v, ds_q, ds_k, ds_v, ix_q, ix_k, ix_w,
     gl_q, gl_k, gl_v, gl_g, gl_o, gates) = split_columns(z, SPLIT_SIZES)
    heads = lambda t, nh: t.reshape(B, S, nh, -1)
    y_a = stick_breaking_attention(heads(sb_q, SB_HEADS), heads(sb_k, SB_HEADS), heads(sb_v, SB_HEADS))
    y_a = y_a.reshape(B, S, SB_W) @ w_br_a
    q_b = rope(heads(ds_q, DSA_HEADS), pos)
    k_b = rope(ds_k[:, :, None, :], pos)[:, :, 0, :]
    qi = rope(heads(ix_q, IDX_HEADS), pos)
    ki = rope(ix_k[:, :, None, :], pos)[:, :, 0, :]
    wi = ix_w * (IDX_HEADS ** -0.5)
    y_b = dsa_attention(q_b, k_b, ds_v, qi, ki, wi)
    y_b = y_b.reshape(B, S, DSA_W) @ w_br_b
    gate_logit = (gl_g @ gla_w_up + gla_b).astype(F32)
    log_alpha = jax.nn.log_sigmoid(gate_logit) / GLA_TAU
    o_c = gated_linear_attention(heads(gl_q, GLA_HEADS), heads(gl_k, GLA_HEADS),
                                 heads(gl_v, GLA_HEADS), heads(log_alpha, GLA_HEADS))
    o_c = rmsnorm(o_c, gla_norm_g) * jax.nn.silu(heads(gl_o, GLA_HEADS))
    y_c = o_c.reshape(B, S, GLA_VW) @ w_br_c
    g = jax.nn.sigmoid(gates.reshape(B, S, N_BRANCH, D_MODEL))
    merged = g[:, :, 0] * y_a + g[:, :, 1] * y_b + g[:, :, 2] * y_c
    return merged @ w_mix_out


def memory_cross_attention(h, mem_n, w_xq, w_xkv, w_xo):
    B, S, _ = h.shape
    M = mem_n.shape[1]
    q = (h @ w_xq).reshape(B, S, X_HEADS, X_DIM)
    kv = (mem_n @ w_xkv).reshape(B, M, 2, X_HEADS, X_DIM)
    k, v = kv[:, :, 0], kv[:, :, 1]
    s = jnp.einsum('bqhd,bmhd->bhqm', q.astype(F32), k.astype(F32)) * (X_DIM ** -0.5)
    p = jax.nn.softmax(s, axis=-1)
    o = jnp.einsum('bhqm,bmhd->bqhd', p, v.astype(F32)).astype(h.dtype)
    return o.reshape(B, S, D_MODEL) @ w_xo


def swiglu(h, w_ffn_in, w_ffn_out):
    gu = h @ w_ffn_in
    gate, up = gu[..., :D_FF], gu[..., D_FF:]
    return (jax.nn.silu(gate) * up) @ w_ffn_out


def setup_inputs(seed: int = 0) -> dict:
    key = jax.random.key(seed)
    ks = jax.random.split(key, 20)

    def nrm(k, shape, fan_in):
        return jax.random.normal(k, shape, F32) * (fan_in ** -0.5)

    def gain(k, shape):
        return 1.0 + 0.02 * jax.random.normal(k, shape, F32)

    return {
        'x': jax.random.normal(ks[0], (BATCH, SEQ, D_MODEL), F32),
        'mem': jax.random.normal(ks[1], (BATCH, N_MEM, D_MODEL), F32),
        'mix_norm_g': gain(ks[2], (DEPTH, D_MODEL)),
        'w_in': nrm(ks[3], (DEPTH, D_MODEL, IN_WIDTH), D_MODEL),
        'gla_w_up': nrm(ks[4], (DEPTH, GLA_RANK, GLA_KW), GLA_RANK),
        'gla_b': 0.02 * jax.random.normal(ks[5], (DEPTH, GLA_KW), F32),
        'gla_norm_g': gain(ks[6], (DEPTH, GLA_DV)),
        'w_br_a': nrm(ks[7], (DEPTH, SB_W, D_MODEL), SB_W),
        'w_br_b': nrm(ks[8], (DEPTH, DSA_W, D_MODEL), DSA_W),
        'w_br_c': nrm(ks[9], (DEPTH, GLA_VW, D_MODEL), GLA_VW),
        'w_mix_out': nrm(ks[10], (DEPTH, D_MODEL, D_MODEL), D_MODEL),
        'xattn_norm_g': gain(ks[11], (DEPTH, D_MODEL)),
        'mem_norm_g': gain(ks[12], (DEPTH, D_MODEL)),
        'w_xq': nrm(ks[13], (DEPTH, D_MODEL, D_MODEL), D_MODEL),
        'w_xkv': nrm(ks[14], (DEPTH, D_MODEL, 2 * D_MODEL), D_MODEL),
        'w_xo': nrm(ks[15], (DEPTH, D_MODEL, D_MODEL), D_MODEL),
        'ffn_norm_g': gain(ks[16], (DEPTH, D_MODEL)),
        'w_ffn_in': nrm(ks[17], (DEPTH, D_MODEL, 2 * D_FF), D_MODEL),
        'w_ffn_out': nrm(ks[18], (DEPTH, D_FF, D_MODEL), D_FF),
        'final_norm_g': gain(ks[19], (D_MODEL,)),
    }


def reference(x, mem, mix_norm_g, w_in, gla_w_up, gla_b, gla_norm_g, w_br_a, w_br_b, w_br_c,
              w_mix_out, xattn_norm_g, mem_norm_g, w_xq, w_xkv, w_xo, ffn_norm_g,
              w_ffn_in, w_ffn_out, final_norm_g):
    pos = jnp.arange(x.shape[1], dtype=F32)
    for l in range(DEPTH):
        h = rmsnorm(x, mix_norm_g[l])
        x = x + hybrid_mixer(h, w_in[l], gla_w_up[l], gla_b[l], gla_norm_g[l],
                             w_br_a[l], w_br_b[l], w_br_c[l], w_mix_out[l], pos)
        h = rmsnorm(x, xattn_norm_g[l])
        mem_n = rmsnorm(mem, mem_norm_g[l])
        x = x + memory_cross_attention(h, mem_n, w_xq[l], w_xkv[l], w_xo[l])
        h = rmsnorm(x, ffn_norm_g[l])
        x = x + swiglu(h, w_ffn_in[l], w_ffn_out[l])
    return rmsnorm(x, final_norm_g)
```

```cpp
#include <hip/hip_runtime.h>
#include <stdint.h>
#include <stdio.h>

#define LAS __attribute__((address_space(3)))
typedef unsigned short bf16_t;
typedef short bf16x8 __attribute__((ext_vector_type(8)));
typedef float f32x4 __attribute__((ext_vector_type(4)));
typedef float f32x2 __attribute__((ext_vector_type(2)));
typedef unsigned u32x4 __attribute__((ext_vector_type(4)));
typedef unsigned u32x2 __attribute__((ext_vector_type(2)));

#ifndef DBG_MODE
#define DBG_MODE 0
#endif
#ifndef ONLY
#define ONLY -1
#endif
#define PH_EN(k) (ONLY < 0 || ONLY == (k))
#ifndef N_LAUNCH_MODE
#define N_LAUNCH_MODE 1
#endif

constexpr int S_ = 16384, D_ = 1024, NIN = 5376, INW = 5332, DFF = 2816, NFF = 5632, NMEM = 256, DEPTH = 4;
constexpr int NTHREADS = 512;
constexpr int LDS_BYTES = 147456;
constexpr int MISC_OFF = 143360;
constexpr float EPS = 1e-6f;
constexpr float LOG2E = 1.4426950408889634f;
constexpr float SBQ_SCALE = 0.125f * LOG2E;
constexpr float DSQ_SCALE = 0.125f * LOG2E;
constexpr float IXQ_SCALE = 0.125f;
constexpr float GLQ_SCALE = 0.17677669529663687f;
constexpr float XQ_SCALE = 0.0625f * LOG2E;

constexpr size_t MB = 1u << 20;
constexpr size_t WS_CTL = 0;
constexpr size_t WS_CS = 65536;
constexpr size_t WS_SSQ = WS_CS + 4 * MB;
constexpr size_t WS_MEMB = WS_SSQ + 1 * MB;
constexpr size_t WS_RSTDM = WS_MEMB + 512 * 1024;
constexpr size_t WS_KM = WS_RSTDM + 4096;
constexpr size_t WS_VMT = WS_KM + 512 * 1024;
constexpr size_t WS_WIN = WS_VMT + 512 * 1024;
constexpr size_t WS_WBR = WS_WIN + (size_t)NIN * 1024 * 2;
constexpr size_t WS_WMIX = WS_WBR + 3 * 1024 * 256 * 2;
constexpr size_t WS_WXQ = WS_WMIX + 2 * MB;
constexpr size_t WS_WXKV = WS_WXQ + 2 * MB;
constexpr size_t WS_WXO = WS_WXKV + 4 * MB;
constexpr size_t WS_WFI = WS_WXO + 2 * MB;
constexpr size_t WS_WFO = WS_WFI + (size_t)NFF * 1024 * 2;
constexpr size_t WS_XB = WS_WFO + (size_t)1024 * DFF * 2;
constexpr size_t WS_SBQ = WS_XB + 32 * MB;
constexpr size_t WS_SBK = WS_SBQ + 8 * MB;
constexpr size_t WS_SBV = WS_SBK + 8 * MB;
constexpr size_t WS_DSQ = WS_SBV + 8 * MB;
constexpr size_t WS_IXQ = WS_DSQ + 8 * MB;
constexpr size_t WS_DSK = WS_IXQ + 8 * MB;
constexpr size_t WS_IXK = WS_DSK + 2 * MB;
constexpr size_t WS_DSV = WS_IXK + 2 * MB;
constexpr size_t WS_SMALL = WS_DSV + 2 * MB;
constexpr size_t WS_GLQ = WS_SMALL + 4 * MB;
constexpr size_t WS_GLK = WS_GLQ + 4 * MB;
constexpr size_t WS_GLV = WS_GLK + 4 * MB;
constexpr size_t WS_GLO = WS_GLV + 8 * MB;
constexpr size_t WS_OA = WS_GLO + 8 * MB;
constexpr size_t WS_OB = WS_OA + 8 * MB;
constexpr size_t WS_OC = WS_OB + 8 * MB;
constexpr size_t WS_BC = WS_OC + 8 * MB;
constexpr size_t WS_UC = WS_BC + 8 * MB;
constexpr size_t WS_ST = WS_UC + 8 * MB;
constexpr size_t WS_AC = WS_ST + 8 * MB;
constexpr size_t WS_MERGED = WS_AC + 128 * 1024;
constexpr size_t WS_GATES = WS_MERGED + 32 * MB;
constexpr size_t WS_XQ = WS_GATES;
constexpr size_t WS_AO = WS_GATES + 32 * MB;
constexpr size_t WS_HID = WS_GATES;
constexpr size_t WS_END = WS_GATES + 96 * MB;
constexpr size_t WS_DBG = WS_END;
constexpr size_t WS_DBGSEL = WS_DBG + 65536;
constexpr size_t WS_DBGEND = WS_DBGSEL + 8 * MB;
constexpr size_t CTL_ZERO_BYTES = 65536;
constexpr int CW_BAR = 0;
constexpr int CW_QUEUE = 4096;

typedef __bf16 bf16x2_t __attribute__((ext_vector_type(2)));
__device__ __forceinline__ unsigned cvt_pk_bf16(float lo, float hi) { const f32x2 v = {lo, hi}; return __builtin_bit_cast(unsigned, __builtin_convertvector(v, bf16x2_t)); }
__device__ __forceinline__ bf16_t f2bf(float f) { return (bf16_t)(cvt_pk_bf16(f, 0.f) & 0xffffu); }
__device__ __forceinline__ float bf2f(unsigned b) { return __uint_as_float(b << 16); }
__device__ __forceinline__ float bflo(unsigned w) { return __uint_as_float(w << 16); }
__device__ __forceinline__ float bfhi(unsigned w) { return __uint_as_float(w & 0xffff0000u); }
__device__ __forceinline__ void st_bf16x8(bf16_t* p, const float (&v)[8]) {
    u32x4 w; w.x = cvt_pk_bf16(v[0], v[1]); w.y = cvt_pk_bf16(v[2], v[3]); w.z = cvt_pk_bf16(v[4], v[5]); w.w = cvt_pk_bf16(v[6], v[7]); *(u32x4*)p = w; }
__device__ __forceinline__ void ld_bf16x8(const bf16_t* p, float (&v)[8]) {
    const u32x4 w = *(const u32x4*)p; v[0] = bflo(w.x); v[1] = bfhi(w.x); v[2] = bflo(w.y); v[3] = bfhi(w.y); v[4] = bflo(w.z); v[5] = bfhi(w.z); v[6] = bflo(w.w); v[7] = bfhi(w.w); }
__device__ __forceinline__ float row_rstd(const float* ssq, int r) {
    const f32x4* p = (const f32x4*)(ssq + (size_t)r * 16); const f32x4 a = p[0], b = p[1], c = p[2], d = p[3];
    const float s = ((a.x + a.y) + (a.z + a.w)) + ((b.x + b.y) + (b.z + b.w)) + ((c.x + c.y) + (c.z + c.w)) + ((d.x + d.y) + (d.z + d.w));
    return rsqrtf(s * (1.0f / 1024.0f) + EPS); }
__device__ __forceinline__ float sigmoidf_(float v) { return __builtin_amdgcn_rcpf(1.0f + __builtin_amdgcn_exp2f(-v * LOG2E)); }
__device__ __forceinline__ float shx(float v, int m, int lane) { return __int_as_float(__builtin_amdgcn_ds_bpermute((lane ^ m) << 2, __float_as_int(v))); }
__device__ __forceinline__ unsigned shdn(unsigned v, int off, int lane) { return (unsigned)__builtin_amdgcn_ds_bpermute((lane + off) << 2, (int)v); }
__device__ __forceinline__ float wave_sum(float v, int lane) { for (int o = 32; o >= 1; o >>= 1) v += shx(v, o, lane); return v; }
__device__ __forceinline__ float wave_max(float v, int lane) { for (int o = 32; o >= 1; o >>= 1) v = fmaxf(v, shx(v, o, lane)); return v; }

__device__ __forceinline__ int mytid(int wave) { int lane; asm volatile("v_mbcnt_lo_u32_b32 %0, -1, 0\n\tv_mbcnt_hi_u32_b32 %0, -1, %0" : "=v"(lane)); asm volatile("" : "+s"(wave)); return wave * 64 + lane; }

#define XB_TMO      128
#define XB_XCNT(j)  (256  + 64 * (j))
#define XB_XSUB(j)  (1280 + 64 * (j))
#define XB_XGEN(j)  (2304 + 64 * (j))
#define XB_TOP      3328
#define XB_TOPGEN   3392
#define XCD_BAR_WORDS 3456
#define XB_SPIN_CAP (1u << 22)
__device__ __forceinline__ unsigned xb_ld(unsigned* p)              { return __hip_atomic_load(p, __ATOMIC_RELAXED, __HIP_MEMORY_SCOPE_AGENT); }
__device__ __forceinline__ unsigned xb_add(unsigned* p, unsigned v) { return __hip_atomic_fetch_add(p, v, __ATOMIC_RELAXED, __HIP_MEMORY_SCOPE_AGENT); }
__device__ __forceinline__ unsigned xb_xcc_id() { return (unsigned)__builtin_amdgcn_s_getreg((3 << 11) | 20) & 0xFu; }
#define XB_SPIN(cond, bar) do { unsigned _sp = 0; while (cond) { __builtin_amdgcn_s_sleep(1); \
    if ((++_sp & 255u) == 0u) { if (xb_ld(&(bar)[XB_TMO])) break; if (_sp > XB_SPIN_CAP) { atomicAdd(&(bar)[XB_TMO], 1u); break; } } } } while (0)
struct XcdBarrier { unsigned* bar; unsigned x; volatile LAS unsigned* st; };
__device__ __forceinline__ XcdBarrier xcd_barrier_post(unsigned* bar, volatile LAS unsigned* st, int wave_s) {
    XcdBarrier b; b.bar = bar; b.x = xb_xcc_id(); b.st = st;
    if (mytid(wave_s) == 0) (void)xb_add(&bar[XB_XCNT(b.x)], 1u);
    return b;
}
__device__ __forceinline__ void xcd_barrier_complete(unsigned* bar, unsigned x, unsigned& nloc, unsigned& nx) {
    const unsigned G = gridDim.x * gridDim.y * gridDim.z;
    unsigned sum, cnt, mine, sp = 0u;
    for (;;) {
        sum = 0u; cnt = 0u; mine = 0u;
#pragma unroll
        for (unsigned j = 0; j < 16; ++j) { const unsigned c = xb_ld(&bar[XB_XCNT(j)]); sum += c; cnt += (c > 0u) ? 1u : 0u; mine = (j == x) ? c : mine; }
        if (sum == G) break;
        __builtin_amdgcn_s_sleep(1);
        if ((++sp & 255u) == 0u) { if (xb_ld(&bar[XB_TMO])) break; if (sp > XB_SPIN_CAP) { atomicAdd(&bar[XB_TMO], 1u); break; } }
    }
    nloc = mine > 0u ? mine : 1u; nx = cnt > 0u ? cnt : 1u;
}
__device__ __forceinline__ void xcd_barrier(const XcdBarrier& b, int wave_s) {
    asm volatile("s_waitcnt vmcnt(0)" ::: "memory");
    __syncthreads();
    if (mytid(wave_s) == 0) {
        unsigned* bar = b.bar;
        __builtin_amdgcn_s_waitcnt(0);
        unsigned nloc = b.st[0], nx = b.st[1];
        if (nloc == 0u) { xcd_barrier_complete(bar, b.x, nloc, nx); b.st[0] = nloc; b.st[1] = nx; }
        const unsigned old = xb_add(&bar[XB_XSUB(b.x)], 1u);
        const unsigned gen = old / nloc;
        if (old + 1u == (gen + 1u) * nloc) {
            __builtin_amdgcn_fence(__ATOMIC_RELEASE, "agent");
            asm volatile("s_waitcnt vmcnt(0)" ::: "memory");
            const unsigned og = xb_add(&bar[XB_TOP], 1u);
            const unsigned tg = og / nx;
            if (og + 1u == (tg + 1u) * nx) xb_add(&bar[XB_TOPGEN], 1u);
            else XB_SPIN(xb_ld(&bar[XB_TOPGEN]) == tg, bar);
            __builtin_amdgcn_fence(__ATOMIC_ACQUIRE, "agent");
            xb_add(&bar[XB_XGEN(b.x)], 1u);
            asm volatile("s_waitcnt vmcnt(0)" ::: "memory");
        } else {
            XB_SPIN(xb_ld(&bar[XB_XGEN(b.x)]) == gen, bar);
            __builtin_amdgcn_fence(__ATOMIC_ACQUIRE, "agent");
            asm volatile("s_waitcnt vmcnt(0)" ::: "memory");
        }
    }
    __syncthreads();
}

namespace pg8 {
constexpr int BM = 256, BK = 64, HALF = 128, HTB = HALF * BK * 2, STAGE_BYTES = 8 * HTB, NXCD = 8, WGM = 8;
__host__ __device__ __forceinline__ int lds_byte(int r, int c) { const int st = (r >> 4) * 2 + (c >> 5), rr = r & 15, cc = c & 31, ob = rr * 64 + cc * 2; return st * 1024 + (ob ^ (((ob >> 9) & 1) << 5)); }
__host__ __device__ __forceinline__ void stage_rc(int b, int& R, int& C) { const int st = b / 1024, sb = b % 1024, swz = sb ^ (((sb >> 9) & 1) << 5); R = (st >> 1) * 16 + swz / 64; C = (st & 1) * 32 + (swz % 64) / 2; }
__host__ __device__ __forceinline__ int perm32(int rho) { const int n = rho >> 4, i = rho & 15; return 8 * (i >> 2) + 4 * n + (i & 3); }
struct Unit { int pm, pn; };
struct Gemm { const bf16_t* A; const bf16_t* Bt; int M, N, K; };
struct StaticOrder {
    int nM, nN, nwg, G, c;
    __host__ __device__ void init(int M, int N, int G_, int c_) { nM = M / BM; nN = N / BM; nwg = nM * nN; G = G_; c = c_; }
    __host__ __device__ bool next(int i, Unit& u) const {
        const long L = (long)i * G + c; if (L >= nwg) return false;
        int wgid = (int)L; { const int q = nwg / NXCD, r = nwg % NXCD, xcd = wgid % NXCD, off = wgid / NXCD; wgid = (xcd < r ? xcd * (q + 1) : r * (q + 1) + (xcd - r) * q) + off; }
        const int nig = WGM * nN, gid = wgid / nig, fm = gid * WGM, gsz = (nM - fm) < WGM ? (nM - fm) : WGM;
        u.pm = fm + ((wgid % nig) % gsz); u.pn = (wgid % nig) / gsz; return true;
    }
    __device__ __forceinline__ void a_ready(const Unit&) const {}
    __device__ __forceinline__ void done(const Unit&) const {}
};
template <class Epi, class Sched>
__device__ __forceinline__ void gemm_phase(LAS unsigned char* lds, const Gemm g, const Sched& S, const Epi& E, int wave_s) {
    const int tid_l = mytid(wave_s);
    const int tid = tid_l, wid = __builtin_amdgcn_readfirstlane(tid >> 6), lane = tid & 63, wr = wid >> 2, wc = wid & 3, fr = lane & 15, fq = lane >> 4;
    const int K = g.K, nt = K / BK;
    unsigned voffA[2], voffB[2];
#pragma unroll
    for (int i = 0; i < 2; ++i) { int R, C; stage_rc(tid * 16 + i * 8192, R, C); const int Rb = Epi::PERM ? ((R & ~31) + perm32(R & 31)) : R;
        voffA[i] = (unsigned)(R * K + C) * 2u; voffB[i] = (unsigned)(Rb * K + C) * 2u; }
    const size_t kstep = (size_t)(BK * 2);
    const size_t hstep = (size_t)HALF * K * 2;
    const size_t tstep = 2 * hstep;
    const unsigned ldsw = (unsigned)wid * 1024u;
    const int aoff = lds_byte(wr * 64 + fr, fq * 8), boff = lds_byte(wc * 32 + fr, fq * 8);
#define PG8_SA(b, h) (((b) * 2 + (h)) * HTB)
#define PG8_SB(b, h) ((4 + (b) * 2 + (h)) * HTB)
#define PG8_STAGE(bufoff, gbase, voff) do { _Pragma("unroll") for (int _i = 0; _i < 2; ++_i) \
        __builtin_amdgcn_global_load_lds((const unsigned*)((const char*)(gbase) + (voff)[_i]), (LAS unsigned*)(lds + (bufoff) + ldsw + _i * 8192), 16, 0, 0); } while (0)
#define PG8_LDA(dst, b, h) do { _Pragma("unroll") for (int m = 0; m < 4; ++m) _Pragma("unroll") for (int k = 0; k < 2; ++k) dst[m][k] = *(const LAS bf16x8*)(lds + PG8_SA(b, h) + aoff + m * 2048 + k * 1024); } while (0)
#define PG8_LDB(dst, b, h) do { _Pragma("unroll") for (int n = 0; n < 2; ++n) _Pragma("unroll") for (int k = 0; k < 2; ++k) dst[n][k] = *(const LAS bf16x8*)(lds + PG8_SB(b, h) + boff + n * 2048 + k * 1024); } while (0)
#define PG8_MMA(ai, bj, At, Bt) do { __builtin_amdgcn_s_setprio(1); _Pragma("unroll") for (int m = 0; m < 4; ++m) _Pragma("unroll") for (int n = 0; n < 2; ++n) _Pragma("unroll") for (int k = 0; k < 2; ++k) \
        acc[ai][bj][m][n] = __builtin_amdgcn_mfma_f32_16x16x32_bf16(Bt[n][k], At[m][k], acc[ai][bj][m][n], 0, 0, 0); __builtin_amdgcn_s_setprio(0); } while (0)
#define PG8_WAIT_V(n) asm volatile("s_waitcnt vmcnt(" #n ")" ::: "memory")
#define PG8_WAIT_L(n) asm volatile("s_waitcnt lgkmcnt(" #n ")" ::: "memory")
#define PG8_BAR __builtin_amdgcn_s_barrier()
#define PG8_SCHED __builtin_amdgcn_sched_barrier(0)
    Unit cur, nxt; int ui = 0;
    if (!S.next(0, cur)) return;
    cur.pm = __builtin_amdgcn_readfirstlane(cur.pm); cur.pn = __builtin_amdgcn_readfirstlane(cur.pn);
    f32x4 acc[2][2][4][2];
#pragma unroll
    for (int a = 0; a < 2; ++a)
#pragma unroll
        for (int b = 0; b < 2; ++b)
#pragma unroll
            for (int m = 0; m < 4; ++m)
#pragma unroll
                for (int n = 0; n < 2; ++n) acc[a][b][m][n] = (f32x4){0.f, 0.f, 0.f, 0.f};
    bf16x8 At[4][2], B0[2][2], B1[2][2];
    const char* cA = (const char*)g.A + (size_t)cur.pm * tstep; const char* cB = (const char*)g.Bt + (size_t)cur.pn * tstep;
    S.a_ready(cur);
    PG8_STAGE(PG8_SB(0, 0), cB, voffB); PG8_STAGE(PG8_SA(0, 0), cA, voffA); PG8_STAGE(PG8_SB(0, 1), cB + hstep, voffB); PG8_STAGE(PG8_SA(0, 1), cA + hstep, voffA);
    if (wr == 1) PG8_BAR;
    PG8_WAIT_V(4); PG8_BAR;
    PG8_STAGE(PG8_SB(1, 0), cB + kstep, voffB); PG8_STAGE(PG8_SA(1, 0), cA + kstep, voffA); PG8_STAGE(PG8_SB(1, 1), cB + hstep + kstep, voffB);
    PG8_WAIT_V(6); PG8_BAR;
    for (;;) {
        const bool has_next = S.next(ui + 1, nxt);
        nxt.pm = __builtin_amdgcn_readfirstlane(nxt.pm); nxt.pn = __builtin_amdgcn_readfirstlane(nxt.pn);
        const char* nA = has_next ? (const char*)g.A + (size_t)nxt.pm * tstep : cA; const char* nB = has_next ? (const char*)g.Bt + (size_t)nxt.pn * tstep : cB;
        for (int t = 0; t < nt; t += 2) {
            const bool last = (t == nt - 2);
            const char* a1 = cA + (size_t)(t + 1) * kstep;
            const char* a2 = last ? nA : cA + (size_t)(t + 2) * kstep; const char* b2 = last ? nB : cB + (size_t)(t + 2) * kstep;
            const char* a3 = a2 + kstep; const char* b3 = b2 + kstep;
            if (last && has_next) S.a_ready(nxt);
            PG8_LDB(B0, 0, 0); PG8_SCHED; PG8_LDA(At, 0, 0); PG8_STAGE(PG8_SA(1, 1), a1 + hstep, voffA);
            PG8_WAIT_L(8); PG8_BAR; PG8_WAIT_L(0); PG8_MMA(0, 0, At, B0); PG8_BAR; PG8_SCHED;
            PG8_LDB(B1, 0, 1); PG8_STAGE(PG8_SB(0, 0), b2, voffB);
            PG8_BAR; PG8_WAIT_L(0); PG8_MMA(0, 1, At, B1); PG8_BAR;
            PG8_LDA(At, 0, 1); PG8_STAGE(PG8_SA(0, 0), a2, voffA);
            PG8_BAR; PG8_WAIT_L(0); PG8_MMA(1, 0, At, B0); PG8_BAR; PG8_SCHED;
            PG8_STAGE(PG8_SB(0, 1), b2 + hstep, voffB);
            PG8_WAIT_V(6); PG8_BAR; PG8_MMA(1, 1, At, B1); PG8_BAR;
            PG8_LDB(B0, 1, 0); PG8_SCHED; PG8_LDA(At, 1, 0); PG8_STAGE(PG8_SA(0, 1), a2 + hstep, voffA);
            PG8_WAIT_L(8); PG8_BAR; PG8_WAIT_L(0); PG8_MMA(0, 0, At, B0); PG8_BAR; PG8_SCHED;
            PG8_LDB(B1, 1, 1); PG8_STAGE(PG8_SB(1, 0), b3, voffB);
            PG8_BAR; PG8_WAIT_L(0); PG8_MMA(0, 1, At, B1); PG8_BAR;
            PG8_LDA(At, 1, 1); PG8_STAGE(PG8_SA(1, 0), a3, voffA);
            PG8_BAR; PG8_WAIT_L(0); PG8_MMA(1, 0, At, B0); PG8_BAR; PG8_SCHED;
            PG8_STAGE(PG8_SB(1, 1), b3 + hstep, voffB);
            PG8_WAIT_V(6); PG8_BAR; PG8_MMA(1, 1, At, B1); PG8_BAR;
        }
        { const int l2 = mytid(wave_s) & 63; E(acc, cur, wr, wc, l2 & 15, l2 >> 4); } S.done(cur);
        if (!has_next) break;
#pragma unroll
        for (int a = 0; a < 2; ++a)
#pragma unroll
            for (int b = 0; b < 2; ++b)
#pragma unroll
                for (int m = 0; m < 4; ++m)
#pragma unroll
                    for (int n = 0; n < 2; ++n) acc[a][b][m][n] = (f32x4){0.f, 0.f, 0.f, 0.f};
        cur = nxt; cA = nA; cB = nB; ++ui;
    }
    PG8_WAIT_V(0);
    if (wr == 0) PG8_BAR;
    PG8_BAR;
#undef PG8_SA
#undef PG8_SB
#undef PG8_STAGE
#undef PG8_LDA
#undef PG8_LDB
#undef PG8_MMA
#undef PG8_WAIT_V
#undef PG8_WAIT_L
#undef PG8_BAR
#undef PG8_SCHED
}
}

#define GAS __attribute__((address_space(1)))
struct Args { float* out; unsigned char* ws; LAS unsigned char* ring; int wave; };
__device__ __forceinline__ unsigned char* opq(unsigned char* p) { unsigned z = 0; asm volatile("" : "+s"(z)); return p + z; }
__device__ __forceinline__ int obid() { int b = blockIdx.x; asm volatile("" : "+s"(b)); return b; }
__device__ __forceinline__ int ogrid() { int b = gridDim.x; asm volatile("" : "+s"(b)); return b; }
constexpr int ARGV_OFF = MISC_OFF + 1024;
__device__ __forceinline__ const GAS float* ldarg(const Args& A, int i) {
    volatile LAS unsigned* p = (volatile LAS unsigned*)(A.ring + ARGV_OFF) + 2 * i; unsigned lo = p[0], hi = p[1];
    lo = __builtin_amdgcn_readfirstlane(lo); hi = __builtin_amdgcn_readfirstlane(hi);
    return (const GAS float*)(((unsigned long long)hi << 32) | lo); }
enum { I_X = 0, I_MEM, I_MIXG, I_WIN, I_GUP, I_GB, I_GNG, I_WBA, I_WBB, I_WBC, I_WMIX, I_XG, I_MG, I_WXQ, I_WXKV, I_WXO, I_FG, I_WFI, I_WFO, I_FING };

typedef const f32x4 (&AccRef)[2][2][4][2];
#define EPI_ROWS_BEGIN _Pragma("unroll") for (int ai = 0; ai < 2; ++ai) _Pragma("unroll") for (int m = 0; m < 4; ++m) { \
    const int r = u.pm * 256 + ai * 128 + wr * 64 + m * 16 + fr; float a[8], b[8]; \
    _Pragma("unroll") for (int i = 0; i < 8; ++i) { a[i] = acc[ai][0][m][i >> 2][i & 3]; b[i] = acc[ai][1][m][i >> 2][i & 3]; }
#define EPI_ROWS_END asm volatile("" ::: "memory"); }

struct EpiIn {
    static constexpr bool PERM = true;
    const float* ssq; const float* cs;
    bf16_t *sbq, *sbk, *sbv, *dsq, *ixq, *dsk, *ixk, *dsv, *glq, *glk, *glv, *glo, *gates; float* small;
    __device__ __forceinline__ void operator()(AccRef acc, const pg8::Unit& u, int wr, int wc, int fr, int fq) const {
        const int pn = u.pn;
        int mode = 0, ld = 256, off0 = wc * 32, off1 = 128 + wc * 32; float sc0 = 1.0f, sc1 = 1.0f; bf16_t* O0 = sbq; bf16_t* O1 = sbq;
        if (pn == 0) { O0 = O1 = sbq; sc0 = sc1 = SBQ_SCALE; }
        else if (pn == 1) { O0 = O1 = sbk; }
        else if (pn == 2) { O0 = O1 = sbv; }
        else if (pn == 3) { O0 = O1 = dsq; mode = 1; sc0 = sc1 = DSQ_SCALE; off0 = wc * 64; off1 = wc * 64 + 32; }
        else if (pn == 4) { O0 = O1 = ixq; mode = 1; sc0 = sc1 = IXQ_SCALE; off0 = wc * 64; off1 = wc * 64 + 32; }
        else if (pn == 5) { ld = 64; off0 = 0; off1 = 32;
            if (wc == 0) { O0 = O1 = dsk; mode = 1; } else if (wc == 1) { O0 = O1 = ixk; mode = 1; } else if (wc == 2) { O0 = O1 = dsv; } else { O0 = O1 = (bf16_t*)small; mode = 4; } }
        else if (pn == 6) { O0 = glq; O1 = glk; ld = 128; off1 = wc * 32; sc0 = GLQ_SCALE; }
        else if (pn == 7) { O0 = O1 = glv; }
        else if (pn == 8) { O0 = O1 = glo; mode = 2; }
        else { O0 = O1 = gates + (pn - 9) * 256; ld = 3072; mode = 3; }
        EPI_ROWS_BEGIN
            const float rs = row_rstd(ssq, r);
#pragma unroll
            for (int i = 0; i < 8; ++i) { a[i] *= rs * sc0; b[i] *= rs * sc1; }
            if (mode == 1) {
                const f32x4* cp = (const f32x4*)(cs + ((size_t)r * 32 + fq * 8) * 2);
#pragma unroll
                for (int i2 = 0; i2 < 4; ++i2) { const f32x4 q = cp[i2];
                    const float a0 = a[2 * i2], b0 = b[2 * i2], a1 = a[2 * i2 + 1], b1 = b[2 * i2 + 1];
                    a[2 * i2] = a0 * q.x - b0 * q.y; b[2 * i2] = b0 * q.x + a0 * q.y; a[2 * i2 + 1] = a1 * q.z - b1 * q.w; b[2 * i2 + 1] = b1 * q.z + a1 * q.w; }
            } else if (mode == 2) {
#pragma unroll
                for (int i = 0; i < 8; ++i) { a[i] = a[i] * sigmoidf_(a[i]); b[i] = b[i] * sigmoidf_(b[i]); }
            } else if (mode == 3) {
#pragma unroll
                for (int i = 0; i < 8; ++i) { a[i] = sigmoidf_(a[i]); b[i] = sigmoidf_(b[i]); }
            }
            if (mode == 4) { float* p = (float*)O0 + (size_t)r * 64 + fq * 8;
                *(f32x4*)p = (f32x4){a[0], a[1], a[2], a[3]}; *(f32x4*)(p + 4) = (f32x4){a[4], a[5], a[6], a[7]};
                *(f32x4*)(p + 32) = (f32x4){b[0], b[1], b[2], b[3]}; *(f32x4*)(p + 36) = (f32x4){b[4], b[5], b[6], b[7]}; }
            else { st_bf16x8(O0 + (size_t)r * ld + off0 + fq * 8, a); st_bf16x8(O1 + (size_t)r * ld + off1 + fq * 8, b); }
        EPI_ROWS_END
    }
};
struct EpiKV {
    static constexpr bool PERM = true;
    const float* rstdm; bf16_t* km; bf16_t* vmt;
    __device__ __forceinline__ void operator()(AccRef acc, const pg8::Unit& u, int wr, int wc, int fr, int fq) const {
        const int c8 = wc * 32 + fq * 8, pn = u.pn;
        EPI_ROWS_BEGIN
            const float rs = rstdm[r];
#pragma unroll
            for (int i = 0; i < 8; ++i) { a[i] *= rs; b[i] *= rs; }
            if (pn < 4) { st_bf16x8(km + (size_t)r * 1024 + pn * 256 + c8, a); st_bf16x8(km + (size_t)r * 1024 + pn * 256 + 128 + c8, b); }
            else {
                const int pos = (r & ~31) + 8 * ((r >> 2) & 3) + 4 * ((r >> 4) & 1) + (r & 3);
                const int d0 = (pn - 4) * 256 + c8;
#pragma unroll
                for (int i = 0; i < 8; ++i) { vmt[(size_t)(d0 + i) * 256 + pos] = f2bf(a[i]); vmt[(size_t)(d0 + 128 + i) * 256 + pos] = f2bf(b[i]); }
            }
        EPI_ROWS_END
    }
};
template <int BR> struct EpiMerge {
    static constexpr bool PERM = true;
    const bf16_t* gates; bf16_t* merged;
    __device__ __forceinline__ void operator()(AccRef acc, const pg8::Unit& u, int wr, int wc, int fr, int fq) const {
        const int c8 = wc * 32 + fq * 8;
        EPI_ROWS_BEGIN
            const int c = u.pn * 256 + c8;
            const bf16_t* gp = gates + (size_t)r * 3072 + BR * 1024 + c; bf16_t* mp = merged + (size_t)r * 1024 + c;
            { float g0[8]; ld_bf16x8(gp, g0);
              if (BR > 0) { float m0[8]; ld_bf16x8(mp, m0);
#pragma unroll
                  for (int i = 0; i < 8; ++i) a[i] = m0[i] + g0[i] * a[i]; }
              else {
#pragma unroll
                  for (int i = 0; i < 8; ++i) a[i] = g0[i] * a[i]; }
              st_bf16x8(mp, a); }
            asm volatile("" ::: "memory");
            { float g1[8]; ld_bf16x8(gp + 128, g1);
              if (BR > 0) { float m1[8]; ld_bf16x8(mp + 128, m1);
#pragma unroll
                  for (int i = 0; i < 8; ++i) b[i] = m1[i] + g1[i] * b[i]; }
              else {
#pragma unroll
                  for (int i = 0; i < 8; ++i) b[i] = g1[i] * b[i]; }
              st_bf16x8(mp + 128, b); }
        EPI_ROWS_END
    }
};
struct EpiRes {
    static constexpr bool PERM = true;
    float* x; bf16_t* xb; float* ssq;
    __device__ __forceinline__ void operator()(AccRef acc, const pg8::Unit& u, int wr, int wc, int fr, int fq) const {
        const int c8 = wc * 32 + fq * 8;
        EPI_ROWS_BEGIN
            float* xp = x + (size_t)r * 1024 + u.pn * 256 + c8;
            const f32x4 x0 = *(const f32x4*)xp, x1 = *(const f32x4*)(xp + 4), x2 = *(const f32x4*)(xp + 128), x3 = *(const f32x4*)(xp + 132);
            a[0] += x0.x; a[1] += x0.y; a[2] += x0.z; a[3] += x0.w; a[4] += x1.x; a[5] += x1.y; a[6] += x1.z; a[7] += x1.w;
            b[0] += x2.x; b[1] += x2.y; b[2] += x2.z; b[3] += x2.w; b[4] += x3.x; b[5] += x3.y; b[6] += x3.z; b[7] += x3.w;
            *(f32x4*)xp = (f32x4){a[0], a[1], a[2], a[3]}; *(f32x4*)(xp + 4) = (f32x4){a[4], a[5], a[6], a[7]};
            *(f32x4*)(xp + 128) = (f32x4){b[0], b[1], b[2], b[3]}; *(f32x4*)(xp + 132) = (f32x4){b[4], b[5], b[6], b[7]};
            bf16_t* bp = xb + (size_t)r * 1024 + u.pn * 256 + c8; st_bf16x8(bp, a); st_bf16x8(bp + 128, b);
            float sq = 0.f;
#pragma unroll
            for (int i = 0; i < 8; ++i) sq += a[i] * a[i] + b[i] * b[i];
            sq += shx(sq, 16, fq * 16 + fr); sq += shx(sq, 32, fq * 16 + fr);
            if (fq == 0) ssq[(size_t)r * 16 + u.pn * 4 + wc] = sq;
        EPI_ROWS_END
    }
};
struct EpiXq {
    static constexpr bool PERM = true;
    const float* ssq; bf16_t* xq;
    __device__ __forceinline__ void operator()(AccRef acc, const pg8::Unit& u, int wr, int wc, int fr, int fq) const {
        const int c8 = wc * 32 + fq * 8;
        EPI_ROWS_BEGIN
            const float rs = row_rstd(ssq, r) * XQ_SCALE;
#pragma unroll
            for (int i = 0; i < 8; ++i) { a[i] *= rs; b[i] *= rs; }
            bf16_t* O = xq + (size_t)r * 1024 + u.pn * 256 + c8; st_bf16x8(O, a); st_bf16x8(O + 128, b);
        EPI_ROWS_END
    }
};
struct EpiFfnIn {
    static constexpr bool PERM = true;
    const float* ssq; bf16_t* hid;
    __device__ __forceinline__ void operator()(AccRef acc, const pg8::Unit& u, int wr, int wc, int fr, int fq) const {
        const int c8 = wc * 32 + fq * 8;
        EPI_ROWS_BEGIN
            const float rs = row_rstd(ssq, r);
#pragma unroll
            for (int i = 0; i < 8; ++i) { const float g = a[i] * rs, up = b[i] * rs; a[i] = g * sigmoidf_(g) * up; }
            st_bf16x8(hid + (size_t)r * DFF + u.pn * 128 + c8, a);
        EPI_ROWS_END
    }
};

__device__ __forceinline__ int nlog_win(int n) {
    const int t = n >> 8, p = n & 255;
    if (t < 3) return n;
    if (t == 3 || t == 4) { const int bj = p >> 7, hh = (p & 127) >> 5, dd = p & 31; return (t == 3 ? 768 : 1152) + 64 * hh + 32 * bj + dd; }
    if (t == 5) { const int bj = p >> 7, g = (p & 127) >> 5, dd = p & 31, j = 32 * bj + dd;
        if (g == 0) return 1024 + j; if (g == 1) return 1408 + j; if (g == 2) return 1088 + j;
        if (j < 4) return 1472 + j; if (j < 20) return 1988 + (j - 4); return -1; }
    if (t == 6) return (p < 128) ? 1476 + p : 1604 + (p - 128);
    if (t == 7) return 1732 + p;
    if (t == 8) return 2004 + p;
    return 2260 + (t - 9) * 256 + p;
}
__device__ __forceinline__ int nlog_ffn(int n) { const int j = n >> 8, p = n & 255; return (p >> 7) * DFF + 128 * j + (p & 127); }
__device__ __forceinline__ void conv_tile(LAS unsigned char* lds, const GAS float* W, int ldw, int K, int map, const GAS float* gain, bf16_t* Bt, int kt, int ntile, int tid) {
    LAS float* tile = (LAS float*)lds;
    const int k0 = kt * 64, n0 = ntile * 64;
    { const int nn = tid & 63, kq = tid >> 6; const int n = n0 + nn; const int nl = map == 0 ? n : (map == 1 ? nlog_win(n) : nlog_ffn(n));
#pragma unroll
      for (int i = 0; i < 8; ++i) { const int kk = kq + 8 * i; float v = 0.f; if (nl >= 0) { v = W[(size_t)(k0 + kk) * ldw + nl]; if (gain) v *= gain[k0 + kk]; } tile[kk * 65 + nn] = v; } }
    __syncthreads();
    { const int nn = tid >> 3, kg = tid & 7; float v[8];
#pragma unroll
      for (int i = 0; i < 8; ++i) v[i] = tile[(8 * kg + i) * 65 + nn];
      st_bf16x8(Bt + (size_t)(n0 + nn) * K + k0 + 8 * kg, v); }
    __syncthreads();
}
__device__ __forceinline__ void conv_layer(LAS unsigned char* lds, const Args& A, int l) {
    unsigned char* ws = opq(A.ws);
    const int bid = obid(), Gl = ogrid(), tid = mytid(A.wave);
    for (int t = bid; t < 4928; t += Gl) {
        int tt = t; const GAS float* W; const GAS float* gain = nullptr; bf16_t* Bt; int ldw, K, map = 0, kt, ntile;
        if (tt < 1344) { W = ldarg(A, I_WIN) + (size_t)l * 1024 * INW; ldw = INW; K = 1024; map = 1; gain = ldarg(A, I_MIXG) + l * 1024; Bt = (bf16_t*)(ws + WS_WIN); kt = tt & 15; ntile = tt >> 4; }
        else if ((tt -= 1344) < 192) { const int b = tt >> 6, q = tt & 63; const GAS float* w0 = ldarg(A, I_WBA); const GAS float* w1 = ldarg(A, I_WBB); const GAS float* w2 = ldarg(A, I_WBC); W = (b == 0 ? w0 : (b == 1 ? w1 : w2)) + (size_t)l * 256 * 1024; ldw = 1024; K = 256; Bt = (bf16_t*)(ws + WS_WBR) + (size_t)b * 262144; kt = q & 3; ntile = q >> 2; }
        else if ((tt -= 192) < 256) { W = ldarg(A, I_WMIX) + (size_t)l * 1048576; ldw = 1024; K = 1024; Bt = (bf16_t*)(ws + WS_WMIX); kt = tt & 15; ntile = tt >> 4; }
        else if ((tt -= 256) < 256) { W = ldarg(A, I_WXQ) + (size_t)l * 1048576; ldw = 1024; K = 1024; gain = ldarg(A, I_XG) + l * 1024; Bt = (bf16_t*)(ws + WS_WXQ); kt = tt & 15; ntile = tt >> 4; }
        else if ((tt -= 256) < 512) { W = ldarg(A, I_WXKV) + (size_t)l * 2097152; ldw = 2048; K = 1024; gain = ldarg(A, I_MG) + l * 1024; Bt = (bf16_t*)(ws + WS_WXKV); kt = tt & 15; ntile = tt >> 4; }
        else if ((tt -= 512) < 256) { W = ldarg(A, I_WXO) + (size_t)l * 1048576; ldw = 1024; K = 1024; Bt = (bf16_t*)(ws + WS_WXO); kt = tt & 15; ntile = tt >> 4; }
        else if ((tt -= 256) < 1408) { W = ldarg(A, I_WFI) + (size_t)l * 1024 * NFF; ldw = NFF; K = 1024; map = 2; gain = ldarg(A, I_FG) + l * 1024; Bt = (bf16_t*)(ws + WS_WFI); kt = tt & 15; ntile = tt >> 4; }
        else { tt -= 1408; W = ldarg(A, I_WFO) + (size_t)l * DFF * 1024; ldw = 1024; K = DFF; Bt = (bf16_t*)(ws + WS_WFO); kt = tt % 44; ntile = tt / 44; }
        conv_tile(lds, W, ldw, K, map, gain, Bt, kt, ntile, tid);
    }
}

__constant__ float c_inv_freq[32] = {1.000000000e+00f, 7.498942018e-01f, 5.623413324e-01f, 4.216965139e-01f, 3.162277639e-01f, 2.371373922e-01f, 1.778279394e-01f, 1.333521456e-01f,
    1.000000015e-01f, 7.498941571e-02f, 5.623412877e-02f, 4.216964915e-02f, 3.162277862e-02f, 2.371373586e-02f, 1.778279431e-02f, 1.333521493e-02f,
    9.999999776e-03f, 7.498942316e-03f, 5.623413250e-03f, 4.216964822e-03f, 3.162277862e-03f, 2.371373819e-03f, 1.778279431e-03f, 1.333521446e-03f,
    1.000000047e-03f, 7.498941850e-04f, 5.623413017e-04f, 4.216965463e-04f, 3.162277862e-04f, 2.371373848e-04f, 1.778279402e-04f, 1.333521504e-04f};
__device__ __forceinline__ void prologue(LAS unsigned char* lds, const Args& A) {
    unsigned char* ws = opq(A.ws); const int tid = mytid(A.wave), lane = tid & 63, wave = tid >> 6; const int bid = obid(), Gl = ogrid();
    { const GAS float* x = ldarg(A, I_X); float* out = A.out; bf16_t* xb = (bf16_t*)(ws + WS_XB); float* ssq = (float*)(ws + WS_SSQ);
      for (int r = bid * 8 + wave; r < S_; r += Gl * 8) {
          const GAS float* xr = x + (size_t)r * 1024 + lane * 16; float v[16]; float sq = 0.f;
#pragma unroll
          for (int i = 0; i < 4; ++i) { const f32x4 q = *(const GAS f32x4*)(xr + 4 * i); v[4 * i] = q.x; v[4 * i + 1] = q.y; v[4 * i + 2] = q.z; v[4 * i + 3] = q.w; }
#pragma unroll
          for (int i = 0; i < 16; ++i) sq += v[i] * v[i];
          sq = wave_sum(sq, lane);
          float* orow = out + (size_t)r * 1024 + lane * 16;
#pragma unroll
          for (int i = 0; i < 4; ++i) *(f32x4*)(orow + 4 * i) = (f32x4){v[4 * i], v[4 * i + 1], v[4 * i + 2], v[4 * i + 3]};
          float v0[8], v1[8];
#pragma unroll
          for (int i = 0; i < 8; ++i) { v0[i] = v[i]; v1[i] = v[8 + i]; }
          st_bf16x8(xb + (size_t)r * 1024 + lane * 16, v0); st_bf16x8(xb + (size_t)r * 1024 + lane * 16 + 8, v1);
          if (lane < 16) ssq[(size_t)r * 16 + lane] = lane == 0 ? sq : 0.f;
      } }
    { const GAS float* mem = ldarg(A, I_MEM); bf16_t* memb = (bf16_t*)(ws + WS_MEMB); float* rstdm = (float*)(ws + WS_RSTDM);
      for (int r = bid * 8 + wave; r < NMEM; r += Gl * 8) {
          const GAS float* xr = mem + (size_t)r * 1024 + lane * 16; float v0[8], v1[8]; float sq = 0.f;
#pragma unroll
          for (int i = 0; i < 8; ++i) { v0[i] = xr[i]; v1[i] = xr[8 + i]; sq += v0[i] * v0[i] + v1[i] * v1[i]; }
          sq = wave_sum(sq, lane);
          st_bf16x8(memb + (size_t)r * 1024 + lane * 16, v0); st_bf16x8(memb + (size_t)r * 1024 + lane * 16 + 8, v1);
          if (lane == 0) rstdm[r] = rsqrtf(sq * (1.0f / 1024.0f) + EPS);
      } }
    { float* cs = (float*)(ws + WS_CS);
      for (int i = bid * NTHREADS + tid; i < S_ * 32; i += Gl * NTHREADS) {
          const int pos = i >> 5, dd = i & 31; const float angf = (float)pos * c_inv_freq[dd]; const double a = (double)angf;
          const double kk = rint(a * 0.63661977236758134); double rr = fma(-kk, 1.5707963267948966, a); rr = fma(-kk, 6.123233995736766e-17, rr);
          const double r2 = rr * rr;
          const double sn = rr * (1.0 + r2 * (-1.0 / 6 + r2 * (1.0 / 120 + r2 * (-1.0 / 5040 + r2 * (1.0 / 362880 + r2 * (-1.0 / 39916800 + r2 * (1.0 / 6227020800.0)))))));
          const double cn = 1.0 + r2 * (-0.5 + r2 * (1.0 / 24 + r2 * (-1.0 / 720 + r2 * (1.0 / 40320 + r2 * (-1.0 / 3628800 + r2 * (1.0 / 479001600.0))))));
          const int q = ((int)kk) & 3; double c, s;
          if (q == 0) { c = cn; s = sn; } else if (q == 1) { c = -sn; s = cn; } else if (q == 2) { c = -cn; s = -sn; } else { c = sn; s = -cn; }
          cs[2 * i] = (float)c; cs[2 * i + 1] = (float)s;
      } }
}

__device__ __forceinline__ void sb_unit(LAS unsigned char* lds, const Args& A, int u) {
    unsigned char* ws = opq(A.ws); const int tid_l = mytid(A.wave); const int tid = tid_l, lane = tid & 63, wave = __builtin_amdgcn_readfirstlane(tid >> 6);
    const bf16_t* Q = (const bf16_t*)(ws + WS_SBQ); const bf16_t* Kp = (const bf16_t*)(ws + WS_SBK); const bf16_t* Vp = (const bf16_t*)(ws + WS_SBV); bf16_t* O = (bf16_t*)(ws + WS_OA);
    LAS float* kf = (LAS float*)lds; LAS float* vf = (LAS float*)(lds + 65536); volatile LAS int* flags = (volatile LAS int*)(lds + MISC_OFF + 64);
    const int h = wave & 3, sub = wave >> 2, q0 = u * 128, t = q0 + 64 * sub + lane;
    float q[64], acc[64];
#pragma unroll
    for (int i = 0; i < 8; ++i) { float v[8]; ld_bf16x8(Q + (size_t)t * 256 + 64 * h + 8 * i, v);
#pragma unroll
        for (int j = 0; j < 8; ++j) q[8 * i + j] = v[j]; }
#pragma unroll
    for (int i = 0; i < 64; ++i) acc[i] = 0.f;
    float runp = 1.0f; bool wdone = false;
    for (int tile = (q0 + 127) >> 6; tile >= 0; --tile) {
#pragma unroll
        for (int i = 0; i < 4; ++i) { const int idx = tid + 512 * i, row = idx >> 5, c8 = (idx & 31) * 8; float v[8];
            ld_bf16x8(Kp + (size_t)(64 * tile + row) * 256 + c8, v);
            *(LAS f32x4*)(kf + row * 256 + c8) = (f32x4){v[0], v[1], v[2], v[3]}; *(LAS f32x4*)(kf + row * 256 + c8 + 4) = (f32x4){v[4], v[5], v[6], v[7]};
            ld_bf16x8(Vp + (size_t)(64 * tile + row) * 256 + c8, v);
            *(LAS f32x4*)(vf + row * 256 + c8) = (f32x4){v[0], v[1], v[2], v[3]}; *(LAS f32x4*)(vf + row * 256 + c8 + 4) = (f32x4){v[4], v[5], v[6], v[7]}; }
        __syncthreads();
        if (!wdone) {
            const int tmax = q0 + 64 * sub + 63;
            for (int j = 63; j >= 0; --j) {
                const int s = 64 * tile + j;
                if (s >= tmax) continue;
                const LAS float* kr = kf + j * 256 + 64 * h; const LAS float* vr = vf + j * 256 + 64 * h;
                float z0 = 0.f, z1 = 0.f, z2 = 0.f, z3 = 0.f;
#pragma unroll
                for (int d = 0; d < 16; ++d) { const f32x4 kk = *(const LAS f32x4*)(kr + 4 * d); z0 += q[4 * d] * kk.x; z1 += q[4 * d + 1] * kk.y; z2 += q[4 * d + 2] * kk.z; z3 += q[4 * d + 3] * kk.w; }
                float z = (z0 + z1) + (z2 + z3);
                z = fminf(z, 120.0f);
                const float e = __builtin_amdgcn_exp2f(z), rk = __builtin_amdgcn_rcpf(1.0f + e), beta = e * rk;
                const bool valid = s < t;
                const float w = valid ? beta * runp : 0.f;
                runp = valid ? runp * rk : runp;
#pragma unroll
                for (int d = 0; d < 16; ++d) { const f32x4 vv = *(const LAS f32x4*)(vr + 4 * d); acc[4 * d] += w * vv.x; acc[4 * d + 1] += w * vv.y; acc[4 * d + 2] += w * vv.z; acc[4 * d + 3] += w * vv.w; }
            }
            wdone = __all(runp == 0.f) != 0;
        }
        if (lane == 0) flags[wave] = wdone ? 1 : 0;
        __syncthreads();
        int alld = 1;
#pragma unroll
        for (int i = 0; i < 8; ++i) alld &= flags[i];
        if (alld) break;
    }
#pragma unroll
    for (int i = 0; i < 8; ++i) { float v[8];
#pragma unroll
        for (int j = 0; j < 8; ++j) v[j] = acc[8 * i + j];
        st_bf16x8(O + (size_t)t * 256 + 64 * h + 8 * i, v); }
    __syncthreads();
}

__device__ __forceinline__ void gla1_unit(LAS unsigned char* lds, const Args& A, int l, int c) {
    unsigned char* ws = opq(A.ws); const int tid_l = mytid(A.wave); const int tid = tid_l;
    const float* small = (const float*)(ws + WS_SMALL); const bf16_t* GK = (const bf16_t*)(ws + WS_GLK); const bf16_t* GV = (const bf16_t*)(ws + WS_GLV);
    float* BC = (float*)(ws + WS_BC); float* UC = (float*)(ws + WS_UC); float* AC = (float*)(ws + WS_AC);
    const GAS float* wup = ldarg(A, I_GUP) + l * 16 * 128; const GAS float* gb = ldarg(A, I_GB) + l * 128;
    LAS float* la = (LAS float*)lds;
    LAS float* kh = (LAS float*)(lds + 32768);
    LAS float* vv = (LAS float*)(lds + 65536);
    const int row0 = c * 64;
    { const int t = tid >> 3, jg = tid & 7; float g[16];
#pragma unroll
      for (int i = 0; i < 4; ++i) { const f32x4 q = *(const f32x4*)(small + (size_t)(row0 + t) * 64 + 4 + 4 * i); g[4 * i] = q.x; g[4 * i + 1] = q.y; g[4 * i + 2] = q.z; g[4 * i + 3] = q.w; }
      for (int jj = 0; jj < 16; ++jj) { const int j = 16 * jg + jj; float x = gb[j];
#pragma unroll
          for (int r = 0; r < 16; ++r) x += g[r] * wup[r * 128 + j];
          const float ls = fminf(x, 0.f) - log1pf(expf(-fabsf(x)));
          la[t * 128 + j] = ls * (1.0f / 16.0f); } }
    for (int i = tid; i < 64 * 32; i += NTHREADS) { const int t = i >> 5, c8 = (i & 31) * 8; float v[8]; ld_bf16x8(GV + (size_t)(row0 + t) * 256 + c8, v);
#pragma unroll
        for (int j = 0; j < 8; ++j) vv[t * 256 + c8 + j] = v[j]; }
    __syncthreads();
    if (tid < 128) { float run = 0.f; for (int t = 0; t < 64; ++t) { run += la[t * 128 + tid]; la[t * 128 + tid] = run; BC[(size_t)(row0 + t) * 128 + tid] = run; } AC[c * 128 + tid] = expf(run); }
    __syncthreads();
    for (int i = tid; i < 64 * 128; i += NTHREADS) { const int t = i >> 7, j = i & 127; kh[i] = bf2f(GK[(size_t)(row0 + t) * 128 + j]) * expf(la[63 * 128 + j] - la[i]); }
    __syncthreads();
    { const int hd = tid >> 2, eg = tid & 3, hh = hd >> 5; float a[16];
#pragma unroll
      for (int i = 0; i < 16; ++i) a[i] = 0.f;
      for (int t = 0; t < 64; ++t) { const float kk = kh[t * 128 + hd]; const LAS float* vp = vv + t * 256 + 64 * hh + 16 * eg;
#pragma unroll
          for (int i = 0; i < 16; ++i) a[i] += kk * vp[i]; }
      float* up = UC + (size_t)c * 8192 + hd * 64 + 16 * eg;
#pragma unroll
      for (int i = 0; i < 4; ++i) *(f32x4*)(up + 4 * i) = (f32x4){a[4 * i], a[4 * i + 1], a[4 * i + 2], a[4 * i + 3]}; }
    __syncthreads();
}
__device__ __forceinline__ void gla2_phase(const Args& A) {
    unsigned char* ws = opq(A.ws); const float* UC = (const float*)(ws + WS_UC); const float* AC = (const float*)(ws + WS_AC); float* ST = (float*)(ws + WS_ST);
    const int tid_l = mytid(A.wave); const int gid = obid() * NTHREADS + tid_l; if (gid >= 8192) return;
    const int hd = gid >> 6; float st = 0.f;
    for (int c0 = 0; c0 < 256; c0 += 8) { float uu[8], aa[8];
#pragma unroll
        for (int i = 0; i < 8; ++i) { uu[i] = UC[(size_t)(c0 + i) * 8192 + gid]; aa[i] = AC[(c0 + i) * 128 + hd]; }
#pragma unroll
        for (int i = 0; i < 8; ++i) { ST[(size_t)(c0 + i) * 8192 + gid] = st; st = aa[i] * st + uu[i]; } }
}
__device__ __forceinline__ void gla3_unit(LAS unsigned char* lds, const Args& A, int l, int c) {
    unsigned char* ws = opq(A.ws); const int tid_l = mytid(A.wave); const int tid = tid_l;
    const bf16_t* GQ = (const bf16_t*)(ws + WS_GLQ); const bf16_t* GK = (const bf16_t*)(ws + WS_GLK); const bf16_t* GV = (const bf16_t*)(ws + WS_GLV); const bf16_t* GO = (const bf16_t*)(ws + WS_GLO);
    const float* BC = (const float*)(ws + WS_BC); const float* ST = (const float*)(ws + WS_ST) + (size_t)c * 8192; bf16_t* OC = (bf16_t*)(ws + WS_OC);
    const GAS float* gn = ldarg(A, I_GNG) + l * 64;
    constexpr int QS = 132;
    LAS float* qt = (LAS float*)lds;
    LAS float* kt = (LAS float*)(lds + 33792);
    LAS float* am = (LAS float*)(lds + 67584);
    const int row0 = c * 64;
    for (int i = tid; i < 64 * 128; i += NTHREADS) { const int t = i >> 7, j = i & 127; const float b = BC[(size_t)(row0 + t) * 128 + j];
        qt[t * QS + j] = bf2f(GQ[(size_t)(row0 + t) * 128 + j]) * expf(b); kt[t * QS + j] = bf2f(GK[(size_t)(row0 + t) * 128 + j]) * expf(-b); }
    __syncthreads();
    for (int i = tid; i < 4 * 64 * 64; i += NTHREADS) { const int j = i & 63, t = (i >> 6) & 63, hh = i >> 12; float s = 0.f;
        if (j <= t) { const LAS float* qp = qt + t * QS + 32 * hh; const LAS float* kp = kt + j * QS + 32 * hh;
#pragma unroll
            for (int d = 0; d < 32; ++d) s += qp[d] * kp[d]; }
        am[i] = s; }
    __syncthreads();
    for (int rep = 0; rep < 2; ++rep) { const int idx = tid + NTHREADS * rep, eg = idx & 3, t = (idx >> 2) & 63, hh = idx >> 8; float o[16];
#pragma unroll
        for (int i = 0; i < 16; ++i) o[i] = 0.f;
        const LAS float* ap = am + (hh * 64 + t) * 64;
        for (int j = 0; j <= t; ++j) { const float aw = ap[j]; float v0[8], v1[8]; const bf16_t* vp = GV + (size_t)(row0 + j) * 256 + 64 * hh + 16 * eg; ld_bf16x8(vp, v0); ld_bf16x8(vp + 8, v1);
#pragma unroll
            for (int i = 0; i < 8; ++i) { o[i] += aw * v0[i]; o[8 + i] += aw * v1[i]; } }
        for (int d = 0; d < 32; ++d) { const float qw = qt[t * QS + 32 * hh + d]; const float* sp = ST + (32 * hh + d) * 64 + 16 * eg;
#pragma unroll
            for (int i = 0; i < 4; ++i) { const f32x4 s4 = *(const f32x4*)(sp + 4 * i); o[4 * i] += qw * s4.x; o[4 * i + 1] += qw * s4.y; o[4 * i + 2] += qw * s4.z; o[4 * i + 3] += qw * s4.w; } }
        float sq = 0.f;
#pragma unroll
        for (int i = 0; i < 16; ++i) sq += o[i] * o[i];
        sq += shx(sq, 1, tid & 63); sq += shx(sq, 2, tid & 63);
        const float rs = rsqrtf(sq * (1.0f / 64.0f) + EPS);
        float g0[8], g1[8]; const bf16_t* gp = GO + (size_t)(row0 + t) * 256 + 64 * hh + 16 * eg; ld_bf16x8(gp, g0); ld_bf16x8(gp + 8, g1);
        float r0[8], r1[8];
#pragma unroll
        for (int i = 0; i < 8; ++i) { r0[i] = o[i] * rs * gn[16 * eg + i] * g0[i]; r1[i] = o[8 + i] * rs * gn[16 * eg + 8 + i] * g1[i]; }
        bf16_t* op = OC + (size_t)(row0 + t) * 256 + 64 * hh + 16 * eg; st_bf16x8(op, r0); st_bf16x8(op + 8, r1); }
    __syncthreads();
}

constexpr int DS_CAND = 384;
constexpr int DS_OFF_CK = 0;
constexpr int DS_OFF_CU = 24576;
constexpr int DS_OFF_SEL = 73728;
constexpr int DS_OFF_P = 98304;
constexpr int DS_OFF_Q = 131072;
constexpr int DS_OFF_CTL = MISC_OFF + 128;
__device__ __forceinline__ int ds_bin(float sc, unsigned& mono) {
    const unsigned ub = __float_as_uint(sc + 0.0f); const unsigned mag = ub & 0x7fffffffu; const int e = (int)(mag >> 19) - 1648;
    mono = (ub & 0x80000000u) ? ~ub : (ub | 0x80000000u);
    if (ub & 0x80000000u) { const int ee = e < 0 ? 0 : (e > 511 ? 511 : e); return 511 - ee; }
    if (mag == 0u) return 512;
    const int ee = e < 0 ? 0 : (e > 509 ? 509 : e); return 513 + ee;
}
__device__ __forceinline__ void ds_compact(LAS unsigned char* lds, int qq, int need, int lane) {
    volatile LAS unsigned short* ck = (volatile LAS unsigned short*)(lds + DS_OFF_CK) + qq * DS_CAND; volatile LAS unsigned* cu = (volatile LAS unsigned*)(lds + DS_OFF_CU) + qq * DS_CAND;
    volatile LAS int* ctl = (volatile LAS int*)(lds + DS_OFF_CTL);
    const int n = ctl[32 + qq];
    if (n <= need) return;
    unsigned mu[6], mk[6]; int rank[6];
#pragma unroll
    for (int ii = 0; ii < 6; ++ii) { const int i = lane + 64 * ii; mu[ii] = i < n ? cu[i] : 0u; mk[ii] = i < n ? (unsigned)ck[i] : 0xffffffffu; rank[ii] = 0; }
    for (int j = 0; j < n; ++j) { const unsigned uj = cu[j], kj = ck[j];
#pragma unroll
        for (int ii = 0; ii < 6; ++ii) rank[ii] += (uj > mu[ii] || (uj == mu[ii] && kj < mk[ii])) ? 1 : 0; }
    __builtin_amdgcn_s_waitcnt(0);
    int base = 0;
#pragma unroll
    for (int ii = 0; ii < 6; ++ii) { const int i = lane + 64 * ii; const bool keep = i < n && rank[ii] < need;
        const unsigned long long mask = __ballot(keep); const int pos = base + __popcll(mask & ((1ull << lane) - 1ull));
        if (keep) { ck[pos] = (unsigned short)mk[ii]; cu[pos] = mu[ii]; if (rank[ii] == need - 1) { ctl[128 + qq] = (int)mu[ii]; ctl[160 + qq] = (int)mk[ii]; } }
        base += __popcll(mask); }
    if (lane == 0) ctl[32 + qq] = need;
}
__device__ __forceinline__ void dsa_unit(LAS unsigned char* lds, const Args& A, int u) {
    unsigned char* ws = opq(A.ws); const int tid_l = mytid(A.wave); const int tid = tid_l, lane = tid & 63, wave = __builtin_amdgcn_readfirstlane(tid >> 6);
    const bf16_t* IQ = (const bf16_t*)(ws + WS_IXQ); const bf16_t* IK = (const bf16_t*)(ws + WS_IXK); const float* small = (const float*)(ws + WS_SMALL);
    const bf16_t* DQ = (const bf16_t*)(ws + WS_DSQ); const bf16_t* DK = (const bf16_t*)(ws + WS_DSK); const bf16_t* DV = (const bf16_t*)(ws + WS_DSV); bf16_t* OB = (bf16_t*)(ws + WS_OB);
    const int q0 = u * 32, N = ((q0 >> 6) + 1) * 64;
    volatile LAS unsigned* hist = (volatile LAS unsigned*)lds;
    volatile LAS unsigned short* sel = (volatile LAS unsigned short*)(lds + DS_OFF_SEL);
    volatile LAS unsigned short* ck = (volatile LAS unsigned short*)(lds + DS_OFF_CK); volatile LAS unsigned* cu = (volatile LAS unsigned*)(lds + DS_OFF_CU);
    volatile LAS int* ctl = (volatile LAS int*)(lds + DS_OFF_CTL);
    const int fr = lane & 15, fq = lane >> 4;
    if (N <= 256) {
        for (int i = tid; i < 32 * 256; i += NTHREADS) sel[i] = (unsigned short)(i & 255);
        __syncthreads();
    } else {
        bf16x8 qf[2][4][2]; float wq[2][4];
#pragma unroll
        for (int g = 0; g < 2; ++g)
#pragma unroll
            for (int h = 0; h < 4; ++h) { wq[g][h] = small[(size_t)(q0 + 16 * g + fr) * 64 + h] * 0.5f;
#pragma unroll
                for (int s = 0; s < 2; ++s) qf[g][h][s] = *(const bf16x8*)(IQ + (size_t)(q0 + 16 * g + fr) * 256 + 64 * h + 32 * s + 8 * fq); }
        const int ntiles = (N + 127) >> 7;
        for (int pass = 0; pass < 2; ++pass) {
            if (pass == 0) { for (int i = tid; i < 32 * 512; i += NTHREADS) hist[i] = 0u; }
            else { if (tid < 32) { ctl[tid] = 0; ctl[32 + tid] = 0; ctl[128 + tid] = 0; ctl[160 + tid] = -1; } }
            __syncthreads();
            int b1r[2] = {0, 0};
            if (pass == 1) { b1r[0] = ctl[64 + fr]; b1r[1] = ctl[64 + 16 + fr]; }
            for (int tile = 0; tile < ntiles; ++tile) {
                const int kb = tile * 128 + 16 * wave;
                if (kb < N) {
                    const int krow = kb + fr;
                    const bf16x8 kf0 = *(const bf16x8*)(IK + (size_t)krow * 64 + 8 * fq), kf1 = *(const bf16x8*)(IK + (size_t)krow * 64 + 32 + 8 * fq);
#pragma unroll
                    for (int g = 0; g < 2; ++g) {
                        float sc[4] = {0.f, 0.f, 0.f, 0.f};
#pragma unroll
                        for (int h = 0; h < 4; ++h) { f32x4 c4 = (f32x4){0.f, 0.f, 0.f, 0.f};
                            c4 = __builtin_amdgcn_mfma_f32_16x16x32_bf16(kf0, qf[g][h][0], c4, 0, 0, 0);
                            c4 = __builtin_amdgcn_mfma_f32_16x16x32_bf16(kf1, qf[g][h][1], c4, 0, 0, 0);
                            sc[0] += wq[g][h] * fmaxf(c4.x, 0.f); sc[1] += wq[g][h] * fmaxf(c4.y, 0.f); sc[2] += wq[g][h] * fmaxf(c4.z, 0.f); sc[3] += wq[g][h] * fmaxf(c4.w, 0.f); }
                        const int qq = 16 * g + fr;
#pragma unroll
                        for (int r = 0; r < 4; ++r) { const int key = kb + 4 * fq + r; unsigned mono; const int bin = ds_bin(sc[r], mono);
                            if (pass == 0) { __hip_atomic_fetch_add((LAS unsigned*)&hist[qq * 512 + (bin >> 1)], 1u << ((bin & 1) * 16), __ATOMIC_RELAXED, __HIP_MEMORY_SCOPE_WORKGROUP); }
                            else {
                                if (bin > b1r[g]) { const int slot = __hip_atomic_fetch_add((LAS int*)&ctl[qq], 1, __ATOMIC_RELAXED, __HIP_MEMORY_SCOPE_WORKGROUP); sel[qq * 256 + slot] = (unsigned short)key; }
                                else if (bin == b1r[g]) { const unsigned tu = (unsigned)ctl[128 + qq], tk = (unsigned)ctl[160 + qq];
                                    if (mono > tu || (mono == tu && (unsigned)key < tk)) { const int slot = __hip_atomic_fetch_add((LAS int*)&ctl[32 + qq], 1, __ATOMIC_RELAXED, __HIP_MEMORY_SCOPE_WORKGROUP); ck[qq * DS_CAND + slot] = (unsigned short)key; cu[qq * DS_CAND + slot] = mono; } }
                            } }
                    }
                }
                if (pass == 1) { __syncthreads();
                    for (int k = 0; k < 4; ++k) { const int qq = 4 * wave + k; if (ctl[32 + qq] > 256) ds_compact(lds, qq, ctl[96 + qq], lane); }
                    __syncthreads(); }
            }
            __syncthreads();
            if (pass == 0) {
                for (int k = 0; k < 4; ++k) { const int qq = 4 * wave + k; unsigned cnt[16]; unsigned s = 0;
#pragma unroll
                    for (int i = 0; i < 8; ++i) { const unsigned w = hist[qq * 512 + 8 * lane + i]; cnt[2 * i] = w & 0xffffu; cnt[2 * i + 1] = w >> 16; s += cnt[2 * i] + cnt[2 * i + 1]; }
                    unsigned T = s;
#pragma unroll
                    for (int off = 1; off < 64; off <<= 1) { const unsigned v = shdn(T, off, lane); if (lane + off < 64) T += v; }
                    const unsigned long long mask = __ballot(T >= 256u); const int L = 63 - __builtin_clzll(mask);
                    const unsigned Tn = shdn(T, 1, lane); const unsigned above = lane == 63 ? 0u : Tn;
                    if (lane == L) { unsigned cum = above; int b1 = 0, G1 = 0; bool found = false;
#pragma unroll
                        for (int b = 15; b >= 0; --b) { if (!found && cum + cnt[b] >= 256u) { b1 = 16 * lane + b; G1 = (int)cum; found = true; } if (!found) cum += cnt[b]; }
                        ctl[64 + qq] = b1; ctl[96 + qq] = 256 - G1; }
                }
                __syncthreads();
            }
        }
        for (int k = 0; k < 4; ++k) { const int qq = 4 * wave + k; const int need = ctl[96 + qq]; ds_compact(lds, qq, need, lane);
            __builtin_amdgcn_s_waitcnt(0);
            const int base = ctl[qq];
            for (int i = lane; i < need; i += 64) sel[qq * 256 + base + i] = ck[qq * DS_CAND + i];
            __builtin_amdgcn_s_waitcnt(0);
            unsigned kk4[4]; int rk[4];
#pragma unroll
            for (int ii = 0; ii < 4; ++ii) { kk4[ii] = sel[qq * 256 + lane + 64 * ii]; rk[ii] = 0; }
            for (int j = 0; j < 256; ++j) { const unsigned kj = sel[qq * 256 + j];
#pragma unroll
                for (int ii = 0; ii < 4; ++ii) rk[ii] += kj < kk4[ii] ? 1 : 0; }
            __builtin_amdgcn_s_waitcnt(0);
#pragma unroll
            for (int ii = 0; ii < 4; ++ii) sel[qq * 256 + rk[ii]] = (unsigned short)kk4[ii]; }
        __syncthreads();
    }
    const int nsel = N < 256 ? N : 256;
    LAS float* pb = (LAS float*)(lds + DS_OFF_P) + wave * 1024; LAS float* qb = (LAS float*)(lds + DS_OFF_Q) + wave * 256;
    for (int k = 0; k < 4; ++k) { const int qq = 4 * wave + k, t = q0 + qq;
        { const u32x2 w = *(const u32x2*)(DQ + (size_t)t * 256 + 4 * lane); *(LAS f32x4*)(qb + 4 * lane) = (f32x4){bflo(w.x), bfhi(w.x), bflo(w.y), bfhi(w.y)}; }
        __builtin_amdgcn_s_waitcnt(0);
#pragma unroll 1
        for (int jj = 0; jj < 4; ++jj) { const int idx = lane + 64 * jj; const bool valid = idx < nsel; const int key = valid ? (int)sel[qq * 256 + idx] : 0;
            float s0 = 0.f, s1 = 0.f, s2 = 0.f, s3 = 0.f;
#pragma unroll
            for (int d8 = 0; d8 < 8; ++d8) { float kv[8]; ld_bf16x8(DK + (size_t)key * 64 + 8 * d8, kv);
#pragma unroll
                for (int j = 0; j < 8; ++j) { const int d = 8 * d8 + j; s0 += kv[j] * qb[d]; s1 += kv[j] * qb[64 + d]; s2 += kv[j] * qb[128 + d]; s3 += kv[j] * qb[192 + d]; } }
            pb[idx] = valid ? s0 : -INFINITY; pb[256 + idx] = valid ? s1 : -INFINITY; pb[512 + idx] = valid ? s2 : -INFINITY; pb[768 + idx] = valid ? s3 : -INFINITY; }
        __builtin_amdgcn_s_waitcnt(0);
#pragma unroll
        for (int h = 0; h < 4; ++h) { float p[4];
#pragma unroll
            for (int jj = 0; jj < 4; ++jj) p[jj] = pb[h * 256 + lane + 64 * jj];
            float mx = fmaxf(fmaxf(p[0], p[1]), fmaxf(p[2], p[3])); mx = wave_max(mx, lane);
            float sm = 0.f;
#pragma unroll
            for (int jj = 0; jj < 4; ++jj) { p[jj] = __builtin_amdgcn_exp2f(p[jj] - mx); sm += p[jj]; }
            sm = wave_sum(sm, lane); const float inv = 1.0f / sm;
#pragma unroll
            for (int jj = 0; jj < 4; ++jj) pb[h * 256 + lane + 64 * jj] = p[jj] * inv; }
        __builtin_amdgcn_s_waitcnt(0);
        float o0 = 0.f, o1 = 0.f, o2 = 0.f, o3 = 0.f;
        for (int n = 0; n < nsel; ++n) { const int key = sel[qq * 256 + n]; const float v = bf2f(DV[(size_t)key * 64 + lane]);
            o0 += pb[n] * v; o1 += pb[256 + n] * v; o2 += pb[512 + n] * v; o3 += pb[768 + n] * v; }
        bf16_t* op = OB + (size_t)t * 256 + lane; op[0] = f2bf(o0); op[64] = f2bf(o1); op[128] = f2bf(o2); op[192] = f2bf(o3);
    }
    __syncthreads();
#if DBG_MODE
    { unsigned short* ds = (unsigned short*)(opq(A.ws) + WS_DBGSEL) + (size_t)u * 8192; for (int i = mytid(A.wave); i < 32 * 256; i += NTHREADS) ds[i] = sel[i]; }
    __syncthreads();
#endif
}

__device__ __forceinline__ void xattn_unit(const Args& A, int u) {
    unsigned char* ws = opq(A.ws); const int tid_l = mytid(A.wave); const int tid = tid_l, lane = tid & 63, wave = __builtin_amdgcn_readfirstlane(tid >> 6), fr = lane & 15, fq = lane >> 4;
    const bf16_t* XQ = (const bf16_t*)(ws + WS_XQ); const bf16_t* KM = (const bf16_t*)(ws + WS_KM); const bf16_t* VMT = (const bf16_t*)(ws + WS_VMT); bf16_t* AO = (bf16_t*)(ws + WS_AO);
    const int hh = u & 3, q0 = (u >> 2) * 128 + 16 * wave;
    bf16x8 qf[8];
#pragma unroll
    for (int s = 0; s < 8; ++s) qf[s] = *(const bf16x8*)(XQ + (size_t)(q0 + fr) * 1024 + 256 * hh + 32 * s + 8 * fq);
    f32x4 sacc[16];
#pragma unroll
    for (int g = 0; g < 16; ++g) { f32x4 c4 = (f32x4){0.f, 0.f, 0.f, 0.f};
#pragma unroll
        for (int s = 0; s < 8; ++s) { const bf16x8 kf = *(const bf16x8*)(KM + (size_t)(16 * g + fr) * 1024 + 256 * hh + 32 * s + 8 * fq); c4 = __builtin_amdgcn_mfma_f32_16x16x32_bf16(kf, qf[s], c4, 0, 0, 0); }
        sacc[g] = c4; }
    float mx = -INFINITY;
#pragma unroll
    for (int g = 0; g < 16; ++g) mx = fmaxf(mx, fmaxf(fmaxf(sacc[g].x, sacc[g].y), fmaxf(sacc[g].z, sacc[g].w)));
    mx = fmaxf(mx, shx(mx, 16, lane)); mx = fmaxf(mx, shx(mx, 32, lane));
    float sm = 0.f;
#pragma unroll
    for (int g = 0; g < 16; ++g) { sacc[g].x = __builtin_amdgcn_exp2f(sacc[g].x - mx); sacc[g].y = __builtin_amdgcn_exp2f(sacc[g].y - mx); sacc[g].z = __builtin_amdgcn_exp2f(sacc[g].z - mx); sacc[g].w = __builtin_amdgcn_exp2f(sacc[g].w - mx);
        sm += (sacc[g].x + sacc[g].y) + (sacc[g].z + sacc[g].w); }
    sm += shx(sm, 16, lane); sm += shx(sm, 32, lane);
    const float inv = 1.0f / sm;
    bf16x8 pf[8];
#pragma unroll
    for (int s = 0; s < 8; ++s) { u32x4 w; w.x = cvt_pk_bf16(sacc[2 * s].x * inv, sacc[2 * s].y * inv); w.y = cvt_pk_bf16(sacc[2 * s].z * inv, sacc[2 * s].w * inv);
        w.z = cvt_pk_bf16(sacc[2 * s + 1].x * inv, sacc[2 * s + 1].y * inv); w.w = cvt_pk_bf16(sacc[2 * s + 1].z * inv, sacc[2 * s + 1].w * inv); pf[s] = __builtin_bit_cast(bf16x8, w); }
#pragma unroll
    for (int dg = 0; dg < 16; ++dg) { f32x4 c4 = (f32x4){0.f, 0.f, 0.f, 0.f};
#pragma unroll
        for (int s = 0; s < 8; ++s) { const bf16x8 vf = *(const bf16x8*)(VMT + (size_t)(256 * hh + 16 * dg + fr) * 256 + 32 * s + 8 * fq); c4 = __builtin_amdgcn_mfma_f32_16x16x32_bf16(vf, pf[s], c4, 0, 0, 0); }
        u32x2 w; w.x = cvt_pk_bf16(c4.x, c4.y); w.y = cvt_pk_bf16(c4.z, c4.w);
        *(u32x2*)(AO + (size_t)(q0 + fr) * 1024 + 256 * hh + 16 * dg + 4 * fq) = w; }
}

__device__ __forceinline__ void final_norm(const Args& A) {
    const int tid = mytid(A.wave), lane = tid & 63, wave = tid >> 6; const int bid = obid(), Gl = ogrid(); const float* ssq = (const float*)(opq(A.ws) + WS_SSQ); const GAS float* g = ldarg(A, I_FING);
    for (int r = bid * 8 + wave; r < S_; r += Gl * 8) { const float rs = row_rstd(ssq, r); float* xr = (float*)opq((unsigned char*)A.out) + (size_t)r * 1024 + lane * 16;
#pragma unroll
        for (int i = 0; i < 4; ++i) { f32x4 v = *(const f32x4*)(xr + 4 * i); const f32x4 gg = *(const GAS f32x4*)(g + lane * 16 + 4 * i); v.x *= rs * gg.x; v.y *= rs * gg.y; v.z *= rs * gg.z; v.w *= rs * gg.w; *(f32x4*)(xr + 4 * i) = v; } }
}

constexpr int PH_PER_LAYER = 12, N_PHASES = 2 + PH_PER_LAYER * DEPTH;
__global__ void __launch_bounds__(NTHREADS, 2) mk_fwd(const float* i0, const float* i1, const float* i2, const float* i3, const float* i4, const float* i5, const float* i6, const float* i7, const float* i8, const float* i9,
                                                      const float* i10, const float* i11, const float* i12, const float* i13, const float* i14, const float* i15, const float* i16, const float* i17, const float* i18, const float* i19,
                                                      float* outp, unsigned char* wsp, int ph_lo, int ph_hi) {
    extern __shared__ __attribute__((aligned(16))) unsigned char lds[];
    LAS unsigned char* ring = (LAS unsigned char*)lds;
    Args args; args.out = outp; args.ws = wsp; args.ring = ring; args.wave = __builtin_amdgcn_readfirstlane(threadIdx.x >> 6);
    const int tid = threadIdx.x;
    unsigned char* ws = args.ws;
    unsigned* ctl = (unsigned*)(ws + WS_CTL);
    volatile LAS unsigned* misc = (volatile LAS unsigned*)(ring + MISC_OFF);
    if (tid < 16) misc[tid] = 0u;
    if (tid == 0) { volatile LAS unsigned long long* av = (volatile LAS unsigned long long*)(ring + ARGV_OFF);
        av[0] = (unsigned long long)i0; av[1] = (unsigned long long)i1; av[2] = (unsigned long long)i2; av[3] = (unsigned long long)i3; av[4] = (unsigned long long)i4;
        av[5] = (unsigned long long)i5; av[6] = (unsigned long long)i6; av[7] = (unsigned long long)i7; av[8] = (unsigned long long)i8; av[9] = (unsigned long long)i9;
        av[10] = (unsigned long long)i10; av[11] = (unsigned long long)i11; av[12] = (unsigned long long)i12; av[13] = (unsigned long long)i13; av[14] = (unsigned long long)i14;
        av[15] = (unsigned long long)i15; av[16] = (unsigned long long)i16; av[17] = (unsigned long long)i17; av[18] = (unsigned long long)i18; av[19] = (unsigned long long)i19; }
    __syncthreads();
    const bool one = (ph_hi - ph_lo) > 1;
    XcdBarrier bar; bar.bar = ctl + CW_BAR; bar.x = 0; bar.st = misc;
    if (one) bar = xcd_barrier_post(ctl + CW_BAR, misc, args.wave);
    const int lo = ph_lo, hi = ph_hi, G = gridDim.x;
#define IN(k) (lo <= (k) && (k) < hi)
#define SEAM(k) do { if (IN((k) + 1)) xcd_barrier(bar, args.wave); } while (0)

    if (PH_EN(100) && IN(0)) { prologue(ring, args); SEAM(0); }

    for (int l = 0; l < DEPTH; ++l) {
        const int pb = 1 + PH_PER_LAYER * l;
        if (PH_EN(0) && IN(pb + 0)) { unsigned char* wsl = opq(ws); (void)wsl; const int bid = obid(), Gl = ogrid(); (void)bid; (void)Gl; conv_layer(ring, args, l); SEAM(pb + 0); }
        if (PH_EN(1) && IN(pb + 1)) { unsigned char* wsl = opq(ws); (void)wsl; const int bid = obid(), Gl = ogrid(); (void)bid; (void)Gl;
            { pg8::Gemm g{(const bf16_t*)(wsl + WS_XB), (const bf16_t*)(wsl + WS_WIN), S_, NIN, D_}; pg8::StaticOrder S; S.init(S_, NIN, Gl, bid);
              EpiIn E{(const float*)(wsl + WS_SSQ), (const float*)(wsl + WS_CS), (bf16_t*)(wsl + WS_SBQ), (bf16_t*)(wsl + WS_SBK), (bf16_t*)(wsl + WS_SBV), (bf16_t*)(wsl + WS_DSQ), (bf16_t*)(wsl + WS_IXQ), (bf16_t*)(wsl + WS_DSK), (bf16_t*)(wsl + WS_IXK),
                      (bf16_t*)(wsl + WS_DSV), (bf16_t*)(wsl + WS_GLQ), (bf16_t*)(wsl + WS_GLK), (bf16_t*)(wsl + WS_GLV), (bf16_t*)(wsl + WS_GLO), (bf16_t*)(wsl + WS_GATES), (float*)(wsl + WS_SMALL)};
              pg8::gemm_phase<EpiIn, pg8::StaticOrder>(ring, g, S, E, args.wave); }
            { pg8::Gemm g{(const bf16_t*)(wsl + WS_MEMB), (const bf16_t*)(wsl + WS_WXKV), NMEM, 2048, D_}; pg8::StaticOrder S; S.init(NMEM, 2048, Gl, (bid + 128) % Gl);
              EpiKV E{(const float*)(wsl + WS_RSTDM), (bf16_t*)(wsl + WS_KM), (bf16_t*)(wsl + WS_VMT)};
              pg8::gemm_phase<EpiKV, pg8::StaticOrder>(ring, g, S, E, args.wave); }
            SEAM(pb + 1);
        }
        if (PH_EN(2) && IN(pb + 2)) { unsigned char* wsl = opq(ws); (void)wsl; const int bid = obid(), Gl = ogrid(); (void)bid; (void)Gl;
            volatile LAS int* qslot = (volatile LAS int*)(ring + MISC_OFF + 32);
            for (;;) {
                __syncthreads();
                if (mytid(args.wave) == 0) *qslot = (int)atomicAdd((unsigned*)(wsl + WS_CTL) + CW_QUEUE + 64 * l, 1u);
                __syncthreads();
                const int uq = *qslot;
                if (uq >= 896) break;
                if (uq < 512) dsa_unit(ring, args, 511 - uq);
                else if (uq < 640) sb_unit(ring, args, 639 - uq);
                else gla1_unit(ring, args, l, uq - 640);
            }
            SEAM(pb + 2);
        }
        if (PH_EN(3) && IN(pb + 3)) { unsigned char* wsl = opq(ws); (void)wsl; const int bid = obid(), Gl = ogrid(); (void)bid; (void)Gl; gla2_phase(args); SEAM(pb + 3); }
        if (PH_EN(4) && IN(pb + 4)) { unsigned char* wsl = opq(ws); (void)wsl; const int bid = obid(), Gl = ogrid(); (void)bid; (void)Gl; for (int c = bid; c < 256; c += Gl) gla3_unit(ring, args, l, c); SEAM(pb + 4); }
        if (PH_EN(5) && IN(pb + 5)) { unsigned char* wsl = opq(ws); (void)wsl; const int bid = obid(), Gl = ogrid(); (void)bid; (void)Gl;
            pg8::StaticOrder S; S.init(S_, D_, Gl, bid);
            { pg8::Gemm g{(const bf16_t*)(wsl + WS_OA), (const bf16_t*)(wsl + WS_WBR), S_, D_, 256}; EpiMerge<0> E{(const bf16_t*)(wsl + WS_GATES), (bf16_t*)(wsl + WS_MERGED)}; pg8::gemm_phase<EpiMerge<0>, pg8::StaticOrder>(ring, g, S, E, args.wave); }
            { pg8::Gemm g{(const bf16_t*)(wsl + WS_OB), (const bf16_t*)(wsl + WS_WBR) + 262144, S_, D_, 256}; EpiMerge<1> E{(const bf16_t*)(wsl + WS_GATES), (bf16_t*)(wsl + WS_MERGED)}; pg8::gemm_phase<EpiMerge<1>, pg8::StaticOrder>(ring, g, S, E, args.wave); }
            { pg8::Gemm g{(const bf16_t*)(wsl + WS_OC), (const bf16_t*)(wsl + WS_WBR) + 524288, S_, D_, 256}; EpiMerge<2> E{(const bf16_t*)(wsl + WS_GATES), (bf16_t*)(wsl + WS_MERGED)}; pg8::gemm_phase<EpiMerge<2>, pg8::StaticOrder>(ring, g, S, E, args.wave); }
            SEAM(pb + 5);
        }
        if (PH_EN(6) && IN(pb + 6)) { unsigned char* wsl = opq(ws); (void)wsl; const int bid = obid(), Gl = ogrid(); (void)bid; (void)Gl; pg8::Gemm g{(const bf16_t*)(wsl + WS_MERGED), (const bf16_t*)(wsl + WS_WMIX), S_, D_, D_}; pg8::StaticOrder S; S.init(S_, D_, Gl, bid);
            EpiRes E{(float*)opq((unsigned char*)args.out), (bf16_t*)(wsl + WS_XB), (float*)(wsl + WS_SSQ)}; pg8::gemm_phase<EpiRes, pg8::StaticOrder>(ring, g, S, E, args.wave); SEAM(pb + 6); }
        if (PH_EN(7) && IN(pb + 7)) { unsigned char* wsl = opq(ws); (void)wsl; const int bid = obid(), Gl = ogrid(); (void)bid; (void)Gl; pg8::Gemm g{(const bf16_t*)(wsl + WS_XB), (const bf16_t*)(wsl + WS_WXQ), S_, D_, D_}; pg8::StaticOrder S; S.init(S_, D_, Gl, bid);
            EpiXq E{(const float*)(wsl + WS_SSQ), (bf16_t*)(wsl + WS_XQ)}; pg8::gemm_phase<EpiXq, pg8::StaticOrder>(ring, g, S, E, args.wave); SEAM(pb + 7); }
        if (PH_EN(8) && IN(pb + 8)) { unsigned char* wsl = opq(ws); (void)wsl; const int bid = obid(), Gl = ogrid(); (void)bid; (void)Gl; for (int u = bid; u < 512; u += Gl) xattn_unit(args, u); SEAM(pb + 8); }
        if (PH_EN(9) && IN(pb + 9)) { unsigned char* wsl = opq(ws); (void)wsl; const int bid = obid(), Gl = ogrid(); (void)bid; (void)Gl; pg8::Gemm g{(const bf16_t*)(wsl + WS_AO), (const bf16_t*)(wsl + WS_WXO), S_, D_, D_}; pg8::StaticOrder S; S.init(S_, D_, Gl, bid);
            EpiRes E{(float*)opq((unsigned char*)args.out), (bf16_t*)(wsl + WS_XB), (float*)(wsl + WS_SSQ)}; pg8::gemm_phase<EpiRes, pg8::StaticOrder>(ring, g, S, E, args.wave); SEAM(pb + 9); }
        if (PH_EN(10) && IN(pb + 10)) { unsigned char* wsl = opq(ws); (void)wsl; const int bid = obid(), Gl = ogrid(); (void)bid; (void)Gl; pg8::Gemm g{(const bf16_t*)(wsl + WS_XB), (const bf16_t*)(wsl + WS_WFI), S_, NFF, D_}; pg8::StaticOrder S; S.init(S_, NFF, Gl, bid);
            EpiFfnIn E{(const float*)(wsl + WS_SSQ), (bf16_t*)(wsl + WS_HID)}; pg8::gemm_phase<EpiFfnIn, pg8::StaticOrder>(ring, g, S, E, args.wave); SEAM(pb + 10); }
        if (PH_EN(11) && IN(pb + 11)) { unsigned char* wsl = opq(ws); (void)wsl; const int bid = obid(), Gl = ogrid(); (void)bid; (void)Gl; pg8::Gemm g{(const bf16_t*)(wsl + WS_HID), (const bf16_t*)(wsl + WS_WFO), S_, D_, DFF}; pg8::StaticOrder S; S.init(S_, D_, Gl, bid);
            EpiRes E{(float*)opq((unsigned char*)args.out), (bf16_t*)(wsl + WS_XB), (float*)(wsl + WS_SSQ)}; pg8::gemm_phase<EpiRes, pg8::StaticOrder>(ring, g, S, E, args.wave); SEAM(pb + 11); }
    }
    if (PH_EN(101) && IN(N_PHASES - 1)) final_norm(args);
#undef IN
#undef SEAM
}

#if DBG_MODE
constexpr size_t WS_DBGSC = WS_DBGEND;
constexpr size_t WS_DBGFL = WS_DBGSC + 1 * MB;
constexpr size_t WS_DBGEND2 = WS_DBGFL + 256 * 1024;
__device__ __forceinline__ int dbg_row(int i) { if (i == 0) return 0; if (i == 1) return 63; if (i == 2) return 64; if (i == 3) return 255; if (i == 4) return 256; if (i == 5) return S_ - 1; if (i == 6) return 300; if (i == 7) return 16000; return (int)((((unsigned)i * 2654435761u) >> 14) % (unsigned)S_); }
__device__ __forceinline__ void dbg_err(float* dbg, int stage, float got, float ex, float atol, float rtol) { float e = fabsf(got - ex) / (atol + rtol * fabsf(ex)); if (!(e == e)) e = 1e30f; atomicMax((unsigned*)(dbg + stage), __float_as_uint(e)); }
__device__ __forceinline__ void dbg_sincos(float angf, double& c, double& s) {
    double a = (double)angf; const double k = floor(a / 6.283185307179586476925286766559); a -= k * 6.283185307179586476925286766559; if (a > 3.14159265358979323846) a -= 6.283185307179586476925286766559;
    double term = a, sn = a, a2 = a * a; for (int i = 1; i < 20; ++i) { term *= -a2 / ((2 * i) * (2 * i + 1)); sn += term; }
    term = 1.0; double cn = 1.0; for (int i = 1; i < 20; ++i) { term *= -a2 / ((2 * i - 1) * (2 * i)); cn += term; }
    c = cn; s = sn; }
__global__ void __launch_bounds__(512) dbg_inproj(const float* x, const float* g, const float* win, unsigned char* ws) {
    __shared__ float xs[1024]; __shared__ float z[INW]; __shared__ float red[8];
    float* dbg = (float*)(ws + WS_DBG); const int r = dbg_row(blockIdx.x), tid = threadIdx.x;
    float sq = 0.f; for (int k = tid; k < 1024; k += 512) { const float v = x[(size_t)r * 1024 + k]; sq += v * v; xs[k] = v * g[k]; }
    for (int o = 32; o >= 1; o >>= 1) sq += __shfl_xor(sq, o);
    if ((tid & 63) == 0) red[tid >> 6] = sq;
    __syncthreads();
    float tot = 0.f; for (int i = 0; i < 8; ++i) tot += red[i];
    const float rstd = rsqrtf(tot * (1.0f / 1024.0f) + EPS);
    if (tid == 0) dbg_err(dbg, 20, row_rstd((const float*)(ws + WS_SSQ), r), rstd, 0.f, 1e-4f);
    for (int n = tid; n < INW; n += 512) { float acc = 0.f; for (int k = 0; k < 1024; ++k) acc += xs[k] * win[(size_t)k * INW + n]; z[n] = acc * rstd; }
    __syncthreads();
    const bf16_t* SBQ = (const bf16_t*)(ws + WS_SBQ); const bf16_t* SBK = (const bf16_t*)(ws + WS_SBK); const bf16_t* SBV = (const bf16_t*)(ws + WS_SBV);
    const bf16_t* DSQ = (const bf16_t*)(ws + WS_DSQ); const bf16_t* IXQ = (const bf16_t*)(ws + WS_IXQ); const bf16_t* DSK = (const bf16_t*)(ws + WS_DSK); const bf16_t* IXK = (const bf16_t*)(ws + WS_IXK); const bf16_t* DSV = (const bf16_t*)(ws + WS_DSV);
    const float* SM = (const float*)(ws + WS_SMALL); const bf16_t* GLQ = (const bf16_t*)(ws + WS_GLQ); const bf16_t* GLK = (const bf16_t*)(ws + WS_GLK); const bf16_t* GLV = (const bf16_t*)(ws + WS_GLV); const bf16_t* GLO = (const bf16_t*)(ws + WS_GLO); const bf16_t* GT = (const bf16_t*)(ws + WS_GATES);
    const float AT = 0.04f, RT = 0.02f;
    for (int n = tid; n < INW; n += 512) {
        const float zn = z[n];
        if (n < 768) { const int w = n >> 8, c = n & 255; const bf16_t* B = w == 0 ? SBQ : (w == 1 ? SBK : SBV); dbg_err(dbg, 1 + w, bf2f(B[(size_t)r * 256 + c]), zn * (w == 0 ? SBQ_SCALE : 1.0f), AT, RT); }
        else if (n < 1152 && !(n >= 1088) || (n >= 1152 && n < 1472)) {
            int base, stage, ld, col; float sc; const bf16_t* B;
            if (n < 1024) { base = 768; stage = 4; ld = 256; sc = DSQ_SCALE; B = DSQ; } else if (n < 1088) { base = 1024; stage = 5; ld = 64; sc = 1.f; B = DSK; }
            else if (n < 1408) { base = 1152; stage = 7; ld = 256; sc = IXQ_SCALE; B = IXQ; } else { base = 1408; stage = 8; ld = 64; sc = 1.f; B = IXK; }
            col = n - base; const int d = col & 63, dd = d & 31; double c, s_; dbg_sincos((float)r * c_inv_freq[dd], c, s_);
            const float ex = d < 32 ? (float)(zn * c - z[n + 32] * s_) : (float)(zn * c + z[n - 32] * s_);
            dbg_err(dbg, stage, bf2f(B[(size_t)r * ld + col]), ex * sc, AT, RT); }
        else if (n < 1152) dbg_err(dbg, 6, bf2f(DSV[(size_t)r * 64 + n - 1088]), zn, AT, RT);
        else if (n < 1476) dbg_err(dbg, 9, SM[(size_t)r * 64 + n - 1472], zn, AT, RT);
        else if (n < 1604) dbg_err(dbg, 10, bf2f(GLQ[(size_t)r * 128 + n - 1476]), zn * GLQ_SCALE, AT, RT);
        else if (n < 1732) dbg_err(dbg, 11, bf2f(GLK[(size_t)r * 128 + n - 1604]), zn, AT, RT);
        else if (n < 1988) dbg_err(dbg, 12, bf2f(GLV[(size_t)r * 256 + n - 1732]), zn, AT, RT);
        else if (n < 2004) dbg_err(dbg, 13, SM[(size_t)r * 64 + 4 + n - 1988], zn, AT, RT);
        else if (n < 2260) dbg_err(dbg, 14, bf2f(GLO[(size_t)r * 256 + n - 2004]), zn / (1.0f + expf(-zn)), AT, RT);
        else dbg_err(dbg, 15, bf2f(GT[(size_t)r * 3072 + n - 2260]), 1.0f / (1.0f + expf(-zn)), AT, RT);
    }
}
__global__ void __launch_bounds__(64) dbg_sb(unsigned char* ws) {
    float* dbg = (float*)(ws + WS_DBG); const int i = threadIdx.x, t = dbg_row(i), h = i & 3;
    const bf16_t* Q = (const bf16_t*)(ws + WS_SBQ); const bf16_t* K = (const bf16_t*)(ws + WS_SBK); const bf16_t* V = (const bf16_t*)(ws + WS_SBV); const bf16_t* O = (const bf16_t*)(ws + WS_OA);
    float q[64], acc[64];
#pragma unroll
    for (int d8 = 0; d8 < 8; ++d8) { float v[8]; ld_bf16x8(Q + (size_t)t * 256 + 64 * h + 8 * d8, v);
#pragma unroll
        for (int j = 0; j < 8; ++j) { q[8 * d8 + j] = v[j] * (1.0f / LOG2E); acc[8 * d8 + j] = 0.f; } }
    float run = 0.f;
    for (int s = t - 1; s >= 0; --s) { float z = 0.f;
#pragma unroll
        for (int d8 = 0; d8 < 8; ++d8) { float v[8]; ld_bf16x8(K + (size_t)s * 256 + 64 * h + 8 * d8, v);
#pragma unroll
            for (int j = 0; j < 8; ++j) z += q[8 * d8 + j] * v[j]; }
        const float lb = z >= 0.f ? -log1pf(expf(-z)) : z - log1pf(expf(z)); const float lk = lb - z; const float w = expf(lb + run);
#pragma unroll
        for (int d8 = 0; d8 < 8; ++d8) { float v[8]; ld_bf16x8(V + (size_t)s * 256 + 64 * h + 8 * d8, v);
#pragma unroll
            for (int j = 0; j < 8; ++j) acc[8 * d8 + j] += w * v[j]; }
        run += lk; }
#pragma unroll
    for (int d8 = 0; d8 < 8; ++d8) { float v[8]; ld_bf16x8(O + (size_t)t * 256 + 64 * h + 8 * d8, v);
#pragma unroll
        for (int j = 0; j < 8; ++j) dbg_err(dbg, 16, v[j], acc[8 * d8 + j], 0.02f, 0.02f); }
}
__global__ void __launch_bounds__(512) dbg_dsa(unsigned char* ws) {
    __shared__ float qi[256]; __shared__ float dq[256]; __shared__ float pp[4][256]; __shared__ float wsm[4]; __shared__ int mism; __shared__ float mxs[4], sms[4];
    float* dbg = (float*)(ws + WS_DBG); const int tid = threadIdx.x, t = dbg_row(blockIdx.x), N = ((t >> 6) + 1) * 64, nsel = N < 256 ? N : 256;
    const bf16_t* IQ = (const bf16_t*)(ws + WS_IXQ); const bf16_t* IK = (const bf16_t*)(ws + WS_IXK); const float* SM = (const float*)(ws + WS_SMALL);
    const bf16_t* DQ = (const bf16_t*)(ws + WS_DSQ); const bf16_t* DK = (const bf16_t*)(ws + WS_DSK); const bf16_t* DV = (const bf16_t*)(ws + WS_DSV); const bf16_t* OB = (const bf16_t*)(ws + WS_OB);
    const unsigned short* msel = (const unsigned short*)(ws + WS_DBGSEL) + (size_t)t * 256;
    float* sc = (float*)(ws + WS_DBGSC) + (size_t)blockIdx.x * 16384; int* fl = (int*)(ws + WS_DBGFL) + (size_t)blockIdx.x * 16384;
    if (tid < 256) { qi[tid] = bf2f(IQ[(size_t)t * 256 + tid]); dq[tid] = bf2f(DQ[(size_t)t * 256 + tid]); } if (tid < 4) wsm[tid] = SM[(size_t)t * 64 + tid] * 0.5f; if (tid == 0) mism = 0;
    __syncthreads();
    for (int s = tid; s < N; s += 512) { float tot = 0.f;
#pragma unroll 1
        for (int h = 0; h < 4; ++h) { float a = 0.f;
#pragma unroll 4
            for (int d = 0; d < 64; ++d) a += qi[64 * h + d] * bf2f(IK[(size_t)s * 64 + d]); tot += wsm[h] * fmaxf(a, 0.f); } sc[s] = tot + 0.0f; }
    __threadfence_block(); __syncthreads();
    { float mine[32]; int rank[32];
#pragma unroll
      for (int k = 0; k < 32; ++k) { const int s = tid + 512 * k; mine[k] = s < N ? sc[s] : 0.f; rank[k] = 0; }
      for (int j = 0; j < N; ++j) { const float v = sc[j];
#pragma unroll
          for (int k = 0; k < 32; ++k) { const int s = tid + 512 * k; rank[k] += (v > mine[k] || (v == mine[k] && j < s)) ? 1 : 0; } }
#pragma unroll
      for (int k = 0; k < 32; ++k) { const int s = tid + 512 * k; if (s < N) fl[s] = (N <= 256 || rank[k] < 256) ? 1 : 0; } }
    __threadfence_block(); __syncthreads();
    if (tid < nsel) { const int key = msel[tid]; bool ok = key < N; if (ok) ok = atomicExch(fl + key, 2) == 1; if (!ok) atomicAdd(&mism, 1); }
    __syncthreads();
    if (tid == 0) dbg_err(dbg, 17, (float)mism, 0.f, 6.0f, 0.f);
    if (tid < 256) { const bool valid = tid < nsel; const int key = valid ? (int)msel[tid] : 0; const int kk = key < S_ ? key : 0;
#pragma unroll 1
        for (int h = 0; h < 4; ++h) { float a = 0.f;
#pragma unroll 4
            for (int d = 0; d < 64; ++d) a += dq[64 * h + d] * bf2f(DK[(size_t)kk * 64 + d]);
            pp[h][tid] = valid ? a : -INFINITY; } }
    __syncthreads();
    if (tid < 4) { float mx = -INFINITY; for (int i = 0; i < 256; ++i) mx = fmaxf(mx, pp[tid][i]); float sm = 0.f; for (int i = 0; i < 256; ++i) sm += exp2f(pp[tid][i] - mx); mxs[tid] = mx; sms[tid] = sm; }
    __syncthreads();
    if (tid < 256) { const int h = tid >> 6, d = tid & 63; float o = 0.f;
#pragma unroll 2
        for (int i = 0; i < nsel; ++i) { const int key = msel[i] < S_ ? msel[i] : 0; o += exp2f(pp[h][i] - mxs[h]) * bf2f(DV[(size_t)key * 64 + d]); }
        dbg_err(dbg, 18, bf2f(OB[(size_t)t * 256 + tid]), o / sms[h], 0.02f, 0.02f); }
}
__global__ void __launch_bounds__(512) dbg_gla(const float* wup, const float* gb, const float* gn, unsigned char* ws) {
    __shared__ float qs[32], ks[32], al[32], vs[64], part[32][65], os[64];
    float* dbg = (float*)(ws + WS_DBG); const int tid = threadIdx.x, h = blockIdx.x, d = tid >> 4, e0 = (tid & 15) * 4;
    const float* SM = (const float*)(ws + WS_SMALL); const bf16_t* GQ = (const bf16_t*)(ws + WS_GLQ); const bf16_t* GK = (const bf16_t*)(ws + WS_GLK); const bf16_t* GV = (const bf16_t*)(ws + WS_GLV); const bf16_t* GO = (const bf16_t*)(ws + WS_GLO); const bf16_t* OC = (const bf16_t*)(ws + WS_OC);
    float st[4] = {0.f, 0.f, 0.f, 0.f}; float emax = 0.f;
    for (int t = 0; t < S_; ++t) {
        if (tid < 32) { qs[tid] = bf2f(GQ[(size_t)t * 128 + 32 * h + tid]); ks[tid] = bf2f(GK[(size_t)t * 128 + 32 * h + tid]);
            float x = gb[32 * h + tid]; for (int r = 0; r < 16; ++r) x += SM[(size_t)t * 64 + 4 + r] * wup[r * 128 + 32 * h + tid];
            const float ls = x >= 0.f ? -log1pf(expf(-x)) : x - log1pf(expf(x)); al[tid] = expf(ls * (1.0f / 16.0f)); }
        else if (tid < 96) vs[tid - 32] = bf2f(GV[(size_t)t * 256 + 64 * h + tid - 32]);
        __syncthreads();
#pragma unroll
        for (int i = 0; i < 4; ++i) { st[i] = al[d] * st[i] + ks[d] * vs[e0 + i]; part[d][e0 + i] = qs[d] * st[i]; }
        __syncthreads();
        if (tid < 64) { float o = 0.f; for (int dd = 0; dd < 32; ++dd) o += part[dd][tid]; float sq = o * o; for (int m = 32; m >= 1; m >>= 1) sq += __shfl_xor(sq, m);
            const float ex = o * rsqrtf(sq * (1.0f / 64.0f) + EPS) * gn[tid] * bf2f(GO[(size_t)t * 256 + 64 * h + tid]);
            float e = fabsf(bf2f(OC[(size_t)t * 256 + 64 * h + tid]) - ex) / (0.03f + 0.03f * fabsf(ex)); if (!(e == e)) e = 1e30f; emax = fmaxf(emax, e); }
        __syncthreads();
    }
    if (tid < 64) atomicMax((unsigned*)(dbg + 19), __float_as_uint(emax));
}
constexpr size_t WS_DBGCK = WS_DBGEND2;
constexpr size_t WS_DBGEND3 = WS_DBGCK + 2 * 64 * 1024 * 4;
__device__ __forceinline__ float dbg_dot(const float* arow, const float* W, int ldw, int K, int n) { float a = 0.f; for (int k = 0; k < K; ++k) a += arow[k] * W[(size_t)k * ldw + n]; return a; }
__global__ void __launch_bounds__(512) dbg_merge(const float* wa, const float* wb, const float* wc, unsigned char* ws) {
    __shared__ float oa[256], ob[256], oc[256]; float* dbg = (float*)(ws + WS_DBG); const int r = dbg_row(blockIdx.x), tid = threadIdx.x;
    if (tid < 256) { oa[tid] = bf2f(((const bf16_t*)(ws + WS_OA))[(size_t)r * 256 + tid]); ob[tid] = bf2f(((const bf16_t*)(ws + WS_OB))[(size_t)r * 256 + tid]); oc[tid] = bf2f(((const bf16_t*)(ws + WS_OC))[(size_t)r * 256 + tid]); }
    __syncthreads();
    const bf16_t* G = (const bf16_t*)(ws + WS_GATES) + (size_t)r * 3072; const bf16_t* M = (const bf16_t*)(ws + WS_MERGED) + (size_t)r * 1024;
    for (int c = tid; c < 1024; c += 512) { const float ex = bf2f(G[c]) * dbg_dot(oa, wa, 1024, 256, c) + bf2f(G[1024 + c]) * dbg_dot(ob, wb, 1024, 256, c) + bf2f(G[2048 + c]) * dbg_dot(oc, wc, 1024, 256, c);
        dbg_err(dbg, 21, bf2f(M[c]), ex, 0.03f, 0.03f); }
}
__global__ void __launch_bounds__(512) dbg_resid(const float* xin, int xin_ld_is_ck, const float* W, int K, size_t abuf_off, const float* out, unsigned char* ws, int st, int ckslot) {
    __shared__ float arow[2816]; __shared__ float red[8]; float* dbg = (float*)(ws + WS_DBG); const int smp = blockIdx.x, r = dbg_row(smp), tid = threadIdx.x;
    const bf16_t* Ab = (const bf16_t*)(ws + abuf_off) + (size_t)r * K; for (int k = tid; k < K; k += 512) arow[k] = bf2f(Ab[k]);
    __syncthreads();
    const float* xrow = xin_ld_is_ck ? xin + (size_t)smp * 1024 : xin + (size_t)r * 1024; float* ck = (float*)(ws + WS_DBGCK) + ((size_t)ckslot * 64 + smp) * 1024;
    float sq = 0.f;
    for (int c = tid; c < 1024; c += 512) { const float ex = xrow[c] + dbg_dot(arow, W, 1024, K, c); const float got = out[(size_t)r * 1024 + c];
        dbg_err(dbg, st, got, ex, 0.03f, 0.02f); dbg_err(dbg, st + 1, bf2f(((const bf16_t*)(ws + WS_XB))[(size_t)r * 1024 + c]), got, 0.001f, 0.01f); sq += got * got; ck[c] = got; }
    for (int o = 32; o >= 1; o >>= 1) sq += __shfl_xor(sq, o);
    if ((tid & 63) == 0) red[tid >> 6] = sq;
    __syncthreads();
    if (tid == 0) { float tot = 0.f; for (int i = 0; i < 8; ++i) tot += red[i]; const float* sp = (const float*)(ws + WS_SSQ) + (size_t)r * 16; float got = 0.f; for (int i = 0; i < 16; ++i) got += sp[i]; dbg_err(dbg, st + 2, got, tot, 0.f, 1e-3f); }
}
__global__ void __launch_bounds__(512) dbg_normproj(const float* x, const float* gain, const float* W, int mode, unsigned char* ws, int st) {
    __shared__ float xs[1024]; __shared__ float red[8]; float* dbg = (float*)(ws + WS_DBG); const int r = dbg_row(blockIdx.x), tid = threadIdx.x;
    float sq = 0.f; for (int k = tid; k < 1024; k += 512) { const float v = x[(size_t)r * 1024 + k]; sq += v * v; xs[k] = v * gain[k]; }
    for (int o = 32; o >= 1; o >>= 1) sq += __shfl_xor(sq, o);
    if ((tid & 63) == 0) red[tid >> 6] = sq;
    __syncthreads();
    float tot = 0.f; for (int i = 0; i < 8; ++i) tot += red[i]; const float rstd = rsqrtf(tot * (1.0f / 1024.0f) + EPS);
    if (mode == 0) { for (int c = tid; c < 1024; c += 512) dbg_err(dbg, st, bf2f(((const bf16_t*)(ws + WS_XQ))[(size_t)r * 1024 + c]), rstd * dbg_dot(xs, W, 1024, 1024, c) * XQ_SCALE, 0.03f, 0.02f); }
    else { for (int j = tid; j < DFF; j += 512) { const float g = rstd * dbg_dot(xs, W, NFF, 1024, j), up = rstd * dbg_dot(xs, W, NFF, 1024, DFF + j);
            dbg_err(dbg, st, bf2f(((const bf16_t*)(ws + WS_HID))[(size_t)r * DFF + j]), g / (1.0f + expf(-g)) * up, 0.03f, 0.03f); } }
}
__global__ void __launch_bounds__(512) dbg_kv(const float* mem, const float* gain, const float* W, unsigned char* ws, int st) {
    __shared__ float xs[1024]; __shared__ float red[8]; float* dbg = (float*)(ws + WS_DBG); const int r = blockIdx.x * 4 + 1, tid = threadIdx.x;
    float sq = 0.f; for (int k = tid; k < 1024; k += 512) { const float v = mem[(size_t)r * 1024 + k]; sq += v * v; xs[k] = v * gain[k]; }
    for (int o = 32; o >= 1; o >>= 1) sq += __shfl_xor(sq, o);
    if ((tid & 63) == 0) red[tid >> 6] = sq;
    __syncthreads();
    float tot = 0.f; for (int i = 0; i < 8; ++i) tot += red[i]; const float rstd = rsqrtf(tot * (1.0f / 1024.0f) + EPS);
    const int pos = (r & ~31) + 8 * ((r >> 2) & 3) + 4 * ((r >> 4) & 1) + (r & 3);
    for (int n = tid; n < 2048; n += 512) { const float ex = rstd * dbg_dot(xs, W, 2048, 1024, n);
        if (n < 1024) dbg_err(dbg, st, bf2f(((const bf16_t*)(ws + WS_KM))[(size_t)r * 1024 + n]), ex, 0.03f, 0.02f);
        else dbg_err(dbg, st + 1, bf2f(((const bf16_t*)(ws + WS_VMT))[(size_t)(n - 1024) * 256 + pos]), ex, 0.03f, 0.02f); }
}
__global__ void __launch_bounds__(512) dbg_xattn(unsigned char* ws, int st) {
    __shared__ float q[1024]; __shared__ float sc[256]; float* dbg = (float*)(ws + WS_DBG); const int r = dbg_row(blockIdx.x), tid = threadIdx.x;
    const bf16_t* XQ = (const bf16_t*)(ws + WS_XQ); const bf16_t* KM = (const bf16_t*)(ws + WS_KM); const bf16_t* VMT = (const bf16_t*)(ws + WS_VMT); const bf16_t* AO = (const bf16_t*)(ws + WS_AO);
    for (int k = tid; k < 1024; k += 512) q[k] = bf2f(XQ[(size_t)r * 1024 + k]);
    for (int h = 0; h < 4; ++h) {
        __syncthreads();
        if (tid < 256) { float a = 0.f; for (int d = 0; d < 256; ++d) a += q[256 * h + d] * bf2f(KM[(size_t)tid * 1024 + 256 * h + d]); sc[tid] = a; }
        __syncthreads();
        float mx = -INFINITY; for (int i = 0; i < 256; ++i) mx = fmaxf(mx, sc[i]); float sm = 0.f; for (int i = 0; i < 256; ++i) sm += exp2f(sc[i] - mx);
        if (tid < 256) { float o = 0.f; for (int key = 0; key < 256; ++key) { const int pos = (key & ~31) + 8 * ((key >> 2) & 3) + 4 * ((key >> 4) & 1) + (key & 3); o += exp2f(sc[key] - mx) * bf2f(VMT[(size_t)(256 * h + tid) * 256 + pos]); }
            dbg_err(dbg, st, bf2f(AO[(size_t)r * 1024 + 256 * h + tid]), o / sm, 0.02f, 0.02f); }
    }
}
__global__ void dbg_encode(unsigned char* ws, float* out, int nstage) {
    const float* dbg = (const float*)(ws + WS_DBG); int first = 0; for (int i = 1; i <= nstage; ++i) if (dbg[i] > 1.0f) { first = i; break; }
#ifdef DBG_PROBE
    { float e = dbg[DBG_PROBE] * 100.0f; first = e > 98.0f ? 98 : (int)(e + 0.5f); }
#endif
    const float c = sqrtf(10.0f * (float)first);
    for (size_t i = (size_t)blockIdx.x * blockDim.x + threadIdx.x; i < (size_t)S_ * D_; i += (size_t)gridDim.x * blockDim.x) out[i] = c;
}
#endif
extern "C" void kernel_launch(void* const* d_in, const int* in_sizes, int n_in, void* d_out, int out_size, void* d_ws, size_t ws_size, hipStream_t stream) {
    static int grid = 0;
    if (grid == 0) {
        if (n_in != 20 || out_size != S_ * D_ || ws_size < WS_END) { fprintf(stderr, "kernel_launch: unexpected shapes (n_in %d out %d ws %zu need %zu)\n", n_in, out_size, ws_size, (size_t)WS_END); grid = -1; return; }
        int dev = 0, cus = 0, per_cu = 0;
        if (hipGetDevice(&dev) != hipSuccess || hipDeviceGetAttribute(&cus, hipDeviceAttributeMultiprocessorCount, dev) != hipSuccess) { grid = -1; return; }
        if (hipFuncSetAttribute((const void*)mk_fwd, hipFuncAttributeMaxDynamicSharedMemorySize, LDS_BYTES) != hipSuccess) { fprintf(stderr, "kernel_launch: hipFuncSetAttribute failed\n"); grid = -1; return; }
        if (hipOccupancyMaxActiveBlocksPerMultiprocessor(&per_cu, (const void*)mk_fwd, NTHREADS, LDS_BYTES) != hipSuccess || per_cu < 1) { fprintf(stderr, "kernel_launch: occupancy query says %d\n", per_cu); }
        (void)hipGetLastError();
        grid = cus;
    }
    if (grid < 0) return;
    (void)hipMemsetAsync((char*)d_ws + WS_CTL, 0, CTL_ZERO_BYTES, stream);
    const float* p[20];
    for (int i = 0; i < 20; ++i) p[i] = (const float*)d_in[i];
#define MK_LAUNCH(LO, HI) hipLaunchKernelGGL(mk_fwd, dim3(grid), dim3(NTHREADS), LDS_BYTES, stream, p[0], p[1], p[2], p[3], p[4], p[5], p[6], p[7], p[8], p[9], p[10], p[11], p[12], p[13], p[14], p[15], p[16], p[17], p[18], p[19], \
        (float*)d_out, (unsigned char*)d_ws, (int)(LO), (int)(HI))
#if DBG_MODE == 1
    if (ws_size < WS_DBGEND3) { fprintf(stderr, "debug build: workspace too small\n"); return; }
    (void)hipMemsetAsync((char*)d_ws + WS_DBG, 0, 65536, stream);
    for (int ph = 0; ph <= 5; ++ph) MK_LAUNCH(ph, ph + 1);
    unsigned char* W8 = (unsigned char*)d_ws;
    hipLaunchKernelGGL(dbg_inproj, dim3(64), dim3(512), 0, stream, p[I_X], p[I_MIXG], p[I_WIN], W8);
    hipLaunchKernelGGL(dbg_sb, dim3(1), dim3(64), 0, stream, W8);
    hipLaunchKernelGGL(dbg_dsa, dim3(16), dim3(512), 0, stream, W8);
    hipLaunchKernelGGL(dbg_gla, dim3(4), dim3(512), 0, stream, p[I_GUP], p[I_GB], p[I_GNG], W8);
    hipLaunchKernelGGL(dbg_kv, dim3(64), dim3(512), 0, stream, p[I_MEM], p[I_MG], p[I_WXKV], W8, 26);
    MK_LAUNCH(6, 7);
    hipLaunchKernelGGL(dbg_merge, dim3(64), dim3(512), 0, stream, p[I_WBA], p[I_WBB], p[I_WBC], W8);
    MK_LAUNCH(7, 8);
    hipLaunchKernelGGL(dbg_resid, dim3(64), dim3(512), 0, stream, p[I_X], 0, p[I_WMIX], 1024, (size_t)WS_MERGED, (const float*)d_out, W8, 22, 0);
    MK_LAUNCH(8, 9);
    hipLaunchKernelGGL(dbg_normproj, dim3(64), dim3(512), 0, stream, (const float*)d_out, p[I_XG], p[I_WXQ], 0, W8, 25);
    MK_LAUNCH(9, 10);
    hipLaunchKernelGGL(dbg_xattn, dim3(64), dim3(512), 0, stream, W8, 28);
    MK_LAUNCH(10, 11);
    hipLaunchKernelGGL(dbg_resid, dim3(64), dim3(512), 0, stream, (const float*)((char*)d_ws + WS_DBGCK), 1, p[I_WXO], 1024, (size_t)WS_AO, (const float*)d_out, W8, 29, 1);
    MK_LAUNCH(11, 12);
    hipLaunchKernelGGL(dbg_normproj, dim3(64), dim3(512), 0, stream, (const float*)d_out, p[I_FG], p[I_WFI], 1, W8, 32);
    MK_LAUNCH(12, 13);
    hipLaunchKernelGGL(dbg_resid, dim3(64), dim3(512), 0, stream, (const float*)((char*)d_ws + WS_DBGCK) + 64 * 1024, 1, p[I_WFO], DFF, (size_t)WS_HID, (const float*)d_out, W8, 33, 0);
    hipLaunchKernelGGL(dbg_encode, dim3(1024), dim3(256), 0, stream, W8, (float*)d_out, 35);
#elif N_LAUNCH_MODE == 1
    MK_LAUNCH(0, N_PHASES);
#else
    for (int ph = 0; ph < N_PHASES; ++ph) MK_LAUNCH(ph, ph + 1);
#endif
}
```

```cpp
#include <hip/hip_runtime.h>
#include <stdint.h>
#include <stdio.h>

#define LAS __attribute__((address_space(3)))
typedef unsigned short bf16_t;
typedef short bf16x8 __attribute__((ext_vector_type(8)));
typedef float f32x4 __attribute__((ext_vector_type(4)));
typedef float f32x2 __attribute__((ext_vector_type(2)));
typedef unsigned u32x4 __attribute__((ext_vector_type(4)));
typedef unsigned u32x2 __attribute__((ext_vector_type(2)));
typedef short s16x4 __attribute__((ext_vector_type(4)));

#ifndef DBG_MODE
#define DBG_MODE 0
#endif
#ifndef STAMP_A
#define STAMP_A 0
#endif
#define STAMP_MUL 4
#ifndef ONLY
#define ONLY -1
#endif
#define PH_EN(k) (ONLY < 0 || ONLY == (k))
#ifndef N_LAUNCH_MODE
#define N_LAUNCH_MODE 1
#endif

constexpr int S_ = 16384, D_ = 1024, NIN = 5376, INW = 5332, DFF = 2816, NFF = 5632, NMEM = 256, DEPTH = 4;
constexpr int NTHREADS = 512;
constexpr int LDS_BYTES = 147456;
constexpr int MISC_OFF = 143360;
constexpr float EPS = 1e-6f;
constexpr float LOG2E = 1.4426950408889634f;
constexpr float SBQ_SCALE = 0.125f * LOG2E;
constexpr float DSQ_SCALE = 0.125f * LOG2E;
constexpr float IXQ_SCALE = 0.125f;
constexpr float GLQ_SCALE = 0.17677669529663687f;
constexpr float XQ_SCALE = 0.0625f * LOG2E;

constexpr size_t MB = 1u << 20;
constexpr size_t WS_CTL = 0;
constexpr size_t WS_CS = 65536;
constexpr size_t WS_SSQ = WS_CS + 4 * MB;
constexpr size_t WS_MEMB = WS_SSQ + 1 * MB;
constexpr size_t WS_RSTDM = WS_MEMB + 512 * 1024;
constexpr size_t WS_KM = WS_RSTDM + 4096;
constexpr size_t WS_VMT = WS_KM + 512 * 1024;
constexpr size_t WS_WIN = WS_VMT + 512 * 1024;
constexpr size_t WS_WBR = WS_WIN + (size_t)NIN * 1024 * 2;
constexpr size_t WS_WMIX = WS_WBR + 3 * 1024 * 256 * 2;
constexpr size_t WS_WXQ = WS_WMIX + 2 * MB;
constexpr size_t WS_WXKV = WS_WXQ + 2 * MB;
constexpr size_t WS_WXO = WS_WXKV + 4 * MB;
constexpr size_t WS_WFI = WS_WXO + 2 * MB;
constexpr size_t WS_WFO = WS_WFI + (size_t)NFF * 1024 * 2;
constexpr size_t WS_XB = WS_WFO + (size_t)1024 * DFF * 2;
constexpr size_t WS_SBQ = WS_XB + 32 * MB;
constexpr size_t WS_SBK = WS_SBQ + 8 * MB;
constexpr size_t WS_SBV = WS_SBK + 8 * MB;
constexpr size_t WS_DSQ = WS_SBV + 8 * MB;
constexpr size_t WS_IXQ = WS_DSQ + 8 * MB;
constexpr size_t WS_DSK = WS_IXQ + 8 * MB;
constexpr size_t WS_IXK = WS_DSK + 2 * MB;
constexpr size_t WS_DSV = WS_IXK + 2 * MB;
constexpr size_t WS_SMALL = WS_DSV + 2 * MB;
constexpr size_t WS_GLQ = WS_SMALL + 4 * MB;
constexpr size_t WS_GLK = WS_GLQ + 4 * MB;
constexpr size_t WS_GLV = WS_GLK + 4 * MB;
constexpr size_t WS_GLO = WS_GLV + 8 * MB;
constexpr size_t WS_OA = WS_GLO + 8 * MB;
constexpr size_t WS_OB = WS_OA + 8 * MB;
constexpr size_t WS_OC = WS_OB + 8 * MB;
constexpr size_t WS_BC = WS_OC + 8 * MB;
constexpr size_t WS_UC = WS_BC + 8 * MB;
constexpr size_t WS_ST = WS_UC + 8 * MB;
constexpr size_t WS_AC = WS_ST + 8 * MB;
constexpr size_t WS_SBVT = WS_AC + 128 * 1024;
constexpr size_t WS_GLVT = WS_SBVT + 8 * MB;
constexpr size_t WS_MERGED = WS_GLVT + 8 * MB;
constexpr size_t WS_GATES = WS_MERGED + 32 * MB;
constexpr size_t WS_XQ = WS_GATES;
constexpr size_t WS_AO = WS_GATES + 32 * MB;
constexpr size_t WS_HID = WS_GATES;
constexpr size_t WS_END = WS_GATES + 96 * MB;
constexpr size_t WS_DBG = WS_END;
constexpr size_t WS_DBGSEL = WS_DBG + 65536;
constexpr size_t WS_DBGEND = WS_DBGSEL + 8 * MB;
constexpr size_t CTL_ZERO_BYTES = 65536;
constexpr int CW_BAR = 0;
constexpr int CW_QUEUE = 4096;

typedef __bf16 bf16x2_t __attribute__((ext_vector_type(2)));
__device__ __forceinline__ unsigned cvt_pk_bf16(float lo, float hi) { const f32x2 v = {lo, hi}; return __builtin_bit_cast(unsigned, __builtin_convertvector(v, bf16x2_t)); }
__device__ __forceinline__ bf16_t f2bf(float f) { return (bf16_t)(cvt_pk_bf16(f, 0.f) & 0xffffu); }
__device__ __forceinline__ float bf2f(unsigned b) { return __uint_as_float(b << 16); }
__device__ __forceinline__ float bflo(unsigned w) { return __uint_as_float(w << 16); }
__device__ __forceinline__ float bfhi(unsigned w) { return __uint_as_float(w & 0xffff0000u); }
__device__ __forceinline__ void st_bf16x8(bf16_t* p, const float (&v)[8]) {
    u32x4 w; w.x = cvt_pk_bf16(v[0], v[1]); w.y = cvt_pk_bf16(v[2], v[3]); w.z = cvt_pk_bf16(v[4], v[5]); w.w = cvt_pk_bf16(v[6], v[7]); *(u32x4*)p = w; }
__device__ __forceinline__ void ld_bf16x8(const bf16_t* p, float (&v)[8]) {
    const u32x4 w = *(const u32x4*)p; v[0] = bflo(w.x); v[1] = bfhi(w.x); v[2] = bflo(w.y); v[3] = bfhi(w.y); v[4] = bflo(w.z); v[5] = bfhi(w.z); v[6] = bflo(w.w); v[7] = bfhi(w.w); }
__device__ __forceinline__ float row_rstd(const float* ssq, int r) {
    const f32x4* p = (const f32x4*)(ssq + (size_t)r * 16); const f32x4 a = p[0], b = p[1], c = p[2], d = p[3];
    const float s = ((a.x + a.y) + (a.z + a.w)) + ((b.x + b.y) + (b.z + b.w)) + ((c.x + c.y) + (c.z + c.w)) + ((d.x + d.y) + (d.z + d.w));
    return rsqrtf(s * (1.0f / 1024.0f) + EPS); }
__device__ __forceinline__ float sigmoidf_(float v) { return __builtin_amdgcn_rcpf(1.0f + __builtin_amdgcn_exp2f(-v * LOG2E)); }
__device__ __forceinline__ float shx(float v, int m, int lane) { return __int_as_float(__builtin_amdgcn_ds_bpermute((lane ^ m) << 2, __float_as_int(v))); }
__device__ __forceinline__ unsigned shdn(unsigned v, int off, int lane) { return (unsigned)__builtin_amdgcn_ds_bpermute((lane + off) << 2, (int)v); }
__device__ __forceinline__ float wave_sum(float v, int lane) { for (int o = 32; o >= 1; o >>= 1) v += shx(v, o, lane); return v; }
__device__ __forceinline__ float wave_max(float v, int lane) { for (int o = 32; o >= 1; o >>= 1) v = fmaxf(v, shx(v, o, lane)); return v; }

__device__ __forceinline__ int mytid(int wave) { int lane; asm volatile("v_mbcnt_lo_u32_b32 %0, -1, 0\n\tv_mbcnt_hi_u32_b32 %0, -1, %0" : "=v"(lane)); asm volatile("" : "+s"(wave)); return wave * 64 + lane; }

#define XB_TMO      128
#define XB_XCNT(j)  (256  + 64 * (j))
#define XB_XSUB(j)  (1280 + 64 * (j))
#define XB_XGEN(j)  (2304 + 64 * (j))
#define XB_TOP      3328
#define XB_TOPGEN   3392
#define XCD_BAR_WORDS 3456
#define XB_SPIN_CAP (1u << 22)
__device__ __forceinline__ unsigned xb_ld(unsigned* p)              { return __hip_atomic_load(p, __ATOMIC_RELAXED, __HIP_MEMORY_SCOPE_AGENT); }
__device__ __forceinline__ unsigned xb_add(unsigned* p, unsigned v) { return __hip_atomic_fetch_add(p, v, __ATOMIC_RELAXED, __HIP_MEMORY_SCOPE_AGENT); }
__device__ __forceinline__ unsigned xb_xcc_id() { return (unsigned)__builtin_amdgcn_s_getreg((3 << 11) | 20) & 0xFu; }
#define XB_SPIN(cond, bar) do { unsigned _sp = 0; while (cond) { __builtin_amdgcn_s_sleep(1); \
    if ((++_sp & 255u) == 0u) { if (xb_ld(&(bar)[XB_TMO])) break; if (_sp > XB_SPIN_CAP) { atomicAdd(&(bar)[XB_TMO], 1u); break; } } } } while (0)
struct XcdBarrier { unsigned* bar; unsigned x; volatile LAS unsigned* st; };
__device__ __forceinline__ XcdBarrier xcd_barrier_post(unsigned* bar, volatile LAS unsigned* st, int wave_s) {
    XcdBarrier b; b.bar = bar; b.x = xb_xcc_id(); b.st = st;
    if (mytid(wave_s) == 0) (void)xb_add(&bar[XB_XCNT(b.x)], 1u);
    return b;
}
__device__ __forceinline__ void xcd_barrier_complete(unsigned* bar, unsigned x, unsigned& nloc, unsigned& nx) {
    const unsigned G = gridDim.x * gridDim.y * gridDim.z;
    unsigned sum, cnt, mine, sp = 0u;
    for (;;) {
        sum = 0u; cnt = 0u; mine = 0u;
#pragma unroll
        for (unsigned j = 0; j < 16; ++j) { const unsigned c = xb_ld(&bar[XB_XCNT(j)]); sum += c; cnt += (c > 0u) ? 1u : 0u; mine = (j == x) ? c : mine; }
        if (sum == G) break;
        __builtin_amdgcn_s_sleep(1);
        if ((++sp & 255u) == 0u) { if (xb_ld(&bar[XB_TMO])) break; if (sp > XB_SPIN_CAP) { atomicAdd(&bar[XB_TMO], 1u); break; } }
    }
    nloc = mine > 0u ? mine : 1u; nx = cnt > 0u ? cnt : 1u;
}
__device__ __forceinline__ void xcd_barrier(const XcdBarrier& b, int wave_s) {
    asm volatile("s_waitcnt vmcnt(0)" ::: "memory");
    __syncthreads();
    if (mytid(wave_s) == 0) {
        unsigned* bar = b.bar;
        __builtin_amdgcn_s_waitcnt(0);
        unsigned nloc = b.st[0], nx = b.st[1];
        if (nloc == 0u) { xcd_barrier_complete(bar, b.x, nloc, nx); b.st[0] = nloc; b.st[1] = nx; }
        const unsigned old = xb_add(&bar[XB_XSUB(b.x)], 1u);
        const unsigned gen = old / nloc;
        if (old + 1u == (gen + 1u) * nloc) {
            __builtin_amdgcn_fence(__ATOMIC_RELEASE, "agent");
            asm volatile("s_waitcnt vmcnt(0)" ::: "memory");
            const unsigned og = xb_add(&bar[XB_TOP], 1u);
            const unsigned tg = og / nx;
            if (og + 1u == (tg + 1u) * nx) xb_add(&bar[XB_TOPGEN], 1u);
            else XB_SPIN(xb_ld(&bar[XB_TOPGEN]) == tg, bar);
            __builtin_amdgcn_fence(__ATOMIC_ACQUIRE, "agent");
            xb_add(&bar[XB_XGEN(b.x)], 1u);
            asm volatile("s_waitcnt vmcnt(0)" ::: "memory");
        } else {
            XB_SPIN(xb_ld(&bar[XB_XGEN(b.x)]) == gen, bar);
            __builtin_amdgcn_fence(__ATOMIC_ACQUIRE, "agent");
            asm volatile("s_waitcnt vmcnt(0)" ::: "memory");
        }
    }
    __syncthreads();
}

#if DBG_MODE == 3
#define TICKR(ring_, wave_, i) do { if (blockIdx.x == 0 && mytid(wave_) == 0) { volatile LAS unsigned long long* _a = (volatile LAS unsigned long long*)((ring_) + MISC_OFF + 2560); const unsigned long long _n = __builtin_amdgcn_s_memrealtime(); if ((i) > 0) _a[(i)] += _n - _a[0]; _a[0] = _n; } } while (0)
#else
#define TICKR(ring_, wave_, i) do { } while (0)
#endif
namespace pg8 {
constexpr int BM = 256, BK = 64, HALF = 128, HTB = HALF * BK * 2, STAGE_BYTES = 8 * HTB, NXCD = 8, WGM = 8;
__host__ __device__ __forceinline__ int lds_byte(int r, int c) { const int st = (r >> 4) * 2 + (c >> 5), rr = r & 15, cc = c & 31, ob = rr * 64 + cc * 2; return st * 1024 + (ob ^ (((ob >> 9) & 1) << 5)); }
__host__ __device__ __forceinline__ void stage_rc(int b, int& R, int& C) { const int st = b / 1024, sb = b % 1024, swz = sb ^ (((sb >> 9) & 1) << 5); R = (st >> 1) * 16 + swz / 64; C = (st & 1) * 32 + (swz % 64) / 2; }
__host__ __device__ __forceinline__ int perm32(int rho) { const int n = rho >> 4, i = rho & 15; return 8 * (i >> 2) + 4 * n + (i & 3); }
struct Unit { int pm, pn, z; };
struct Gemm { const bf16_t* A; const bf16_t* Bt; int M, N, K; size_t azstep, bzstep; };
struct StaticOrder {
    int nM, nN, nwg, G, c;
    __host__ __device__ void init(int M, int N, int G_, int c_) { nM = M / BM; nN = N / BM; nwg = nM * nN; G = G_; c = c_; }
    __host__ __device__ bool next(int i, Unit& u) const {
        const long L = (long)i * G + c; if (L >= nwg) return false;
        int wgid = (int)L; { const int q = nwg / NXCD, r = nwg % NXCD, xcd = wgid % NXCD, off = wgid / NXCD; wgid = (xcd < r ? xcd * (q + 1) : r * (q + 1) + (xcd - r) * q) + off; }
        const int nig = WGM * nN, gid = wgid / nig, fm = gid * WGM, gsz = (nM - fm) < WGM ? (nM - fm) : WGM;
        u.pm = fm + ((wgid % nig) % gsz); u.pn = (wgid % nig) / gsz; u.z = 0; return true;
    }
    __device__ __forceinline__ void a_ready(const Unit&) const {}
    __device__ __forceinline__ void done(const Unit&) const {}
};
struct TripleOrder : StaticOrder {
    __host__ __device__ bool next(int i, Unit& u) const { const int b = i / 3; if (!StaticOrder::next(b, u)) return false; u.z = i - 3 * b; return true; }
};
template <class Epi, class Sched>
__device__ __forceinline__ void gemm_phase(LAS unsigned char* lds, const Gemm g, const Sched& S, const Epi& E, int wave_s) {
    const int tid_l = mytid(wave_s);
    const int tid = tid_l, wid = __builtin_amdgcn_readfirstlane(tid >> 6), lane = tid & 63, wr = wid >> 2, wc = wid & 3, fr = lane & 15, fq = lane >> 4;
    const int K = g.K, nt = K / BK;
    unsigned voffA[2], voffB[2];
#pragma unroll
    for (int i = 0; i < 2; ++i) { int R, C; stage_rc(tid * 16 + i * 8192, R, C); const int Rb = Epi::PERM ? ((R & ~31) + perm32(R & 31)) : R;
        voffA[i] = (unsigned)(R * K + C) * 2u; voffB[i] = (unsigned)(Rb * K + C) * 2u; }
    const size_t kstep = (size_t)(BK * 2);
    const size_t hstep = (size_t)HALF * K * 2;
    const size_t tstep = 2 * hstep;
    const unsigned ldsw = (unsigned)wid * 1024u;
    const int aoff = lds_byte(wr * 64 + fr, fq * 8), boff = lds_byte(wc * 32 + fr, fq * 8);
#define PG8_SA(b, h) (((b) * 2 + (h)) * HTB)
#define PG8_SB(b, h) ((4 + (b) * 2 + (h)) * HTB)
#define PG8_STAGE(bufoff, gbase, voff) do { _Pragma("unroll") for (int _i = 0; _i < 2; ++_i) \
        __builtin_amdgcn_global_load_lds((const unsigned*)((const char*)(gbase) + (voff)[_i]), (LAS unsigned*)(lds + (bufoff) + ldsw + _i * 8192), 16, 0, 0); } while (0)
#define PG8_LDA(dst, b, h) do { _Pragma("unroll") for (int m = 0; m < 4; ++m) _Pragma("unroll") for (int k = 0; k < 2; ++k) dst[m][k] = *(const LAS bf16x8*)(lds + PG8_SA(b, h) + aoff + m * 2048 + k * 1024); } while (0)
#define PG8_LDB(dst, b, h) do { _Pragma("unroll") for (int n = 0; n < 2; ++n) _Pragma("unroll") for (int k = 0; k < 2; ++k) dst[n][k] = *(const LAS bf16x8*)(lds + PG8_SB(b, h) + boff + n * 2048 + k * 1024); } while (0)
#define PG8_MMA(ai, bj, At, Bt) do { __builtin_amdgcn_s_setprio(1); _Pragma("unroll") for (int m = 0; m < 4; ++m) _Pragma("unroll") for (int n = 0; n < 2; ++n) _Pragma("unroll") for (int k = 0; k < 2; ++k) \
        acc[ai][bj][m][n] = __builtin_amdgcn_mfma_f32_16x16x32_bf16(Bt[n][k], At[m][k], acc[ai][bj][m][n], 0, 0, 0); __builtin_amdgcn_s_setprio(0); } while (0)
#define PG8_WAIT_V(n) asm volatile("s_waitcnt vmcnt(" #n ")" ::: "memory")
#define PG8_WAIT_L(n) asm volatile("s_waitcnt lgkmcnt(" #n ")" ::: "memory")
#define PG8_BAR __builtin_amdgcn_s_barrier()
#define PG8_SCHED __builtin_amdgcn_sched_barrier(0)
    Unit cur, nxt; int ui = 0;
    if (!S.next(0, cur)) return;
    TICKR(lds, wave_s, 0);
#if DBG_MODE == 3
    if (blockIdx.x == 0 && mytid(wave_s) == 0) ((volatile LAS unsigned long long*)(lds + MISC_OFF + 2560))[11] = clock64();
#endif
    cur.pm = __builtin_amdgcn_readfirstlane(cur.pm); cur.pn = __builtin_amdgcn_readfirstlane(cur.pn); cur.z = __builtin_amdgcn_readfirstlane(cur.z);
    f32x4 acc[2][2][4][2];
#pragma unroll
    for (int a = 0; a < 2; ++a)
#pragma unroll
        for (int b = 0; b < 2; ++b)
#pragma unroll
            for (int m = 0; m < 4; ++m)
#pragma unroll
                for (int n = 0; n < 2; ++n) acc[a][b][m][n] = (f32x4){0.f, 0.f, 0.f, 0.f};
    bf16x8 At[4][2], B0[2][2], B1[2][2];
    const char* cA = (const char*)g.A + (size_t)cur.pm * tstep + (size_t)cur.z * g.azstep; const char* cB = (const char*)g.Bt + (size_t)cur.pn * tstep + (size_t)cur.z * g.bzstep;
    S.a_ready(cur);
    PG8_STAGE(PG8_SB(0, 0), cB, voffB); PG8_STAGE(PG8_SA(0, 0), cA, voffA); PG8_STAGE(PG8_SB(0, 1), cB + hstep, voffB); PG8_STAGE(PG8_SA(0, 1), cA + hstep, voffA);
    if (wr == 1) PG8_BAR;
    PG8_WAIT_V(4); PG8_BAR;
    PG8_STAGE(PG8_SB(1, 0), cB + kstep, voffB); PG8_STAGE(PG8_SA(1, 0), cA + kstep, voffA); PG8_STAGE(PG8_SB(1, 1), cB + hstep + kstep, voffB);
    PG8_WAIT_V(6); PG8_BAR;
    for (;;) {
        const bool has_next = S.next(ui + 1, nxt);
        nxt.pm = __builtin_amdgcn_readfirstlane(nxt.pm); nxt.pn = __builtin_amdgcn_readfirstlane(nxt.pn); nxt.z = __builtin_amdgcn_readfirstlane(nxt.z);
        const char* nA = has_next ? (const char*)g.A + (size_t)nxt.pm * tstep + (size_t)nxt.z * g.azstep : cA; const char* nB = has_next ? (const char*)g.Bt + (size_t)nxt.pn * tstep + (size_t)nxt.z * g.bzstep : cB;
        for (int t = 0; t < nt; t += 2) {
            const bool last = (t == nt - 2);
            const char* a1 = cA + (size_t)(t + 1) * kstep;
            const char* a2 = last ? nA : cA + (size_t)(t + 2) * kstep; const char* b2 = last ? nB : cB + (size_t)(t + 2) * kstep;
            const char* a3 = a2 + kstep; const char* b3 = b2 + kstep;
            if (last && has_next) S.a_ready(nxt);
            PG8_LDB(B0, 0, 0); PG8_SCHED; PG8_LDA(At, 0, 0); PG8_STAGE(PG8_SA(1, 1), a1 + hstep, voffA);
            PG8_WAIT_L(8); PG8_BAR; PG8_WAIT_L(0); PG8_MMA(0, 0, At, B0); PG8_BAR; PG8_SCHED;
            PG8_LDB(B1, 0, 1); PG8_STAGE(PG8_SB(0, 0), b2, voffB);
            PG8_BAR; PG8_WAIT_L(0); PG8_MMA(0, 1, At, B1); PG8_BAR;
            PG8_LDA(At, 0, 1); PG8_STAGE(PG8_SA(0, 0), a2, voffA);
            PG8_BAR; PG8_WAIT_L(0); PG8_MMA(1, 0, At, B0); PG8_BAR; PG8_SCHED;
            PG8_STAGE(PG8_SB(0, 1), b2 + hstep, voffB);
            PG8_WAIT_V(6); PG8_BAR; PG8_MMA(1, 1, At, B1); PG8_BAR;
            PG8_LDB(B0, 1, 0); PG8_SCHED; PG8_LDA(At, 1, 0); PG8_STAGE(PG8_SA(0, 1), a2 + hstep, voffA);
            PG8_WAIT_L(8); PG8_BAR; PG8_WAIT_L(0); PG8_MMA(0, 0, At, B0); PG8_BAR; PG8_SCHED;
            PG8_LDB(B1, 1, 1); PG8_STAGE(PG8_SB(1, 0), b3, voffB);
            PG8_BAR; PG8_WAIT_L(0); PG8_MMA(0, 1, At, B1); PG8_BAR;
            PG8_LDA(At, 1, 1); PG8_STAGE(PG8_SA(1, 0), a3, voffA);
            PG8_BAR; PG8_WAIT_L(0); PG8_MMA(1, 0, At, B0); PG8_BAR; PG8_SCHED;
            PG8_STAGE(PG8_SB(1, 1), b3 + hstep, voffB);
            PG8_WAIT_V(6); PG8_BAR; PG8_MMA(1, 1, At, B1); PG8_BAR;
        }
        TICKR(lds, wave_s, 8);
#if DBG_MODE == 3
        if (blockIdx.x == 0 && mytid(wave_s) == 0) { volatile LAS unsigned long long* _a = (volatile LAS unsigned long long*)(lds + MISC_OFF + 2560); const unsigned long long _c = clock64(); _a[10] += _c - _a[11]; }
#endif
        { const int l2 = mytid(wave_s) & 63; E(acc, cur, wr, wc, l2 >> 2, l2 & 3); }
        TICKR(lds, wave_s, 9);
#if DBG_MODE == 3
        if (blockIdx.x == 0 && mytid(wave_s) == 0) ((volatile LAS unsigned long long*)(lds + MISC_OFF + 2560))[11] = clock64();
#endif
        if (!has_next) break;
#pragma unroll
        for (int a = 0; a < 2; ++a)
#pragma unroll
            for (int b = 0; b < 2; ++b)
#pragma unroll
                for (int m = 0; m < 4; ++m)
#pragma unroll
                    for (int n = 0; n < 2; ++n) acc[a][b][m][n] = (f32x4){0.f, 0.f, 0.f, 0.f};
        cur = nxt; cA = nA; cB = nB; ++ui;
    }
    PG8_WAIT_V(0);
    if (wr == 0) PG8_BAR;
    PG8_BAR;
#undef PG8_SA
#undef PG8_SB
#undef PG8_STAGE
#undef PG8_LDA
#undef PG8_LDB
#undef PG8_MMA
#undef PG8_WAIT_V
#undef PG8_WAIT_L
#undef PG8_BAR
#undef PG8_SCHED
}
}

#define GAS __attribute__((address_space(1)))
struct Args { float* out; unsigned char* ws; LAS unsigned char* ring; int wave; };
__device__ __forceinline__ unsigned char* opq(unsigned char* p) { unsigned z = 0; asm volatile("" : "+s"(z)); return p + z; }
__device__ __forceinline__ int obid() { int b = blockIdx.x; asm volatile("" : "+s"(b)); return b; }
__device__ __forceinline__ int ogrid() { int b = gridDim.x; asm volatile("" : "+s"(b)); return b; }
constexpr int ARGV_OFF = MISC_OFF + 3072;
__device__ __forceinline__ const GAS float* ldarg(const Args& A, int i) {
    volatile LAS unsigned* p = (volatile LAS unsigned*)(A.ring + ARGV_OFF) + 2 * i; unsigned lo = p[0], hi = p[1];
    lo = __builtin_amdgcn_readfirstlane(lo); hi = __builtin_amdgcn_readfirstlane(hi);
    return (const GAS float*)(((unsigned long long)hi << 32) | lo); }
#if DBG_MODE == 3
#define TICK(A_, i) do { if (obid() == 0 && mytid((A_).wave) == 0) { volatile LAS unsigned long long* _a = (volatile LAS unsigned long long*)((A_).ring + MISC_OFF + 2560); const unsigned long long _n = __builtin_amdgcn_s_memrealtime(); if ((i) > 0) _a[(i)] += _n - _a[0]; _a[0] = _n; } } while (0)
#else
#define TICK(A_, i) do { } while (0)
#endif
enum { I_X = 0, I_MEM, I_MIXG, I_WIN, I_GUP, I_GB, I_GNG, I_WBA, I_WBB, I_WBC, I_WMIX, I_XG, I_MG, I_WXQ, I_WXKV, I_WXO, I_FG, I_WFI, I_WFO, I_FING };

typedef const f32x4 (&AccRef)[2][2][4][2];
#define EPI_XPOSE(a_, b_) do { const int xa_ = (fq * 16 + fr) << 2; _Pragma("unroll") for (int i = 0; i < 8; ++i) { a_[i] = __int_as_float(__builtin_amdgcn_ds_bpermute(xa_, __float_as_int(a_[i]))); b_[i] = __int_as_float(__builtin_amdgcn_ds_bpermute(xa_, __float_as_int(b_[i]))); } } while (0)
#define EPI_ROWS_BEGIN _Pragma("unroll") for (int ai = 0; ai < 2; ++ai) _Pragma("unroll") for (int m = 0; m < 4; ++m) { \
    const int r = u.pm * 256 + ai * 128 + wr * 64 + m * 16 + fr; float a[8], b[8]; \
    _Pragma("unroll") for (int i = 0; i < 8; ++i) { a[i] = acc[ai][0][m][i >> 2][i & 3]; b[i] = acc[ai][1][m][i >> 2][i & 3]; } EPI_XPOSE(a, b);
#define EPI_ROWS_END asm volatile("" ::: "memory"); }

#define EPI_AB(ai_, m_) float a[8], b[8]; _Pragma("unroll") for (int i = 0; i < 8; ++i) { a[i] = acc[ai_][0][m_][i >> 2][i & 3]; b[i] = acc[ai_][1][m_][i >> 2][i & 3]; } EPI_XPOSE(a, b);
#define EPI_ROWOF(ai_, m_) (u.pm * 256 + (ai_) * 128 + wr * 64 + (m_) * 16 + fr)
#define EPI_RSTD4(ssq_, ai_, rs_) do { f32x4 q_[4]; _Pragma("unroll") for (int m = 0; m < 4; ++m) q_[m] = *(const f32x4*)((ssq_) + (size_t)EPI_ROWOF(ai_, m) * 16 + 4 * fq);        \
    _Pragma("unroll") for (int m = 0; m < 4; ++m) { float t_ = (q_[m].x + q_[m].y) + (q_[m].z + q_[m].w); t_ += shx(t_, 1, 4 * fr + fq); t_ += shx(t_, 2, 4 * fr + fq); rs_[m] = rsqrtf(t_ * (1.0f / 1024.0f) + EPS); } } while (0)
#define EPI_AB0(ai_, m_) float a[8], b[8]; _Pragma("unroll") for (int i = 0; i < 8; ++i) { a[i] = acc[ai_][0][m_][i >> 2][i & 3]; b[i] = acc[ai_][1][m_][i >> 2][i & 3]; }
#define EPI_RS_ORIG(rs_, rso_) do { const int ra_ = (4 * ((4 * fr + fq) & 15)) << 2; _Pragma("unroll") for (int m = 0; m < 4; ++m) rso_[m] = __int_as_float(__builtin_amdgcn_ds_bpermute(ra_, __float_as_int(rs_[m]))); } while (0)
__device__ __forceinline__ void st_bf16x8_x(bf16_t* p, const float (&v)[8], int xa) {
    u32x4 w; w.x = (unsigned)__builtin_amdgcn_ds_bpermute(xa, (int)cvt_pk_bf16(v[0], v[1])); w.y = (unsigned)__builtin_amdgcn_ds_bpermute(xa, (int)cvt_pk_bf16(v[2], v[3]));
    w.z = (unsigned)__builtin_amdgcn_ds_bpermute(xa, (int)cvt_pk_bf16(v[4], v[5])); w.w = (unsigned)__builtin_amdgcn_ds_bpermute(xa, (int)cvt_pk_bf16(v[6], v[7])); *(u32x4*)p = w; }
struct EpiIn {
    static constexpr bool PERM = true;
    const float* ssq; const float* cs;
    bf16_t *sbq, *sbk, *sbv, *dsq, *ixq, *dsk, *ixk, *dsv, *glq, *glk, *glv, *glo, *gates; float* small; bf16_t* sbvt; int pn_off; bf16_t* glvt;
    __device__ __forceinline__ void operator()(AccRef acc, const pg8::Unit& u, int wr, int wc, int fr, int fq) const {
        const int pn = u.pn + pn_off;
        int mode = 0, ld = 256, off0 = wc * 32, off1 = 128 + wc * 32; float sc0 = 1.0f, sc1 = 1.0f; bf16_t* O0 = sbq; bf16_t* O1 = sbq;
        if (pn == 0) { O0 = O1 = sbq; sc0 = sc1 = SBQ_SCALE; }
        else if (pn == 1) { O0 = O1 = sbk; }
        else if (pn == 2) { O0 = O1 = sbv; }
        else if (pn == 3) { O0 = O1 = dsq; mode = 1; sc0 = sc1 = DSQ_SCALE; off0 = wc * 64; off1 = wc * 64 + 32; }
        else if (pn == 4) { O0 = O1 = ixq; mode = 1; sc0 = sc1 = IXQ_SCALE; off0 = wc * 64; off1 = wc * 64 + 32; }
        else if (pn == 5) { ld = 64; off0 = 0; off1 = 32;
            if (wc == 0) { O0 = O1 = dsk; mode = 1; } else if (wc == 1) { O0 = O1 = ixk; mode = 1; } else if (wc == 2) { O0 = O1 = dsv; } else { O0 = O1 = (bf16_t*)small; mode = 4; } }
        else if (pn == 6) { O0 = glq; O1 = glk; ld = 128; off1 = wc * 32; sc0 = GLQ_SCALE; }
        else if (pn == 7) { O0 = O1 = glv; }
        else if (pn == 8) { O0 = O1 = glo; mode = 2; }
        else { O0 = O1 = gates + (pn - 9) * 256; ld = 3072; mode = 3; }
        if (mode == 1 || mode == 4) {
#pragma unroll
        for (int ai = 0; ai < 2; ++ai) {
            float rs4[4]; EPI_RSTD4(ssq, ai, rs4);
#pragma unroll
            for (int m = 0; m < 4; ++m) { const int r = EPI_ROWOF(ai, m); EPI_AB(ai, m)
                const float rs = rs4[m];
#pragma unroll
                for (int i = 0; i < 8; ++i) { a[i] *= rs * sc0; b[i] *= rs * sc1; }
                if (mode == 1) {
                    const f32x4* cp = (const f32x4*)(cs + ((size_t)r * 32 + fq * 8) * 2);
#pragma unroll
                    for (int i2 = 0; i2 < 4; ++i2) { const f32x4 q = cp[i2];
                        const float a0 = a[2 * i2], b0 = b[2 * i2], a1 = a[2 * i2 + 1], b1 = b[2 * i2 + 1];
                        a[2 * i2] = a0 * q.x - b0 * q.y; b[2 * i2] = b0 * q.x + a0 * q.y; a[2 * i2 + 1] = a1 * q.z - b1 * q.w; b[2 * i2 + 1] = b1 * q.z + a1 * q.w; }
                }
                if (mode == 4) { float* p = (float*)O0 + (size_t)r * 64 + fq * 8;
                    *(f32x4*)p = (f32x4){a[0], a[1], a[2], a[3]}; *(f32x4*)(p + 4) = (f32x4){a[4], a[5], a[6], a[7]};
                    *(f32x4*)(p + 32) = (f32x4){b[0], b[1], b[2], b[3]}; *(f32x4*)(p + 36) = (f32x4){b[4], b[5], b[6], b[7]}; }
                else { st_bf16x8(O0 + (size_t)r * ld + off0 + fq * 8, a); st_bf16x8(O1 + (size_t)r * ld + off1 + fq * 8, b); }
            }
            asm volatile("" ::: "memory");
        }
        } else {
        const int xa = (fq * 16 + fr) << 2;
#pragma unroll
        for (int ai = 0; ai < 2; ++ai) {
            float rs4[4], rso[4]; EPI_RSTD4(ssq, ai, rs4); EPI_RS_ORIG(rs4, rso);
#pragma unroll
            for (int m = 0; m < 4; ++m) { const int r = EPI_ROWOF(ai, m); EPI_AB0(ai, m)
                const float rs = rso[m];
#pragma unroll
                for (int i = 0; i < 8; ++i) { a[i] *= rs * sc0; b[i] *= rs * sc1; }
                if (mode == 2) {
#pragma unroll
                    for (int i = 0; i < 8; ++i) { a[i] = a[i] * sigmoidf_(a[i]); b[i] = b[i] * sigmoidf_(b[i]); }
                } else if (mode == 3) {
#pragma unroll
                    for (int i = 0; i < 8; ++i) { a[i] = sigmoidf_(a[i]); b[i] = sigmoidf_(b[i]); }
                }
                st_bf16x8_x(O0 + (size_t)r * ld + off0 + fq * 8, a, xa); st_bf16x8_x(O1 + (size_t)r * ld + off1 + fq * 8, b, xa);
            }
            asm volatile("" ::: "memory");
        }
        }
    }
};
struct EpiKV {
    static constexpr bool PERM = true;
    const float* rstdm; bf16_t* km; bf16_t* vmt;
    __device__ __forceinline__ void operator()(AccRef acc, const pg8::Unit& u, int wr, int wc, int fr, int fq) const {
        const int c8 = wc * 32 + fq * 8, pn = u.pn;
        EPI_ROWS_BEGIN
            const float rs = rstdm[r];
#pragma unroll
            for (int i = 0; i < 8; ++i) { a[i] *= rs; b[i] *= rs; }
            if (pn < 4) { st_bf16x8(km + (size_t)r * 1024 + pn * 256 + c8, a); st_bf16x8(km + (size_t)r * 1024 + pn * 256 + 128 + c8, b); }
            else {
                const int pos = (r & ~31) + 8 * ((r >> 2) & 3) + 4 * ((r >> 4) & 1) + (r & 3);
                const int d0 = (pn - 4) * 256 + c8;
#pragma unroll
                for (int i = 0; i < 8; ++i) { vmt[(size_t)(d0 + i) * 256 + pos] = f2bf(a[i]); vmt[(size_t)(d0 + 128 + i) * 256 + pos] = f2bf(b[i]); }
            }
        EPI_ROWS_END
    }
};
struct EpiMerge {
    static constexpr bool PERM = true;
    const bf16_t* gates; bf16_t* merged;
    __device__ __forceinline__ void operator()(AccRef acc, const pg8::Unit& u, int wr, int wc, int fr, int fq) const {
        const int c = u.pn * 256 + wc * 32 + fq * 8, br = u.z;
#pragma unroll
        for (int ai = 0; ai < 2; ++ai) {
            u32x4 gw[4][2], mw[4][2];
#pragma unroll
            for (int m = 0; m < 4; ++m) { const int r = EPI_ROWOF(ai, m); const bf16_t* gp = gates + (size_t)r * 3072 + br * 1024 + c; gw[m][0] = *(const u32x4*)gp; gw[m][1] = *(const u32x4*)(gp + 128);
                if (br > 0) { const bf16_t* mp = merged + (size_t)r * 1024 + c; mw[m][0] = *(const u32x4*)mp; mw[m][1] = *(const u32x4*)(mp + 128); } }
#pragma unroll
            for (int m = 0; m < 4; ++m) { const int r = EPI_ROWOF(ai, m); EPI_AB(ai, m)
                const unsigned g0[4] = {gw[m][0].x, gw[m][0].y, gw[m][0].z, gw[m][0].w}, g1[4] = {gw[m][1].x, gw[m][1].y, gw[m][1].z, gw[m][1].w};
#pragma unroll
                for (int i = 0; i < 4; ++i) { a[2 * i] *= bflo(g0[i]); a[2 * i + 1] *= bfhi(g0[i]); b[2 * i] *= bflo(g1[i]); b[2 * i + 1] *= bfhi(g1[i]); }
                if (br > 0) { const unsigned m0[4] = {mw[m][0].x, mw[m][0].y, mw[m][0].z, mw[m][0].w}, m1[4] = {mw[m][1].x, mw[m][1].y, mw[m][1].z, mw[m][1].w};
#pragma unroll
                    for (int i = 0; i < 4; ++i) { a[2 * i] += bflo(m0[i]); a[2 * i + 1] += bfhi(m0[i]); b[2 * i] += bflo(m1[i]); b[2 * i + 1] += bfhi(m1[i]); } }
                bf16_t* mp = merged + (size_t)r * 1024 + c; st_bf16x8(mp, a); st_bf16x8(mp + 128, b); }
            asm volatile("" ::: "memory");
        }
    }
};
struct EpiRes {
    static constexpr bool PERM = true;
    float* x; bf16_t* xb; float* ssq;
    __device__ __forceinline__ void operator()(AccRef acc, const pg8::Unit& u, int wr, int wc, int fr, int fq) const {
        const int c8 = wc * 32 + fq * 8;
#pragma unroll
        for (int ai = 0; ai < 2; ++ai) {
            u32x4 xv[4][2];
#pragma unroll
            for (int m = 0; m < 4; ++m) { const bf16_t* xp = xb + (size_t)EPI_ROWOF(ai, m) * 1024 + u.pn * 256 + c8; xv[m][0] = *(const u32x4*)xp; xv[m][1] = *(const u32x4*)(xp + 128); }
#pragma unroll
            for (int m = 0; m < 4; ++m) { const int r = EPI_ROWOF(ai, m); EPI_AB(ai, m)
                a[0] += bflo(xv[m][0].x); a[1] += bfhi(xv[m][0].x); a[2] += bflo(xv[m][0].y); a[3] += bfhi(xv[m][0].y); a[4] += bflo(xv[m][0].z); a[5] += bfhi(xv[m][0].z); a[6] += bflo(xv[m][0].w); a[7] += bfhi(xv[m][0].w);
                b[0] += bflo(xv[m][1].x); b[1] += bfhi(xv[m][1].x); b[2] += bflo(xv[m][1].y); b[3] += bfhi(xv[m][1].y); b[4] += bflo(xv[m][1].z); b[5] += bfhi(xv[m][1].z); b[6] += bflo(xv[m][1].w); b[7] += bfhi(xv[m][1].w);
                if (x) { float* xp = x + (size_t)r * 1024 + u.pn * 256 + c8;
                    *(f32x4*)xp = (f32x4){a[0], a[1], a[2], a[3]}; *(f32x4*)(xp + 4) = (f32x4){a[4], a[5], a[6], a[7]};
                    *(f32x4*)(xp + 128) = (f32x4){b[0], b[1], b[2], b[3]}; *(f32x4*)(xp + 132) = (f32x4){b[4], b[5], b[6], b[7]}; }
                else { bf16_t* bp = xb + (size_t)r * 1024 + u.pn * 256 + c8; st_bf16x8(bp, a); st_bf16x8(bp + 128, b); }
                float sq = 0.f;
#pragma unroll
                for (int i = 0; i < 8; ++i) sq += a[i] * a[i] + b[i] * b[i];
                sq += shx(sq, 1, 4 * fr + fq); sq += shx(sq, 2, 4 * fr + fq);
                if (fq == 0) ssq[(size_t)r * 16 + u.pn * 4 + wc] = sq; }
            asm volatile("" ::: "memory");
        }
    }
};
struct EpiXq {
    static constexpr bool PERM = true;
    const float* ssq; bf16_t* xq;
    __device__ __forceinline__ void operator()(AccRef acc, const pg8::Unit& u, int wr, int wc, int fr, int fq) const {
        const int c8 = wc * 32 + fq * 8, xa = (fq * 16 + fr) << 2;
#pragma unroll
        for (int ai = 0; ai < 2; ++ai) {
            float rs4[4], rso[4]; EPI_RSTD4(ssq, ai, rs4); EPI_RS_ORIG(rs4, rso);
#pragma unroll
            for (int m = 0; m < 4; ++m) { const int r = EPI_ROWOF(ai, m); EPI_AB0(ai, m)
                const float rs = rso[m] * XQ_SCALE;
#pragma unroll
                for (int i = 0; i < 8; ++i) { a[i] *= rs; b[i] *= rs; }
                bf16_t* O = xq + (size_t)r * 1024 + u.pn * 256 + c8; st_bf16x8_x(O, a, xa); st_bf16x8_x(O + 128, b, xa); }
            asm volatile("" ::: "memory");
        }
    }
};
struct EpiFfnIn {
    static constexpr bool PERM = true;
    const float* ssq; bf16_t* hid;
    __device__ __forceinline__ void operator()(AccRef acc, const pg8::Unit& u, int wr, int wc, int fr, int fq) const {
        const int c8 = wc * 32 + fq * 8, xa = (fq * 16 + fr) << 2;
#pragma unroll
        for (int ai = 0; ai < 2; ++ai) {
            float rs4[4], rso[4]; EPI_RSTD4(ssq, ai, rs4); EPI_RS_ORIG(rs4, rso);
#pragma unroll
            for (int m = 0; m < 4; ++m) { const int r = EPI_ROWOF(ai, m); EPI_AB0(ai, m)
                const float rs = rso[m];
#pragma unroll
                for (int i = 0; i < 8; ++i) { const float g = a[i] * rs, up = b[i] * rs; a[i] = g * sigmoidf_(g) * up; }
                st_bf16x8_x(hid + (size_t)r * DFF + u.pn * 128 + c8, a, xa); }
            asm volatile("" ::: "memory");
        }
    }
};

__device__ __forceinline__ int nlog_win(int n) {
    const int t = n >> 8, p = n & 255;
    if (t < 3) return n;
    if (t == 3 || t == 4) { const int bj = p >> 7, hh = (p & 127) >> 5, dd = p & 31; return (t == 3 ? 768 : 1152) + 64 * hh + 32 * bj + dd; }
    if (t == 5) { const int bj = p >> 7, g = (p & 127) >> 5, dd = p & 31, j = 32 * bj + dd;
        if (g == 0) return 1024 + j; if (g == 1) return 1408 + j; if (g == 2) return 1088 + j;
        if (j < 4) return 1472 + j; if (j < 20) return 1988 + (j - 4); return -1; }
    if (t == 6) return (p < 128) ? 1476 + p : 1604 + (p - 128);
    if (t == 7) return 1732 + p;
    if (t == 8) return 2004 + p;
    return 2260 + (t - 9) * 256 + p;
}
__device__ __forceinline__ int nlog_ffn(int n) { const int j = n >> 8, p = n & 255; return (p >> 7) * DFF + 128 * j + (p & 127); }
struct ConvJob { const GAS float* W; const GAS float* gain; bf16_t* Bt; int ldw, K, map, kt, ns; };
__device__ __forceinline__ ConvJob conv_job(const Args& A, unsigned char* ws, int l, int t) {
    ConvJob j; int tt = t; j.gain = nullptr; j.map = 0;
    if (tt < 336) { j.W = ldarg(A, I_WIN) + (size_t)l * 1024 * INW; j.ldw = INW; j.K = 1024; j.map = 1; j.gain = ldarg(A, I_MIXG) + l * 1024; j.Bt = (bf16_t*)(ws + WS_WIN); j.kt = tt & 15; j.ns = tt >> 4; }
    else if ((tt -= 336) < 128) { j.W = ldarg(A, I_WXKV) + (size_t)l * 2097152; j.ldw = 2048; j.K = 1024; j.gain = ldarg(A, I_MG) + l * 1024; j.Bt = (bf16_t*)(ws + WS_WXKV); j.kt = tt & 15; j.ns = tt >> 4; }
    else if ((tt -= 128) < 48) { const int b = tt >> 4, q = tt & 15; const GAS float* w0 = ldarg(A, I_WBA); const GAS float* w1 = ldarg(A, I_WBB); const GAS float* w2 = ldarg(A, I_WBC); j.W = (b == 0 ? w0 : (b == 1 ? w1 : w2)) + (size_t)l * 256 * 1024; j.ldw = 1024; j.K = 256; j.Bt = (bf16_t*)(ws + WS_WBR) + (size_t)b * 262144; j.kt = q & 3; j.ns = q >> 2; }
    else if ((tt -= 48) < 64) { j.W = ldarg(A, I_WMIX) + (size_t)l * 1048576; j.ldw = 1024; j.K = 1024; j.Bt = (bf16_t*)(ws + WS_WMIX); j.kt = tt & 15; j.ns = tt >> 4; }
    else if ((tt -= 64) < 64) { j.W = ldarg(A, I_WXQ) + (size_t)l * 1048576; j.ldw = 1024; j.K = 1024; j.gain = ldarg(A, I_XG) + l * 1024; j.Bt = (bf16_t*)(ws + WS_WXQ); j.kt = tt & 15; j.ns = tt >> 4; }
    else if ((tt -= 64) < 64) { j.W = ldarg(A, I_WXO) + (size_t)l * 1048576; j.ldw = 1024; j.K = 1024; j.Bt = (bf16_t*)(ws + WS_WXO); j.kt = tt & 15; j.ns = tt >> 4; }
    else if ((tt -= 64) < 352) { j.W = ldarg(A, I_WFI) + (size_t)l * 1024 * NFF; j.ldw = NFF; j.K = 1024; j.map = 2; j.gain = ldarg(A, I_FG) + l * 1024; j.Bt = (bf16_t*)(ws + WS_WFI); j.kt = tt & 15; j.ns = tt >> 4; }
    else { tt -= 352; j.W = ldarg(A, I_WFO) + (size_t)l * DFF * 1024; j.ldw = 1024; j.K = DFF; j.Bt = (bf16_t*)(ws + WS_WFO); j.kt = tt % 44; j.ns = tt / 44; }
    return j;
}
#define CONV_LOAD(j_, v_, g_) do { const int nn_ = tid & 255, kq_ = tid >> 8, n_ = (j_).ns * 256 + nn_; const int nl_ = (j_).map == 0 ? n_ : ((j_).map == 1 ? nlog_win(n_) : nlog_ffn(n_)); \
        _Pragma("unroll") for (int i = 0; i < 32; ++i) { const int kk_ = (j_).kt * 64 + kq_ + 2 * i; v_[i] = nl_ >= 0 ? (j_).W[(size_t)kk_ * (j_).ldw + nl_] : 0.f; g_[i] = (j_).gain ? (j_).gain[kk_] : 1.0f; } } while (0)
#define CONV_WRITE(tile_, v_, g_) do { const int nn_ = tid & 255, kq_ = tid >> 8; _Pragma("unroll") for (int i = 0; i < 32; ++i) (tile_)[(kq_ + 2 * i) * 257 + nn_] = v_[i] * g_[i]; } while (0)
#define CONV_STORE(tile_, j_) do { const int nn_ = tid >> 1, kh_ = tid & 1; _Pragma("unroll") for (int jj = 0; jj < 4; ++jj) { float o_[8]; \
        _Pragma("unroll") for (int i = 0; i < 8; ++i) o_[i] = (tile_)[(32 * kh_ + 8 * jj + i) * 257 + nn_]; \
        st_bf16x8((j_).Bt + (size_t)((j_).ns * 256 + nn_) * (j_).K + (j_).kt * 64 + 32 * kh_ + 8 * jj, o_); } } while (0)
constexpr int CONV_EARLY = 704, CONV_ALL = 1232;
__device__ __forceinline__ void conv_range(LAS unsigned char* lds, const Args& A, int l, int first, int end, int widx, int nw) {
    unsigned char* ws = opq(A.ws);
    const int Gl = nw, tid = mytid(A.wave);
    LAS float* t0 = (LAS float*)lds; LAS float* t1 = (LAS float*)(lds + 65792);
    float va[32], ga[32], vb[32], gb[32];
    int t = first + widx; if (t >= end) return;
    ConvJob ja = conv_job(A, ws, l, t), jb = ja;
    CONV_LOAD(ja, va, ga);
    for (;;) {
        CONV_WRITE(t0, va, ga);
        const bool hb = t + Gl < end; if (hb) { jb = conv_job(A, ws, l, t + Gl); CONV_LOAD(jb, vb, gb); }
        __syncthreads();
        CONV_STORE(t0, ja);
        if (!hb) break;
        t += Gl;
        CONV_WRITE(t1, vb, gb);
        const bool ha = t + Gl < end; if (ha) { ja = conv_job(A, ws, l, t + Gl); CONV_LOAD(ja, va, ga); }
        __syncthreads();
        CONV_STORE(t1, jb);
        if (!ha) break;
        t += Gl;
    }
    __syncthreads();
}
#undef CONV_LOAD
#undef CONV_WRITE
#undef CONV_STORE

__constant__ float c_inv_freq[32] = {1.000000000e+00f, 7.498942018e-01f, 5.623413324e-01f, 4.216965139e-01f, 3.162277639e-01f, 2.371373922e-01f, 1.778279394e-01f, 1.333521456e-01f,
    1.000000015e-01f, 7.498941571e-02f, 5.623412877e-02f, 4.216964915e-02f, 3.162277862e-02f, 2.371373586e-02f, 1.778279431e-02f, 1.333521493e-02f,
    9.999999776e-03f, 7.498942316e-03f, 5.623413250e-03f, 4.216964822e-03f, 3.162277862e-03f, 2.371373819e-03f, 1.778279431e-03f, 1.333521446e-03f,
    1.000000047e-03f, 7.498941850e-04f, 5.623413017e-04f, 4.216965463e-04f, 3.162277862e-04f, 2.371373848e-04f, 1.778279402e-04f, 1.333521504e-04f};
__device__ __forceinline__ void prologue(LAS unsigned char* lds, const Args& A) {
    unsigned char* ws = opq(A.ws); const int tid = mytid(A.wave), lane = tid & 63, wave = tid >> 6; const int bid = obid(), Gl = ogrid();
    { const GAS float* x = ldarg(A, I_X); bf16_t* xb = (bf16_t*)(ws + WS_XB); float* ssq = (float*)(ws + WS_SSQ);
      for (int r = bid * 8 + wave; r < S_; r += Gl * 8) {
          const GAS float* xr = x + (size_t)r * 1024 + lane * 16; float v[16]; float sq = 0.f;
#pragma unroll
          for (int i = 0; i < 4; ++i) { const f32x4 q = *(const GAS f32x4*)(xr + 4 * i); v[4 * i] = q.x; v[4 * i + 1] = q.y; v[4 * i + 2] = q.z; v[4 * i + 3] = q.w; }
#pragma unroll
          for (int i = 0; i < 16; ++i) sq += v[i] * v[i];
          sq = wave_sum(sq, lane);
          float v0[8], v1[8];
#pragma unroll
          for (int i = 0; i < 8; ++i) { v0[i] = v[i]; v1[i] = v[8 + i]; }
          st_bf16x8(xb + (size_t)r * 1024 + lane * 16, v0); st_bf16x8(xb + (size_t)r * 1024 + lane * 16 + 8, v1);
          if (lane < 16) ssq[(size_t)r * 16 + lane] = lane == 0 ? sq : 0.f;
      } }
    { const GAS float* mem = ldarg(A, I_MEM); bf16_t* memb = (bf16_t*)(ws + WS_MEMB); float* rstdm = (float*)(ws + WS_RSTDM);
      for (int r = bid * 8 + wave; r < NMEM; r += Gl * 8) {
          const GAS float* xr = mem + (size_t)r * 1024 + lane * 16; float v0[8], v1[8]; float sq = 0.f;
#pragma unroll
          for (int i = 0; i < 8; ++i) { v0[i] = xr[i]; v1[i] = xr[8 + i]; sq += v0[i] * v0[i] + v1[i] * v1[i]; }
          sq = wave_sum(sq, lane);
          st_bf16x8(memb + (size_t)r * 1024 + lane * 16, v0); st_bf16x8(memb + (size_t)r * 1024 + lane * 16 + 8, v1);
          if (lane == 0) rstdm[r] = rsqrtf(sq * (1.0f / 1024.0f) + EPS);
      } }
    { float* cs = (float*)(ws + WS_CS);
      for (int i = bid * NTHREADS + tid; i < S_ * 32; i += Gl * NTHREADS) {
          const int pos = i >> 5, dd = i & 31; const float angf = (float)pos * c_inv_freq[dd]; const double a = (double)angf;
          const double kk = rint(a * 0.63661977236758134); double rr = fma(-kk, 1.5707963267948966, a); rr = fma(-kk, 6.123233995736766e-17, rr);
          const double r2 = rr * rr;
          const double sn = rr * (1.0 + r2 * (-1.0 / 6 + r2 * (1.0 / 120 + r2 * (-1.0 / 5040 + r2 * (1.0 / 362880 + r2 * (-1.0 / 39916800 + r2 * (1.0 / 6227020800.0)))))));
          const double cn = 1.0 + r2 * (-0.5 + r2 * (1.0 / 24 + r2 * (-1.0 / 720 + r2 * (1.0 / 40320 + r2 * (-1.0 / 3628800 + r2 * (1.0 / 479001600.0))))));
          const int q = ((int)kk) & 3; double c, s;
          if (q == 0) { c = cn; s = sn; } else if (q == 1) { c = -sn; s = cn; } else if (q == 2) { c = -cn; s = -sn; } else { c = sn; s = -cn; }
          cs[2 * i] = (float)c; cs[2 * i + 1] = (float)s;
      } }
}

__device__ __forceinline__ void sb_unit(LAS unsigned char* lds, const Args& A, int u) {
    unsigned char* ws = opq(A.ws); const int tid_l = mytid(A.wave); const int tid = tid_l, lane = tid & 63, wave = __builtin_amdgcn_readfirstlane(tid >> 6), fr = lane & 15, fq = lane >> 4;
    const bf16_t* Q = (const bf16_t*)(ws + WS_SBQ); const bf16_t* Kp = (const bf16_t*)(ws + WS_SBK); const bf16_t* Vp = (const bf16_t*)(ws + WS_SBV); bf16_t* O = (bf16_t*)(ws + WS_OA);
    LAS unsigned char* vst = lds + wave * 4608;
    const int vrow = 8 * ((lane >> 3) & 3) + 4 * ((lane >> 5) & 1) + ((lane >> 1) & 3), vhalf = lane & 1;
    const int h = wave & 3, qw = u * 128 + 64 * (wave >> 2);
    bf16x8 qf[4][2];
#pragma unroll
    for (int g = 0; g < 4; ++g)
#pragma unroll
        for (int s = 0; s < 2; ++s) qf[g][s] = *(const bf16x8*)(Q + (size_t)(qw + 16 * g + fr) * 256 + 64 * h + 32 * s + 8 * fq);
    f32x4 oacc[4][4];
#pragma unroll
    for (int g = 0; g < 4; ++g)
#pragma unroll
        for (int dg = 0; dg < 4; ++dg) oacc[g][dg] = (f32x4){0.f, 0.f, 0.f, 0.f};
    float runp[4] = {1.f, 1.f, 1.f, 1.f};
    const bool inc1 = (fq & 1) == 0, inc2 = (fq & 2) == 0, inc3 = (fq & 2) == 0;
    const int a1 = (lane ^ 16) << 2, a2 = (lane ^ 32) << 2, a3 = (lane ^ 48) << 2;
    bf16x8 nkf[2][2]; u32x4 nvr[4];
#define SB_LOAD(kb_) do { _Pragma("unroll") for (int a_ = 0; a_ < 2; ++a_) _Pragma("unroll") for (int s_ = 0; s_ < 2; ++s_) nkf[a_][s_] = *(const bf16x8*)(Kp + (size_t)((kb_) + 16 * a_ + fr) * 256 + 64 * h + 32 * s_ + 8 * fq); \
        _Pragma("unroll") for (int i_ = 0; i_ < 4; ++i_) nvr[i_] = *(const u32x4*)(Vp + (size_t)((kb_) + (lane >> 1)) * 256 + 64 * h + 32 * vhalf + 8 * i_); } while (0)
    SB_LOAD(qw + 32);
    for (int kb = qw + 32; kb >= 0; kb -= 32) {
        bf16x8 kf[2][2], vf[4];
#pragma unroll
        for (int a_ = 0; a_ < 2; ++a_)
#pragma unroll
            for (int s_ = 0; s_ < 2; ++s_) kf[a_][s_] = nkf[a_][s_];
#pragma unroll
        for (int i = 0; i < 4; ++i) *(LAS u32x4*)(vst + vrow * 144 + 64 * vhalf + 16 * i) = nvr[i];
        if (kb >= 32) SB_LOAD(kb - 32);
#pragma unroll
        for (int dg = 0; dg < 4; ++dg) { const s16x4 lo_ = __builtin_amdgcn_ds_read_tr16_b64_v4i16((LAS s16x4*)(vst + (8 * fq + (fr >> 2)) * 144 + 32 * dg + 8 * (fr & 3)));
            const s16x4 hi_ = __builtin_amdgcn_ds_read_tr16_b64_v4i16((LAS s16x4*)(vst + (8 * fq + 4 + (fr >> 2)) * 144 + 32 * dg + 8 * (fr & 3)));
            vf[dg] = __builtin_shufflevector(lo_, hi_, 0, 1, 2, 3, 4, 5, 6, 7); }
        bool alldone = true;
#pragma unroll
        for (int g = 0; g < 4; ++g) {
            const int qg = qw + 16 * g;
            if (kb >= qg + 15) { alldone = false; continue; }
            if (__all(runp[g] == 0.f)) continue;
            alldone = false;
            f32x4 sa[2];
#pragma unroll
            for (int a_ = 0; a_ < 2; ++a_) { sa[a_] = __builtin_amdgcn_mfma_f32_16x16x32_bf16(kf[a_][0], qf[g][0], (f32x4){0.f, 0.f, 0.f, 0.f}, 0, 0, 0); sa[a_] = __builtin_amdgcn_mfma_f32_16x16x32_bf16(kf[a_][1], qf[g][1], sa[a_], 0, 0, 0); }
            const bool diag = kb + 31 >= qg; const int t = qg + fr;
            float w[2][4];
#pragma unroll
            for (int ai = 1; ai >= 0; --ai) {
                float kp[4], bt[4];
#pragma unroll
                for (int r = 0; r < 4; ++r) { const float e = __builtin_amdgcn_exp2f(fminf(sa[ai][r], 120.0f)); kp[r] = __builtin_amdgcn_rcpf(1.0f + e); bt[r] = e * kp[r]; }
                if (diag) {
#pragma unroll
                    for (int r = 0; r < 4; ++r) { const bool valid = kb + 16 * ai + 4 * fq + r < t; kp[r] = valid ? kp[r] : 1.0f; bt[r] = valid ? bt[r] : 0.0f; } }
                const float pl = (kp[0] * kp[1]) * (kp[2] * kp[3]);
                const float x1 = __int_as_float(__builtin_amdgcn_ds_bpermute(a1, __float_as_int(pl))), x2 = __int_as_float(__builtin_amdgcn_ds_bpermute(a2, __float_as_int(pl))), x3 = __int_as_float(__builtin_amdgcn_ds_bpermute(a3, __float_as_int(pl)));
                float pref = runp[g] * (inc1 ? x1 : 1.0f) * (inc2 ? x2 : 1.0f) * (inc3 ? x3 : 1.0f);
                w[ai][3] = bt[3] * pref; pref *= kp[3]; w[ai][2] = bt[2] * pref; pref *= kp[2]; w[ai][1] = bt[1] * pref; pref *= kp[1]; w[ai][0] = bt[0] * pref;
                runp[g] *= (pl * x1) * (x2 * x3);
            }
            u32x4 pw; pw.x = cvt_pk_bf16(w[0][0], w[0][1]); pw.y = cvt_pk_bf16(w[0][2], w[0][3]); pw.z = cvt_pk_bf16(w[1][0], w[1][1]); pw.w = cvt_pk_bf16(w[1][2], w[1][3]);
            const bf16x8 pf = __builtin_bit_cast(bf16x8, pw);
#pragma unroll
            for (int dg = 0; dg < 4; ++dg) oacc[g][dg] = __builtin_amdgcn_mfma_f32_16x16x32_bf16(vf[dg], pf, oacc[g][dg], 0, 0, 0);
        }
        if (alldone) break;
    }
#undef SB_LOAD
#pragma unroll
    for (int g = 0; g < 4; ++g)
#pragma unroll
        for (int dg = 0; dg < 4; ++dg) { u32x2 w2; w2.x = cvt_pk_bf16(oacc[g][dg].x, oacc[g][dg].y); w2.y = cvt_pk_bf16(oacc[g][dg].z, oacc[g][dg].w);
            *(u32x2*)(O + (size_t)(qw + 16 * g + fr) * 256 + 64 * h + 16 * dg + 4 * fq) = w2; }
}

__device__ __forceinline__ void gla1_unit(LAS unsigned char* lds, const Args& A, int l, int c) {
    unsigned char* ws = opq(A.ws); const int tid_l = mytid(A.wave); const int tid = tid_l;
    const float* small = (const float*)(ws + WS_SMALL); const bf16_t* GK = (const bf16_t*)(ws + WS_GLK); const bf16_t* GV = (const bf16_t*)(ws + WS_GLV);
    float* BC = (float*)(ws + WS_BC); float* UC = (float*)(ws + WS_UC); float* AC = (float*)(ws + WS_AC);
    const GAS float* wup = ldarg(A, I_GUP) + l * 16 * 128; const GAS float* gb = ldarg(A, I_GB) + l * 128;
    LAS float* la = (LAS float*)lds;
    LAS float* kh = (LAS float*)(lds + 32768);
    LAS float* vv = (LAS float*)(lds + 65536);
    const int row0 = c * 64;
    float kLog2e = LOG2E, kLn2 = 0.6931471805599453f; asm volatile("" : "+v"(kLog2e), "+v"(kLn2));
    LAS float* wl = (LAS float*)(lds + 131072);
    for (int i = tid; i < 2048 + 128; i += NTHREADS) wl[i] = i < 2048 ? wup[i] : gb[i - 2048];
    __syncthreads();
    { const int t = tid >> 3, jg = tid & 7; float g[16];
#pragma unroll
      for (int i = 0; i < 4; ++i) { const f32x4 q = *(const f32x4*)(small + (size_t)(row0 + t) * 64 + 4 + 4 * i); g[4 * i] = q.x; g[4 * i + 1] = q.y; g[4 * i + 2] = q.z; g[4 * i + 3] = q.w; }
      for (int jj = 0; jj < 16; ++jj) { const int j = 16 * jg + jj; float x = wl[2048 + j];
#pragma unroll
          for (int r = 0; r < 16; ++r) x += g[r] * wl[r * 128 + j];
          const float ls = fminf(x, 0.f) - __builtin_amdgcn_logf(1.0f + __builtin_amdgcn_exp2f(-fabsf(x) * kLog2e)) * kLn2;
          la[t * 128 + j] = ls * (1.0f / 16.0f); } }
    for (int i = tid; i < 64 * 32; i += NTHREADS) { const int t = i >> 5, c8 = (i & 31) * 8; float v[8]; ld_bf16x8(GV + (size_t)(row0 + t) * 256 + c8, v);
#pragma unroll
        for (int j = 0; j < 8; ++j) vv[t * 256 + c8 + j] = v[j]; }
    __syncthreads();
    if (tid < 128) { float run = 0.f; for (int t = 0; t < 64; ++t) { run += la[t * 128 + tid]; la[t * 128 + tid] = run; BC[(size_t)(row0 + t) * 128 + tid] = run; } AC[c * 128 + tid] = __builtin_amdgcn_exp2f(run * kLog2e); }
    __syncthreads();
    for (int i = tid; i < 64 * 128; i += NTHREADS) { const int t = i >> 7, j = i & 127; kh[i] = bf2f(GK[(size_t)(row0 + t) * 128 + j]) * __builtin_amdgcn_exp2f((la[63 * 128 + j] - la[i]) * kLog2e); }
    __syncthreads();
    { const int hd = tid >> 2, eg = tid & 3, hh = hd >> 5; float a[16];
#pragma unroll
      for (int i = 0; i < 16; ++i) a[i] = 0.f;
      for (int t = 0; t < 64; ++t) { const float kk = kh[t * 128 + hd]; const LAS float* vp = vv + t * 256 + 64 * hh + 16 * eg;
#pragma unroll
          for (int i = 0; i < 16; ++i) a[i] += kk * vp[i]; }
      float* up = UC + (size_t)c * 8192 + hd * 64 + 16 * eg;
#pragma unroll
      for (int i = 0; i < 4; ++i) *(f32x4*)(up + 4 * i) = (f32x4){a[4 * i], a[4 * i + 1], a[4 * i + 2], a[4 * i + 3]}; }
    __syncthreads();
}
__device__ __forceinline__ void gla2_phase(LAS unsigned char* lds, const Args& A) {
    unsigned char* ws = opq(A.ws); const float* UC = (const float*)(ws + WS_UC); const float* AC = (const float*)(ws + WS_AC); float* ST = (float*)(ws + WS_ST);
    const int tid = mytid(A.wave), lane = tid & 63, seg = tid >> 6, bid = obid(); if (bid >= 128) return;
    const int gid = bid * 64 + lane, hd = bid;
    LAS float* Ls = (LAS float*)lds; LAS float* Ps = Ls + 512;
    float u[32], a[32];
#pragma unroll
    for (int i = 0; i < 32; ++i) { const int c = 32 * seg + i; u[i] = UC[(size_t)c * 8192 + gid]; a[i] = AC[c * 128 + hd]; }
    float L = 0.f, P = 1.f;
#pragma unroll
    for (int i = 0; i < 32; ++i) { L = a[i] * L + u[i]; P *= a[i]; }
    Ls[seg * 64 + lane] = L; Ps[seg * 64 + lane] = P;
    __syncthreads();
    float st = 0.f;
    for (int s2 = 0; s2 < seg; ++s2) st = Ps[s2 * 64 + lane] * st + Ls[s2 * 64 + lane];
#pragma unroll
    for (int i = 0; i < 32; ++i) { ST[(size_t)(32 * seg + i) * 8192 + gid] = st; st = a[i] * st + u[i]; }
}
__device__ __forceinline__ void glvt_slab(LAS unsigned char* lds, const Args& A, int sb) {
    unsigned char* ws = opq(A.ws); const int tid = mytid(A.wave); const bf16_t* GV = (const bf16_t*)(ws + WS_GLV); bf16_t* GVT = (bf16_t*)(ws + WS_GLVT);
    const int t0 = sb * 128;
#pragma unroll
    for (int i = 0; i < 8; ++i) { const int idx = tid + 512 * i, row = idx >> 5, c8 = (idx & 31) * 8; *(LAS u32x4*)(lds + row * 528 + c8 * 2) = *(const u32x4*)(GV + (size_t)(t0 + row) * 256 + c8); }
    __syncthreads();
#pragma unroll
    for (int i = 0; i < 8; ++i) { const int idx = tid + 512 * i, col = idx & 255, g = idx >> 8; float v[8];
#pragma unroll
        for (int k = 0; k < 8; ++k) { const int tok = 32 * (g >> 2) + 16 * (k >> 2) + 4 * (g & 3) + (k & 3); v[k] = bf2f(*(const LAS bf16_t*)(lds + tok * 528 + col * 2)); }
        st_bf16x8(GVT + (size_t)col * S_ + t0 + 8 * g, v); }
    __syncthreads();
}
__device__ __forceinline__ void gla3_unit(LAS unsigned char* lds, const Args& A, int l, int c) {
    unsigned char* ws = opq(A.ws); const int tid_l = mytid(A.wave); const int tid = tid_l, lane = tid & 63, wave = __builtin_amdgcn_readfirstlane(tid >> 6), fr = lane & 15, fq = lane >> 4;
    const bf16_t* GQ = (const bf16_t*)(ws + WS_GLQ); const bf16_t* GK = (const bf16_t*)(ws + WS_GLK); const bf16_t* GVT = (const bf16_t*)(ws + WS_GLVT); const bf16_t* GO = (const bf16_t*)(ws + WS_GLO);
    const float* BC = (const float*)(ws + WS_BC); const float* ST = (const float*)(ws + WS_ST) + (size_t)c * 8192; bf16_t* OC = (bf16_t*)(ws + WS_OC);
    const GAS float* gn = ldarg(A, I_GNG) + l * 64;
    LAS unsigned char* qb = lds;
    LAS unsigned char* kb = lds + 17408;
    LAS unsigned char* sb = lds + 34816;
    const int row0 = c * 64;
    float kLog2e = LOG2E; asm volatile("" : "+v"(kLog2e));
    for (int i = tid; i < 1024; i += NTHREADS) { const int t = i >> 4, j8 = (i & 15) * 8; float qv[8], kv[8];
        ld_bf16x8(GQ + (size_t)(row0 + t) * 128 + j8, qv); ld_bf16x8(GK + (size_t)(row0 + t) * 128 + j8, kv);
        const f32x4 b0 = *(const f32x4*)(BC + (size_t)(row0 + t) * 128 + j8), b1 = *(const f32x4*)(BC + (size_t)(row0 + t) * 128 + j8 + 4);
        const float bb[8] = {b0.x, b0.y, b0.z, b0.w, b1.x, b1.y, b1.z, b1.w};
#pragma unroll
        for (int k = 0; k < 8; ++k) { const float e = bb[k] * kLog2e; qv[k] *= __builtin_amdgcn_exp2f(e); kv[k] *= __builtin_amdgcn_exp2f(-e); }
        u32x4 wq4, wk4; wq4.x = cvt_pk_bf16(qv[0], qv[1]); wq4.y = cvt_pk_bf16(qv[2], qv[3]); wq4.z = cvt_pk_bf16(qv[4], qv[5]); wq4.w = cvt_pk_bf16(qv[6], qv[7]);
        wk4.x = cvt_pk_bf16(kv[0], kv[1]); wk4.y = cvt_pk_bf16(kv[2], kv[3]); wk4.z = cvt_pk_bf16(kv[4], kv[5]); wk4.w = cvt_pk_bf16(kv[6], kv[7]);
        *(LAS u32x4*)(qb + t * 272 + j8 * 2) = wq4; *(LAS u32x4*)(kb + t * 272 + j8 * 2) = wk4; }
    for (int i = tid; i < 2048; i += NTHREADS) { const int hd = i >> 4, e4 = (i & 15) * 4, hh = hd >> 5, d = hd & 31; const f32x4 v = *(const f32x4*)(ST + hd * 64 + e4);
        LAS bf16_t* p = (LAS bf16_t*)(sb + ((hh * 64 + e4) * 40 + d) * 2); p[0] = f2bf(v.x); p[40] = f2bf(v.y); p[80] = f2bf(v.z); p[120] = f2bf(v.w); }
    __syncthreads();
    const int h = wave & 3, th = wave >> 2;
#pragma unroll
    for (int tbl = 0; tbl < 2; ++tbl) { const int tb = 2 * th + tbl;
        const bf16x8 qf = *(const LAS bf16x8*)(qb + (16 * tb + fr) * 272 + (32 * h + 8 * fq) * 2);
        f32x4 sa[4];
#pragma unroll
        for (int jb = 0; jb < 4; ++jb) { sa[jb] = (f32x4){0.f, 0.f, 0.f, 0.f};
            if (jb <= tb) { const bf16x8 kf = *(const LAS bf16x8*)(kb + (16 * jb + fr) * 272 + (32 * h + 8 * fq) * 2); sa[jb] = __builtin_amdgcn_mfma_f32_16x16x32_bf16(kf, qf, sa[jb], 0, 0, 0); }
            if (jb == tb) {
#pragma unroll
                for (int r = 0; r < 4; ++r) if (4 * fq + r > fr) sa[jb][r] = 0.f; } }
        bf16x8 pf[2];
#pragma unroll
        for (int s2 = 0; s2 < 2; ++s2) { u32x4 w; w.x = cvt_pk_bf16(sa[2 * s2].x, sa[2 * s2].y); w.y = cvt_pk_bf16(sa[2 * s2].z, sa[2 * s2].w); w.z = cvt_pk_bf16(sa[2 * s2 + 1].x, sa[2 * s2 + 1].y); w.w = cvt_pk_bf16(sa[2 * s2 + 1].z, sa[2 * s2 + 1].w); pf[s2] = __builtin_bit_cast(bf16x8, w); }
        f32x4 oacc[4]; float sq = 0.f;
#pragma unroll
        for (int eb = 0; eb < 4; ++eb) {
            const bf16x8 sf = *(const LAS bf16x8*)(sb + ((h * 64 + 16 * eb + fr) * 40 + 8 * fq) * 2);
            f32x4 acc = __builtin_amdgcn_mfma_f32_16x16x32_bf16(sf, qf, (f32x4){0.f, 0.f, 0.f, 0.f}, 0, 0, 0);
            { const bf16x8 vf = *(const bf16x8*)(GVT + (size_t)(64 * h + 16 * eb + fr) * S_ + row0 + 8 * fq); acc = __builtin_amdgcn_mfma_f32_16x16x32_bf16(vf, pf[0], acc, 0, 0, 0); }
            if (tb >= 2) { const bf16x8 vf = *(const bf16x8*)(GVT + (size_t)(64 * h + 16 * eb + fr) * S_ + row0 + 32 + 8 * fq); acc = __builtin_amdgcn_mfma_f32_16x16x32_bf16(vf, pf[1], acc, 0, 0, 0); }
            oacc[eb] = acc; sq += (acc.x * acc.x + acc.y * acc.y) + (acc.z * acc.z + acc.w * acc.w); }
        sq += shx(sq, 16, lane); sq += shx(sq, 32, lane);
        const float rs = rsqrtf(sq * (1.0f / 64.0f) + EPS);
        const int t = row0 + 16 * tb + fr;
#pragma unroll
        for (int eb = 0; eb < 4; ++eb) { const int e0 = 16 * eb + 4 * fq; const f32x4 g4 = *(const GAS f32x4*)(gn + e0); const u32x2 gw = *(const u32x2*)(GO + (size_t)t * 256 + 64 * h + e0);
            u32x2 w2; w2.x = cvt_pk_bf16(oacc[eb].x * rs * g4.x * bflo(gw.x), oacc[eb].y * rs * g4.y * bfhi(gw.x)); w2.y = cvt_pk_bf16(oacc[eb].z * rs * g4.z * bflo(gw.y), oacc[eb].w * rs * g4.w * bfhi(gw.y));
            *(u32x2*)(OC + (size_t)t * 256 + 64 * h + e0) = w2; }
    }
    __syncthreads();
}

constexpr int DS_CAND = 384;
#ifdef FORCE_SLOW
constexpr int DS_TRIM = 12;
#else
constexpr int DS_TRIM = 256;
#endif
constexpr int DS_OFF_ZC = 65536;
constexpr int DS_OFF_CK = 65536;
constexpr int DS_OFF_CU = 90112;
constexpr int DS_OFF_SEL = 81920;
constexpr int DS_OFF_CTL = MISC_OFF + 128;
typedef short s16x2 __attribute__((ext_vector_type(2)));
typedef unsigned short u16x2 __attribute__((ext_vector_type(2)));
typedef __fp16 h16x2 __attribute__((ext_vector_type(2)));
__device__ __forceinline__ unsigned ds_bins2(float a, float b) {
    const s16x2 hs = __builtin_bit_cast(s16x2, __builtin_amdgcn_cvt_pkrtz(a, b)); const s16x2 sm = hs >> (s16x2){15, 15};
    const unsigned mono = __builtin_bit_cast(unsigned, hs) ^ (__builtin_bit_cast(unsigned, sm) | 0x80008000u);
    return __builtin_bit_cast(unsigned, __builtin_bit_cast(u16x2, mono) >> (u16x2){6, 6});
}
__device__ __forceinline__ float ds_h2f(unsigned hbits) { return (float)__builtin_bit_cast(__fp16, (unsigned short)hbits); }
__device__ __forceinline__ float ds_edge(int b) {
    if (b <= 0) return -INFINITY; if (b >= 1024) return INFINITY;
    if (b >= 512) return ds_h2f(((unsigned)b << 6) ^ 0x8000u);
    const float v = ds_h2f(~(((unsigned)b << 6) - 1u) & 0xffffu);
    return __uint_as_float(__float_as_uint(v) - 1u);
}
__device__ __forceinline__ void ds_compact(LAS unsigned char* lds, int qq, int need, int lane) {
    volatile LAS unsigned short* ck = (volatile LAS unsigned short*)(lds + DS_OFF_CK) + qq * DS_CAND; volatile LAS unsigned* cu = (volatile LAS unsigned*)(lds + DS_OFF_CU) + qq * DS_CAND;
    volatile LAS int* ctl = (volatile LAS int*)(lds + DS_OFF_CTL);
    const int n = ctl[32 + qq];
    if (n <= need) return;
    if (n <= 64) {
        const unsigned mu = lane < n ? cu[lane] : 0u, mk = lane < n ? (unsigned)ck[lane] : 0xffffffffu; int rank = 0;
        for (int j = 0; j < n; ++j) { const unsigned uj = (unsigned)__builtin_amdgcn_readlane((int)mu, j), kj = (unsigned)__builtin_amdgcn_readlane((int)mk, j); rank += (uj > mu || (uj == mu && kj < mk)) ? 1 : 0; }
        const bool keep = lane < n && rank < need; const unsigned long long mask = __ballot(keep); const int pos = __popcll(mask & ((1ull << lane) - 1ull));
        if (keep) { ck[pos] = (unsigned short)mk; cu[pos] = mu; if (rank == need - 1) { ctl[128 + qq] = (int)mu; ctl[160 + qq] = (int)mk; } }
        if (lane == 0) ctl[32 + qq] = need;
        return; }
    if (n <= 128) {
        const unsigned mu0 = cu[lane], mk0 = (unsigned)ck[lane]; const bool v1 = lane + 64 < n; const unsigned mu1 = v1 ? cu[lane + 64] : 0u, mk1 = v1 ? (unsigned)ck[lane + 64] : 0xffffffffu; int r0 = 0, r1 = 0;
        for (int j = 0; j < 64; ++j) { const unsigned uj = (unsigned)__builtin_amdgcn_readlane((int)mu0, j), kj = (unsigned)__builtin_amdgcn_readlane((int)mk0, j);
            r0 += (uj > mu0 || (uj == mu0 && kj < mk0)) ? 1 : 0; r1 += (uj > mu1 || (uj == mu1 && kj < mk1)) ? 1 : 0; }
        for (int j = 0; j < n - 64; ++j) { const unsigned uj = (unsigned)__builtin_amdgcn_readlane((int)mu1, j), kj = (unsigned)__builtin_amdgcn_readlane((int)mk1, j);
            r0 += (uj > mu0 || (uj == mu0 && kj < mk0)) ? 1 : 0; r1 += (uj > mu1 || (uj == mu1 && kj < mk1)) ? 1 : 0; }
        const bool k0 = r0 < need, k1 = v1 && r1 < need; const unsigned long long m0 = __ballot(k0), m1 = __ballot(k1); const unsigned long long below = (1ull << lane) - 1ull;
        const int p0 = __popcll(m0 & below), p1 = __popcll(m0) + __popcll(m1 & below);
        __builtin_amdgcn_s_waitcnt(0);
        if (k0) { ck[p0] = (unsigned short)mk0; cu[p0] = mu0; if (r0 == need - 1) { ctl[128 + qq] = (int)mu0; ctl[160 + qq] = (int)mk0; } }
        if (k1) { ck[p1] = (unsigned short)mk1; cu[p1] = mu1; if (r1 == need - 1) { ctl[128 + qq] = (int)mu1; ctl[160 + qq] = (int)mk1; } }
        if (lane == 0) ctl[32 + qq] = need;
        return; }
    unsigned mu[6], mk[6]; int rank[6];
#pragma unroll
    for (int ii = 0; ii < 6; ++ii) { const int i = lane + 64 * ii; mu[ii] = i < n ? cu[i] : 0u; mk[ii] = i < n ? (unsigned)ck[i] : 0xffffffffu; rank[ii] = 0; }
    const LAS unsigned short* ckn = (const LAS unsigned short*)(lds + DS_OFF_CK) + qq * DS_CAND; const LAS unsigned* cun = (const LAS unsigned*)(lds + DS_OFF_CU) + qq * DS_CAND;
#pragma unroll 4
    for (int j = 0; j < n; ++j) { const unsigned uj = cun[j], kj = ckn[j];
#pragma unroll
        for (int ii = 0; ii < 6; ++ii) rank[ii] += (uj > mu[ii] || (uj == mu[ii] && kj < mk[ii])) ? 1 : 0; }
    __builtin_amdgcn_s_waitcnt(0);
    int base = 0;
#pragma unroll
    for (int ii = 0; ii < 6; ++ii) { const int i = lane + 64 * ii; const bool keep = i < n && rank[ii] < need;
        const unsigned long long mask = __ballot(keep); const int pos = base + __popcll(mask & ((1ull << lane) - 1ull));
        if (keep) { ck[pos] = (unsigned short)mk[ii]; cu[pos] = mu[ii]; if (rank[ii] == need - 1) { ctl[128 + qq] = (int)mu[ii]; ctl[160 + qq] = (int)mk[ii]; } }
        base += __popcll(mask); }
    if (lane == 0) ctl[32 + qq] = need;
}
__device__ __forceinline__ void dsa_unit(LAS unsigned char* lds, const Args& A, int u) {
    unsigned char* ws = opq(A.ws); const int tid_l = mytid(A.wave); const int tid = tid_l, lane = tid & 63, wave = __builtin_amdgcn_readfirstlane(tid >> 6);
    const bf16_t* IQ = (const bf16_t*)(ws + WS_IXQ); const bf16_t* IK = (const bf16_t*)(ws + WS_IXK); const float* small = (const float*)(ws + WS_SMALL);
    const bf16_t* DQ = (const bf16_t*)(ws + WS_DSQ); const bf16_t* DK = (const bf16_t*)(ws + WS_DSK); const bf16_t* DV = (const bf16_t*)(ws + WS_DSV); bf16_t* OB = (bf16_t*)(ws + WS_OB);
    const int q0 = u * 32, N = ((q0 >> 6) + 1) * 64;
    volatile LAS unsigned* hist = (volatile LAS unsigned*)lds;
    volatile LAS unsigned short* sel = (volatile LAS unsigned short*)(lds + DS_OFF_SEL);
    volatile LAS unsigned short* ck = (volatile LAS unsigned short*)(lds + DS_OFF_CK); volatile LAS unsigned* cu = (volatile LAS unsigned*)(lds + DS_OFF_CU);
    volatile LAS int* ctl = (volatile LAS int*)(lds + DS_OFF_CTL);
    volatile LAS float* ctf = (volatile LAS float*)(lds + DS_OFF_CTL);
    const int fr = lane & 15, fq = lane >> 4;
    TICK(A, 0);
    if (N <= 256) {
        for (int i = tid; i < 32 * 256; i += NTHREADS) sel[i] = (unsigned short)(i & 255);
        __syncthreads();
    } else {
        volatile LAS unsigned* zc = (volatile LAS unsigned*)(lds + 131072);
        bf16x8 qf[2][4][2]; float wq[2][4];
#pragma unroll
        for (int g = 0; g < 2; ++g)
#pragma unroll
            for (int h = 0; h < 4; ++h) { wq[g][h] = small[(size_t)(q0 + 16 * g + fr) * 64 + h] * 0.5f;
#pragma unroll
                for (int s = 0; s < 2; ++s) qf[g][h][s] = *(const bf16x8*)(IQ + (size_t)(q0 + 16 * g + fr) * 256 + 64 * h + 32 * s + 8 * fq); }
        const int ntiles = (N + 127) >> 7;
        float pinf = INFINITY; asm volatile("" : "+v"(pinf));
#pragma unroll
        for (int g = 0; g < 2; ++g)
#pragma unroll
            for (int h = 0; h < 4; ++h) { asm volatile("" : "+v"(wq[g][h]));
#pragma unroll
                for (int s2 = 0; s2 < 2; ++s2) asm volatile("" : "+v"(qf[g][h][s2])); }
#define DS_LOADK(kbase, d0, d1) do { const int _kr = min((kbase) + fr, N - 1); const bf16_t* _p = IK + (size_t)_kr * 64 + 8 * fq; \
            asm volatile("global_load_dwordx4 %0, %2, off\n\tglobal_load_dwordx4 %1, %2, off offset:64" : "+v"(d0), "+v"(d1) : "v"(_p) : "memory"); } while (0)
#define DS_WAITK(d0, d1) asm volatile("s_waitcnt vmcnt(4)" : "+v"(d0), "+v"(d1) :: "memory")
#define DS_SCORES(kf0, kf1) f32x4 c4[2][4]; _Pragma("unroll") for (int g = 0; g < 2; ++g) _Pragma("unroll") for (int h = 0; h < 4; ++h) c4[g][h] = __builtin_amdgcn_mfma_f32_16x16x32_bf16(kf0, qf[g][h][0], (f32x4){0.f, 0.f, 0.f, 0.f}, 0, 0, 0); \
        _Pragma("unroll") for (int g = 0; g < 2; ++g) _Pragma("unroll") for (int h = 0; h < 4; ++h) c4[g][h] = __builtin_amdgcn_mfma_f32_16x16x32_bf16(kf1, qf[g][h][1], c4[g][h], 0, 0, 0); \
        float sc[2][4]; _Pragma("unroll") for (int g = 0; g < 2; ++g) _Pragma("unroll") for (int r = 0; r < 4; ++r) { float a_ = 0.f; _Pragma("unroll") for (int h = 0; h < 4; ++h) a_ += wq[g][h] * __builtin_amdgcn_fmed3f(c4[g][h][r], 0.f, pinf); sc[g][r] = a_; }
        for (int i = tid; i < 32 * 1024 + 32 * 32; i += NTHREADS) hist[i] = 0u;
        if (tid == 0) ctl[224] = 0;
        __syncthreads();
#define DS_P0_BODY(kf0, kf1, tile_) do { const int kb = (tile_) * 128 + 16 * wave; DS_WAITK(kf0, kf1); if (kb < N) { DS_SCORES(kf0, kf1) \
            _Pragma("unroll") for (int g = 0; g < 2; ++g) { LAS unsigned* hq = (LAS unsigned*)lds + (16 * g + fr) * 1024; \
                const unsigned p01 = ds_bins2(sc[g][0], sc[g][1]), p23 = ds_bins2(sc[g][2], sc[g][3]); \
                __hip_atomic_fetch_add(hq + (p01 & 0xffffu), 1u, __ATOMIC_RELAXED, __HIP_MEMORY_SCOPE_WORKGROUP); __hip_atomic_fetch_add(hq + (p01 >> 16), 1u, __ATOMIC_RELAXED, __HIP_MEMORY_SCOPE_WORKGROUP); \
                __hip_atomic_fetch_add(hq + (p23 & 0xffffu), 1u, __ATOMIC_RELAXED, __HIP_MEMORY_SCOPE_WORKGROUP); __hip_atomic_fetch_add(hq + (p23 >> 16), 1u, __ATOMIC_RELAXED, __HIP_MEMORY_SCOPE_WORKGROUP); \
                const unsigned nz = (sc[g][0] == 0.f ? 1u : 0u) + (sc[g][1] == 0.f ? 1u : 0u) + (sc[g][2] == 0.f ? 1u : 0u) + (sc[g][3] == 0.f ? 1u : 0u); \
                if (nz) __hip_atomic_fetch_add((LAS unsigned*)&zc[(16 * g + fr) * 32 + ((tile_) >> 2)], nz << (8 * ((tile_) & 3)), __ATOMIC_RELAXED, __HIP_MEMORY_SCOPE_WORKGROUP); } } \
            DS_LOADK(kb + 384, kf0, kf1); } while (0)
        { bf16x8 ka0 = qf[0][0][0], ka1 = ka0, kb0 = ka0, kb1 = ka0, kc0 = ka0, kc1 = ka0;
          DS_LOADK(16 * wave, ka0, ka1); DS_LOADK(128 + 16 * wave, kb0, kb1); DS_LOADK(256 + 16 * wave, kc0, kc1);
          for (int tile = 0; tile < ntiles; tile += 3) {
              DS_P0_BODY(ka0, ka1, tile); DS_P0_BODY(kb0, kb1, tile + 1); DS_P0_BODY(kc0, kc1, tile + 2);
          }
          asm volatile("s_waitcnt vmcnt(0)" : "+v"(ka0), "+v"(ka1), "+v"(kb0), "+v"(kb1), "+v"(kc0), "+v"(kc1) :: "memory"); }
#undef DS_P0_BODY
        __syncthreads();
        TICK(A, 1);
        for (int k = 0; k < 4; ++k) { const int qq = 4 * wave + k; unsigned cnt[16]; unsigned s = 0;
#pragma unroll
            for (int i = 0; i < 16; ++i) { cnt[i] = hist[qq * 1024 + 16 * lane + i]; s += cnt[i]; }
            unsigned T = s;
#pragma unroll
            for (int off = 1; off < 64; off <<= 1) { const unsigned v = shdn(T, off, lane); if (lane + off < 64) T += v; }
            const unsigned long long mask = __ballot(T >= 256u); const int L = 63 - __builtin_clzll(mask);
            const unsigned Tn = shdn(T, 1, lane); const unsigned above = lane == 63 ? 0u : Tn;
            if (lane == L) { unsigned cum = above; int b1 = 0, G1 = 0; unsigned C1 = 0; bool found = false;
#pragma unroll
                for (int b = 15; b >= 0; --b) { if (!found && cum + cnt[b] >= 256u) { b1 = 16 * lane + b; G1 = (int)cum; C1 = cnt[b]; found = true; } if (!found) cum += cnt[b]; }
                int need = 256 - G1, tl = -1;
                if (b1 == 512) {
                    unsigned zt = 0; for (int t = 0; t < ntiles; ++t) zt += (zc[qq * 32 + (t >> 2)] >> (8 * (t & 3))) & 0xffu;
                    if (zt == C1) { unsigned cz = 0; tl = 0; for (int t = 0; t < ntiles; ++t) { const unsigned z = (zc[qq * 32 + (t >> 2)] >> (8 * (t & 3))) & 0xffu; if (cz + z >= (unsigned)need) { tl = t; break; } cz += z; }
                        need -= (int)cz; } }
#ifdef FORCE_SLOW
                if (tl < 0) ctl[224] = 1;
#else
                if (tl < 0 && C1 > (unsigned)DS_CAND) ctl[224] = 1;
#endif
                ctl[64 + qq] = b1; ctl[96 + qq] = need; ctl[192 + qq] = tl; ctf[225 + qq] = ds_edge(b1); ctf[257 + qq] = ds_edge(b1 + 1); }
        }
        __syncthreads();
        TICK(A, 2);
        for (int i = tid; i < 32 * 512; i += NTHREADS) hist[i] = 0u;
        if (tid < 32) { ctl[32 + tid] = 0; ctl[128 + tid] = 0; ctl[160 + tid] = -1; }
        __syncthreads();
        { float flo[2], fhi[2]; int tlo[2];
#pragma unroll
          for (int g = 0; g < 2; ++g) { flo[g] = ctf[225 + 16 * g + fr]; fhi[g] = ctf[257 + 16 * g + fr]; tlo[g] = ctl[192 + 16 * g + fr]; }
          const bool slow = ctl[224] != 0;
#define DS_P1_BODY(kf0, kf1, tile_) do { const int kb = (tile_) * 128 + 16 * wave; DS_WAITK(kf0, kf1); if (kb < N) { DS_SCORES(kf0, kf1) \
            unsigned cbits = 0; \
            _Pragma("unroll") for (int g = 0; g < 2; ++g) { const int qq = 16 * g + fr; \
                const float tD = tlo[g] < 0 ? fhi[g] : ((tile_) < tlo[g] ? 0.0f : fhi[g]), tC = tlo[g] < 0 ? flo[g] : ((tile_) <= tlo[g] ? 0.0f : fhi[g]); \
                unsigned nib = 0; \
                _Pragma("unroll") for (int r = 0; r < 4; ++r) { const bool d = sc[g][r] >= tD, c = sc[g][r] >= tC; nib |= d ? (1u << r) : 0u; cbits |= (c && !d) ? (1u << (4 * g + r)) : 0u; } \
                __hip_atomic_fetch_or((LAS unsigned*)&hist[qq * 512 + (((kb >> 5) + qq) & 511)], nib << ((kb & 31) + 4 * fq), __ATOMIC_RELAXED, __HIP_MEMORY_SCOPE_WORKGROUP); } \
            while (__ballot(cbits != 0u)) {         \
                if (cbits) { const int ix = __builtin_ctz(cbits); cbits &= cbits - 1u; const int g = ix >> 2, r = ix & 3; \
                    float sv = sc[0][0]; sv = ix == 1 ? sc[0][1] : sv; sv = ix == 2 ? sc[0][2] : sv; sv = ix == 3 ? sc[0][3] : sv; sv = ix == 4 ? sc[1][0] : sv; sv = ix == 5 ? sc[1][1] : sv; sv = ix == 6 ? sc[1][2] : sv; sv = ix == 7 ? sc[1][3] : sv; \
                    const int qq = 16 * g + fr, key = kb + 4 * fq + r; \
                    const unsigned ub = __float_as_uint(sv), mono = ub ^ ((unsigned)((int)ub >> 31) | 0x80000000u); \
                    bool ok = true; if (slow) { const unsigned tu = (unsigned)ctl[128 + qq], tk = (unsigned)ctl[160 + qq]; ok = mono > tu || (mono == tu && (unsigned)key < tk); } \
                    if (ok) { const int slot = __hip_atomic_fetch_add((LAS int*)&ctl[32 + qq], 1, __ATOMIC_RELAXED, __HIP_MEMORY_SCOPE_WORKGROUP); ck[qq * DS_CAND + slot] = (unsigned short)key; cu[qq * DS_CAND + slot] = mono; } } } } \
            DS_LOADK(kb + 384, kf0, kf1); \
            if (slow) { __syncthreads();         \
                for (int k = 0; k < 4; ++k) { const int qq = 4 * wave + k; if (ctl[32 + qq] > DS_TRIM) ds_compact(lds, qq, ctl[96 + qq], lane); } \
                __syncthreads(); } } while (0)
          bf16x8 ka0 = qf[0][0][0], ka1 = ka0, kb0 = ka0, kb1 = ka0, kc0 = ka0, kc1 = ka0;
          DS_LOADK(16 * wave, ka0, ka1); DS_LOADK(128 + 16 * wave, kb0, kb1); DS_LOADK(256 + 16 * wave, kc0, kc1);
          for (int tile = 0; tile < ntiles; tile += 3) {
              DS_P1_BODY(ka0, ka1, tile); DS_P1_BODY(kb0, kb1, tile + 1); DS_P1_BODY(kc0, kc1, tile + 2);
          }
          asm volatile("s_waitcnt vmcnt(0)" : "+v"(ka0), "+v"(ka1), "+v"(kb0), "+v"(kb1), "+v"(kc0), "+v"(kc1) :: "memory"); }
#undef DS_P1_BODY
        __syncthreads();
#undef DS_LOADK
#undef DS_WAITK
#undef DS_SCORES
        TICK(A, 3);
        for (int k = 0; k < 4; ++k) { const int qq = 4 * wave + k; const int need = ctl[96 + qq]; ds_compact(lds, qq, need, lane);
            __builtin_amdgcn_s_waitcnt(0);
            for (int i = lane; i < need; i += 64) { const int key = ck[qq * DS_CAND + i]; __hip_atomic_fetch_or((LAS unsigned*)&hist[qq * 512 + (((key >> 5) + qq) & 511)], 1u << (key & 31), __ATOMIC_RELAXED, __HIP_MEMORY_SCOPE_WORKGROUP); } }
        __syncthreads();
        { volatile LAS unsigned short* offs = (volatile LAS unsigned short*)(lds + DS_OFF_CK) + wave * 512;
          for (int k = 0; k < 4; ++k) { const int qq = 4 * wave + k; unsigned wd[8]; unsigned c8 = 0;
#pragma unroll
            for (int i = 0; i < 8; ++i) { wd[i] = hist[qq * 512 + ((8 * lane + i + qq) & 511)]; c8 += __popc(wd[i]); }
            unsigned incl = c8;
#pragma unroll
            for (int off = 1; off < 64; off <<= 1) { const unsigned v = (unsigned)__builtin_amdgcn_ds_bpermute((lane - off) << 2, (int)incl); if (lane >= off) incl += v; }
            unsigned pos = incl - c8;
#pragma unroll
            for (int i = 0; i < 8; ++i) { offs[8 * lane + i] = (unsigned short)pos; pos += __popc(wd[i]); }
            __builtin_amdgcn_s_waitcnt(0);
#pragma unroll 1
            for (int i = 0; i < 8; ++i) { const int w = 64 * i + lane; unsigned bits = hist[qq * 512 + ((w + qq) & 511)]; unsigned p = offs[w];
                while (bits) { const int bpos = __builtin_ctz(bits); bits &= bits - 1u; if (p < 256u) sel[qq * 256 + p] = (unsigned short)(w * 32 + bpos); ++p; } }
            __builtin_amdgcn_s_waitcnt(0); } }
        __syncthreads();
    }
    TICK(A, 4);
    const int nsel = N < 256 ? N : 256;
    LAS unsigned char* vst = lds + wave * 9216;
#define AT_SELQ(qq_) ((const LAS unsigned short*)(lds + DS_OFF_SEL) + (qq_) * 256)
#define AT_ISSUE_K(buf, sq_, b_) do { _Pragma("unroll") for (int i8 = 0; i8 < 8; ++i8) { const int key_ = (sq_)[64 * (b_) + 8 * i8 + (lane >> 3)]; buf[i8] = *(const u32x4*)(DK + (size_t)key_ * 64 + 8 * (lane & 7)); } } while (0)
#define AT_ISSUE_V(buf, sq_, c_) do { _Pragma("unroll") for (int i8 = 0; i8 < 8; ++i8) { const int key_ = (sq_)[64 * (c_) + 8 * i8 + (lane >> 3)]; buf[i8] = *(const u32x4*)(DV + (size_t)key_ * 64 + 8 * (lane & 7)); } } while (0)
#define AT_QK(buf, b_) do { _Pragma("unroll") for (int i8 = 0; i8 < 8; ++i8) *(LAS u32x4*)(vst + (8 * i8 + (lane >> 3)) * 144 + 16 * (lane & 7)) = buf[i8]; \
        _Pragma("unroll") for (int g4 = 0; g4 < 4; ++g4) { const f32x4 c4_ = __builtin_amdgcn_mfma_f32_16x16x32_bf16(*(const LAS bf16x8*)(vst + (16 * g4 + fr) * 144 + 16 * fq), qf[0], (f32x4){0.f, 0.f, 0.f, 0.f}, 0, 0, 0); \
        sacc[4 * (b_) + g4] = __builtin_amdgcn_mfma_f32_16x16x32_bf16(*(const LAS bf16x8*)(vst + (16 * g4 + fr) * 144 + 64 + 16 * fq), qf[1], c4_, 0, 0, 0); } } while (0)
#define AT_PV(buf, c_) do { _Pragma("unroll") for (int i8 = 0; i8 < 8; ++i8) { const int row_ = 32 * (i8 >> 2) + 16 * (i8 & 1) + 4 * ((i8 >> 1) & 1) + 8 * (lane >> 5) + ((lane >> 3) & 3); \
            *(LAS u32x4*)(vst + row_ * 144 + 16 * (lane & 7)) = buf[i8]; } \
        _Pragma("unroll") for (int s2 = 0; s2 < 2; ++s2) _Pragma("unroll") for (int dg = 0; dg < 4; ++dg) { \
            const s16x4 lo_ = __builtin_amdgcn_ds_read_tr16_b64_v4i16((LAS s16x4*)(vst + (32 * s2 + 8 * fq + (fr >> 2)) * 144 + 32 * dg + 8 * (fr & 3))); \
            const s16x4 hi_ = __builtin_amdgcn_ds_read_tr16_b64_v4i16((LAS s16x4*)(vst + (32 * s2 + 8 * fq + 4 + (fr >> 2)) * 144 + 32 * dg + 8 * (fr & 3))); \
            const bf16x8 vf_ = __builtin_shufflevector(lo_, hi_, 0, 1, 2, 3, 4, 5, 6, 7); \
            oacc[dg] = __builtin_amdgcn_mfma_f32_16x16x32_bf16(vf_, pf[2 * (c_) + s2], oacc[dg], 0, 0, 0); } } while (0)
    u32x4 B0[8], B1[8], B2[8]; bf16x8 qf[2];
    { const int t0 = q0 + 4 * wave;
#pragma unroll
      for (int s2 = 0; s2 < 2; ++s2) qf[s2] = *(const bf16x8*)(DQ + (size_t)t0 * 256 + 64 * (fr & 3) + 32 * s2 + 8 * fq);
      AT_ISSUE_K(B0, AT_SELQ(4 * wave), 0); AT_ISSUE_K(B1, AT_SELQ(4 * wave), 1); }
#define AT_QUERY(k_, X, Y, Z) do { const int qq = 4 * wave + (k_), t = q0 + qq; const LAS unsigned short* selq = AT_SELQ(qq); f32x4 sacc[16]; \
        AT_ISSUE_K(Z, selq, 2); AT_QK(X, 0); \
        AT_ISSUE_K(X, selq, 3); AT_QK(Y, 1); \
        AT_ISSUE_V(Y, selq, 0); AT_QK(Z, 2); \
        AT_ISSUE_V(Z, selq, 1); AT_QK(X, 3); \
        if ((k_) < 3) { _Pragma("unroll") for (int s2 = 0; s2 < 2; ++s2) qf[s2] = *(const bf16x8*)(DQ + (size_t)(t + 1) * 256 + 64 * (fr & 3) + 32 * s2 + 8 * fq); } \
        if (nsel < 256) { _Pragma("unroll") for (int g = 0; g < 16; ++g) _Pragma("unroll") for (int r = 0; r < 4; ++r) if (16 * g + 4 * fq + r >= nsel) sacc[g][r] = -INFINITY; } \
        float mx = -INFINITY; \
        _Pragma("unroll") for (int g = 0; g < 16; ++g) mx = fmaxf(mx, fmaxf(fmaxf(sacc[g].x, sacc[g].y), fmaxf(sacc[g].z, sacc[g].w))); \
        mx = fmaxf(mx, shx(mx, 16, lane)); mx = fmaxf(mx, shx(mx, 32, lane)); \
        float sm = 0.f; \
        _Pragma("unroll") for (int g = 0; g < 16; ++g) { sacc[g].x = __builtin_amdgcn_exp2f(sacc[g].x - mx); sacc[g].y = __builtin_amdgcn_exp2f(sacc[g].y - mx); sacc[g].z = __builtin_amdgcn_exp2f(sacc[g].z - mx); sacc[g].w = __builtin_amdgcn_exp2f(sacc[g].w - mx); \
            sm += (sacc[g].x + sacc[g].y) + (sacc[g].z + sacc[g].w); } \
        sm += shx(sm, 16, lane); sm += shx(sm, 32, lane); \
        const float inv = 1.0f / sm; \
        bf16x8 pf[8]; \
        _Pragma("unroll") for (int s2 = 0; s2 < 8; ++s2) { u32x4 w; w.x = cvt_pk_bf16(sacc[2 * s2].x * inv, sacc[2 * s2].y * inv); w.y = cvt_pk_bf16(sacc[2 * s2].z * inv, sacc[2 * s2].w * inv); \
            w.z = cvt_pk_bf16(sacc[2 * s2 + 1].x * inv, sacc[2 * s2 + 1].y * inv); w.w = cvt_pk_bf16(sacc[2 * s2 + 1].z * inv, sacc[2 * s2 + 1].w * inv); pf[s2] = __builtin_bit_cast(bf16x8, w); } \
        f32x4 oacc[4]; \
        _Pragma("unroll") for (int dg = 0; dg < 4; ++dg) oacc[dg] = (f32x4){0.f, 0.f, 0.f, 0.f}; \
        AT_ISSUE_V(X, selq, 2); AT_PV(Y, 0); \
        AT_ISSUE_V(Y, selq, 3); AT_PV(Z, 1); \
        if ((k_) < 3) AT_ISSUE_K(Z, AT_SELQ(qq + 1), 0); \
        AT_PV(X, 2); \
        if ((k_) < 3) AT_ISSUE_K(X, AT_SELQ(qq + 1), 1); \
        AT_PV(Y, 3); \
        if (fr < 4) { _Pragma("unroll") for (int dg = 0; dg < 4; ++dg) { u32x2 w2; w2.x = cvt_pk_bf16(oacc[dg].x, oacc[dg].y); w2.y = cvt_pk_bf16(oacc[dg].z, oacc[dg].w); \
                *(u32x2*)(OB + (size_t)t * 256 + 64 * fr + 16 * dg + 4 * fq) = w2; } } } while (0)
    AT_QUERY(0, B0, B1, B2); AT_QUERY(1, B2, B0, B1); AT_QUERY(2, B1, B2, B0); AT_QUERY(3, B0, B1, B2);
#undef AT_QUERY
#undef AT_SELQ
#undef AT_ISSUE_K
#undef AT_ISSUE_V
#undef AT_QK
#undef AT_PV
    __syncthreads();
    TICK(A, 5);
#if DBG_MODE == 1
    { unsigned short* ds = (unsigned short*)(opq(A.ws) + WS_DBGSEL) + (size_t)u * 8192; for (int i = mytid(A.wave); i < 32 * 256; i += NTHREADS) ds[i] = sel[i]; }
    __syncthreads();
#endif
}

__device__ __forceinline__ void xattn_phase(LAS unsigned char* lds, const Args& A, const pg8::StaticOrder& S) {
    unsigned char* ws = opq(A.ws); const int tid_l = mytid(A.wave); const int tid = tid_l, lane = tid & 63, wave = __builtin_amdgcn_readfirstlane(tid >> 6), fr = lane & 15, fq = lane >> 4;
    const bf16_t* XQ = (const bf16_t*)(ws + WS_XQ); const bf16_t* KM = (const bf16_t*)(ws + WS_KM); const bf16_t* VMT = (const bf16_t*)(ws + WS_VMT); bf16_t* AO = (bf16_t*)(ws + WS_AO);
    for (int ui = 0;; ++ui) { pg8::Unit un; if (!S.next(ui, un)) break;
        const int hh = __builtin_amdgcn_readfirstlane(un.pn), rb = __builtin_amdgcn_readfirstlane(un.pm);
        __syncthreads();
        { const int row = tid >> 1, half = tid & 1; const bf16_t* src = KM + (size_t)row * 1024 + 256 * hh + 128 * half; LAS unsigned char* dst = lds + row * 528 + 256 * half;
#pragma unroll
          for (int b8 = 0; b8 < 2; ++b8) { u32x4 t8[8];
#pragma unroll
              for (int i = 0; i < 8; ++i) t8[i] = *(const u32x4*)(src + 64 * b8 + 8 * i);
#pragma unroll
              for (int i = 0; i < 8; ++i) *(LAS u32x4*)(dst + 128 * b8 + 16 * i) = t8[i]; } }
        __syncthreads();
        bf16x8 pf[2][8];
        { bf16x8 qf[2][8]; f32x4 sacc[2][16];
#pragma unroll
          for (int j = 0; j < 2; ++j) { const int row = rb * 256 + 128 * j + 16 * wave + fr;
#pragma unroll
              for (int s2 = 0; s2 < 8; ++s2) qf[j][s2] = *(const bf16x8*)(XQ + (size_t)row * 1024 + 256 * hh + 32 * s2 + 8 * fq); }
#pragma unroll
          for (int g = 0; g < 16; ++g) { f32x4 c0 = (f32x4){0.f, 0.f, 0.f, 0.f}, c1 = c0;
#pragma unroll
              for (int s2 = 0; s2 < 8; ++s2) { const bf16x8 kf = *(const LAS bf16x8*)(lds + (16 * g + fr) * 528 + (32 * s2 + 8 * fq) * 2);
                  c0 = __builtin_amdgcn_mfma_f32_16x16x32_bf16(kf, qf[0][s2], c0, 0, 0, 0); c1 = __builtin_amdgcn_mfma_f32_16x16x32_bf16(kf, qf[1][s2], c1, 0, 0, 0); }
              sacc[0][g] = c0; sacc[1][g] = c1; asm volatile("" ::: "memory"); }
#pragma unroll
          for (int j = 0; j < 2; ++j) {
            float mx = -INFINITY;
#pragma unroll
            for (int g = 0; g < 16; ++g) mx = fmaxf(mx, fmaxf(fmaxf(sacc[j][g].x, sacc[j][g].y), fmaxf(sacc[j][g].z, sacc[j][g].w)));
            mx = fmaxf(mx, shx(mx, 16, lane)); mx = fmaxf(mx, shx(mx, 32, lane));
            float sm = 0.f;
#pragma unroll
            for (int g = 0; g < 16; ++g) { sacc[j][g].x = __builtin_amdgcn_exp2f(sacc[j][g].x - mx); sacc[j][g].y = __builtin_amdgcn_exp2f(sacc[j][g].y - mx); sacc[j][g].z = __builtin_amdgcn_exp2f(sacc[j][g].z - mx); sacc[j][g].w = __builtin_amdgcn_exp2f(sacc[j][g].w - mx);
                sm += (sacc[j][g].x + sacc[j][g].y) + (sacc[j][g].z + sacc[j][g].w); }
            sm += shx(sm, 16, lane); sm += shx(sm, 32, lane);
            const float inv = 1.0f / sm;
#pragma unroll
            for (int s2 = 0; s2 < 8; ++s2) { u32x4 w; w.x = cvt_pk_bf16(sacc[j][2 * s2].x * inv, sacc[j][2 * s2].y * inv); w.y = cvt_pk_bf16(sacc[j][2 * s2].z * inv, sacc[j][2 * s2].w * inv);
                w.z = cvt_pk_bf16(sacc[j][2 * s2 + 1].x * inv, sacc[j][2 * s2 + 1].y * inv); w.w = cvt_pk_bf16(sacc[j][2 * s2 + 1].z * inv, sacc[j][2 * s2 + 1].w * inv); pf[j][s2] = __builtin_bit_cast(bf16x8, w); }
            asm volatile("" ::: "memory");
          } }
        __syncthreads();
        const int tid2 = mytid(A.wave), lane2 = tid2 & 63, wave2 = __builtin_amdgcn_readfirstlane(tid2 >> 6), fr2 = lane2 & 15, fq2 = lane2 >> 4; unsigned char* ws2 = opq(A.ws);
        const bf16_t* VMT2 = (const bf16_t*)(ws2 + WS_VMT); bf16_t* AO2 = (bf16_t*)(ws2 + WS_AO);
        { const int row = tid2 >> 1, half = tid2 & 1; const bf16_t* src = VMT2 + (size_t)(256 * hh + row) * 256 + 128 * half; LAS unsigned char* dst = lds + row * 528 + 256 * half;
#pragma unroll
          for (int b8 = 0; b8 < 2; ++b8) { u32x4 t8[8];
#pragma unroll
              for (int i = 0; i < 8; ++i) t8[i] = *(const u32x4*)(src + 64 * b8 + 8 * i);
#pragma unroll
              for (int i = 0; i < 8; ++i) *(LAS u32x4*)(dst + 128 * b8 + 16 * i) = t8[i]; } }
        __syncthreads();
        { const int row0 = rb * 256 + 16 * wave2 + fr2;
#pragma unroll
            for (int dg = 0; dg < 16; ++dg) { f32x4 c0 = (f32x4){0.f, 0.f, 0.f, 0.f}, c1 = c0;
#pragma unroll
                for (int s2 = 0; s2 < 8; ++s2) { const bf16x8 vf = *(const LAS bf16x8*)(lds + (16 * dg + fr2) * 528 + (32 * s2 + 8 * fq2) * 2);
                    c0 = __builtin_amdgcn_mfma_f32_16x16x32_bf16(vf, pf[0][s2], c0, 0, 0, 0); c1 = __builtin_amdgcn_mfma_f32_16x16x32_bf16(vf, pf[1][s2], c1, 0, 0, 0); }
                u32x2 w; w.x = cvt_pk_bf16(c0.x, c0.y); w.y = cvt_pk_bf16(c0.z, c0.w);
                *(u32x2*)(AO2 + (size_t)row0 * 1024 + 256 * hh + 16 * dg + 4 * fq2) = w;
                w.x = cvt_pk_bf16(c1.x, c1.y); w.y = cvt_pk_bf16(c1.z, c1.w);
                *(u32x2*)(AO2 + (size_t)(row0 + 128) * 1024 + 256 * hh + 16 * dg + 4 * fq2) = w; if (dg & 1) asm volatile("" ::: "memory"); } }
    }
    __syncthreads();
}

__device__ __forceinline__ void final_norm(const Args& A) {
    const int tid = mytid(A.wave), lane = tid & 63, wave = tid >> 6; const int bid = obid(), Gl = ogrid(); unsigned char* ws = opq(A.ws); const float* ssq = (const float*)(ws + WS_SSQ); const bf16_t* xb = (const bf16_t*)(ws + WS_XB); const GAS float* g = ldarg(A, I_FING);
    for (int r = bid * 8 + wave; r < S_; r += Gl * 8) { const float rs = row_rstd(ssq, r); float* xr = (float*)opq((unsigned char*)A.out) + (size_t)r * 1024 + lane * 16;
        float v[16]; { float v0[8], v1[8]; ld_bf16x8(xb + (size_t)r * 1024 + lane * 16, v0); ld_bf16x8(xb + (size_t)r * 1024 + lane * 16 + 8, v1);
#pragma unroll
            for (int i = 0; i < 8; ++i) { v[i] = v0[i]; v[8 + i] = v1[i]; } }
#pragma unroll
        for (int i = 0; i < 4; ++i) { const f32x4 gg = *(const GAS f32x4*)(g + lane * 16 + 4 * i); *(f32x4*)(xr + 4 * i) = (f32x4){v[4 * i] * rs * gg.x, v[4 * i + 1] * rs * gg.y, v[4 * i + 2] * rs * gg.z, v[4 * i + 3] * rs * gg.w}; } }
}

constexpr int PH_PER_LAYER = 11, N_PHASES = 2 + PH_PER_LAYER * DEPTH;
__global__ void __launch_bounds__(NTHREADS, 2) mk_fwd(const float* i0, const float* i1, const float* i2, const float* i3, const float* i4, const float* i5, const float* i6, const float* i7, const float* i8, const float* i9,
                                                      const float* i10, const float* i11, const float* i12, const float* i13, const float* i14, const float* i15, const float* i16, const float* i17, const float* i18, const float* i19,
                                                      float* outp, unsigned char* wsp, int ph_lo, int ph_hi) {
    extern __shared__ __attribute__((aligned(16))) unsigned char lds[];
    LAS unsigned char* ring = (LAS unsigned char*)lds;
    Args args; args.out = outp; args.ws = wsp; args.ring = ring; args.wave = __builtin_amdgcn_readfirstlane(threadIdx.x >> 6);
    const int tid = threadIdx.x;
    unsigned char* ws = args.ws;
    unsigned* ctl = (unsigned*)(ws + WS_CTL);
    volatile LAS unsigned* misc = (volatile LAS unsigned*)(ring + MISC_OFF);
    if (tid < 16) misc[tid] = 0u;
#if DBG_MODE == 3
    if (tid < 32) ((volatile LAS unsigned long long*)(ring + MISC_OFF + 2560))[tid] = 0ull;
#endif
    if (tid == 0) { volatile LAS unsigned long long* av = (volatile LAS unsigned long long*)(ring + ARGV_OFF);
        av[0] = (unsigned long long)i0; av[1] = (unsigned long long)i1; av[2] = (unsigned long long)i2; av[3] = (unsigned long long)i3; av[4] = (unsigned long long)i4;
        av[5] = (unsigned long long)i5; av[6] = (unsigned long long)i6; av[7] = (unsigned long long)i7; av[8] = (unsigned long long)i8; av[9] = (unsigned long long)i9;
        av[10] = (unsigned long long)i10; av[11] = (unsigned long long)i11; av[12] = (unsigned long long)i12; av[13] = (unsigned long long)i13; av[14] = (unsigned long long)i14;
        av[15] = (unsigned long long)i15; av[16] = (unsigned long long)i16; av[17] = (unsigned long long)i17; av[18] = (unsigned long long)i18; av[19] = (unsigned long long)i19; }
    __syncthreads();
    const bool one = (ph_hi - ph_lo) > 1;
    XcdBarrier bar; bar.bar = ctl + CW_BAR; bar.x = 0; bar.st = misc;
    if (one) bar = xcd_barrier_post(ctl + CW_BAR, misc, args.wave);
    const int lo = ph_lo, hi = ph_hi, G = gridDim.x;
#define IN(k) (lo <= (k) && (k) < hi)
#if DBG_MODE == 3
#define STAMP(k) do { if (obid() == 0 && mytid(args.wave) == 0) ((volatile LAS unsigned long long*)(ring + MISC_OFF + 2048))[(k)] = __builtin_amdgcn_s_memrealtime(); } while (0)
#else
#define STAMP(k) do { } while (0)
#endif
#define SEAM(k) do { if (IN((k) + 1)) xcd_barrier(bar, args.wave); STAMP((k) + 1); } while (0)

#if DBG_MODE == 3
    const unsigned long long clk0_ = clock64();
#endif
    STAMP(0);
    if (PH_EN(100) && IN(0)) { prologue(ring, args); __syncthreads(); STAMP(1); }

    for (int l = 0; l < DEPTH; ++l) {
        const int pb = 1 + PH_PER_LAYER * l;
        if (l == 0) { if (PH_EN(0) && IN(pb + 0)) { const int bid = obid(), Gl = ogrid(); conv_range(ring, args, 0, 0, CONV_EARLY, bid, Gl); SEAM(pb + 0); } }
        else STAMP(pb + 1);
        if (PH_EN(1) && IN(pb + 1)) { unsigned char* wsl = opq(ws); (void)wsl; const int bid = obid(), Gl = ogrid(); (void)bid; (void)Gl;
            { pg8::Gemm g{(const bf16_t*)(wsl + WS_XB), (const bf16_t*)(wsl + WS_WIN), S_, NIN - 256, D_, 0, 0}; pg8::StaticOrder S; S.init(S_, NIN - 256, Gl, bid);
              EpiIn E{(const float*)(wsl + WS_SSQ), (const float*)(wsl + WS_CS), (bf16_t*)(wsl + WS_SBQ), (bf16_t*)(wsl + WS_SBK), (bf16_t*)(wsl + WS_SBV), (bf16_t*)(wsl + WS_DSQ), (bf16_t*)(wsl + WS_IXQ), (bf16_t*)(wsl + WS_DSK), (bf16_t*)(wsl + WS_IXK),
                      (bf16_t*)(wsl + WS_DSV), (bf16_t*)(wsl + WS_GLQ), (bf16_t*)(wsl + WS_GLK), (bf16_t*)(wsl + WS_GLV), (bf16_t*)(wsl + WS_GLO), (bf16_t*)(wsl + WS_GATES), (float*)(wsl + WS_SMALL), (bf16_t*)(wsl + WS_SBVT), 0, (bf16_t*)(wsl + WS_GLVT)};
              pg8::gemm_phase<EpiIn, pg8::StaticOrder>(ring, g, S, E, args.wave); }
            SEAM(pb + 1);
        }
        if (PH_EN(2) && IN(pb + 2)) { unsigned char* wsl = opq(ws); (void)wsl; const int bid = obid(), Gl = ogrid(); (void)bid; (void)Gl;
            volatile LAS int* qslot = (volatile LAS int*)(ring + MISC_OFF + 32);
            for (;;) {
                __syncthreads();
                if (mytid(args.wave) == 0) *qslot = (int)atomicAdd((unsigned*)(wsl + WS_CTL) + CW_QUEUE + 64 * l, 1u);
                __syncthreads();
                const int uq = *qslot;
                if (uq >= 1232) break;
                if (uq >= 64 && uq < 72) {
                    pg8::Gemm g{(const bf16_t*)(wsl + WS_MEMB), (const bf16_t*)(wsl + WS_WXKV), NMEM, 2048, D_, 0, 0}; pg8::StaticOrder S; S.init(NMEM, 2048, 8, uq - 64);
                    EpiKV E{(const float*)(wsl + WS_RSTDM), (bf16_t*)(wsl + WS_KM), (bf16_t*)(wsl + WS_VMT)};
                    pg8::gemm_phase<EpiKV, pg8::StaticOrder>(ring, g, S, E, args.wave); }
                else if (uq < 64) {
                    pg8::Gemm g{(const bf16_t*)(wsl + WS_XB), (const bf16_t*)(wsl + WS_WIN) + (size_t)(NIN - 256) * D_, S_, 256, D_, 0, 0}; pg8::StaticOrder S; S.init(S_, 256, 64, uq);
                    EpiIn E{(const float*)(wsl + WS_SSQ), (const float*)(wsl + WS_CS), (bf16_t*)(wsl + WS_SBQ), (bf16_t*)(wsl + WS_SBK), (bf16_t*)(wsl + WS_SBV), (bf16_t*)(wsl + WS_DSQ), (bf16_t*)(wsl + WS_IXQ), (bf16_t*)(wsl + WS_DSK), (bf16_t*)(wsl + WS_IXK),
                            (bf16_t*)(wsl + WS_DSV), (bf16_t*)(wsl + WS_GLQ), (bf16_t*)(wsl + WS_GLK), (bf16_t*)(wsl + WS_GLV), (bf16_t*)(wsl + WS_GLO), (bf16_t*)(wsl + WS_GATES), (float*)(wsl + WS_SMALL), (bf16_t*)(wsl + WS_SBVT), 20, (bf16_t*)(wsl + WS_GLVT)};
                    pg8::gemm_phase<EpiIn, pg8::StaticOrder>(ring, g, S, E, args.wave); }
                else if (uq < 584) dsa_unit(ring, args, 583 - uq);
                else if (uq < 848) { const int c0 = CONV_EARLY + 2 * (uq - 584); conv_range(ring, args, l, c0, c0 + 2, 0, 1); }
                else if (uq < 976) { TICK(args, 0); sb_unit(ring, args, 975 - uq); TICK(args, 6); }
                else { TICK(args, 0); gla1_unit(ring, args, l, uq - 976); TICK(args, 7); }
            }
            SEAM(pb + 2);
        }
        if (PH_EN(3) && IN(pb + 3)) { unsigned char* wsl = opq(ws); (void)wsl; const int bid = obid(), Gl = ogrid(); (void)bid; (void)Gl; gla2_phase(ring, args);
            if (bid >= 128) for (int sb = bid - 128; sb < 128; sb += Gl - 128) glvt_slab(ring, args, sb);
            SEAM(pb + 3); }
        if (PH_EN(4) && IN(pb + 4)) { unsigned char* wsl = opq(ws); (void)wsl; const int bid = obid(), Gl = ogrid(); (void)bid; (void)Gl; for (int c = bid; c < 256; c += Gl) gla3_unit(ring, args, l, c); SEAM(pb + 4); }
        if (PH_EN(5) && IN(pb + 5)) { unsigned char* wsl = opq(ws); (void)wsl; const int bid = obid(), Gl = ogrid(); (void)bid; (void)Gl;
            pg8::Gemm g{(const bf16_t*)(wsl + WS_OA), (const bf16_t*)(wsl + WS_WBR), S_, D_, 256, (size_t)(WS_OB - WS_OA), (size_t)1024 * 256 * 2}; pg8::TripleOrder S; S.init(S_, D_, Gl, bid);
            EpiMerge E{(const bf16_t*)(wsl + WS_GATES), (bf16_t*)(wsl + WS_MERGED)}; pg8::gemm_phase<EpiMerge, pg8::TripleOrder>(ring, g, S, E, args.wave);
            SEAM(pb + 5);
        }
        if (PH_EN(6) && IN(pb + 6)) { unsigned char* wsl = opq(ws); (void)wsl; const int bid = obid(), Gl = ogrid(); (void)bid; (void)Gl; pg8::Gemm g{(const bf16_t*)(wsl + WS_MERGED), (const bf16_t*)(wsl + WS_WMIX), S_, D_, D_, 0, 0}; pg8::StaticOrder S; S.init(S_, D_, Gl, bid);
            EpiRes E{(float*)nullptr, (bf16_t*)(wsl + WS_XB), (float*)(wsl + WS_SSQ)}; pg8::gemm_phase<EpiRes, pg8::StaticOrder>(ring, g, S, E, args.wave); SEAM(pb + 6); }
        if (PH_EN(7) && IN(pb + 7)) { unsigned char* wsl = opq(ws); (void)wsl; const int bid = obid(), Gl = ogrid(); (void)bid; (void)Gl; pg8::Gemm g{(const bf16_t*)(wsl + WS_XB), (const bf16_t*)(wsl + WS_WXQ), S_, D_, D_, 0, 0}; pg8::StaticOrder S; S.init(S_, D_, Gl, bid);
            EpiXq E{(const float*)(wsl + WS_SSQ), (bf16_t*)(wsl + WS_XQ)}; pg8::gemm_phase<EpiXq, pg8::StaticOrder>(ring, g, S, E, args.wave);
            __syncthreads();
            xattn_phase(ring, args, S); SEAM(pb + 7); }
        if (PH_EN(8) && IN(pb + 8)) { unsigned char* wsl = opq(ws); (void)wsl; const int bid = obid(), Gl = ogrid(); (void)bid; (void)Gl; pg8::Gemm g{(const bf16_t*)(wsl + WS_AO), (const bf16_t*)(wsl + WS_WXO), S_, D_, D_, 0, 0}; pg8::StaticOrder S; S.init(S_, D_, Gl, bid);
            EpiRes E{(float*)nullptr, (bf16_t*)(wsl + WS_XB), (float*)(wsl + WS_SSQ)}; pg8::gemm_phase<EpiRes, pg8::StaticOrder>(ring, g, S, E, args.wave); SEAM(pb + 8); }
        if (PH_EN(9) && IN(pb + 9)) { unsigned char* wsl = opq(ws); (void)wsl; const int bid = obid(), Gl = ogrid(); (void)bid; (void)Gl; pg8::Gemm g{(const bf16_t*)(wsl + WS_XB), (const bf16_t*)(wsl + WS_WFI), S_, NFF, D_, 0, 0}; pg8::StaticOrder S; S.init(S_, NFF, Gl, bid);
            EpiFfnIn E{(const float*)(wsl + WS_SSQ), (bf16_t*)(wsl + WS_HID)}; pg8::gemm_phase<EpiFfnIn, pg8::StaticOrder>(ring, g, S, E, args.wave);
            if (l + 1 < DEPTH) {
                const int nun = (S_ / 256) * (NFF / 256), nmax = (nun + Gl - 1) / Gl; int fi = nun - (nmax - 1) * Gl; if (fi >= Gl) fi = 0;
                __syncthreads();
                if (bid >= fi) conv_range(ring, args, l + 1, 0, CONV_EARLY, bid - fi, Gl - fi); }
            SEAM(pb + 9); }
        if (PH_EN(10) && IN(pb + 10)) { unsigned char* wsl = opq(ws); (void)wsl; const int bid = obid(), Gl = ogrid(); (void)bid; (void)Gl; pg8::Gemm g{(const bf16_t*)(wsl + WS_HID), (const bf16_t*)(wsl + WS_WFO), S_, D_, DFF, 0, 0}; pg8::StaticOrder S; S.init(S_, D_, Gl, bid);
            EpiRes E{(float*)nullptr, (bf16_t*)(wsl + WS_XB), (float*)(wsl + WS_SSQ)}; pg8::gemm_phase<EpiRes, pg8::StaticOrder>(ring, g, S, E, args.wave); SEAM(pb + 10); }
    }
    if (PH_EN(101) && IN(N_PHASES - 1)) { final_norm(args); __syncthreads(); STAMP(N_PHASES); }
#if DBG_MODE == 3
    if (obid() == 0 && mytid(args.wave) == 0) { volatile LAS unsigned long long* st = (volatile LAS unsigned long long*)(ring + MISC_OFF + 2048); unsigned long long T = 0;
        if (STAMP_A == 40) { const unsigned long long cyc = clock64() - clk0_; const unsigned long long rt = st[N_PHASES] - st[0]; T = (cyc * 1000ull / rt) * 10ull; }
        else if (STAMP_A == 30) T = ((volatile LAS unsigned long long*)(ring + MISC_OFF + 2560))[10] / 20ull;
        else if (STAMP_A >= 20) T = ((volatile LAS unsigned long long*)(ring + MISC_OFF + 2560))[STAMP_A - 20];
        else if (STAMP_A < PH_PER_LAYER) { for (int l = 0; l < DEPTH; ++l) T += st[2 + PH_PER_LAYER * l + STAMP_A] - st[1 + PH_PER_LAYER * l + STAMP_A]; } else if (STAMP_A == 12) T = st[1] - st[0]; else T = st[N_PHASES] - st[N_PHASES - 1];
        const unsigned long long t0 = __builtin_amdgcn_s_memrealtime(); while (__builtin_amdgcn_s_memrealtime() - t0 < T * STAMP_MUL) __builtin_amdgcn_s_sleep(8); }
#endif
#undef IN
#undef SEAM
}

#if DBG_MODE == 1
constexpr size_t WS_DBGSC = WS_DBGEND;
constexpr size_t WS_DBGFL = WS_DBGSC + 1 * MB;
constexpr size_t WS_DBGEND2 = WS_DBGFL + 256 * 1024;
__device__ __forceinline__ int dbg_row(int i) { if (i == 0) return 0; if (i == 1) return 63; if (i == 2) return 64; if (i == 3) return 255; if (i == 4) return 256; if (i == 5) return S_ - 1; if (i == 6) return 300; if (i == 7) return 16000; return (int)((((unsigned)i * 2654435761u) >> 14) % (unsigned)S_); }
__device__ __forceinline__ void dbg_err(float* dbg, int stage, float got, float ex, float atol, float rtol) { float e = fabsf(got - ex) / (atol + rtol * fabsf(ex)); if (!(e == e)) e = 1e30f; atomicMax((unsigned*)(dbg + stage), __float_as_uint(e)); }
__device__ __forceinline__ void dbg_sincos(float angf, double& c, double& s) {
    double a = (double)angf; const double k = floor(a / 6.283185307179586476925286766559); a -= k * 6.283185307179586476925286766559; if (a > 3.14159265358979323846) a -= 6.283185307179586476925286766559;
    double term = a, sn = a, a2 = a * a; for (int i = 1; i < 20; ++i) { term *= -a2 / ((2 * i) * (2 * i + 1)); sn += term; }
    term = 1.0; double cn = 1.0; for (int i = 1; i < 20; ++i) { term *= -a2 / ((2 * i - 1) * (2 * i)); cn += term; }
    c = cn; s = sn; }
__global__ void __launch_bounds__(512) dbg_inproj(const float* x, const float* g, const float* win, unsigned char* ws) {
    __shared__ float xs[1024]; __shared__ float z[INW]; __shared__ float red[8];
    float* dbg = (float*)(ws + WS_DBG); const int r = dbg_row(blockIdx.x), tid = threadIdx.x;
    float sq = 0.f; for (int k = tid; k < 1024; k += 512) { const float v = x[(size_t)r * 1024 + k]; sq += v * v; xs[k] = v * g[k]; }
    for (int o = 32; o >= 1; o >>= 1) sq += __shfl_xor(sq, o);
    if ((tid & 63) == 0) red[tid >> 6] = sq;
    __syncthreads();
    float tot = 0.f; for (int i = 0; i < 8; ++i) tot += red[i];
    const float rstd = rsqrtf(tot * (1.0f / 1024.0f) + EPS);
    if (tid == 0) dbg_err(dbg, 20, row_rstd((const float*)(ws + WS_SSQ), r), rstd, 0.f, 1e-4f);
    for (int n = tid; n < INW; n += 512) { float acc = 0.f; for (int k = 0; k < 1024; ++k) acc += xs[k] * win[(size_t)k * INW + n]; z[n] = acc * rstd; }
    __syncthreads();
    const bf16_t* SBQ = (const bf16_t*)(ws + WS_SBQ); const bf16_t* SBK = (const bf16_t*)(ws + WS_SBK); const bf16_t* SBV = (const bf16_t*)(ws + WS_SBV);
    const bf16_t* DSQ = (const bf16_t*)(ws + WS_DSQ); const bf16_t* IXQ = (const bf16_t*)(ws + WS_IXQ); const bf16_t* DSK = (const bf16_t*)(ws + WS_DSK); const bf16_t* IXK = (const bf16_t*)(ws + WS_IXK); const bf16_t* DSV = (const bf16_t*)(ws + WS_DSV);
    const float* SM = (const float*)(ws + WS_SMALL); const bf16_t* GLQ = (const bf16_t*)(ws + WS_GLQ); const bf16_t* GLK = (const bf16_t*)(ws + WS_GLK); const bf16_t* GLV = (const bf16_t*)(ws + WS_GLV); const bf16_t* GLO = (const bf16_t*)(ws + WS_GLO); const bf16_t* GT = (const bf16_t*)(ws + WS_GATES);
    const float AT = 0.04f, RT = 0.02f;
    for (int n = tid; n < INW; n += 512) {
        const float zn = z[n];
        if (n < 768) { const int w = n >> 8, c = n & 255; const bf16_t* B = w == 0 ? SBQ : (w == 1 ? SBK : SBV); dbg_err(dbg, 1 + w, bf2f(B[(size_t)r * 256 + c]), zn * (w == 0 ? SBQ_SCALE : 1.0f), AT, RT); }
        else if (n < 1152 && !(n >= 1088) || (n >= 1152 && n < 1472)) {
            int base, stage, ld, col; float sc; const bf16_t* B;
            if (n < 1024) { base = 768; stage = 4; ld = 256; sc = DSQ_SCALE; B = DSQ; } else if (n < 1088) { base = 1024; stage = 5; ld = 64; sc = 1.f; B = DSK; }
            else if (n < 1408) { base = 1152; stage = 7; ld = 256; sc = IXQ_SCALE; B = IXQ; } else { base = 1408; stage = 8; ld = 64; sc = 1.f; B = IXK; }
            col = n - base; const int d = col & 63, dd = d & 31; double c, s_; dbg_sincos((float)r * c_inv_freq[dd], c, s_);
            const float ex = d < 32 ? (float)(zn * c - z[n + 32] * s_) : (float)(zn * c + z[n - 32] * s_);
            dbg_err(dbg, stage, bf2f(B[(size_t)r * ld + col]), ex * sc, AT, RT); }
        else if (n < 1152) dbg_err(dbg, 6, bf2f(DSV[(size_t)r * 64 + n - 1088]), zn, AT, RT);
        else if (n < 1476) dbg_err(dbg, 9, SM[(size_t)r * 64 + n - 1472], zn, AT, RT);
        else if (n < 1604) dbg_err(dbg, 10, bf2f(GLQ[(size_t)r * 128 + n - 1476]), zn * GLQ_SCALE, AT, RT);
        else if (n < 1732) dbg_err(dbg, 11, bf2f(GLK[(size_t)r * 128 + n - 1604]), zn, AT, RT);
        else if (n < 1988) dbg_err(dbg, 12, bf2f(GLV[(size_t)r * 256 + n - 1732]), zn, AT, RT);
        else if (n < 2004) dbg_err(dbg, 13, SM[(size_t)r * 64 + 4 + n - 1988], zn, AT, RT);
        else if (n < 2260) dbg_err(dbg, 14, bf2f(GLO[(size_t)r * 256 + n - 2004]), zn / (1.0f + expf(-zn)), AT, RT);
        else dbg_err(dbg, 15, bf2f(GT[(size_t)r * 3072 + n - 2260]), 1.0f / (1.0f + expf(-zn)), AT, RT);
    }
}
__global__ void __launch_bounds__(64) dbg_sb(unsigned char* ws) {
    float* dbg = (float*)(ws + WS_DBG); const int i = threadIdx.x, t = dbg_row(i), h = i & 3;
    const bf16_t* Q = (const bf16_t*)(ws + WS_SBQ); const bf16_t* K = (const bf16_t*)(ws + WS_SBK); const bf16_t* V = (const bf16_t*)(ws + WS_SBV); const bf16_t* O = (const bf16_t*)(ws + WS_OA);
    float q[64], acc[64];
#pragma unroll
    for (int d8 = 0; d8 < 8; ++d8) { float v[8]; ld_bf16x8(Q + (size_t)t * 256 + 64 * h + 8 * d8, v);
#pragma unroll
        for (int j = 0; j < 8; ++j) { q[8 * d8 + j] = v[j] * (1.0f / LOG2E); acc[8 * d8 + j] = 0.f; } }
    float run = 0.f;
    for (int s = t - 1; s >= 0; --s) { float z = 0.f;
#pragma unroll
        for (int d8 = 0; d8 < 8; ++d8) { float v[8]; ld_bf16x8(K + (size_t)s * 256 + 64 * h + 8 * d8, v);
#pragma unroll
            for (int j = 0; j < 8; ++j) z += q[8 * d8 + j] * v[j]; }
        const float lb = z >= 0.f ? -log1pf(expf(-z)) : z - log1pf(expf(z)); const float lk = lb - z; const float w = expf(lb + run);
#pragma unroll
        for (int d8 = 0; d8 < 8; ++d8) { float v[8]; ld_bf16x8(V + (size_t)s * 256 + 64 * h + 8 * d8, v);
#pragma unroll
            for (int j = 0; j < 8; ++j) acc[8 * d8 + j] += w * v[j]; }
        run += lk; }
#pragma unroll
    for (int d8 = 0; d8 < 8; ++d8) { float v[8]; ld_bf16x8(O + (size_t)t * 256 + 64 * h + 8 * d8, v);
#pragma unroll
        for (int j = 0; j < 8; ++j) dbg_err(dbg, 16, v[j], acc[8 * d8 + j], 0.02f, 0.02f); }
}
__global__ void __launch_bounds__(512) dbg_dsa(unsigned char* ws) {
    __shared__ float qi[256]; __shared__ float dq[256]; __shared__ float pp[4][256]; __shared__ float wsm[4]; __shared__ int mism; __shared__ float mxs[4], sms[4];
    float* dbg = (float*)(ws + WS_DBG); const int tid = threadIdx.x, t = dbg_row(blockIdx.x), N = ((t >> 6) + 1) * 64, nsel = N < 256 ? N : 256;
    const bf16_t* IQ = (const bf16_t*)(ws + WS_IXQ); const bf16_t* IK = (const bf16_t*)(ws + WS_IXK); const float* SM = (const float*)(ws + WS_SMALL);
    const bf16_t* DQ = (const bf16_t*)(ws + WS_DSQ); const bf16_t* DK = (const bf16_t*)(ws + WS_DSK); const bf16_t* DV = (const bf16_t*)(ws + WS_DSV); const bf16_t* OB = (const bf16_t*)(ws + WS_OB);
    const unsigned short* msel = (const unsigned short*)(ws + WS_DBGSEL) + (size_t)t * 256;
    float* sc = (float*)(ws + WS_DBGSC) + (size_t)blockIdx.x * 16384; int* fl = (int*)(ws + WS_DBGFL) + (size_t)blockIdx.x * 16384;
    if (tid < 256) { qi[tid] = bf2f(IQ[(size_t)t * 256 + tid]); dq[tid] = bf2f(DQ[(size_t)t * 256 + tid]); } if (tid < 4) wsm[tid] = SM[(size_t)t * 64 + tid] * 0.5f; if (tid == 0) mism = 0;
    __syncthreads();
    for (int s = tid; s < N; s += 512) { float tot = 0.f;
#pragma unroll 1
        for (int h = 0; h < 4; ++h) { float a = 0.f;
#pragma unroll 4
            for (int d = 0; d < 64; ++d) a += qi[64 * h + d] * bf2f(IK[(size_t)s * 64 + d]); tot += wsm[h] * fmaxf(a, 0.f); } sc[s] = tot + 0.0f; }
    __threadfence_block(); __syncthreads();
    { float mine[32]; int rank[32];
#pragma unroll
      for (int k = 0; k < 32; ++k) { const int s = tid + 512 * k; mine[k] = s < N ? sc[s] : 0.f; rank[k] = 0; }
      for (int j = 0; j < N; ++j) { const float v = sc[j];
#pragma unroll
          for (int k = 0; k < 32; ++k) { const int s = tid + 512 * k; rank[k] += (v > mine[k] || (v == mine[k] && j < s)) ? 1 : 0; } }
#pragma unroll
      for (int k = 0; k < 32; ++k) { const int s = tid + 512 * k; if (s < N) fl[s] = (N <= 256 || rank[k] < 256) ? 1 : 0; } }
    __threadfence_block(); __syncthreads();
    if (tid < nsel) { const int key = msel[tid]; bool ok = key < N; if (ok) ok = atomicExch(fl + key, 2) == 1; if (!ok) atomicAdd(&mism, 1); }
    __syncthreads();
    if (tid == 0) dbg_err(dbg, 17, (float)mism, 0.f, 6.0f, 0.f);
    if (tid < 256) { const bool valid = tid < nsel; const int key = valid ? (int)msel[tid] : 0; const int kk = key < S_ ? key : 0;
#pragma unroll 1
        for (int h = 0; h < 4; ++h) { float a = 0.f;
#pragma unroll 4
            for (int d = 0; d < 64; ++d) a += dq[64 * h + d] * bf2f(DK[(size_t)kk * 64 + d]);
            pp[h][tid] = valid ? a : -INFINITY; } }
    __syncthreads();
    if (tid < 4) { float mx = -INFINITY; for (int i = 0; i < 256; ++i) mx = fmaxf(mx, pp[tid][i]); float sm = 0.f; for (int i = 0; i < 256; ++i) sm += exp2f(pp[tid][i] - mx); mxs[tid] = mx; sms[tid] = sm; }
    __syncthreads();
    if (tid < 256) { const int h = tid >> 6, d = tid & 63; float o = 0.f;
#pragma unroll 2
        for (int i = 0; i < nsel; ++i) { const int key = msel[i] < S_ ? msel[i] : 0; o += exp2f(pp[h][i] - mxs[h]) * bf2f(DV[(size_t)key * 64 + d]); }
        dbg_err(dbg, 18, bf2f(OB[(size_t)t * 256 + tid]), o / sms[h], 0.02f, 0.02f); }
}
__global__ void __launch_bounds__(512) dbg_gla(const float* wup, const float* gb, const float* gn, unsigned char* ws) {
    __shared__ float qs[32], ks[32], al[32], vs[64], part[32][65], os[64];
    float* dbg = (float*)(ws + WS_DBG); const int tid = threadIdx.x, h = blockIdx.x, d = tid >> 4, e0 = (tid & 15) * 4;
    const float* SM = (const float*)(ws + WS_SMALL); const bf16_t* GQ = (const bf16_t*)(ws + WS_GLQ); const bf16_t* GK = (const bf16_t*)(ws + WS_GLK); const bf16_t* GV = (const bf16_t*)(ws + WS_GLV); const bf16_t* GO = (const bf16_t*)(ws + WS_GLO); const bf16_t* OC = (const bf16_t*)(ws + WS_OC);
    float st[4] = {0.f, 0.f, 0.f, 0.f}; float emax = 0.f;
    for (int t = 0; t < S_; ++t) {
        if (tid < 32) { qs[tid] = bf2f(GQ[(size_t)t * 128 + 32 * h + tid]); ks[tid] = bf2f(GK[(size_t)t * 128 + 32 * h + tid]);
            float x = gb[32 * h + tid]; for (int r = 0; r < 16; ++r) x += SM[(size_t)t * 64 + 4 + r] * wup[r * 128 + 32 * h + tid];
            const float ls = x >= 0.f ? -log1pf(expf(-x)) : x - log1pf(expf(x)); al[tid] = expf(ls * (1.0f / 16.0f)); }
        else if (tid < 96) vs[tid - 32] = bf2f(GV[(size_t)t * 256 + 64 * h + tid - 32]);
        __syncthreads();
#pragma unroll
        for (int i = 0; i < 4; ++i) { st[i] = al[d] * st[i] + ks[d] * vs[e0 + i]; part[d][e0 + i] = qs[d] * st[i]; }
        __syncthreads();
        if (tid < 64) { float o = 0.f; for (int dd = 0; dd < 32; ++dd) o += part[dd][tid]; float sq = o * o; for (int m = 32; m >= 1; m >>= 1) sq += __shfl_xor(sq, m);
            const float ex = o * rsqrtf(sq * (1.0f / 64.0f) + EPS) * gn[tid] * bf2f(GO[(size_t)t * 256 + 64 * h + tid]);
            float e = fabsf(bf2f(OC[(size_t)t * 256 + 64 * h + tid]) - ex) / (0.08f + 0.06f * fabsf(ex)); if (!(e == e)) e = 1e30f; emax = fmaxf(emax, e); }
        __syncthreads();
    }
    if (tid < 64) atomicMax((unsigned*)(dbg + 19), __float_as_uint(emax));
}
constexpr size_t WS_DBGCK = WS_DBGEND2;
constexpr size_t WS_DBGEND3 = WS_DBGCK + 2 * 64 * 1024 * 4;
__device__ __forceinline__ float dbg_dot(const float* arow, const float* W, int ldw, int K, int n) { float a = 0.f; for (int k = 0; k < K; ++k) a += arow[k] * W[(size_t)k * ldw + n]; return a; }
__global__ void __launch_bounds__(512) dbg_merge(const float* wa, const float* wb, const float* wc, unsigned char* ws) {
    __shared__ float oa[256], ob[256], oc[256]; float* dbg = (float*)(ws + WS_DBG); const int r = dbg_row(blockIdx.x), tid = threadIdx.x;
    if (tid < 256) { oa[tid] = bf2f(((const bf16_t*)(ws + WS_OA))[(size_t)r * 256 + tid]); ob[tid] = bf2f(((const bf16_t*)(ws + WS_OB))[(size_t)r * 256 + tid]); oc[tid] = bf2f(((const bf16_t*)(ws + WS_OC))[(size_t)r * 256 + tid]); }
    __syncthreads();
    const bf16_t* G = (const bf16_t*)(ws + WS_GATES) + (size_t)r * 3072; const bf16_t* M = (const bf16_t*)(ws + WS_MERGED) + (size_t)r * 1024;
    for (int c = tid; c < 1024; c += 512) { const float ex = bf2f(G[c]) * dbg_dot(oa, wa, 1024, 256, c) + bf2f(G[1024 + c]) * dbg_dot(ob, wb, 1024, 256, c) + bf2f(G[2048 + c]) * dbg_dot(oc, wc, 1024, 256, c);
        dbg_err(dbg, 21, bf2f(M[c]), ex, 0.03f, 0.03f); }
}
__global__ void __launch_bounds__(512) dbg_resid(const float* xin, int xin_ld_is_ck, const float* W, int K, size_t abuf_off, const float* out, unsigned char* ws, int st, int ckslot) {
    __shared__ float arow[2816]; __shared__ float red[8]; float* dbg = (float*)(ws + WS_DBG); const int smp = blockIdx.x, r = dbg_row(smp), tid = threadIdx.x;
    const bf16_t* Ab = (const bf16_t*)(ws + abuf_off) + (size_t)r * K; for (int k = tid; k < K; k += 512) arow[k] = bf2f(Ab[k]);
    __syncthreads();
    const float* xrow = xin_ld_is_ck ? xin + (size_t)smp * 1024 : xin + (size_t)r * 1024; float* ck = (float*)(ws + WS_DBGCK) + ((size_t)ckslot * 64 + smp) * 1024;
    float sq = 0.f;
    for (int c = tid; c < 1024; c += 512) { const float ex = xrow[c] + dbg_dot(arow, W, 1024, K, c); const float got = out[(size_t)r * 1024 + c];
        dbg_err(dbg, st, got, ex, 0.03f, 0.02f); dbg_err(dbg, st + 1, bf2f(((const bf16_t*)(ws + WS_XB))[(size_t)r * 1024 + c]), got, 0.001f, 0.01f); sq += got * got; ck[c] = got; }
    for (int o = 32; o >= 1; o >>= 1) sq += __shfl_xor(sq, o);
    if ((tid & 63) == 0) red[tid >> 6] = sq;
    __syncthreads();
    if (tid == 0) { float tot = 0.f; for (int i = 0; i < 8; ++i) tot += red[i]; const float* sp = (const float*)(ws + WS_SSQ) + (size_t)r * 16; float got = 0.f; for (int i = 0; i < 16; ++i) got += sp[i]; dbg_err(dbg, st + 2, got, tot, 0.f, 1e-3f); }
}
__global__ void __launch_bounds__(512) dbg_normproj(const float* x, const float* gain, const float* W, int mode, unsigned char* ws, int st) {
    __shared__ float xs[1024]; __shared__ float red[8]; float* dbg = (float*)(ws + WS_DBG); const int r = dbg_row(blockIdx.x), tid = threadIdx.x;
    float sq = 0.f; for (int k = tid; k < 1024; k += 512) { const float v = x[(size_t)r * 1024 + k]; sq += v * v; xs[k] = v * gain[k]; }
    for (int o = 32; o >= 1; o >>= 1) sq += __shfl_xor(sq, o);
    if ((tid & 63) == 0) red[tid >> 6] = sq;
    __syncthreads();
    float tot = 0.f; for (int i = 0; i < 8; ++i) tot += red[i]; const float rstd = rsqrtf(tot * (1.0f / 1024.0f) + EPS);
    if (mode == 0) { for (int c = tid; c < 1024; c += 512) dbg_err(dbg, st, bf2f(((const bf16_t*)(ws + WS_XQ))[(size_t)r * 1024 + c]), rstd * dbg_dot(xs, W, 1024, 1024, c) * XQ_SCALE, 0.03f, 0.02f); }
    else { for (int j = tid; j < DFF; j += 512) { const float g = rstd * dbg_dot(xs, W, NFF, 1024, j), up = rstd * dbg_dot(xs, W, NFF, 1024, DFF + j);
            dbg_err(dbg, st, bf2f(((const bf16_t*)(ws + WS_HID))[(size_t)r * DFF + j]), g / (1.0f + expf(-g)) * up, 0.03f, 0.03f); } }
}
__global__ void __launch_bounds__(512) dbg_kv(const float* mem, const float* gain, const float* W, unsigned char* ws, int st) {
    __shared__ float xs[1024]; __shared__ float red[8]; float* dbg = (float*)(ws + WS_DBG); const int r = blockIdx.x * 4 + 1, tid = threadIdx.x;
    float sq = 0.f; for (int k = tid; k < 1024; k += 512) { const float v = mem[(size_t)r * 1024 + k]; sq += v * v; xs[k] = v * gain[k]; }
    for (int o = 32; o >= 1; o >>= 1) sq += __shfl_xor(sq, o);
    if ((tid & 63) == 0) red[tid >> 6] = sq;
    __syncthreads();
    float tot = 0.f; for (int i = 0; i < 8; ++i) tot += red[i]; const float rstd = rsqrtf(tot * (1.0f / 1024.0f) + EPS);
    const int pos = (r & ~31) + 8 * ((r >> 2) & 3) + 4 * ((r >> 4) & 1) + (r & 3);
    for (int n = tid; n < 2048; n += 512) { const float ex = rstd * dbg_dot(xs, W, 2048, 1024, n);
        if (n < 1024) dbg_err(dbg, st, bf2f(((const bf16_t*)(ws + WS_KM))[(size_t)r * 1024 + n]), ex, 0.03f, 0.02f);
        else dbg_err(dbg, st + 1, bf2f(((const bf16_t*)(ws + WS_VMT))[(size_t)(n - 1024) * 256 + pos]), ex, 0.03f, 0.02f); }
}
__global__ void __launch_bounds__(512) dbg_xattn(unsigned char* ws, int st) {
    __shared__ float q[1024]; __shared__ float sc[256]; float* dbg = (float*)(ws + WS_DBG); const int r = dbg_row(blockIdx.x), tid = threadIdx.x;
    const bf16_t* XQ = (const bf16_t*)(ws + WS_XQ); const bf16_t* KM = (const bf16_t*)(ws + WS_KM); const bf16_t* VMT = (const bf16_t*)(ws + WS_VMT); const bf16_t* AO = (const bf16_t*)(ws + WS_AO);
    for (int k = tid; k < 1024; k += 512) q[k] = bf2f(XQ[(size_t)r * 1024 + k]);
    for (int h = 0; h < 4; ++h) {
        __syncthreads();
        if (tid < 256) { float a = 0.f; for (int d = 0; d < 256; ++d) a += q[256 * h + d] * bf2f(KM[(size_t)tid * 1024 + 256 * h + d]); sc[tid] = a; }
        __syncthreads();
        float mx = -INFINITY; for (int i = 0; i < 256; ++i) mx = fmaxf(mx, sc[i]); float sm = 0.f; for (int i = 0; i < 256; ++i) sm += exp2f(sc[i] - mx);
        if (tid < 256) { float o = 0.f; for (int key = 0; key < 256; ++key) { const int pos = (key & ~31) + 8 * ((key >> 2) & 3) + 4 * ((key >> 4) & 1) + (key & 3); o += exp2f(sc[key] - mx) * bf2f(VMT[(size_t)(256 * h + tid) * 256 + pos]); }
            dbg_err(dbg, st, bf2f(AO[(size_t)r * 1024 + 256 * h + tid]), o / sm, 0.02f, 0.02f); }
    }
}
__global__ void dbg_encode(unsigned char* ws, float* out, int nstage) {
    const float* dbg = (const float*)(ws + WS_DBG); int first = 0; for (int i = 1; i <= nstage; ++i) if (dbg[i] > 1.0f) { first = i; break; }
#ifdef DBG_PROBE
    { float e = dbg[DBG_PROBE] * 100.0f; first = e > 98.0f ? 98 : (int)(e + 0.5f); }
#endif
    const float c = sqrtf(10.0f * (float)first);
    for (size_t i = (size_t)blockIdx.x * blockDim.x + threadIdx.x; i < (size_t)S_ * D_; i += (size_t)gridDim.x * blockDim.x) out[i] = c;
}
#endif
extern "C" void kernel_launch(void* const* d_in, const int* in_sizes, int n_in, void* d_out, int out_size, void* d_ws, size_t ws_size, hipStream_t stream) {
    static int grid = 0;
    if (grid == 0) {
        if (n_in != 20 || out_size != S_ * D_ || ws_size < WS_END) { fprintf(stderr, "kernel_launch: unexpected shapes (n_in %d out %d ws %zu need %zu)\n", n_in, out_size, ws_size, (size_t)WS_END); grid = -1; return; }
        int dev = 0, cus = 0, per_cu = 0;
        if (hipGetDevice(&dev) != hipSuccess || hipDeviceGetAttribute(&cus, hipDeviceAttributeMultiprocessorCount, dev) != hipSuccess) { grid = -1; return; }
        if (hipFuncSetAttribute((const void*)mk_fwd, hipFuncAttributeMaxDynamicSharedMemorySize, LDS_BYTES) != hipSuccess) { fprintf(stderr, "kernel_launch: hipFuncSetAttribute failed\n"); grid = -1; return; }
        if (hipOccupancyMaxActiveBlocksPerMultiprocessor(&per_cu, (const void*)mk_fwd, NTHREADS, LDS_BYTES) != hipSuccess || per_cu < 1) { fprintf(stderr, "kernel_launch: occupancy query says %d\n", per_cu); }
        (void)hipGetLastError();
        grid = cus;
    }
    if (grid < 0) return;
    (void)hipMemsetAsync((char*)d_ws + WS_CTL, 0, CTL_ZERO_BYTES, stream);
    const float* p[20];
    for (int i = 0; i < 20; ++i) p[i] = (const float*)d_in[i];
#define MK_LAUNCH(LO, HI) hipLaunchKernelGGL(mk_fwd, dim3(grid), dim3(NTHREADS), LDS_BYTES, stream, p[0], p[1], p[2], p[3], p[4], p[5], p[6], p[7], p[8], p[9], p[10], p[11], p[12], p[13], p[14], p[15], p[16], p[17], p[18], p[19], \
        (float*)d_out, (unsigned char*)d_ws, (int)(LO), (int)(HI))
#if DBG_MODE == 1
    if (ws_size < WS_DBGEND3) { fprintf(stderr, "debug build: workspace too small\n"); return; }
    (void)hipMemsetAsync((char*)d_ws + WS_DBG, 0, 65536, stream);
    for (int ph = 0; ph <= 5; ++ph) MK_LAUNCH(ph, ph + 1);
    unsigned char* W8 = (unsigned char*)d_ws;
    hipLaunchKernelGGL(dbg_inproj, dim3(64), dim3(512), 0, stream, p[I_X], p[I_MIXG], p[I_WIN], W8);
    hipLaunchKernelGGL(dbg_sb, dim3(1), dim3(64), 0, stream, W8);
    hipLaunchKernelGGL(dbg_dsa, dim3(16), dim3(512), 0, stream, W8);
    hipLaunchKernelGGL(dbg_gla, dim3(4), dim3(512), 0, stream, p[I_GUP], p[I_GB], p[I_GNG], W8);
    hipLaunchKernelGGL(dbg_kv, dim3(64), dim3(512), 0, stream, p[I_MEM], p[I_MG], p[I_WXKV], W8, 26);
    MK_LAUNCH(6, 7);
    hipLaunchKernelGGL(dbg_merge, dim3(64), dim3(512), 0, stream, p[I_WBA], p[I_WBB], p[I_WBC], W8);
    MK_LAUNCH(7, 8);
    hipLaunchKernelGGL(dbg_resid, dim3(64), dim3(512), 0, stream, p[I_X], 0, p[I_WMIX], 1024, (size_t)WS_MERGED, (const float*)d_out, W8, 22, 0);
    MK_LAUNCH(8, 9);
    hipLaunchKernelGGL(dbg_normproj, dim3(64), dim3(512), 0, stream, (const float*)d_out, p[I_XG], p[I_WXQ], 0, W8, 25);
    hipLaunchKernelGGL(dbg_xattn, dim3(64), dim3(512), 0, stream, W8, 28);
    MK_LAUNCH(9, 10);
    hipLaunchKernelGGL(dbg_resid, dim3(64), dim3(512), 0, stream, (const float*)((char*)d_ws + WS_DBGCK), 1, p[I_WXO], 1024, (size_t)WS_AO, (const float*)d_out, W8, 29, 1);
    MK_LAUNCH(10, 11);
    hipLaunchKernelGGL(dbg_normproj, dim3(64), dim3(512), 0, stream, (const float*)d_out, p[I_FG], p[I_WFI], 1, W8, 32);
    MK_LAUNCH(11, 12);
    hipLaunchKernelGGL(dbg_resid, dim3(64), dim3(512), 0, stream, (const float*)((char*)d_ws + WS_DBGCK) + 64 * 1024, 1, p[I_WFO], DFF, (size_t)WS_HID, (const float*)d_out, W8, 33, 0);
    hipLaunchKernelGGL(dbg_encode, dim3(1024), dim3(256), 0, stream, W8, (float*)d_out, 35);
#elif N_LAUNCH_MODE == 1
    MK_LAUNCH(0, N_PHASES);
#else
    for (int ph = 0; ph < N_PHASES; ++ph) MK_LAUNCH(ph, ph + 1);
#endif
}
```

```cpp
#include <hip/hip_runtime.h>
#include <stdint.h>
#include <stdio.h>

#define LAS __attribute__((address_space(3)))
typedef unsigned short bf16_t;
typedef short bf16x8 __attribute__((ext_vector_type(8)));
typedef float f32x4 __attribute__((ext_vector_type(4)));
typedef float f32x2 __attribute__((ext_vector_type(2)));
typedef unsigned u32x4 __attribute__((ext_vector_type(4)));
typedef unsigned u32x2 __attribute__((ext_vector_type(2)));
typedef short s16x4 __attribute__((ext_vector_type(4)));

#ifndef DBG_MODE
#define DBG_MODE 0
#endif
#ifndef STAMP_A
#define STAMP_A 0
#endif
#define STAMP_MUL 4
#ifndef ONLY
#define ONLY -1
#endif
#define PH_EN(k) (ONLY < 0 || ONLY == (k))
#ifndef N_LAUNCH_MODE
#define N_LAUNCH_MODE 1
#endif

constexpr int S_ = 16384, D_ = 1024, NIN = 5376, INW = 5332, DFF = 2816, NFF = 5632, NMEM = 256, DEPTH = 4;
constexpr int NTHREADS = 512;
constexpr int LDS_BYTES = 147456;
constexpr int MISC_OFF = 143360;
constexpr float EPS = 1e-6f;
constexpr float LOG2E = 1.4426950408889634f;
constexpr float SBQ_SCALE = 0.125f * LOG2E;
constexpr float DSQ_SCALE = 0.125f * LOG2E;
constexpr float IXQ_SCALE = 0.125f;
constexpr float GLQ_SCALE = 0.17677669529663687f;
constexpr float XQ_SCALE = 0.0625f * LOG2E;

constexpr size_t MB = 1u << 20;
constexpr size_t WS_CTL = 0;
constexpr size_t WS_CS = 65536;
constexpr size_t WS_SSQ = WS_CS + 4 * MB;
constexpr size_t WS_MEMB = WS_SSQ + 1 * MB;
constexpr size_t WS_RSTDM = WS_MEMB + 512 * 1024;
constexpr size_t WS_KM = WS_RSTDM + 4096;
constexpr size_t WS_VMT = WS_KM + 512 * 1024;
constexpr size_t WS_WIN = WS_VMT + 512 * 1024;
constexpr size_t WS_WBR = WS_WIN + (size_t)NIN * 1024 * 2;
constexpr size_t WS_WMIX = WS_WBR + 3 * 1024 * 256 * 2;
constexpr size_t WS_WXQ = WS_WMIX + 2 * MB;
constexpr size_t WS_WXKV = WS_WXQ + 2 * MB;
constexpr size_t WS_WXO = WS_WXKV + 4 * MB;
constexpr size_t WS_WFI = WS_WXO + 2 * MB;
constexpr size_t WS_WFO = WS_WFI + (size_t)NFF * 1024 * 2;
constexpr size_t WS_XB = WS_WFO + (size_t)1024 * DFF * 2;
constexpr size_t WS_SBQ = WS_XB + 32 * MB;
constexpr size_t WS_SBK = WS_SBQ + 8 * MB;
constexpr size_t WS_SBV = WS_SBK + 8 * MB;
constexpr size_t WS_DSQ = WS_SBV + 8 * MB;
constexpr size_t WS_IXQ = WS_DSQ + 8 * MB;
constexpr size_t WS_DSK = WS_IXQ + 8 * MB;
constexpr size_t WS_IXK = WS_DSK + 2 * MB;
constexpr size_t WS_DSV = WS_IXK + 2 * MB;
constexpr size_t WS_SMALL = WS_DSV + 2 * MB;
constexpr size_t WS_GLQ = WS_SMALL + 4 * MB;
constexpr size_t WS_GLK = WS_GLQ + 4 * MB;
constexpr size_t WS_GLV = WS_GLK + 4 * MB;
constexpr size_t WS_GLO = WS_GLV + 8 * MB;
constexpr size_t WS_OA = WS_GLO + 8 * MB;
constexpr size_t WS_OB = WS_OA + 8 * MB;
constexpr size_t WS_OC = WS_OB + 8 * MB;
constexpr size_t WS_BC = WS_OC + 8 * MB;
constexpr size_t WS_UC = WS_BC + 8 * MB;
constexpr size_t WS_ST = WS_UC + 8 * MB;
constexpr size_t WS_AC = WS_ST + 8 * MB;
constexpr size_t WS_SBVT = WS_AC + 128 * 1024;
constexpr size_t WS_GLVT = WS_SBVT + 8 * MB;
constexpr size_t WS_MERGED = WS_GLVT + 8 * MB;
constexpr size_t WS_GATES = WS_MERGED + 32 * MB;
constexpr size_t WS_XQ = WS_GATES;
constexpr size_t WS_AO = WS_GATES + 32 * MB;
constexpr size_t WS_HID = WS_GATES;
constexpr size_t WS_END = WS_GATES + 96 * MB;
constexpr size_t WS_DBG = WS_END;
constexpr size_t WS_DBGSEL = WS_DBG + 65536;
constexpr size_t WS_DBGEND = WS_DBGSEL + 8 * MB;
constexpr size_t CTL_ZERO_BYTES = 65536;
constexpr int CW_BAR = 0;
constexpr int CW_QUEUE = 4096;

typedef __bf16 bf16x2_t __attribute__((ext_vector_type(2)));
__device__ __forceinline__ unsigned cvt_pk_bf16(float lo, float hi) { const f32x2 v = {lo, hi}; return __builtin_bit_cast(unsigned, __builtin_convertvector(v, bf16x2_t)); }
__device__ __forceinline__ bf16_t f2bf(float f) { return (bf16_t)(cvt_pk_bf16(f, 0.f) & 0xffffu); }
__device__ __forceinline__ float bf2f(unsigned b) { return __uint_as_float(b << 16); }
__device__ __forceinline__ float bflo(unsigned w) { return __uint_as_float(w << 16); }
__device__ __forceinline__ float bfhi(unsigned w) { return __uint_as_float(w & 0xffff0000u); }
__device__ __forceinline__ void st_bf16x8(bf16_t* p, const float (&v)[8]) {
    u32x4 w; w.x = cvt_pk_bf16(v[0], v[1]); w.y = cvt_pk_bf16(v[2], v[3]); w.z = cvt_pk_bf16(v[4], v[5]); w.w = cvt_pk_bf16(v[6], v[7]); *(u32x4*)p = w; }
__device__ __forceinline__ void ld_bf16x8(const bf16_t* p, float (&v)[8]) {
    const u32x4 w = *(const u32x4*)p; v[0] = bflo(w.x); v[1] = bfhi(w.x); v[2] = bflo(w.y); v[3] = bfhi(w.y); v[4] = bflo(w.z); v[5] = bfhi(w.z); v[6] = bflo(w.w); v[7] = bfhi(w.w); }
__device__ __forceinline__ float row_rstd(const float* ssq, int r) {
    const f32x4* p = (const f32x4*)(ssq + (size_t)r * 16); const f32x4 a = p[0], b = p[1], c = p[2], d = p[3];
    const float s = ((a.x + a.y) + (a.z + a.w)) + ((b.x + b.y) + (b.z + b.w)) + ((c.x + c.y) + (c.z + c.w)) + ((d.x + d.y) + (d.z + d.w));
    return rsqrtf(s * (1.0f / 1024.0f) + EPS); }
__device__ __forceinline__ float sigmoidf_(float v) { return __builtin_amdgcn_rcpf(1.0f + __builtin_amdgcn_exp2f(-v * LOG2E)); }
__device__ __forceinline__ float shx(float v, int m, int lane) { return __int_as_float(__builtin_amdgcn_ds_bpermute((lane ^ m) << 2, __float_as_int(v))); }
__device__ __forceinline__ unsigned shdn(unsigned v, int off, int lane) { return (unsigned)__builtin_amdgcn_ds_bpermute((lane + off) << 2, (int)v); }
__device__ __forceinline__ float wave_sum(float v, int lane) { for (int o = 32; o >= 1; o >>= 1) v += shx(v, o, lane); return v; }
__device__ __forceinline__ float wave_max(float v, int lane) { for (int o = 32; o >= 1; o >>= 1) v = fmaxf(v, shx(v, o, lane)); return v; }

__device__ __forceinline__ int mytid(int wave) { int lane; asm volatile("v_mbcnt_lo_u32_b32 %0, -1, 0\n\tv_mbcnt_hi_u32_b32 %0, -1, %0" : "=v"(lane)); asm volatile("" : "+s"(wave)); return wave * 64 + lane; }

#define XB_TMO      128
#define XB_XCNT(j)  (256  + 64 * (j))
#define XB_XSUB(j)  (1280 + 64 * (j))
#define XB_XGEN(j)  (2304 + 64 * (j))
#define XB_TOP      3328
#define XB_TOPGEN   3392
#define XCD_BAR_WORDS 3456
#define XB_SPIN_CAP (1u << 22)
__device__ __forceinline__ unsigned xb_ld(unsigned* p)              { return __hip_atomic_load(p, __ATOMIC_RELAXED, __HIP_MEMORY_SCOPE_AGENT); }
__device__ __forceinline__ unsigned xb_add(unsigned* p, unsigned v) { return __hip_atomic_fetch_add(p, v, __ATOMIC_RELAXED, __HIP_MEMORY_SCOPE_AGENT); }
__device__ __forceinline__ unsigned xb_xcc_id() { return (unsigned)__builtin_amdgcn_s_getreg((3 << 11) | 20) & 0xFu; }
#define XB_SPIN(cond, bar) do { unsigned _sp = 0; while (cond) { __builtin_amdgcn_s_sleep(1); \
    if ((++_sp & 255u) == 0u) { if (xb_ld(&(bar)[XB_TMO])) break; if (_sp > XB_SPIN_CAP) { atomicAdd(&(bar)[XB_TMO], 1u); break; } } } } while (0)
struct XcdBarrier { unsigned* bar; unsigned x; volatile LAS unsigned* st; };
__device__ __forceinline__ XcdBarrier xcd_barrier_post(unsigned* bar, volatile LAS unsigned* st, int wave_s) {
    XcdBarrier b; b.bar = bar; b.x = xb_xcc_id(); b.st = st;
    if (mytid(wave_s) == 0) (void)xb_add(&bar[XB_XCNT(b.x)], 1u);
    return b;
}
__device__ __forceinline__ void xcd_barrier_complete(unsigned* bar, unsigned x, unsigned& nloc, unsigned& nx) {
    const unsigned G = gridDim.x * gridDim.y * gridDim.z;
    unsigned sum, cnt, mine, sp = 0u;
    for (;;) {
        sum = 0u; cnt = 0u; mine = 0u;
#pragma unroll
        for (unsigned j = 0; j < 16; ++j) { const unsigned c = xb_ld(&bar[XB_XCNT(j)]); sum += c; cnt += (c > 0u) ? 1u : 0u; mine = (j == x) ? c : mine; }
        if (sum == G) break;
        __builtin_amdgcn_s_sleep(1);
        if ((++sp & 255u) == 0u) { if (xb_ld(&bar[XB_TMO])) break; if (sp > XB_SPIN_CAP) { atomicAdd(&bar[XB_TMO], 1u); break; } }
    }
    nloc = mine > 0u ? mine : 1u; nx = cnt > 0u ? cnt : 1u;
}
__device__ __forceinline__ void xcd_barrier(const XcdBarrier& b, int wave_s) {
    asm volatile("s_waitcnt vmcnt(0)" ::: "memory");
    __syncthreads();
    if (mytid(wave_s) == 0) {
        unsigned* bar = b.bar;
        __builtin_amdgcn_s_waitcnt(0);
        unsigned nloc = b.st[0], nx = b.st[1];
        if (nloc == 0u) { xcd_barrier_complete(bar, b.x, nloc, nx); b.st[0] = nloc; b.st[1] = nx; }
        const unsigned old = xb_add(&bar[XB_XSUB(b.x)], 1u);
        const unsigned gen = old / nloc;
        if (old + 1u == (gen + 1u) * nloc) {
            __builtin_amdgcn_fence(__ATOMIC_RELEASE, "agent");
            asm volatile("s_waitcnt vmcnt(0)" ::: "memory");
            const unsigned og = xb_add(&bar[XB_TOP], 1u);
            const unsigned tg = og / nx;
            if (og + 1u == (tg + 1u) * nx) xb_add(&bar[XB_TOPGEN], 1u);
            else XB_SPIN(xb_ld(&bar[XB_TOPGEN]) == tg, bar);
            __builtin_amdgcn_fence(__ATOMIC_ACQUIRE, "agent");
            xb_add(&bar[XB_XGEN(b.x)], 1u);
            asm volatile("s_waitcnt vmcnt(0)" ::: "memory");
        } else {
            XB_SPIN(xb_ld(&bar[XB_XGEN(b.x)]) == gen, bar);
            __builtin_amdgcn_fence(__ATOMIC_ACQUIRE, "agent");
            asm volatile("s_waitcnt vmcnt(0)" ::: "memory");
        }
    }
    __syncthreads();
}

#if DBG_MODE == 3
#define TICKR(ring_, wave_, i) do { if (blockIdx.x == 0 && mytid(wave_) == 0) { volatile LAS unsigned long long* _a = (volatile LAS unsigned long long*)((ring_) + MISC_OFF + 2560); const unsigned long long _n = __builtin_amdgcn_s_memrealtime(); if ((i) > 0) _a[(i)] += _n - _a[0]; _a[0] = _n; } } while (0)
#else
#define TICKR(ring_, wave_, i) do { } while (0)
#endif
namespace pg8 {
constexpr int BM = 256, BK = 64, HALF = 128, HTB = HALF * BK * 2, STAGE_BYTES = 8 * HTB, NXCD = 8, WGM = 8;
__host__ __device__ __forceinline__ int lds_byte(int r, int c) { const int st = (r >> 4) * 2 + (c >> 5), rr = r & 15, cc = c & 31, ob = rr * 64 + cc * 2; return st * 1024 + (ob ^ (((ob >> 9) & 1) << 5)); }
__host__ __device__ __forceinline__ void stage_rc(int b, int& R, int& C) { const int st = b / 1024, sb = b % 1024, swz = sb ^ (((sb >> 9) & 1) << 5); R = (st >> 1) * 16 + swz / 64; C = (st & 1) * 32 + (swz % 64) / 2; }
__host__ __device__ __forceinline__ int perm32(int rho) { const int n = rho >> 4, i = rho & 15; return 8 * (i >> 2) + 4 * n + (i & 3); }
struct Unit { int pm, pn, z; };
struct Gemm { const bf16_t* A; const bf16_t* Bt; int M, N, K; size_t azstep, bzstep; };
struct StaticOrder {
    int nM, nN, nwg, G, c;
    __host__ __device__ void init(int M, int N, int G_, int c_) { nM = M / BM; nN = N / BM; nwg = nM * nN; G = G_; c = c_; }
    __host__ __device__ bool next(int i, Unit& u) const {
        const long L = (long)i * G + c; if (L >= nwg) return false;
        int wgid = (int)L; { const int q = nwg / NXCD, r = nwg % NXCD, xcd = wgid % NXCD, off = wgid / NXCD; wgid = (xcd < r ? xcd * (q + 1) : r * (q + 1) + (xcd - r) * q) + off; }
        const int nig = WGM * nN, gid = wgid / nig, fm = gid * WGM, gsz = (nM - fm) < WGM ? (nM - fm) : WGM;
        u.pm = fm + ((wgid % nig) % gsz); u.pn = (wgid % nig) / gsz; u.z = 0; return true;
    }
    __device__ __forceinline__ void a_ready(const Unit&) const {}
    __device__ __forceinline__ void done(const Unit&) const {}
};
struct TripleOrder : StaticOrder {
    __host__ __device__ bool next(int i, Unit& u) const { const int b = i / 3; if (!StaticOrder::next(b, u)) return false; u.z = i - 3 * b; return true; }
};
template <class Epi, class Sched>
__device__ __forceinline__ void gemm_phase(LAS unsigned char* lds, const Gemm g, const Sched& S, const Epi& E, int wave_s) {
    const int tid_l = mytid(wave_s);
    const int tid = tid_l, wid = __builtin_amdgcn_readfirstlane(tid >> 6), lane = tid & 63, wr = wid >> 2, wc = wid & 3, fr = lane & 15, fq = lane >> 4;
    const int K = g.K, nt = K / BK;
    unsigned voffA[2], voffB[2];
#pragma unroll
    for (int i = 0; i < 2; ++i) { int R, C; stage_rc(tid * 16 + i * 8192, R, C); const int Rb = Epi::PERM ? ((R & ~31) + perm32(R & 31)) : R;
        voffA[i] = (unsigned)(R * K + C) * 2u; voffB[i] = (unsigned)(Rb * K + C) * 2u; }
    const size_t kstep = (size_t)(BK * 2);
    const size_t hstep = (size_t)HALF * K * 2;
    const size_t tstep = 2 * hstep;
    const unsigned ldsw = (unsigned)wid * 1024u;
    const int aoff = lds_byte(wr * 64 + fr, fq * 8), boff = lds_byte(wc * 32 + fr, fq * 8);
#define PG8_SA(b, h) (((b) * 2 + (h)) * HTB)
#define PG8_SB(b, h) ((4 + (b) * 2 + (h)) * HTB)
#define PG8_STAGE(bufoff, gbase, voff) do { _Pragma("unroll") for (int _i = 0; _i < 2; ++_i) \
        __builtin_amdgcn_global_load_lds((const unsigned*)((const char*)(gbase) + (voff)[_i]), (LAS unsigned*)(lds + (bufoff) + ldsw + _i * 8192), 16, 0, 0); } while (0)
#define PG8_LDA(dst, b, h) do { _Pragma("unroll") for (int m = 0; m < 4; ++m) _Pragma("unroll") for (int k = 0; k < 2; ++k) dst[m][k] = *(const LAS bf16x8*)(lds + PG8_SA(b, h) + aoff + m * 2048 + k * 1024); } while (0)
#define PG8_LDB(dst, b, h) do { _Pragma("unroll") for (int n = 0; n < 2; ++n) _Pragma("unroll") for (int k = 0; k < 2; ++k) dst[n][k] = *(const LAS bf16x8*)(lds + PG8_SB(b, h) + boff + n * 2048 + k * 1024); } while (0)
#define PG8_MMA(ai, bj, At, Bt) do { __builtin_amdgcn_s_setprio(1); _Pragma("unroll") for (int m = 0; m < 4; ++m) _Pragma("unroll") for (int n = 0; n < 2; ++n) _Pragma("unroll") for (int k = 0; k < 2; ++k) \
        acc[ai][bj][m][n] = __builtin_amdgcn_mfma_f32_16x16x32_bf16(Bt[n][k], At[m][k], acc[ai][bj][m][n], 0, 0, 0); __builtin_amdgcn_s_setprio(0); } while (0)
#define PG8_WAIT_V(n) asm volatile("s_waitcnt vmcnt(" #n ")" ::: "memory")
#define PG8_WAIT_L(n) asm volatile("s_waitcnt lgkmcnt(" #n ")" ::: "memory")
#define PG8_BAR __builtin_amdgcn_s_barrier()
#define PG8_SCHED __builtin_amdgcn_sched_barrier(0)
    Unit cur, nxt; int ui = 0;
    if (!S.next(0, cur)) return;
    TICKR(lds, wave_s, 0);
#if DBG_MODE == 3
    if (blockIdx.x == 0 && mytid(wave_s) == 0) ((volatile LAS unsigned long long*)(lds + MISC_OFF + 2560))[11] = clock64();
#endif
    cur.pm = __builtin_amdgcn_readfirstlane(cur.pm); cur.pn = __builtin_amdgcn_readfirstlane(cur.pn); cur.z = __builtin_amdgcn_readfirstlane(cur.z);
    f32x4 acc[2][2][4][2];
#pragma unroll
    for (int a = 0; a < 2; ++a)
#pragma unroll
        for (int b = 0; b < 2; ++b)
#pragma unroll
            for (int m = 0; m < 4; ++m)
#pragma unroll
                for (int n = 0; n < 2; ++n) acc[a][b][m][n] = (f32x4){0.f, 0.f, 0.f, 0.f};
    bf16x8 At[4][2], B0[2][2], B1[2][2];
    const char* cA = (const char*)g.A + (size_t)cur.pm * tstep + (size_t)cur.z * g.azstep; const char* cB = (const char*)g.Bt + (size_t)cur.pn * tstep + (size_t)cur.z * g.bzstep;
    S.a_ready(cur);
    PG8_STAGE(PG8_SB(0, 0), cB, voffB); PG8_STAGE(PG8_SA(0, 0), cA, voffA); PG8_STAGE(PG8_SB(0, 1), cB + hstep, voffB); PG8_STAGE(PG8_SA(0, 1), cA + hstep, voffA);
    if (wr == 1) PG8_BAR;
    PG8_WAIT_V(4); PG8_BAR;
    PG8_STAGE(PG8_SB(1, 0), cB + kstep, voffB); PG8_STAGE(PG8_SA(1, 0), cA + kstep, voffA); PG8_STAGE(PG8_SB(1, 1), cB + hstep + kstep, voffB);
    PG8_WAIT_V(6); PG8_BAR;
    for (;;) {
        const bool has_next = S.next(ui + 1, nxt);
        nxt.pm = __builtin_amdgcn_readfirstlane(nxt.pm); nxt.pn = __builtin_amdgcn_readfirstlane(nxt.pn); nxt.z = __builtin_amdgcn_readfirstlane(nxt.z);
        const char* nA = has_next ? (const char*)g.A + (size_t)nxt.pm * tstep + (size_t)nxt.z * g.azstep : cA; const char* nB = has_next ? (const char*)g.Bt + (size_t)nxt.pn * tstep + (size_t)nxt.z * g.bzstep : cB;
        for (int t = 0; t < nt; t += 2) {
            const bool last = (t == nt - 2);
            const char* a1 = cA + (size_t)(t + 1) * kstep;
            const char* a2 = last ? nA : cA + (size_t)(t + 2) * kstep; const char* b2 = last ? nB : cB + (size_t)(t + 2) * kstep;
            const char* a3 = a2 + kstep; const char* b3 = b2 + kstep;
            if (last && has_next) S.a_ready(nxt);
            PG8_LDB(B0, 0, 0); PG8_SCHED; PG8_LDA(At, 0, 0); PG8_STAGE(PG8_SA(1, 1), a1 + hstep, voffA);
            PG8_WAIT_L(8); PG8_BAR; PG8_WAIT_L(0); PG8_MMA(0, 0, At, B0); PG8_BAR; PG8_SCHED;
            PG8_LDB(B1, 0, 1); PG8_STAGE(PG8_SB(0, 0), b2, voffB);
            PG8_BAR; PG8_WAIT_L(0); PG8_MMA(0, 1, At, B1); PG8_BAR;
            PG8_LDA(At, 0, 1); PG8_STAGE(PG8_SA(0, 0), a2, voffA);
            PG8_BAR; PG8_WAIT_L(0); PG8_MMA(1, 0, At, B0); PG8_BAR; PG8_SCHED;
            PG8_STAGE(PG8_SB(0, 1), b2 + hstep, voffB);
            PG8_WAIT_V(6); PG8_BAR; PG8_MMA(1, 1, At, B1); PG8_BAR;
            PG8_LDB(B0, 1, 0); PG8_SCHED; PG8_LDA(At, 1, 0); PG8_STAGE(PG8_SA(0, 1), a2 + hstep, voffA);
            PG8_WAIT_L(8); PG8_BAR; PG8_WAIT_L(0); PG8_MMA(0, 0, At, B0); PG8_BAR; PG8_SCHED;
            PG8_LDB(B1, 1, 1); PG8_STAGE(PG8_SB(1, 0), b3, voffB);
            PG8_BAR; PG8_WAIT_L(0); PG8_MMA(0, 1, At, B1); PG8_BAR;
            PG8_LDA(At, 1, 1); PG8_STAGE(PG8_SA(1, 0), a3, voffA);
            PG8_BAR; PG8_WAIT_L(0); PG8_MMA(1, 0, At, B0); PG8_BAR; PG8_SCHED;
            PG8_STAGE(PG8_SB(1, 1), b3 + hstep, voffB);
            PG8_WAIT_V(6); PG8_BAR; PG8_MMA(1, 1, At, B1); PG8_BAR;
        }
        TICKR(lds, wave_s, 8);
#if DBG_MODE == 3
        if (blockIdx.x == 0 && mytid(wave_s) == 0) { volatile LAS unsigned long long* _a = (volatile LAS unsigned long long*)(lds + MISC_OFF + 2560); const unsigned long long _c = clock64(); _a[10] += _c - _a[11]; }
#endif
        { const int l2 = mytid(wave_s) & 63; E(acc, cur, wr, wc, l2 >> 2, l2 & 3); }
        TICKR(lds, wave_s, 9);
#if DBG_MODE == 3
        if (blockIdx.x == 0 && mytid(wave_s) == 0) ((volatile LAS unsigned long long*)(lds + MISC_OFF + 2560))[11] = clock64();
#endif
        if (!has_next) break;
#pragma unroll
        for (int a = 0; a < 2; ++a)
#pragma unroll
            for (int b = 0; b < 2; ++b)
#pragma unroll
                for (int m = 0; m < 4; ++m)
#pragma unroll
                    for (int n = 0; n < 2; ++n) acc[a][b][m][n] = (f32x4){0.f, 0.f, 0.f, 0.f};
        cur = nxt; cA = nA; cB = nB; ++ui;
    }
    PG8_WAIT_V(0);
    if (wr == 0) PG8_BAR;
    PG8_BAR;
#undef PG8_SA
#undef PG8_SB
#undef PG8_STAGE
#undef PG8_LDA
#undef PG8_LDB
#undef PG8_MMA
#undef PG8_WAIT_V
#undef PG8_WAIT_L
#undef PG8_BAR
#undef PG8_SCHED
}
}

#define GAS __attribute__((address_space(1)))
struct Args { float* out; unsigned char* ws; LAS unsigned char* ring; int wave; };
__device__ __forceinline__ unsigned char* opq(unsigned char* p) { unsigned z = 0; asm volatile("" : "+s"(z)); return p + z; }
__device__ __forceinline__ int obid() { int b = blockIdx.x; asm volatile("" : "+s"(b)); return b; }
__device__ __forceinline__ int ogrid() { int b = gridDim.x; asm volatile("" : "+s"(b)); return b; }
constexpr int ARGV_OFF = MISC_OFF + 3072;
__device__ __forceinline__ const GAS float* ldarg(const Args& A, int i) {
    volatile LAS unsigned* p = (volatile LAS unsigned*)(A.ring + ARGV_OFF) + 2 * i; unsigned lo = p[0], hi = p[1];
    lo = __builtin_amdgcn_readfirstlane(lo); hi = __builtin_amdgcn_readfirstlane(hi);
    return (const GAS float*)(((unsigned long long)hi << 32) | lo); }
#if DBG_MODE == 3
#define TICK(A_, i) do { if (obid() == 0 && mytid((A_).wave) == 0) { volatile LAS unsigned long long* _a = (volatile LAS unsigned long long*)((A_).ring + MISC_OFF + 2560); const unsigned long long _n = __builtin_amdgcn_s_memrealtime(); if ((i) > 0) _a[(i)] += _n - _a[0]; _a[0] = _n; } } while (0)
#else
#define TICK(A_, i) do { } while (0)
#endif
enum { I_X = 0, I_MEM, I_MIXG, I_WIN, I_GUP, I_GB, I_GNG, I_WBA, I_WBB, I_WBC, I_WMIX, I_XG, I_MG, I_WXQ, I_WXKV, I_WXO, I_FG, I_WFI, I_WFO, I_FING };

typedef const f32x4 (&AccRef)[2][2][4][2];
#define EPI_XPOSE(a_, b_) do { const int xa_ = (fq * 16 + fr) << 2; _Pragma("unroll") for (int i = 0; i < 8; ++i) { a_[i] = __int_as_float(__builtin_amdgcn_ds_bpermute(xa_, __float_as_int(a_[i]))); b_[i] = __int_as_float(__builtin_amdgcn_ds_bpermute(xa_, __float_as_int(b_[i]))); } } while (0)
#define EPI_ROWS_BEGIN _Pragma("unroll") for (int ai = 0; ai < 2; ++ai) _Pragma("unroll") for (int m = 0; m < 4; ++m) { \
    const int r = u.pm * 256 + ai * 128 + wr * 64 + m * 16 + fr; float a[8], b[8]; \
    _Pragma("unroll") for (int i = 0; i < 8; ++i) { a[i] = acc[ai][0][m][i >> 2][i & 3]; b[i] = acc[ai][1][m][i >> 2][i & 3]; } EPI_XPOSE(a, b);
#define EPI_ROWS_END asm volatile("" ::: "memory"); }

#define EPI_AB(ai_, m_) float a[8], b[8]; _Pragma("unroll") for (int i = 0; i < 8; ++i) { a[i] = acc[ai_][0][m_][i >> 2][i & 3]; b[i] = acc[ai_][1][m_][i >> 2][i & 3]; } EPI_XPOSE(a, b);
#define EPI_ROWOF(ai_, m_) (u.pm * 256 + (ai_) * 128 + wr * 64 + (m_) * 16 + fr)
#define EPI_RSTD4(ssq_, ai_, rs_) do { f32x4 q_[4]; _Pragma("unroll") for (int m = 0; m < 4; ++m) q_[m] = *(const f32x4*)((ssq_) + (size_t)EPI_ROWOF(ai_, m) * 16 + 4 * fq);        \
    _Pragma("unroll") for (int m = 0; m < 4; ++m) { float t_ = (q_[m].x + q_[m].y) + (q_[m].z + q_[m].w); t_ += shx(t_, 1, 4 * fr + fq); t_ += shx(t_, 2, 4 * fr + fq); rs_[m] = rsqrtf(t_ * (1.0f / 1024.0f) + EPS); } } while (0)
#define EPI_AB0(ai_, m_) float a[8], b[8]; _Pragma("unroll") for (int i = 0; i < 8; ++i) { a[i] = acc[ai_][0][m_][i >> 2][i & 3]; b[i] = acc[ai_][1][m_][i >> 2][i & 3]; }
#define EPI_RS_ORIG(rs_, rso_) do { const int ra_ = (4 * ((4 * fr + fq) & 15)) << 2; _Pragma("unroll") for (int m = 0; m < 4; ++m) rso_[m] = __int_as_float(__builtin_amdgcn_ds_bpermute(ra_, __float_as_int(rs_[m]))); } while (0)
__device__ __forceinline__ void st_bf16x8_x(bf16_t* p, const float (&v)[8], int xa) {
    u32x4 w; w.x = (unsigned)__builtin_amdgcn_ds_bpermute(xa, (int)cvt_pk_bf16(v[0], v[1])); w.y = (unsigned)__builtin_amdgcn_ds_bpermute(xa, (int)cvt_pk_bf16(v[2], v[3]));
    w.z = (unsigned)__builtin_amdgcn_ds_bpermute(xa, (int)cvt_pk_bf16(v[4], v[5])); w.w = (unsigned)__builtin_amdgcn_ds_bpermute(xa, (int)cvt_pk_bf16(v[6], v[7])); *(u32x4*)p = w; }
struct EpiIn {
    static constexpr bool PERM = true;
    const float* ssq; const float* cs;
    bf16_t *sbq, *sbk, *sbv, *dsq, *ixq, *dsk, *ixk, *dsv, *glq, *glk, *glv, *glo, *gates; float* small; bf16_t* sbvt; int pn_off; bf16_t* glvt;
    __device__ __forceinline__ void operator()(AccRef acc, const pg8::Unit& u, int wr, int wc, int fr, int fq) const {
        const int pn = u.pn + pn_off;
        int mode = 0, ld = 256, off0 = wc * 32, off1 = 128 + wc * 32; float sc0 = 1.0f, sc1 = 1.0f; bf16_t* O0 = sbq; bf16_t* O1 = sbq;
        if (pn == 0) { O0 = O1 = sbq; sc0 = sc1 = SBQ_SCALE; }
        else if (pn == 1) { O0 = O1 = sbk; }
        else if (pn == 2) { O0 = O1 = sbv; }
        else if (pn == 3) { O0 = O1 = dsq; mode = 1; sc0 = sc1 = DSQ_SCALE; off0 = wc * 64; off1 = wc * 64 + 32; }
        else if (pn == 4) { O0 = O1 = ixq; mode = 1; sc0 = sc1 = IXQ_SCALE; off0 = wc * 64; off1 = wc * 64 + 32; }
        else if (pn == 5) { ld = 64; off0 = 0; off1 = 32;
            if (wc == 0) { O0 = O1 = dsk; mode = 1; } else if (wc == 1) { O0 = O1 = ixk; mode = 1; } else if (wc == 2) { O0 = O1 = dsv; } else { O0 = O1 = (bf16_t*)small; mode = 4; } }
        else if (pn == 6) { O0 = glq; O1 = glk; ld = 128; off1 = wc * 32; sc0 = GLQ_SCALE; }
        else if (pn == 7) { O0 = O1 = glv; }
        else if (pn == 8) { O0 = O1 = glo; mode = 2; }
        else { O0 = O1 = gates + (pn - 9) * 256; ld = 3072; mode = 3; }
        if (mode == 1 || mode == 4) {
#pragma unroll
        for (int ai = 0; ai < 2; ++ai) {
            float rs4[4]; EPI_RSTD4(ssq, ai, rs4);
#pragma unroll
            for (int m = 0; m < 4; ++m) { const int r = EPI_ROWOF(ai, m); EPI_AB(ai, m)
                const float rs = rs4[m];
#pragma unroll
                for (int i = 0; i < 8; ++i) { a[i] *= rs * sc0; b[i] *= rs * sc1; }
                if (mode == 1) {
                    const f32x4* cp = (const f32x4*)(cs + ((size_t)r * 32 + fq * 8) * 2);
#pragma unroll
                    for (int i2 = 0; i2 < 4; ++i2) { const f32x4 q = cp[i2];
                        const float a0 = a[2 * i2], b0 = b[2 * i2], a1 = a[2 * i2 + 1], b1 = b[2 * i2 + 1];
                        a[2 * i2] = a0 * q.x - b0 * q.y; b[2 * i2] = b0 * q.x + a0 * q.y; a[2 * i2 + 1] = a1 * q.z - b1 * q.w; b[2 * i2 + 1] = b1 * q.z + a1 * q.w; }
                }
                if (mode == 4) { float* p = (float*)O0 + (size_t)r * 64 + fq * 8;
                    *(f32x4*)p = (f32x4){a[0], a[1], a[2], a[3]}; *(f32x4*)(p + 4) = (f32x4){a[4], a[5], a[6], a[7]};
                    *(f32x4*)(p + 32) = (f32x4){b[0], b[1], b[2], b[3]}; *(f32x4*)(p + 36) = (f32x4){b[4], b[5], b[6], b[7]}; }
                else { st_bf16x8(O0 + (size_t)r * ld + off0 + fq * 8, a); st_bf16x8(O1 + (size_t)r * ld + off1 + fq * 8, b); }
            }
            asm volatile("" ::: "memory");
        }
        } else {
        const int xa = (fq * 16 + fr) << 2;
#pragma unroll
        for (int ai = 0; ai < 2; ++ai) {
            float rs4[4], rso[4]; EPI_RSTD4(ssq, ai, rs4); EPI_RS_ORIG(rs4, rso);
#pragma unroll
            for (int m = 0; m < 4; ++m) { const int r = EPI_ROWOF(ai, m); EPI_AB0(ai, m)
                const float rs = rso[m];
#pragma unroll
                for (int i = 0; i < 8; ++i) { a[i] *= rs * sc0; b[i] *= rs * sc1; }
                if (mode == 2) {
#pragma unroll
                    for (int i = 0; i < 8; ++i) { a[i] = a[i] * sigmoidf_(a[i]); b[i] = b[i] * sigmoidf_(b[i]); }
                } else if (mode == 3) {
#pragma unroll
                    for (int i = 0; i < 8; ++i) { a[i] = sigmoidf_(a[i]); b[i] = sigmoidf_(b[i]); }
                }
                st_bf16x8_x(O0 + (size_t)r * ld + off0 + fq * 8, a, xa); st_bf16x8_x(O1 + (size_t)r * ld + off1 + fq * 8, b, xa);
            }
            asm volatile("" ::: "memory");
        }
        }
    }
};
struct EpiKV {
    static constexpr bool PERM = true;
    const float* rstdm; bf16_t* km; bf16_t* vmt;
    __device__ __forceinline__ void operator()(AccRef acc, const pg8::Unit& u, int wr, int wc, int fr, int fq) const {
        const int c8 = wc * 32 + fq * 8, pn = u.pn;
        EPI_ROWS_BEGIN
            const float rs = rstdm[r];
#pragma unroll
            for (int i = 0; i < 8; ++i) { a[i] *= rs; b[i] *= rs; }
            if (pn < 4) { st_bf16x8(km + (size_t)r * 1024 + pn * 256 + c8, a); st_bf16x8(km + (size_t)r * 1024 + pn * 256 + 128 + c8, b); }
            else {
                const int pos = (r & ~31) + 8 * ((r >> 2) & 3) + 4 * ((r >> 4) & 1) + (r & 3);
                const int d0 = (pn - 4) * 256 + c8;
#pragma unroll
                for (int i = 0; i < 8; ++i) { vmt[(size_t)(d0 + i) * 256 + pos] = f2bf(a[i]); vmt[(size_t)(d0 + 128 + i) * 256 + pos] = f2bf(b[i]); }
            }
        EPI_ROWS_END
    }
};
struct EpiMerge {
    static constexpr bool PERM = true;
    const bf16_t* gates; bf16_t* merged;
    __device__ __forceinline__ void operator()(AccRef acc, const pg8::Unit& u, int wr, int wc, int fr, int fq) const {
        const int c = u.pn * 256 + wc * 32 + fq * 8, br = u.z;
#pragma unroll
        for (int ai = 0; ai < 2; ++ai) {
            u32x4 gw[4][2], mw[4][2];
#pragma unroll
            for (int m = 0; m < 4; ++m) { const int r = EPI_ROWOF(ai, m); const bf16_t* gp = gates + (size_t)r * 3072 + br * 1024 + c; gw[m][0] = *(const u32x4*)gp; gw[m][1] = *(const u32x4*)(gp + 128);
                if (br > 0) { const bf16_t* mp = merged + (size_t)r * 1024 + c; mw[m][0] = *(const u32x4*)mp; mw[m][1] = *(const u32x4*)(mp + 128); } }
#pragma unroll
            for (int m = 0; m < 4; ++m) { const int r = EPI_ROWOF(ai, m); EPI_AB(ai, m)
                const unsigned g0[4] = {gw[m][0].x, gw[m][0].y, gw[m][0].z, gw[m][0].w}, g1[4] = {gw[m][1].x, gw[m][1].y, gw[m][1].z, gw[m][1].w};
#pragma unroll
                for (int i = 0; i < 4; ++i) { a[2 * i] *= bflo(g0[i]); a[2 * i + 1] *= bfhi(g0[i]); b[2 * i] *= bflo(g1[i]); b[2 * i + 1] *= bfhi(g1[i]); }
                if (br > 0) { const unsigned m0[4] = {mw[m][0].x, mw[m][0].y, mw[m][0].z, mw[m][0].w}, m1[4] = {mw[m][1].x, mw[m][1].y, mw[m][1].z, mw[m][1].w};
#pragma unroll
                    for (int i = 0; i < 4; ++i) { a[2 * i] += bflo(m0[i]); a[2 * i + 1] += bfhi(m0[i]); b[2 * i] += bflo(m1[i]); b[2 * i + 1] += bfhi(m1[i]); } }
                bf16_t* mp = merged + (size_t)r * 1024 + c; st_bf16x8(mp, a); st_bf16x8(mp + 128, b); }
            asm volatile("" ::: "memory");
        }
    }
};
struct EpiRes {
    static constexpr bool PERM = true;
    float* x; bf16_t* xb; float* ssq;
    __device__ __forceinline__ void operator()(AccRef acc, const pg8::Unit& u, int wr, int wc, int fr, int fq) const {
        const int c8 = wc * 32 + fq * 8;
#pragma unroll
        for (int ai = 0; ai < 2; ++ai) {
            u32x4 xv[4][2];
#pragma unroll
            for (int m = 0; m < 4; ++m) { const bf16_t* xp = xb + (size_t)EPI_ROWOF(ai, m) * 1024 + u.pn * 256 + c8; xv[m][0] = *(const u32x4*)xp; xv[m][1] = *(const u32x4*)(xp + 128); }
#pragma unroll
            for (int m = 0; m < 4; ++m) { const int r = EPI_ROWOF(ai, m); EPI_AB(ai, m)
                a[0] += bflo(xv[m][0].x); a[1] += bfhi(xv[m][0].x); a[2] += bflo(xv[m][0].y); a[3] += bfhi(xv[m][0].y); a[4] += bflo(xv[m][0].z); a[5] += bfhi(xv[m][0].z); a[6] += bflo(xv[m][0].w); a[7] += bfhi(xv[m][0].w);
                b[0] += bflo(xv[m][1].x); b[1] += bfhi(xv[m][1].x); b[2] += bflo(xv[m][1].y); b[3] += bfhi(xv[m][1].y); b[4] += bflo(xv[m][1].z); b[5] += bfhi(xv[m][1].z); b[6] += bflo(xv[m][1].w); b[7] += bfhi(xv[m][1].w);
                if (x) { float* xp = x + (size_t)r * 1024 + u.pn * 256 + c8;
                    *(f32x4*)xp = (f32x4){a[0], a[1], a[2], a[3]}; *(f32x4*)(xp + 4) = (f32x4){a[4], a[5], a[6], a[7]};
                    *(f32x4*)(xp + 128) = (f32x4){b[0], b[1], b[2], b[3]}; *(f32x4*)(xp + 132) = (f32x4){b[4], b[5], b[6], b[7]}; }
                else { bf16_t* bp = xb + (size_t)r * 1024 + u.pn * 256 + c8; st_bf16x8(bp, a); st_bf16x8(bp + 128, b); }
                float sq = 0.f;
#pragma unroll
                for (int i = 0; i < 8; ++i) sq += a[i] * a[i] + b[i] * b[i];
                sq += shx(sq, 1, 4 * fr + fq); sq += shx(sq, 2, 4 * fr + fq);
                if (fq == 0) ssq[(size_t)r * 16 + u.pn * 4 + wc] = sq; }
            asm volatile("" ::: "memory");
        }
    }
};
struct EpiXq {
    static constexpr bool PERM = true;
    const float* ssq; bf16_t* xq;
    __device__ __forceinline__ void operator()(AccRef acc, const pg8::Unit& u, int wr, int wc, int fr, int fq) const {
        const int c8 = wc * 32 + fq * 8, xa = (fq * 16 + fr) << 2;
#pragma unroll
        for (int ai = 0; ai < 2; ++ai) {
            float rs4[4], rso[4]; EPI_RSTD4(ssq, ai, rs4); EPI_RS_ORIG(rs4, rso);
#pragma unroll
            for (int m = 0; m < 4; ++m) { const int r = EPI_ROWOF(ai, m); EPI_AB0(ai, m)
                const float rs = rso[m] * XQ_SCALE;
#pragma unroll
                for (int i = 0; i < 8; ++i) { a[i] *= rs; b[i] *= rs; }
                bf16_t* O = xq + (size_t)r * 1024 + u.pn * 256 + c8; st_bf16x8_x(O, a, xa); st_bf16x8_x(O + 128, b, xa); }
            asm volatile("" ::: "memory");
        }
    }
};
struct EpiFfnIn {
    static constexpr bool PERM = true;
    const float* ssq; bf16_t* hid;
    __device__ __forceinline__ void operator()(AccRef acc, const pg8::Unit& u, int wr, int wc, int fr, int fq) const {
        const int c8 = wc * 32 + fq * 8, xa = (fq * 16 + fr) << 2;
#pragma unroll
        for (int ai = 0; ai < 2; ++ai) {
            float rs4[4], rso[4]; EPI_RSTD4(ssq, ai, rs4); EPI_RS_ORIG(rs4, rso);
#pragma unroll
            for (int m = 0; m < 4; ++m) { const int r = EPI_ROWOF(ai, m); EPI_AB0(ai, m)
                const float rs = rso[m];
#pragma unroll
                for (int i = 0; i < 8; ++i) { const float g = a[i] * rs, up = b[i] * rs; a[i] = g * sigmoidf_(g) * up; }
                st_bf16x8_x(hid + (size_t)r * DFF + u.pn * 128 + c8, a, xa); }
            asm volatile("" ::: "memory");
        }
    }
};

__device__ __forceinline__ int nlog_win(int n) {
    const int t = n >> 8, p = n & 255;
    if (t < 3) return n;
    if (t == 3 || t == 4) { const int bj = p >> 7, hh = (p & 127) >> 5, dd = p & 31; return (t == 3 ? 768 : 1152) + 64 * hh + 32 * bj + dd; }
    if (t == 5) { const int bj = p >> 7, g = (p & 127) >> 5, dd = p & 31, j = 32 * bj + dd;
        if (g == 0) return 1024 + j; if (g == 1) return 1408 + j; if (g == 2) return 1088 + j;
        if (j < 4) return 1472 + j; if (j < 20) return 1988 + (j - 4); return -1; }
    if (t == 6) return (p < 128) ? 1476 + p : 1604 + (p - 128);
    if (t == 7) return 1732 + p;
    if (t == 8) return 2004 + p;
    return 2260 + (t - 9) * 256 + p;
}
__device__ __forceinline__ int nlog_ffn(int n) { const int j = n >> 8, p = n & 255; return (p >> 7) * DFF + 128 * j + (p & 127); }
struct ConvJob { const GAS float* W; const GAS float* gain; bf16_t* Bt; int ldw, K, map, kt, ns; };
__device__ __forceinline__ ConvJob conv_job(const Args& A, unsigned char* ws, int l, int t) {
    ConvJob j; int tt = t; j.gain = nullptr; j.map = 0;
    if (tt < 336) { j.W = ldarg(A, I_WIN) + (size_t)l * 1024 * INW; j.ldw = INW; j.K = 1024; j.map = 1; j.gain = ldarg(A, I_MIXG) + l * 1024; j.Bt = (bf16_t*)(ws + WS_WIN); j.kt = tt & 15; j.ns = tt >> 4; }
    else if ((tt -= 336) < 128) { j.W = ldarg(A, I_WXKV) + (size_t)l * 2097152; j.ldw = 2048; j.K = 1024; j.gain = ldarg(A, I_MG) + l * 1024; j.Bt = (bf16_t*)(ws + WS_WXKV); j.kt = tt & 15; j.ns = tt >> 4; }
    else if ((tt -= 128) < 48) { const int b = tt >> 4, q = tt & 15; const GAS float* w0 = ldarg(A, I_WBA); const GAS float* w1 = ldarg(A, I_WBB); const GAS float* w2 = ldarg(A, I_WBC); j.W = (b == 0 ? w0 : (b == 1 ? w1 : w2)) + (size_t)l * 256 * 1024; j.ldw = 1024; j.K = 256; j.Bt = (bf16_t*)(ws + WS_WBR) + (size_t)b * 262144; j.kt = q & 3; j.ns = q >> 2; }
    else if ((tt -= 48) < 64) { j.W = ldarg(A, I_WMIX) + (size_t)l * 1048576; j.ldw = 1024; j.K = 1024; j.Bt = (bf16_t*)(ws + WS_WMIX); j.kt = tt & 15; j.ns = tt >> 4; }
    else if ((tt -= 64) < 64) { j.W = ldarg(A, I_WXQ) + (size_t)l * 1048576; j.ldw = 1024; j.K = 1024; j.gain = ldarg(A, I_XG) + l * 1024; j.Bt = (bf16_t*)(ws + WS_WXQ); j.kt = tt & 15; j.ns = tt >> 4; }
    else if ((tt -= 64) < 64) { j.W = ldarg(A, I_WXO) + (size_t)l * 1048576; j.ldw = 1024; j.K = 1024; j.Bt = (bf16_t*)(ws + WS_WXO); j.kt = tt & 15; j.ns = tt >> 4; }
    else if ((tt -= 64) < 352) { j.W = ldarg(A, I_WFI) + (size_t)l * 1024 * NFF; j.ldw = NFF; j.K = 1024; j.map = 2; j.gain = ldarg(A, I_FG) + l * 1024; j.Bt = (bf16_t*)(ws + WS_WFI); j.kt = tt & 15; j.ns = tt >> 4; }
    else { tt -= 352; j.W = ldarg(A, I_WFO) + (size_t)l * DFF * 1024; j.ldw = 1024; j.K = DFF; j.Bt = (bf16_t*)(ws + WS_WFO); j.kt = tt % 44; j.ns = tt / 44; }
    return j;
}
#define CONV_LOAD(j_, v_, g_) do { const int nn_ = tid & 255, kq_ = tid >> 8, n_ = (j_).ns * 256 + nn_; const int nl_ = (j_).map == 0 ? n_ : ((j_).map == 1 ? nlog_win(n_) : nlog_ffn(n_)); \
        _Pragma("unroll") for (int i = 0; i < 32; ++i) { const int kk_ = (j_).kt * 64 + kq_ + 2 * i; v_[i] = nl_ >= 0 ? (j_).W[(size_t)kk_ * (j_).ldw + nl_] : 0.f; g_[i] = (j_).gain ? (j_).gain[kk_] : 1.0f; } } while (0)
#define CONV_WRITE(tile_, v_, g_) do { const int nn_ = tid & 255, kq_ = tid >> 8; _Pragma("unroll") for (int i = 0; i < 32; ++i) (tile_)[(kq_ + 2 * i) * 257 + nn_] = v_[i] * g_[i]; } while (0)
#define CONV_STORE(tile_, j_) do { const int nn_ = tid >> 1, kh_ = tid & 1; _Pragma("unroll") for (int jj = 0; jj < 4; ++jj) { float o_[8]; \
        _Pragma("unroll") for (int i = 0; i < 8; ++i) o_[i] = (tile_)[(32 * kh_ + 8 * jj + i) * 257 + nn_]; \
        st_bf16x8((j_).Bt + (size_t)((j_).ns * 256 + nn_) * (j_).K + (j_).kt * 64 + 32 * kh_ + 8 * jj, o_); } } while (0)
constexpr int CONV_EARLY = 704, CONV_ALL = 1232;
__device__ __forceinline__ void conv_range(LAS unsigned char* lds, const Args& A, int l, int first, int end, int widx, int nw) {
    unsigned char* ws = opq(A.ws);
    const int Gl = nw, tid = mytid(A.wave);
    LAS float* t0 = (LAS float*)lds; LAS float* t1 = (LAS float*)(lds + 65792);
    float va[32], ga[32], vb[32], gb[32];
    int t = first + widx; if (t >= end) return;
    ConvJob ja = conv_job(A, ws, l, t), jb = ja;
    CONV_LOAD(ja, va, ga);
    for (;;) {
        CONV_WRITE(t0, va, ga);
        const bool hb = t + Gl < end; if (hb) { jb = conv_job(A, ws, l, t + Gl); CONV_LOAD(jb, vb, gb); }
        __syncthreads();
        CONV_STORE(t0, ja);
        if (!hb) break;
        t += Gl;
        CONV_WRITE(t1, vb, gb);
        const bool ha = t + Gl < end; if (ha) { ja = conv_job(A, ws, l, t + Gl); CONV_LOAD(ja, va, ga); }
        __syncthreads();
        CONV_STORE(t1, jb);
        if (!ha) break;
        t += Gl;
    }
    __syncthreads();
}
#undef CONV_LOAD
#undef CONV_WRITE
#undef CONV_STORE

__constant__ float c_inv_freq[32] = {1.000000000e+00f, 7.498942018e-01f, 5.623413324e-01f, 4.216965139e-01f, 3.162277639e-01f, 2.371373922e-01f, 1.778279394e-01f, 1.333521456e-01f,
    1.000000015e-01f, 7.498941571e-02f, 5.623412877e-02f, 4.216964915e-02f, 3.162277862e-02f, 2.371373586e-02f, 1.778279431e-02f, 1.333521493e-02f,
    9.999999776e-03f, 7.498942316e-03f, 5.623413250e-03f, 4.216964822e-03f, 3.162277862e-03f, 2.371373819e-03f, 1.778279431e-03f, 1.333521446e-03f,
    1.000000047e-03f, 7.498941850e-04f, 5.623413017e-04f, 4.216965463e-04f, 3.162277862e-04f, 2.371373848e-04f, 1.778279402e-04f, 1.333521504e-04f};
__device__ __forceinline__ void prologue(LAS unsigned char* lds, const Args& A) {
    unsigned char* ws = opq(A.ws); const int tid = mytid(A.wave), lane = tid & 63, wave = tid >> 6; const int bid = obid(), Gl = ogrid();
    { const GAS float* x = ldarg(A, I_X); bf16_t* xb = (bf16_t*)(ws + WS_XB); float* ssq = (float*)(ws + WS_SSQ);
      for (int r = bid * 8 + wave; r < S_; r += Gl * 8) {
          const GAS float* xr = x + (size_t)r * 1024 + lane * 16; float v[16]; float sq = 0.f;
#pragma unroll
          for (int i = 0; i < 4; ++i) { const f32x4 q = *(const GAS f32x4*)(xr + 4 * i); v[4 * i] = q.x; v[4 * i + 1] = q.y; v[4 * i + 2] = q.z; v[4 * i + 3] = q.w; }
#pragma unroll
          for (int i = 0; i < 16; ++i) sq += v[i] * v[i];
          sq = wave_sum(sq, lane);
          float v0[8], v1[8];
#pragma unroll
          for (int i = 0; i < 8; ++i) { v0[i] = v[i]; v1[i] = v[8 + i]; }
          st_bf16x8(xb + (size_t)r * 1024 + lane * 16, v0); st_bf16x8(xb + (size_t)r * 1024 + lane * 16 + 8, v1);
          if (lane < 16) ssq[(size_t)r * 16 + lane] = lane == 0 ? sq : 0.f;
      } }
    { const GAS float* mem = ldarg(A, I_MEM); bf16_t* memb = (bf16_t*)(ws + WS_MEMB); float* rstdm = (float*)(ws + WS_RSTDM);
      for (int r = bid * 8 + wave; r < NMEM; r += Gl * 8) {
          const GAS float* xr = mem + (size_t)r * 1024 + lane * 16; float v0[8], v1[8]; float sq = 0.f;
#pragma unroll
          for (int i = 0; i < 8; ++i) { v0[i] = xr[i]; v1[i] = xr[8 + i]; sq += v0[i] * v0[i] + v1[i] * v1[i]; }
          sq = wave_sum(sq, lane);
          st_bf16x8(memb + (size_t)r * 1024 + lane * 16, v0); st_bf16x8(memb + (size_t)r * 1024 + lane * 16 + 8, v1);
          if (lane == 0) rstdm[r] = rsqrtf(sq * (1.0f / 1024.0f) + EPS);
      } }
    { float* cs = (float*)(ws + WS_CS);
      for (int i = bid * NTHREADS + tid; i < S_ * 32; i += Gl * NTHREADS) {
          const int pos = i >> 5, dd = i & 31; const float angf = (float)pos * c_inv_freq[dd]; const double a = (double)angf;
          const double kk = rint(a * 0.63661977236758134); double rr = fma(-kk, 1.5707963267948966, a); rr = fma(-kk, 6.123233995736766e-17, rr);
          const double r2 = rr * rr;
          const double sn = rr * (1.0 + r2 * (-1.0 / 6 + r2 * (1.0 / 120 + r2 * (-1.0 / 5040 + r2 * (1.0 / 362880 + r2 * (-1.0 / 39916800 + r2 * (1.0 / 6227020800.0)))))));
          const double cn = 1.0 + r2 * (-0.5 + r2 * (1.0 / 24 + r2 * (-1.0 / 720 + r2 * (1.0 / 40320 + r2 * (-1.0 / 3628800 + r2 * (1.0 / 479001600.0))))));
          const int q = ((int)kk) & 3; double c, s;
          if (q == 0) { c = cn; s = sn; } else if (q == 1) { c = -sn; s = cn; } else if (q == 2) { c = -cn; s = -sn; } else { c = sn; s = -cn; }
          cs[2 * i] = (float)c; cs[2 * i + 1] = (float)s;
      } }
}

__device__ __forceinline__ void sb_unit(LAS unsigned char* lds, const Args& A, int u) {
    unsigned char* ws = opq(A.ws); const int tid_l = mytid(A.wave); const int tid = tid_l, lane = tid & 63, wave = __builtin_amdgcn_readfirstlane(tid >> 6), fr = lane & 15, fq = lane >> 4;
    const bf16_t* Q = (const bf16_t*)(ws + WS_SBQ); const bf16_t* Kp = (const bf16_t*)(ws + WS_SBK); const bf16_t* Vp = (const bf16_t*)(ws + WS_SBV); bf16_t* O = (bf16_t*)(ws + WS_OA);
    LAS unsigned char* vst = lds + wave * 4608;
    const int vrow = 8 * ((lane >> 3) & 3) + 4 * ((lane >> 5) & 1) + ((lane >> 1) & 3), vhalf = lane & 1;
    const int h = wave & 3, qw = u * 128 + 64 * (wave >> 2);
    bf16x8 qf[4][2];
#pragma unroll
    for (int g = 0; g < 4; ++g)
#pragma unroll
        for (int s = 0; s < 2; ++s) qf[g][s] = *(const bf16x8*)(Q + (size_t)(qw + 16 * g + fr) * 256 + 64 * h + 32 * s + 8 * fq);
    f32x4 oacc[4][4];
#pragma unroll
    for (int g = 0; g < 4; ++g)
#pragma unroll
        for (int dg = 0; dg < 4; ++dg) oacc[g][dg] = (f32x4){0.f, 0.f, 0.f, 0.f};
    float runp[4] = {1.f, 1.f, 1.f, 1.f};
    const bool inc1 = (fq & 1) == 0, inc2 = (fq & 2) == 0, inc3 = (fq & 2) == 0;
    const int a1 = (lane ^ 16) << 2, a2 = (lane ^ 32) << 2, a3 = (lane ^ 48) << 2;
    bf16x8 nkf[2][2]; u32x4 nvr[4];
#define SB_LOAD(kb_) do { _Pragma("unroll") for (int a_ = 0; a_ < 2; ++a_) _Pragma("unroll") for (int s_ = 0; s_ < 2; ++s_) nkf[a_][s_] = *(const bf16x8*)(Kp + (size_t)((kb_) + 16 * a_ + fr) * 256 + 64 * h + 32 * s_ + 8 * fq); \
        _Pragma("unroll") for (int i_ = 0; i_ < 4; ++i_) nvr[i_] = *(const u32x4*)(Vp + (size_t)((kb_) + (lane >> 1)) * 256 + 64 * h + 32 * vhalf + 8 * i_); } while (0)
    SB_LOAD(qw + 32);
    for (int kb = qw + 32; kb >= 0; kb -= 32) {
        bf16x8 kf[2][2], vf[4];
#pragma unroll
        for (int a_ = 0; a_ < 2; ++a_)
#pragma unroll
            for (int s_ = 0; s_ < 2; ++s_) kf[a_][s_] = nkf[a_][s_];
#pragma unroll
        for (int i = 0; i < 4; ++i) *(LAS u32x4*)(vst + vrow * 144 + 64 * vhalf + 16 * i) = nvr[i];
        if (kb >= 32) SB_LOAD(kb - 32);
#pragma unroll
        for (int dg = 0; dg < 4; ++dg) { const s16x4 lo_ = __builtin_amdgcn_ds_read_tr16_b64_v4i16((LAS s16x4*)(vst + (8 * fq + (fr >> 2)) * 144 + 32 * dg + 8 * (fr & 3)));
            const s16x4 hi_ = __builtin_amdgcn_ds_read_tr16_b64_v4i16((LAS s16x4*)(vst + (8 * fq + 4 + (fr >> 2)) * 144 + 32 * dg + 8 * (fr & 3)));
            vf[dg] = __builtin_shufflevector(lo_, hi_, 0, 1, 2, 3, 4, 5, 6, 7); }
        bool alldone = true;
#pragma unroll
        for (int g = 0; g < 4; ++g) {
            const int qg = qw + 16 * g;
            if (kb >= qg + 15) { alldone = false; continue; }
            if (__all(runp[g] == 0.f)) continue;
            alldone = false;
            f32x4 sa[2];
#pragma unroll
            for (int a_ = 0; a_ < 2; ++a_) { sa[a_] = __builtin_amdgcn_mfma_f32_16x16x32_bf16(kf[a_][0], qf[g][0], (f32x4){0.f, 0.f, 0.f, 0.f}, 0, 0, 0); sa[a_] = __builtin_amdgcn_mfma_f32_16x16x32_bf16(kf[a_][1], qf[g][1], sa[a_], 0, 0, 0); }
            const bool diag = kb + 31 >= qg; const int t = qg + fr;
            float w[2][4];
#pragma unroll
            for (int ai = 1; ai >= 0; --ai) {
                float kp[4], bt[4];
#pragma unroll
                for (int r = 0; r < 4; ++r) { const float e = __builtin_amdgcn_exp2f(fminf(sa[ai][r], 120.0f)); kp[r] = __builtin_amdgcn_rcpf(1.0f + e); bt[r] = e * kp[r]; }
                if (diag) {
#pragma unroll
                    for (int r = 0; r < 4; ++r) { const bool valid = kb + 16 * ai + 4 * fq + r < t; kp[r] = valid ? kp[r] : 1.0f; bt[r] = valid ? bt[r] : 0.0f; } }
                const float pl = (kp[0] * kp[1]) * (kp[2] * kp[3]);
                const float x1 = __int_as_float(__builtin_amdgcn_ds_bpermute(a1, __float_as_int(pl))), x2 = __int_as_float(__builtin_amdgcn_ds_bpermute(a2, __float_as_int(pl))), x3 = __int_as_float(__builtin_amdgcn_ds_bpermute(a3, __float_as_int(pl)));
                float pref = runp[g] * (inc1 ? x1 : 1.0f) * (inc2 ? x2 : 1.0f) * (inc3 ? x3 : 1.0f);
                w[ai][3] = bt[3] * pref; pref *= kp[3]; w[ai][2] = bt[2] * pref; pref *= kp[2]; w[ai][1] = bt[1] * pref; pref *= kp[1]; w[ai][0] = bt[0] * pref;
                runp[g] *= (pl * x1) * (x2 * x3);
            }
            u32x4 pw; pw.x = cvt_pk_bf16(w[0][0], w[0][1]); pw.y = cvt_pk_bf16(w[0][2], w[0][3]); pw.z = cvt_pk_bf16(w[1][0], w[1][1]); pw.w = cvt_pk_bf16(w[1][2], w[1][3]);
            const bf16x8 pf = __builtin_bit_cast(bf16x8, pw);
#pragma unroll
            for (int dg = 0; dg < 4; ++dg) oacc[g][dg] = __builtin_amdgcn_mfma_f32_16x16x32_bf16(vf[dg], pf, oacc[g][dg], 0, 0, 0);
        }
        if (alldone) break;
    }
#undef SB_LOAD
#pragma unroll
    for (int g = 0; g < 4; ++g)
#pragma unroll
        for (int dg = 0; dg < 4; ++dg) { u32x2 w2; w2.x = cvt_pk_bf16(oacc[g][dg].x, oacc[g][dg].y); w2.y = cvt_pk_bf16(oacc[g][dg].z, oacc[g][dg].w);
            *(u32x2*)(O + (size_t)(qw + 16 * g + fr) * 256 + 64 * h + 16 * dg + 4 * fq) = w2; }
}

__device__ __forceinline__ void gla1_unit(LAS unsigned char* lds, const Args& A, int l, int c) {
    unsigned char* ws = opq(A.ws); const int tid_l = mytid(A.wave); const int tid = tid_l;
    const float* small = (const float*)(ws + WS_SMALL); const bf16_t* GK = (const bf16_t*)(ws + WS_GLK); const bf16_t* GV = (const bf16_t*)(ws + WS_GLV);
    float* BC = (float*)(ws + WS_BC); float* UC = (float*)(ws + WS_UC); float* AC = (float*)(ws + WS_AC);
    const GAS float* wup = ldarg(A, I_GUP) + l * 16 * 128; const GAS float* gb = ldarg(A, I_GB) + l * 128;
    LAS float* la = (LAS float*)lds;
    LAS float* kh = (LAS float*)(lds + 32768);
    LAS float* vv = (LAS float*)(lds + 65536);
    const int row0 = c * 64;
    float kLog2e = LOG2E, kLn2 = 0.6931471805599453f; asm volatile("" : "+v"(kLog2e), "+v"(kLn2));
    LAS float* wl = (LAS float*)(lds + 131072);
    for (int i = tid; i < 2048 + 128; i += NTHREADS) wl[i] = i < 2048 ? wup[i] : gb[i - 2048];
    __syncthreads();
    { const int t = tid >> 3, jg = tid & 7; float g[16];
#pragma unroll
      for (int i = 0; i < 4; ++i) { const f32x4 q = *(const f32x4*)(small + (size_t)(row0 + t) * 64 + 4 + 4 * i); g[4 * i] = q.x; g[4 * i + 1] = q.y; g[4 * i + 2] = q.z; g[4 * i + 3] = q.w; }
      for (int jj = 0; jj < 16; ++jj) { const int j = 16 * jg + jj; float x = wl[2048 + j];
#pragma unroll
          for (int r = 0; r < 16; ++r) x += g[r] * wl[r * 128 + j];
          const float ls = fminf(x, 0.f) - __builtin_amdgcn_logf(1.0f + __builtin_amdgcn_exp2f(-fabsf(x) * kLog2e)) * kLn2;
          la[t * 128 + j] = ls * (1.0f / 16.0f); } }
    for (int i = tid; i < 64 * 32; i += NTHREADS) { const int t = i >> 5, c8 = (i & 31) * 8; float v[8]; ld_bf16x8(GV + (size_t)(row0 + t) * 256 + c8, v);
#pragma unroll
        for (int j = 0; j < 8; ++j) vv[t * 256 + c8 + j] = v[j]; }
    __syncthreads();
    if (tid < 128) { float run = 0.f; for (int t = 0; t < 64; ++t) { run += la[t * 128 + tid]; la[t * 128 + tid] = run; BC[(size_t)(row0 + t) * 128 + tid] = run; } AC[c * 128 + tid] = __builtin_amdgcn_exp2f(run * kLog2e); }
    __syncthreads();
    for (int i = tid; i < 64 * 128; i += NTHREADS) { const int t = i >> 7, j = i & 127; kh[i] = bf2f(GK[(size_t)(row0 + t) * 128 + j]) * __builtin_amdgcn_exp2f((la[63 * 128 + j] - la[i]) * kLog2e); }
    __syncthreads();
    { const int hd = tid >> 2, eg = tid & 3, hh = hd >> 5; float a[16];
#pragma unroll
      for (int i = 0; i < 16; ++i) a[i] = 0.f;
      for (int t = 0; t < 64; ++t) { const float kk = kh[t * 128 + hd]; const LAS float* vp = vv + t * 256 + 64 * hh + 16 * eg;
#pragma unroll
          for (int i = 0; i < 16; ++i) a[i] += kk * vp[i]; }
      float* up = UC + (size_t)c * 8192 + hd * 64 + 16 * eg;
#pragma unroll
      for (int i = 0; i < 4; ++i) *(f32x4*)(up + 4 * i) = (f32x4){a[4 * i], a[4 * i + 1], a[4 * i + 2], a[4 * i + 3]}; }
    __syncthreads();
}
__device__ __forceinline__ void gla2_phase(LAS unsigned char* lds, const Args& A) {
    unsigned char* ws = opq(A.ws); const float* UC = (const float*)(ws + WS_UC); const float* AC = (const float*)(ws + WS_AC); float* ST = (float*)(ws + WS_ST);
    const int tid = mytid(A.wave), lane = tid & 63, seg = tid >> 6, bid = obid(); if (bid >= 128) return;
    const int gid = bid * 64 + lane, hd = bid;
    LAS float* Ls = (LAS float*)lds; LAS float* Ps = Ls + 512;
    float u[32], a[32];
#pragma unroll
    for (int i = 0; i < 32; ++i) { const int c = 32 * seg + i; u[i] = UC[(size_t)c * 8192 + gid]; a[i] = AC[c * 128 + hd]; }
    float L = 0.f, P = 1.f;
#pragma unroll
    for (int i = 0; i < 32; ++i) { L = a[i] * L + u[i]; P *= a[i]; }
    Ls[seg * 64 + lane] = L; Ps[seg * 64 + lane] = P;
    __syncthreads();
    float st = 0.f;
    for (int s2 = 0; s2 < seg; ++s2) st = Ps[s2 * 64 + lane] * st + Ls[s2 * 64 + lane];
#pragma unroll
    for (int i = 0; i < 32; ++i) { ST[(size_t)(32 * seg + i) * 8192 + gid] = st; st = a[i] * st + u[i]; }
}
__device__ __forceinline__ void glvt_slab(LAS unsigned char* lds, const Args& A, int sb) {
    unsigned char* ws = opq(A.ws); const int tid = mytid(A.wave); const bf16_t* GV = (const bf16_t*)(ws + WS_GLV); bf16_t* GVT = (bf16_t*)(ws + WS_GLVT);
    const int t0 = sb * 128;
#pragma unroll
    for (int i = 0; i < 8; ++i) { const int idx = tid + 512 * i, row = idx >> 5, c8 = (idx & 31) * 8; *(LAS u32x4*)(lds + row * 528 + c8 * 2) = *(const u32x4*)(GV + (size_t)(t0 + row) * 256 + c8); }
    __syncthreads();
#pragma unroll
    for (int i = 0; i < 8; ++i) { const int idx = tid + 512 * i, col = idx & 255, g = idx >> 8; float v[8];
#pragma unroll
        for (int k = 0; k < 8; ++k) { const int tok = 32 * (g >> 2) + 16 * (k >> 2) + 4 * (g & 3) + (k & 3); v[k] = bf2f(*(const LAS bf16_t*)(lds + tok * 528 + col * 2)); }
        st_bf16x8(GVT + (size_t)col * S_ + t0 + 8 * g, v); }
    __syncthreads();
}
__device__ __forceinline__ void gla3_unit(LAS unsigned char* lds, const Args& A, int l, int c) {
    unsigned char* ws = opq(A.ws); const int tid_l = mytid(A.wave); const int tid = tid_l, lane = tid & 63, wave = __builtin_amdgcn_readfirstlane(tid >> 6), fr = lane & 15, fq = lane >> 4;
    const bf16_t* GQ = (const bf16_t*)(ws + WS_GLQ); const bf16_t* GK = (const bf16_t*)(ws + WS_GLK); const bf16_t* GVT = (const bf16_t*)(ws + WS_GLVT); const bf16_t* GO = (const bf16_t*)(ws + WS_GLO);
    const float* BC = (const float*)(ws + WS_BC); const float* ST = (const float*)(ws + WS_ST) + (size_t)c * 8192; bf16_t* OC = (bf16_t*)(ws + WS_OC);
    const GAS float* gn = ldarg(A, I_GNG) + l * 64;
    LAS unsigned char* qb = lds;
    LAS unsigned char* kb = lds + 17408;
    LAS unsigned char* sb = lds + 34816;
    const int row0 = c * 64;
    float kLog2e = LOG2E; asm volatile("" : "+v"(kLog2e));
    for (int i = tid; i < 1024; i += NTHREADS) { const int t = i >> 4, j8 = (i & 15) * 8; float qv[8], kv[8];
        ld_bf16x8(GQ + (size_t)(row0 + t) * 128 + j8, qv); ld_bf16x8(GK + (size_t)(row0 + t) * 128 + j8, kv);
        const f32x4 b0 = *(const f32x4*)(BC + (size_t)(row0 + t) * 128 + j8), b1 = *(const f32x4*)(BC + (size_t)(row0 + t) * 128 + j8 + 4);
        const float bb[8] = {b0.x, b0.y, b0.z, b0.w, b1.x, b1.y, b1.z, b1.w};
#pragma unroll
        for (int k = 0; k < 8; ++k) { const float e = bb[k] * kLog2e; qv[k] *= __builtin_amdgcn_exp2f(e); kv[k] *= __builtin_amdgcn_exp2f(-e); }
        u32x4 wq4, wk4; wq4.x = cvt_pk_bf16(qv[0], qv[1]); wq4.y = cvt_pk_bf16(qv[2], qv[3]); wq4.z = cvt_pk_bf16(qv[4], qv[5]); wq4.w = cvt_pk_bf16(qv[6], qv[7]);
        wk4.x = cvt_pk_bf16(kv[0], kv[1]); wk4.y = cvt_pk_bf16(kv[2], kv[3]); wk4.z = cvt_pk_bf16(kv[4], kv[5]); wk4.w = cvt_pk_bf16(kv[6], kv[7]);
        *(LAS u32x4*)(qb + t * 272 + j8 * 2) = wq4; *(LAS u32x4*)(kb + t * 272 + j8 * 2) = wk4; }
    for (int i = tid; i < 2048; i += NTHREADS) { const int hd = i >> 4, e4 = (i & 15) * 4, hh = hd >> 5, d = hd & 31; const f32x4 v = *(const f32x4*)(ST + hd * 64 + e4);
        LAS bf16_t* p = (LAS bf16_t*)(sb + ((hh * 64 + e4) * 40 + d) * 2); p[0] = f2bf(v.x); p[40] = f2bf(v.y); p[80] = f2bf(v.z); p[120] = f2bf(v.w); }
    __syncthreads();
    const int h = wave & 3, th = wave >> 2;
#pragma unroll
    for (int tbl = 0; tbl < 2; ++tbl) { const int tb = 2 * th + tbl;
        const bf16x8 qf = *(const LAS bf16x8*)(qb + (16 * tb + fr) * 272 + (32 * h + 8 * fq) * 2);
        f32x4 sa[4];
#pragma unroll
        for (int jb = 0; jb < 4; ++jb) { sa[jb] = (f32x4){0.f, 0.f, 0.f, 0.f};
            if (jb <= tb) { const bf16x8 kf = *(const LAS bf16x8*)(kb + (16 * jb + fr) * 272 + (32 * h + 8 * fq) * 2); sa[jb] = __builtin_amdgcn_mfma_f32_16x16x32_bf16(kf, qf, sa[jb], 0, 0, 0); }
            if (jb == tb) {
#pragma unroll
                for (int r = 0; r < 4; ++r) if (4 * fq + r > fr) sa[jb][r] = 0.f; } }
        bf16x8 pf[2];
#pragma unroll
        for (int s2 = 0; s2 < 2; ++s2) { u32x4 w; w.x = cvt_pk_bf16(sa[2 * s2].x, sa[2 * s2].y); w.y = cvt_pk_bf16(sa[2 * s2].z, sa[2 * s2].w); w.z = cvt_pk_bf16(sa[2 * s2 + 1].x, sa[2 * s2 + 1].y); w.w = cvt_pk_bf16(sa[2 * s2 + 1].z, sa[2 * s2 + 1].w); pf[s2] = __builtin_bit_cast(bf16x8, w); }
        f32x4 oacc[4]; float sq = 0.f;
#pragma unroll
        for (int eb = 0; eb < 4; ++eb) {
            const bf16x8 sf = *(const LAS bf16x8*)(sb + ((h * 64 + 16 * eb + fr) * 40 + 8 * fq) * 2);
            f32x4 acc = __builtin_amdgcn_mfma_f32_16x16x32_bf16(sf, qf, (f32x4){0.f, 0.f, 0.f, 0.f}, 0, 0, 0);
            { const bf16x8 vf = *(const bf16x8*)(GVT + (size_t)(64 * h + 16 * eb + fr) * S_ + row0 + 8 * fq); acc = __builtin_amdgcn_mfma_f32_16x16x32_bf16(vf, pf[0], acc, 0, 0, 0); }
            if (tb >= 2) { const bf16x8 vf = *(const bf16x8*)(GVT + (size_t)(64 * h + 16 * eb + fr) * S_ + row0 + 32 + 8 * fq); acc = __builtin_amdgcn_mfma_f32_16x16x32_bf16(vf, pf[1], acc, 0, 0, 0); }
            oacc[eb] = acc; sq += (acc.x * acc.x + acc.y * acc.y) + (acc.z * acc.z + acc.w * acc.w); }
        sq += shx(sq, 16, lane); sq += shx(sq, 32, lane);
        const float rs = rsqrtf(sq * (1.0f / 64.0f) + EPS);
        const int t = row0 + 16 * tb + fr;
#pragma unroll
        for (int eb = 0; eb < 4; ++eb) { const int e0 = 16 * eb + 4 * fq; const f32x4 g4 = *(const GAS f32x4*)(gn + e0); const u32x2 gw = *(const u32x2*)(GO + (size_t)t * 256 + 64 * h + e0);
            u32x2 w2; w2.x = cvt_pk_bf16(oacc[eb].x * rs * g4.x * bflo(gw.x), oacc[eb].y * rs * g4.y * bfhi(gw.x)); w2.y = cvt_pk_bf16(oacc[eb].z * rs * g4.z * bflo(gw.y), oacc[eb].w * rs * g4.w * bfhi(gw.y));
            *(u32x2*)(OC + (size_t)t * 256 + 64 * h + e0) = w2; }
    }
    __syncthreads();
}

constexpr int DS_CAND = 384;
#ifdef FORCE_SLOW
constexpr int DS_TRIM = 12;
#else
constexpr int DS_TRIM = 256;
#endif
constexpr int DS_OFF_ZC = 65536;
constexpr int DS_OFF_CK = 65536;
constexpr int DS_OFF_CU = 90112;
constexpr int DS_OFF_SEL = 81920;
constexpr int DS_OFF_CTL = MISC_OFF + 128;
typedef short s16x2 __attribute__((ext_vector_type(2)));
typedef unsigned short u16x2 __attribute__((ext_vector_type(2)));
typedef __fp16 h16x2 __attribute__((ext_vector_type(2)));
__device__ __forceinline__ unsigned ds_bins2(float a, float b) {
    const s16x2 hs = __builtin_bit_cast(s16x2, __builtin_amdgcn_cvt_pkrtz(a, b)); const s16x2 sm = hs >> (s16x2){15, 15};
    const unsigned mono = __builtin_bit_cast(unsigned, hs) ^ (__builtin_bit_cast(unsigned, sm) | 0x80008000u);
    return __builtin_bit_cast(unsigned, __builtin_bit_cast(u16x2, mono) >> (u16x2){6, 6});
}
__device__ __forceinline__ float ds_h2f(unsigned hbits) { return (float)__builtin_bit_cast(__fp16, (unsigned short)hbits); }
__device__ __forceinline__ float ds_edge(int b) {
    if (b <= 0) return -INFINITY; if (b >= 1024) return INFINITY;
    if (b >= 512) return ds_h2f(((unsigned)b << 6) ^ 0x8000u);
    const float v = ds_h2f(~(((unsigned)b << 6) - 1u) & 0xffffu);
    return __uint_as_float(__float_as_uint(v) - 1u);
}
__device__ __forceinline__ void ds_compact(LAS unsigned char* lds, int qq, int need, int lane) {
    volatile LAS unsigned short* ck = (volatile LAS unsigned short*)(lds + DS_OFF_CK) + qq * DS_CAND; volatile LAS unsigned* cu = (volatile LAS unsigned*)(lds + DS_OFF_CU) + qq * DS_CAND;
    volatile LAS int* ctl = (volatile LAS int*)(lds + DS_OFF_CTL);
    const int n = ctl[32 + qq];
    if (n <= need) return;
    if (n <= 64) {
        const unsigned mu = lane < n ? cu[lane] : 0u, mk = lane < n ? (unsigned)ck[lane] : 0xffffffffu; int rank = 0;
        for (int j = 0; j < n; ++j) { const unsigned uj = (unsigned)__builtin_amdgcn_readlane((int)mu, j), kj = (unsigned)__builtin_amdgcn_readlane((int)mk, j); rank += (uj > mu || (uj == mu && kj < mk)) ? 1 : 0; }
        const bool keep = lane < n && rank < need; const unsigned long long mask = __ballot(keep); const int pos = __popcll(mask & ((1ull << lane) - 1ull));
        if (keep) { ck[pos] = (unsigned short)mk; cu[pos] = mu; if (rank == need - 1) { ctl[128 + qq] = (int)mu; ctl[160 + qq] = (int)mk; } }
        if (lane == 0) ctl[32 + qq] = need;
        return; }
    if (n <= 128) {
        const unsigned mu0 = cu[lane], mk0 = (unsigned)ck[lane]; const bool v1 = lane + 64 < n; const unsigned mu1 = v1 ? cu[lane + 64] : 0u, mk1 = v1 ? (unsigned)ck[lane + 64] : 0xffffffffu; int r0 = 0, r1 = 0;
        for (int j = 0; j < 64; ++j) { const unsigned uj = (unsigned)__builtin_amdgcn_readlane((int)mu0, j), kj = (unsigned)__builtin_amdgcn_readlane((int)mk0, j);
            r0 += (uj > mu0 || (uj == mu0 && kj < mk0)) ? 1 : 0; r1 += (uj > mu1 || (uj == mu1 && kj < mk1)) ? 1 : 0; }
        for (int j = 0; j < n - 64; ++j) { const unsigned uj = (unsigned)__builtin_amdgcn_readlane((int)mu1, j), kj = (unsigned)__builtin_amdgcn_readlane((int)mk1, j);
            r0 += (uj > mu0 || (uj == mu0 && kj < mk0)) ? 1 : 0; r1 += (uj > mu1 || (uj == mu1 && kj < mk1)) ? 1 : 0; }
        const bool k0 = r0 < need, k1 = v1 && r1 < need; const unsigned long long m0 = __ballot(k0), m1 = __ballot(k1); const unsigned long long below = (1ull << lane) - 1ull;
        const int p0 = __popcll(m0 & below), p1 = __popcll(m0) + __popcll(m1 & below);
        __builtin_amdgcn_s_waitcnt(0);
        if (k0) { ck[p0] = (unsigned short)mk0; cu[p0] = mu0; if (r0 == need - 1) { ctl[128 + qq] = (int)mu0; ctl[160 + qq] = (int)mk0; } }
        if (k1) { ck[p1] = (unsigned short)mk1; cu[p1] = mu1; if (r1 == need - 1) { ctl[128 + qq] = (int)mu1; ctl[160 + qq] = (int)mk1; } }
        if (lane == 0) ctl[32 + qq] = need;
        return; }
    unsigned mu[6], mk[6]; int rank[6];
#pragma unroll
    for (int ii = 0; ii < 6; ++ii) { const int i = lane + 64 * ii; mu[ii] = i < n ? cu[i] : 0u; mk[ii] = i < n ? (unsigned)ck[i] : 0xffffffffu; rank[ii] = 0; }
    const LAS unsigned short* ckn = (const LAS unsigned short*)(lds + DS_OFF_CK) + qq * DS_CAND; const LAS unsigned* cun = (const LAS unsigned*)(lds + DS_OFF_CU) + qq * DS_CAND;
#pragma unroll 4
    for (int j = 0; j < n; ++j) { const unsigned uj = cun[j], kj = ckn[j];
#pragma unroll
        for (int ii = 0; ii < 6; ++ii) rank[ii] += (uj > mu[ii] || (uj == mu[ii] && kj < mk[ii])) ? 1 : 0; }
    __builtin_amdgcn_s_waitcnt(0);
    int base = 0;
#pragma unroll
    for (int ii = 0; ii < 6; ++ii) { const int i = lane + 64 * ii; const bool keep = i < n && rank[ii] < need;
        const unsigned long long mask = __ballot(keep); const int pos = base + __popcll(mask & ((1ull << lane) - 1ull));
        if (keep) { ck[pos] = (unsigned short)mk[ii]; cu[pos] = mu[ii]; if (rank[ii] == need - 1) { ctl[128 + qq] = (int)mu[ii]; ctl[160 + qq] = (int)mk[ii]; } }
        base += __popcll(mask); }
    if (lane == 0) ctl[32 + qq] = need;
}
__device__ __forceinline__ void dsa_unit(LAS unsigned char* lds, const Args& A, int u) {
    unsigned char* ws = opq(A.ws); const int tid_l = mytid(A.wave); const int tid = tid_l, lane = tid & 63, wave = __builtin_amdgcn_readfirstlane(tid >> 6);
    const bf16_t* IQ = (const bf16_t*)(ws + WS_IXQ); const bf16_t* IK = (const bf16_t*)(ws + WS_IXK); const float* small = (const float*)(ws + WS_SMALL);
    const bf16_t* DQ = (const bf16_t*)(ws + WS_DSQ); const bf16_t* DK = (const bf16_t*)(ws + WS_DSK); const bf16_t* DV = (const bf16_t*)(ws + WS_DSV); bf16_t* OB = (bf16_t*)(ws + WS_OB);
    const int q0 = u * 32, N = ((q0 >> 6) + 1) * 64;
    volatile LAS unsigned* hist = (volatile LAS unsigned*)lds;
    volatile LAS unsigned short* sel = (volatile LAS unsigned short*)(lds + DS_OFF_SEL);
    volatile LAS unsigned short* ck = (volatile LAS unsigned short*)(lds + DS_OFF_CK); volatile LAS unsigned* cu = (volatile LAS unsigned*)(lds + DS_OFF_CU);
    volatile LAS int* ctl = (volatile LAS int*)(lds + DS_OFF_CTL);
    volatile LAS float* ctf = (volatile LAS float*)(lds + DS_OFF_CTL);
    const int fr = lane & 15, fq = lane >> 4;
    TICK(A, 0);
    if (N <= 256) {
        for (int i = tid; i < 32 * 256; i += NTHREADS) sel[i] = (unsigned short)(i & 255);
        __syncthreads();
    } else {
        volatile LAS unsigned* zc = (volatile LAS unsigned*)(lds + 131072);
        bf16x8 qf[2][4][2]; float wq[2][4];
#pragma unroll
        for (int g = 0; g < 2; ++g)
#pragma unroll
            for (int h = 0; h < 4; ++h) { wq[g][h] = small[(size_t)(q0 + 16 * g + fr) * 64 + h] * 0.5f;
#pragma unroll
                for (int s = 0; s < 2; ++s) qf[g][h][s] = *(const bf16x8*)(IQ + (size_t)(q0 + 16 * g + fr) * 256 + 64 * h + 32 * s + 8 * fq); }
        const int ntiles = (N + 127) >> 7;
        float pinf = INFINITY; asm volatile("" : "+v"(pinf));
#pragma unroll
        for (int g = 0; g < 2; ++g)
#pragma unroll
            for (int h = 0; h < 4; ++h) { asm volatile("" : "+v"(wq[g][h]));
#pragma unroll
                for (int s2 = 0; s2 < 2; ++s2) asm volatile("" : "+v"(qf[g][h][s2])); }
#define DS_LOADK(kbase, d0, d1) do { const int _kr = min((kbase) + fr, N - 1); const bf16_t* _p = IK + (size_t)_kr * 64 + 8 * fq; \
            asm volatile("global_load_dwordx4 %0, %2, off\n\tglobal_load_dwordx4 %1, %2, off offset:64" : "+v"(d0), "+v"(d1) : "v"(_p) : "memory"); } while (0)
#define DS_WAITK(d0, d1) asm volatile("s_waitcnt vmcnt(4)" : "+v"(d0), "+v"(d1) :: "memory")
#define DS_SCORES(kf0, kf1) f32x4 c4[2][4]; _Pragma("unroll") for (int g = 0; g < 2; ++g) _Pragma("unroll") for (int h = 0; h < 4; ++h) c4[g][h] = __builtin_amdgcn_mfma_f32_16x16x32_bf16(kf0, qf[g][h][0], (f32x4){0.f, 0.f, 0.f, 0.f}, 0, 0, 0); \
        _Pragma("unroll") for (int g = 0; g < 2; ++g) _Pragma("unroll") for (int h = 0; h < 4; ++h) c4[g][h] = __builtin_amdgcn_mfma_f32_16x16x32_bf16(kf1, qf[g][h][1], c4[g][h], 0, 0, 0); \
        float sc[2][4]; _Pragma("unroll") for (int g = 0; g < 2; ++g) _Pragma("unroll") for (int r = 0; r < 4; ++r) { float a_ = 0.f; _Pragma("unroll") for (int h = 0; h < 4; ++h) { a_ += wq[g][h] * __builtin_amdgcn_fmed3f(c4[g][h][r], 0.f, pinf); asm("" : "+v"(a_)); } sc[g][r] = a_; }
        for (int i = tid; i < 32 * 1024 + 32 * 32; i += NTHREADS) hist[i] = 0u;
        if (tid == 0) ctl[224] = 0;
        __syncthreads();
#define DS_P0_BODY(kf0, kf1, tile_) do { const int kb = (tile_) * 128 + 16 * wave; DS_WAITK(kf0, kf1); if (kb < N) { DS_SCORES(kf0, kf1) \
            _Pragma("unroll") for (int g = 0; g < 2; ++g) { LAS unsigned* hq = (LAS unsigned*)lds + (16 * g + fr) * 1024; \
                const unsigned p01 = ds_bins2(sc[g][0], sc[g][1]), p23 = ds_bins2(sc[g][2], sc[g][3]); \
                __hip_atomic_fetch_add(hq + (p01 & 0xffffu), 1u, __ATOMIC_RELAXED, __HIP_MEMORY_SCOPE_WORKGROUP); __hip_atomic_fetch_add(hq + (p01 >> 16), 1u, __ATOMIC_RELAXED, __HIP_MEMORY_SCOPE_WORKGROUP); \
                __hip_atomic_fetch_add(hq + (p23 & 0xffffu), 1u, __ATOMIC_RELAXED, __HIP_MEMORY_SCOPE_WORKGROUP); __hip_atomic_fetch_add(hq + (p23 >> 16), 1u, __ATOMIC_RELAXED, __HIP_MEMORY_SCOPE_WORKGROUP); \
                const unsigned nz = (sc[g][0] == 0.f ? 1u : 0u) + (sc[g][1] == 0.f ? 1u : 0u) + (sc[g][2] == 0.f ? 1u : 0u) + (sc[g][3] == 0.f ? 1u : 0u); \
                if (nz) __hip_atomic_fetch_add((LAS unsigned*)&zc[(16 * g + fr) * 32 + ((tile_) >> 2)], nz << (8 * ((tile_) & 3)), __ATOMIC_RELAXED, __HIP_MEMORY_SCOPE_WORKGROUP); } } \
            DS_LOADK(kb + 384, kf0, kf1); } while (0)
        { bf16x8 ka0 = qf[0][0][0], ka1 = ka0, kb0 = ka0, kb1 = ka0, kc0 = ka0, kc1 = ka0;
          DS_LOADK(16 * wave, ka0, ka1); DS_LOADK(128 + 16 * wave, kb0, kb1); DS_LOADK(256 + 16 * wave, kc0, kc1);
          for (int tile = 0; tile < ntiles; tile += 3) {
              DS_P0_BODY(ka0, ka1, tile); DS_P0_BODY(kb0, kb1, tile + 1); DS_P0_BODY(kc0, kc1, tile + 2);
          }
          asm volatile("s_waitcnt vmcnt(0)" : "+v"(ka0), "+v"(ka1), "+v"(kb0), "+v"(kb1), "+v"(kc0), "+v"(kc1) :: "memory"); }
#undef DS_P0_BODY
        __syncthreads();
        TICK(A, 1);
        for (int k = 0; k < 4; ++k) { const int qq = 4 * wave + k; unsigned cnt[16]; unsigned s = 0;
#pragma unroll
            for (int i = 0; i < 16; ++i) { cnt[i] = hist[qq * 1024 + 16 * lane + i]; s += cnt[i]; }
            unsigned T = s;
#pragma unroll
            for (int off = 1; off < 64; off <<= 1) { const unsigned v = shdn(T, off, lane); if (lane + off < 64) T += v; }
            const unsigned long long mask = __ballot(T >= 256u); const int L = 63 - __builtin_clzll(mask);
            const unsigned Tn = shdn(T, 1, lane); const unsigned above = lane == 63 ? 0u : Tn;
            if (lane == L) { unsigned cum = above; int b1 = 0, G1 = 0; unsigned C1 = 0; bool found = false;
#pragma unroll
                for (int b = 15; b >= 0; --b) { if (!found && cum + cnt[b] >= 256u) { b1 = 16 * lane + b; G1 = (int)cum; C1 = cnt[b]; found = true; } if (!found) cum += cnt[b]; }
                int need = 256 - G1, tl = -1;
                if (b1 == 512) {
                    unsigned zt = 0; for (int t = 0; t < ntiles; ++t) zt += (zc[qq * 32 + (t >> 2)] >> (8 * (t & 3))) & 0xffu;
                    if (zt == C1) { unsigned cz = 0; tl = 0; for (int t = 0; t < ntiles; ++t) { const unsigned z = (zc[qq * 32 + (t >> 2)] >> (8 * (t & 3))) & 0xffu; if (cz + z >= (unsigned)need) { tl = t; break; } cz += z; }
                        need -= (int)cz; } }
#ifdef FORCE_SLOW
                if (tl < 0) ctl[224] = 1;
#else
                if (tl < 0 && C1 > (unsigned)DS_CAND) ctl[224] = 1;
#endif
                ctl[64 + qq] = b1; ctl[96 + qq] = need; ctl[192 + qq] = tl; ctf[225 + qq] = ds_edge(b1); ctf[257 + qq] = ds_edge(b1 + 1); }
        }
        __syncthreads();
        TICK(A, 2);
        for (int i = tid; i < 32 * 512; i += NTHREADS) hist[i] = 0u;
        if (tid < 32) { ctl[32 + tid] = 0; ctl[128 + tid] = 0; ctl[160 + tid] = -1; }
        __syncthreads();
        { float flo[2], fhi[2]; int tlo[2];
#pragma unroll
          for (int g = 0; g < 2; ++g) { flo[g] = ctf[225 + 16 * g + fr]; fhi[g] = ctf[257 + 16 * g + fr]; tlo[g] = ctl[192 + 16 * g + fr]; }
          const bool slow = ctl[224] != 0;
#define DS_P1_BODY(kf0, kf1, tile_) do { const int kb = (tile_) * 128 + 16 * wave; DS_WAITK(kf0, kf1); if (kb < N) { DS_SCORES(kf0, kf1) \
            unsigned cbits = 0; \
            _Pragma("unroll") for (int g = 0; g < 2; ++g) { const int qq = 16 * g + fr; \
                const float tD = tlo[g] < 0 ? fhi[g] : ((tile_) < tlo[g] ? 0.0f : fhi[g]), tC = tlo[g] < 0 ? flo[g] : ((tile_) <= tlo[g] ? 0.0f : fhi[g]); \
                unsigned nib = 0; \
                _Pragma("unroll") for (int r = 0; r < 4; ++r) { const bool d = sc[g][r] >= tD, c = sc[g][r] >= tC; nib |= d ? (1u << r) : 0u; cbits |= (c && !d) ? (1u << (4 * g + r)) : 0u; } \
                __hip_atomic_fetch_or((LAS unsigned*)&hist[qq * 512 + (((kb >> 5) + qq) & 511)], nib << ((kb & 31) + 4 * fq), __ATOMIC_RELAXED, __HIP_MEMORY_SCOPE_WORKGROUP); } \
            while (__ballot(cbits != 0u)) {         \
                if (cbits) { const int ix = __builtin_ctz(cbits); cbits &= cbits - 1u; const int g = ix >> 2, r = ix & 3; \
                    float sv = sc[0][0]; sv = ix == 1 ? sc[0][1] : sv; sv = ix == 2 ? sc[0][2] : sv; sv = ix == 3 ? sc[0][3] : sv; sv = ix == 4 ? sc[1][0] : sv; sv = ix == 5 ? sc[1][1] : sv; sv = ix == 6 ? sc[1][2] : sv; sv = ix == 7 ? sc[1][3] : sv; \
                    const int qq = 16 * g + fr, key = kb + 4 * fq + r; \
                    const unsigned ub = __float_as_uint(sv), mono = ub ^ ((unsigned)((int)ub >> 31) | 0x80000000u); \
                    bool ok = true; if (slow) { const unsigned tu = (unsigned)ctl[128 + qq], tk = (unsigned)ctl[160 + qq]; ok = mono > tu || (mono == tu && (unsigned)key < tk); } \
                    if (ok) { const int slot = __hip_atomic_fetch_add((LAS int*)&ctl[32 + qq], 1, __ATOMIC_RELAXED, __HIP_MEMORY_SCOPE_WORKGROUP); ck[qq * DS_CAND + slot] = (unsigned short)key; cu[qq * DS_CAND + slot] = mono; } } } } \
            DS_LOADK(kb + 384, kf0, kf1); \
            if (slow) { __syncthreads();         \
                for (int k = 0; k < 4; ++k) { const int qq = 4 * wave + k; if (ctl[32 + qq] > DS_TRIM) ds_compact(lds, qq, ctl[96 + qq], lane); } \
                __syncthreads(); } } while (0)
          bf16x8 ka0 = qf[0][0][0], ka1 = ka0, kb0 = ka0, kb1 = ka0, kc0 = ka0, kc1 = ka0;
          DS_LOADK(16 * wave, ka0, ka1); DS_LOADK(128 + 16 * wave, kb0, kb1); DS_LOADK(256 + 16 * wave, kc0, kc1);
          for (int tile = 0; tile < ntiles; tile += 3) {
              DS_P1_BODY(ka0, ka1, tile); DS_P1_BODY(kb0, kb1, tile + 1); DS_P1_BODY(kc0, kc1, tile + 2);
          }
          asm volatile("s_waitcnt vmcnt(0)" : "+v"(ka0), "+v"(ka1), "+v"(kb0), "+v"(kb1), "+v"(kc0), "+v"(kc1) :: "memory"); }
#undef DS_P1_BODY
        __syncthreads();
#undef DS_LOADK
#undef DS_WAITK
#undef DS_SCORES
        TICK(A, 3);
        for (int k = 0; k < 4; ++k) { const int qq = 4 * wave + k; const int need = ctl[96 + qq]; ds_compact(lds, qq, need, lane);
            __builtin_amdgcn_s_waitcnt(0);
            for (int i = lane; i < need; i += 64) { const int key = ck[qq * DS_CAND + i]; __hip_atomic_fetch_or((LAS unsigned*)&hist[qq * 512 + (((key >> 5) + qq) & 511)], 1u << (key & 31), __ATOMIC_RELAXED, __HIP_MEMORY_SCOPE_WORKGROUP); } }
        __syncthreads();
        { volatile LAS unsigned short* offs = (volatile LAS unsigned short*)(lds + DS_OFF_CK) + wave * 512;
          for (int k = 0; k < 4; ++k) { const int qq = 4 * wave + k; unsigned wd[8]; unsigned c8 = 0;
#pragma unroll
            for (int i = 0; i < 8; ++i) { wd[i] = hist[qq * 512 + ((8 * lane + i + qq) & 511)]; c8 += __popc(wd[i]); }
            unsigned incl = c8;
#pragma unroll
            for (int off = 1; off < 64; off <<= 1) { const unsigned v = (unsigned)__builtin_amdgcn_ds_bpermute((lane - off) << 2, (int)incl); if (lane >= off) incl += v; }
            unsigned pos = incl - c8;
#pragma unroll
            for (int i = 0; i < 8; ++i) { offs[8 * lane + i] = (unsigned short)pos; pos += __popc(wd[i]); }
            __builtin_amdgcn_s_waitcnt(0);
#pragma unroll 1
            for (int i = 0; i < 8; ++i) { const int w = 64 * i + lane; unsigned bits = hist[qq * 512 + ((w + qq) & 511)]; unsigned p = offs[w];
                while (bits) { const int bpos = __builtin_ctz(bits); bits &= bits - 1u; if (p < 256u) sel[qq * 256 + p] = (unsigned short)(w * 32 + bpos); ++p; } }
            __builtin_amdgcn_s_waitcnt(0); } }
        __syncthreads();
    }
    TICK(A, 4);
    const int nsel = N < 256 ? N : 256;
    LAS unsigned char* vst = lds + wave * 9216;
#define AT_SELQ(qq_) ((const LAS unsigned short*)(lds + DS_OFF_SEL) + (qq_) * 256)
#define AT_ISSUE_K(buf, sq_, b_) do { _Pragma("unroll") for (int i8 = 0; i8 < 8; ++i8) { const int key_ = (sq_)[64 * (b_) + 8 * i8 + (lane >> 3)]; buf[i8] = *(const u32x4*)(DK + (size_t)key_ * 64 + 8 * (lane & 7)); } } while (0)
#define AT_ISSUE_V(buf, sq_, c_) do { _Pragma("unroll") for (int i8 = 0; i8 < 8; ++i8) { const int key_ = (sq_)[64 * (c_) + 8 * i8 + (lane >> 3)]; buf[i8] = *(const u32x4*)(DV + (size_t)key_ * 64 + 8 * (lane & 7)); } } while (0)
#define AT_QK(buf, b_) do { _Pragma("unroll") for (int i8 = 0; i8 < 8; ++i8) *(LAS u32x4*)(vst + (8 * i8 + (lane >> 3)) * 144 + 16 * (lane & 7)) = buf[i8]; \
        _Pragma("unroll") for (int g4 = 0; g4 < 4; ++g4) { const f32x4 c4_ = __builtin_amdgcn_mfma_f32_16x16x32_bf16(*(const LAS bf16x8*)(vst + (16 * g4 + fr) * 144 + 16 * fq), qf[0], (f32x4){0.f, 0.f, 0.f, 0.f}, 0, 0, 0); \
        sacc[4 * (b_) + g4] = __builtin_amdgcn_mfma_f32_16x16x32_bf16(*(const LAS bf16x8*)(vst + (16 * g4 + fr) * 144 + 64 + 16 * fq), qf[1], c4_, 0, 0, 0); } } while (0)
#define AT_PV(buf, c_) do { _Pragma("unroll") for (int i8 = 0; i8 < 8; ++i8) { const int row_ = 32 * (i8 >> 2) + 16 * (i8 & 1) + 4 * ((i8 >> 1) & 1) + 8 * (lane >> 5) + ((lane >> 3) & 3); \
            *(LAS u32x4*)(vst + row_ * 144 + 16 * (lane & 7)) = buf[i8]; } \
        _Pragma("unroll") for (int s2 = 0; s2 < 2; ++s2) _Pragma("unroll") for (int dg = 0; dg < 4; ++dg) { \
            const s16x4 lo_ = __builtin_amdgcn_ds_read_tr16_b64_v4i16((LAS s16x4*)(vst + (32 * s2 + 8 * fq + (fr >> 2)) * 144 + 32 * dg + 8 * (fr & 3))); \
            const s16x4 hi_ = __builtin_amdgcn_ds_read_tr16_b64_v4i16((LAS s16x4*)(vst + (32 * s2 + 8 * fq + 4 + (fr >> 2)) * 144 + 32 * dg + 8 * (fr & 3))); \
            const bf16x8 vf_ = __builtin_shufflevector(lo_, hi_, 0, 1, 2, 3, 4, 5, 6, 7); \
            oacc[dg] = __builtin_amdgcn_mfma_f32_16x16x32_bf16(vf_, pf[2 * (c_) + s2], oacc[dg], 0, 0, 0); } } while (0)
    u32x4 B0[8], B1[8], B2[8]; bf16x8 qf[2];
    { const int t0 = q0 + 4 * wave;
#pragma unroll
      for (int s2 = 0; s2 < 2; ++s2) qf[s2] = *(const bf16x8*)(DQ + (size_t)t0 * 256 + 64 * (fr & 3) + 32 * s2 + 8 * fq);
      AT_ISSUE_K(B0, AT_SELQ(4 * wave), 0); AT_ISSUE_K(B1, AT_SELQ(4 * wave), 1); }
#define AT_QUERY(k_, X, Y, Z) do { const int qq = 4 * wave + (k_), t = q0 + qq; const LAS unsigned short* selq = AT_SELQ(qq); f32x4 sacc[16]; \
        AT_ISSUE_K(Z, selq, 2); AT_QK(X, 0); \
        AT_ISSUE_K(X, selq, 3); AT_QK(Y, 1); \
        AT_ISSUE_V(Y, selq, 0); AT_QK(Z, 2); \
        AT_ISSUE_V(Z, selq, 1); AT_QK(X, 3); \
        if ((k_) < 3) { _Pragma("unroll") for (int s2 = 0; s2 < 2; ++s2) qf[s2] = *(const bf16x8*)(DQ + (size_t)(t + 1) * 256 + 64 * (fr & 3) + 32 * s2 + 8 * fq); } \
        if (nsel < 256) { _Pragma("unroll") for (int g = 0; g < 16; ++g) _Pragma("unroll") for (int r = 0; r < 4; ++r) if (16 * g + 4 * fq + r >= nsel) sacc[g][r] = -INFINITY; } \
        float mx = -INFINITY; \
        _Pragma("unroll") for (int g = 0; g < 16; ++g) mx = fmaxf(mx, fmaxf(fmaxf(sacc[g].x, sacc[g].y), fmaxf(sacc[g].z, sacc[g].w))); \
        mx = fmaxf(mx, shx(mx, 16, lane)); mx = fmaxf(mx, shx(mx, 32, lane)); \
        float sm = 0.f; \
        _Pragma("unroll") for (int g = 0; g < 16; ++g) { sacc[g].x = __builtin_amdgcn_exp2f(sacc[g].x - mx); sacc[g].y = __builtin_amdgcn_exp2f(sacc[g].y - mx); sacc[g].z = __builtin_amdgcn_exp2f(sacc[g].z - mx); sacc[g].w = __builtin_amdgcn_exp2f(sacc[g].w - mx); \
            sm += (sacc[g].x + sacc[g].y) + (sacc[g].z + sacc[g].w); } \
        sm += shx(sm, 16, lane); sm += shx(sm, 32, lane); \
        const float inv = 1.0f / sm; \
        bf16x8 pf[8]; \
        _Pragma("unroll") for (int s2 = 0; s2 < 8; ++s2) { u32x4 w; w.x = cvt_pk_bf16(sacc[2 * s2].x * inv, sacc[2 * s2].y * inv); w.y = cvt_pk_bf16(sacc[2 * s2].z * inv, sacc[2 * s2].w * inv); \
            w.z = cvt_pk_bf16(sacc[2 * s2 + 1].x * inv, sacc[2 * s2 + 1].y * inv); w.w = cvt_pk_bf16(sacc[2 * s2 + 1].z * inv, sacc[2 * s2 + 1].w * inv); pf[s2] = __builtin_bit_cast(bf16x8, w); } \
        f32x4 oacc[4]; \
        _Pragma("unroll") for (int dg = 0; dg < 4; ++dg) oacc[dg] = (f32x4){0.f, 0.f, 0.f, 0.f}; \
        AT_ISSUE_V(X, selq, 2); AT_PV(Y, 0); \
        AT_ISSUE_V(Y, selq, 3); AT_PV(Z, 1); \
        if ((k_) < 3) AT_ISSUE_K(Z, AT_SELQ(qq + 1), 0); \
        AT_PV(X, 2); \
        if ((k_) < 3) AT_ISSUE_K(X, AT_SELQ(qq + 1), 1); \
        AT_PV(Y, 3); \
        if (fr < 4) { _Pragma("unroll") for (int dg = 0; dg < 4; ++dg) { u32x2 w2; w2.x = cvt_pk_bf16(oacc[dg].x, oacc[dg].y); w2.y = cvt_pk_bf16(oacc[dg].z, oacc[dg].w); \
                *(u32x2*)(OB + (size_t)t * 256 + 64 * fr + 16 * dg + 4 * fq) = w2; } } } while (0)
    AT_QUERY(0, B0, B1, B2); AT_QUERY(1, B2, B0, B1); AT_QUERY(2, B1, B2, B0); AT_QUERY(3, B0, B1, B2);
#undef AT_QUERY
#undef AT_SELQ
#undef AT_ISSUE_K
#undef AT_ISSUE_V
#undef AT_QK
#undef AT_PV
    __syncthreads();
    TICK(A, 5);
#if DBG_MODE == 1
    { unsigned short* ds = (unsigned short*)(opq(A.ws) + WS_DBGSEL) + (size_t)u * 8192; for (int i = mytid(A.wave); i < 32 * 256; i += NTHREADS) ds[i] = sel[i]; }
    __syncthreads();
#endif
}

__device__ __forceinline__ void xattn_phase(LAS unsigned char* lds, const Args& A, const pg8::StaticOrder& S) {
    unsigned char* ws = opq(A.ws); const int tid_l = mytid(A.wave); const int tid = tid_l, lane = tid & 63, wave = __builtin_amdgcn_readfirstlane(tid >> 6), fr = lane & 15, fq = lane >> 4;
    const bf16_t* XQ = (const bf16_t*)(ws + WS_XQ); const bf16_t* KM = (const bf16_t*)(ws + WS_KM); const bf16_t* VMT = (const bf16_t*)(ws + WS_VMT); bf16_t* AO = (bf16_t*)(ws + WS_AO);
    for (int ui = 0;; ++ui) { pg8::Unit un; if (!S.next(ui, un)) break;
        const int hh = __builtin_amdgcn_readfirstlane(un.pn), rb = __builtin_amdgcn_readfirstlane(un.pm);
        __syncthreads();
        { const int row = tid >> 1, half = tid & 1; const bf16_t* src = KM + (size_t)row * 1024 + 256 * hh + 128 * half; LAS unsigned char* dst = lds + row * 528 + 256 * half;
#pragma unroll
          for (int b8 = 0; b8 < 2; ++b8) { u32x4 t8[8];
#pragma unroll
              for (int i = 0; i < 8; ++i) t8[i] = *(const u32x4*)(src + 64 * b8 + 8 * i);
#pragma unroll
              for (int i = 0; i < 8; ++i) *(LAS u32x4*)(dst + 128 * b8 + 16 * i) = t8[i]; } }
        __syncthreads();
        bf16x8 pf[2][8];
        { bf16x8 qf[2][8]; f32x4 sacc[2][16];
#pragma unroll
          for (int j = 0; j < 2; ++j) { const int row = rb * 256 + 128 * j + 16 * wave + fr;
#pragma unroll
              for (int s2 = 0; s2 < 8; ++s2) qf[j][s2] = *(const bf16x8*)(XQ + (size_t)row * 1024 + 256 * hh + 32 * s2 + 8 * fq); }
#pragma unroll
          for (int g = 0; g < 16; ++g) { f32x4 c0 = (f32x4){0.f, 0.f, 0.f, 0.f}, c1 = c0;
#pragma unroll
              for (int s2 = 0; s2 < 8; ++s2) { const bf16x8 kf = *(const LAS bf16x8*)(lds + (16 * g + fr) * 528 + (32 * s2 + 8 * fq) * 2);
                  c0 = __builtin_amdgcn_mfma_f32_16x16x32_bf16(kf, qf[0][s2], c0, 0, 0, 0); c1 = __builtin_amdgcn_mfma_f32_16x16x32_bf16(kf, qf[1][s2], c1, 0, 0, 0); }
              sacc[0][g] = c0; sacc[1][g] = c1; asm volatile("" ::: "memory"); }
#pragma unroll
          for (int j = 0; j < 2; ++j) {
            float mx = -INFINITY;
#pragma unroll
            for (int g = 0; g < 16; ++g) mx = fmaxf(mx, fmaxf(fmaxf(sacc[j][g].x, sacc[j][g].y), fmaxf(sacc[j][g].z, sacc[j][g].w)));
            mx = fmaxf(mx, shx(mx, 16, lane)); mx = fmaxf(mx, shx(mx, 32, lane));
            float sm = 0.f;
#pragma unroll
            for (int g = 0; g < 16; ++g) { sacc[j][g].x = __builtin_amdgcn_exp2f(sacc[j][g].x - mx); sacc[j][g].y = __builtin_amdgcn_exp2f(sacc[j][g].y - mx); sacc[j][g].z = __builtin_amdgcn_exp2f(sacc[j][g].z - mx); sacc[j][g].w = __builtin_amdgcn_exp2f(sacc[j][g].w - mx);
                sm += (sacc[j][g].x + sacc[j][g].y) + (sacc[j][g].z + sacc[j][g].w); }
            sm += shx(sm, 16, lane); sm += shx(sm, 32, lane);
            const float inv = 1.0f / sm;
#pragma unroll
            for (int s2 = 0; s2 < 8; ++s2) { u32x4 w; w.x = cvt_pk_bf16(sacc[j][2 * s2].x * inv, sacc[j][2 * s2].y * inv); w.y = cvt_pk_bf16(sacc[j][2 * s2].z * inv, sacc[j][2 * s2].w * inv);
                w.z = cvt_pk_bf16(sacc[j][2 * s2 + 1].x * inv, sacc[j][2 * s2 + 1].y * inv); w.w = cvt_pk_bf16(sacc[j][2 * s2 + 1].z * inv, sacc[j][2 * s2 + 1].w * inv); pf[j][s2] = __builtin_bit_cast(bf16x8, w); }
            asm volatile("" ::: "memory");
          } }
        __syncthreads();
        const int tid2 = mytid(A.wave), lane2 = tid2 & 63, wave2 = __builtin_amdgcn_readfirstlane(tid2 >> 6), fr2 = lane2 & 15, fq2 = lane2 >> 4; unsigned char* ws2 = opq(A.ws);
        const bf16_t* VMT2 = (const bf16_t*)(ws2 + WS_VMT); bf16_t* AO2 = (bf16_t*)(ws2 + WS_AO);
        { const int row = tid2 >> 1, half = tid2 & 1; const bf16_t* src = VMT2 + (size_t)(256 * hh + row) * 256 + 128 * half; LAS unsigned char* dst = lds + row * 528 + 256 * half;
#pragma unroll
          for (int b8 = 0; b8 < 2; ++b8) { u32x4 t8[8];
#pragma unroll
              for (int i = 0; i < 8; ++i) t8[i] = *(const u32x4*)(src + 64 * b8 + 8 * i);
#pragma unroll
              for (int i = 0; i < 8; ++i) *(LAS u32x4*)(dst + 128 * b8 + 16 * i) = t8[i]; } }
        __syncthreads();
        { const int row0 = rb * 256 + 16 * wave2 + fr2;
#pragma unroll
            for (int dg = 0; dg < 16; ++dg) { f32x4 c0 = (f32x4){0.f, 0.f, 0.f, 0.f}, c1 = c0;
#pragma unroll
                for (int s2 = 0; s2 < 8; ++s2) { const bf16x8 vf = *(const LAS bf16x8*)(lds + (16 * dg + fr2) * 528 + (32 * s2 + 8 * fq2) * 2);
                    c0 = __builtin_amdgcn_mfma_f32_16x16x32_bf16(vf, pf[0][s2], c0, 0, 0, 0); c1 = __builtin_amdgcn_mfma_f32_16x16x32_bf16(vf, pf[1][s2], c1, 0, 0, 0); }
                u32x2 w; w.x = cvt_pk_bf16(c0.x, c0.y); w.y = cvt_pk_bf16(c0.z, c0.w);
                *(u32x2*)(AO2 + (size_t)row0 * 1024 + 256 * hh + 16 * dg + 4 * fq2) = w;
                w.x = cvt_pk_bf16(c1.x, c1.y); w.y = cvt_pk_bf16(c1.z, c1.w);
                *(u32x2*)(AO2 + (size_t)(row0 + 128) * 1024 + 256 * hh + 16 * dg + 4 * fq2) = w; if (dg & 1) asm volatile("" ::: "memory"); } }
    }
    __syncthreads();
}

__device__ __forceinline__ void final_norm(const Args& A) {
    const int tid = mytid(A.wave), lane = tid & 63, wave = tid >> 6; const int bid = obid(), Gl = ogrid(); unsigned char* ws = opq(A.ws); const float* ssq = (const float*)(ws + WS_SSQ); const bf16_t* xb = (const bf16_t*)(ws + WS_XB); const GAS float* g = ldarg(A, I_FING);
    for (int r = bid * 8 + wave; r < S_; r += Gl * 8) { const float rs = row_rstd(ssq, r); float* xr = (float*)opq((unsigned char*)A.out) + (size_t)r * 1024 + lane * 16;
        float v[16]; { float v0[8], v1[8]; ld_bf16x8(xb + (size_t)r * 1024 + lane * 16, v0); ld_bf16x8(xb + (size_t)r * 1024 + lane * 16 + 8, v1);
#pragma unroll
            for (int i = 0; i < 8; ++i) { v[i] = v0[i]; v[8 + i] = v1[i]; } }
#pragma unroll
        for (int i = 0; i < 4; ++i) { const f32x4 gg = *(const GAS f32x4*)(g + lane * 16 + 4 * i); *(f32x4*)(xr + 4 * i) = (f32x4){v[4 * i] * rs * gg.x, v[4 * i + 1] * rs * gg.y, v[4 * i + 2] * rs * gg.z, v[4 * i + 3] * rs * gg.w}; } }
}

constexpr int PH_PER_LAYER = 11, N_PHASES = 2 + PH_PER_LAYER * DEPTH;
__global__ void __launch_bounds__(NTHREADS, 2) mk_fwd(const float* i0, const float* i1, const float* i2, const float* i3, const float* i4, const float* i5, const float* i6, const float* i7, const float* i8, const float* i9,
                                                      const float* i10, const float* i11, const float* i12, const float* i13, const float* i14, const float* i15, const float* i16, const float* i17, const float* i18, const float* i19,
                                                      float* outp, unsigned char* wsp, int ph_lo, int ph_hi) {
    extern __shared__ __attribute__((aligned(16))) unsigned char lds[];
    LAS unsigned char* ring = (LAS unsigned char*)lds;
    Args args; args.out = outp; args.ws = wsp; args.ring = ring; args.wave = __builtin_amdgcn_readfirstlane(threadIdx.x >> 6);
    const int tid = threadIdx.x;
    unsigned char* ws = args.ws;
    unsigned* ctl = (unsigned*)(ws + WS_CTL);
    volatile LAS unsigned* misc = (volatile LAS unsigned*)(ring + MISC_OFF);
    if (tid < 16) misc[tid] = 0u;
#if DBG_MODE == 3
    if (tid < 32) ((volatile LAS unsigned long long*)(ring + MISC_OFF + 2560))[tid] = 0ull;
#endif
    if (tid == 0) { volatile LAS unsigned long long* av = (volatile LAS unsigned long long*)(ring + ARGV_OFF);
        av[0] = (unsigned long long)i0; av[1] = (unsigned long long)i1; av[2] = (unsigned long long)i2; av[3] = (unsigned long long)i3; av[4] = (unsigned long long)i4;
        av[5] = (unsigned long long)i5; av[6] = (unsigned long long)i6; av[7] = (unsigned long long)i7; av[8] = (unsigned long long)i8; av[9] = (unsigned long long)i9;
        av[10] = (unsigned long long)i10; av[11] = (unsigned long long)i11; av[12] = (unsigned long long)i12; av[13] = (unsigned long long)i13; av[14] = (unsigned long long)i14;
        av[15] = (unsigned long long)i15; av[16] = (unsigned long long)i16; av[17] = (unsigned long long)i17; av[18] = (unsigned long long)i18; av[19] = (unsigned long long)i19; }
    __syncthreads();
    const bool one = (ph_hi - ph_lo) > 1;
    XcdBarrier bar; bar.bar = ctl + CW_BAR; bar.x = 0; bar.st = misc;
    if (one) bar = xcd_barrier_post(ctl + CW_BAR, misc, args.wave);
    const int lo = ph_lo, hi = ph_hi, G = gridDim.x;
#define IN(k) (lo <= (k) && (k) < hi)
#if DBG_MODE == 3
#define STAMP(k) do { if (obid() == 0 && mytid(args.wave) == 0) ((volatile LAS unsigned long long*)(ring + MISC_OFF + 2048))[(k)] = __builtin_amdgcn_s_memrealtime(); } while (0)
#else
#define STAMP(k) do { } while (0)
#endif
#define SEAM(k) do { if (IN((k) + 1)) xcd_barrier(bar, args.wave); STAMP((k) + 1); } while (0)

#if DBG_MODE == 3
    const unsigned long long clk0_ = clock64();
#endif
    STAMP(0);
    if (PH_EN(100) && IN(0)) { prologue(ring, args); __syncthreads(); STAMP(1); }

    for (int l = 0; l < DEPTH; ++l) {
        const int pb = 1 + PH_PER_LAYER * l;
        if (l == 0) { if (PH_EN(0) && IN(pb + 0)) { const int bid = obid(), Gl = ogrid(); conv_range(ring, args, 0, 0, CONV_EARLY, bid, Gl); SEAM(pb + 0); } }
        else STAMP(pb + 1);
        if (PH_EN(1) && IN(pb + 1)) { unsigned char* wsl = opq(ws); (void)wsl; const int bid = obid(), Gl = ogrid(); (void)bid; (void)Gl;
            { pg8::Gemm g{(const bf16_t*)(wsl + WS_XB), (const bf16_t*)(wsl + WS_WIN), S_, NIN - 256, D_, 0, 0}; pg8::StaticOrder S; S.init(S_, NIN - 256, Gl, bid);
              EpiIn E{(const float*)(wsl + WS_SSQ), (const float*)(wsl + WS_CS), (bf16_t*)(wsl + WS_SBQ), (bf16_t*)(wsl + WS_SBK), (bf16_t*)(wsl + WS_SBV), (bf16_t*)(wsl + WS_DSQ), (bf16_t*)(wsl + WS_IXQ), (bf16_t*)(wsl + WS_DSK), (bf16_t*)(wsl + WS_IXK),
                      (bf16_t*)(wsl + WS_DSV), (bf16_t*)(wsl + WS_GLQ), (bf16_t*)(wsl + WS_GLK), (bf16_t*)(wsl + WS_GLV), (bf16_t*)(wsl + WS_GLO), (bf16_t*)(wsl + WS_GATES), (float*)(wsl + WS_SMALL), (bf16_t*)(wsl + WS_SBVT), 0, (bf16_t*)(wsl + WS_GLVT)};
              pg8::gemm_phase<EpiIn, pg8::StaticOrder>(ring, g, S, E, args.wave); }
            SEAM(pb + 1);
        }
        if (PH_EN(2) && IN(pb + 2)) { unsigned char* wsl = opq(ws); (void)wsl; const int bid = obid(), Gl = ogrid(); (void)bid; (void)Gl;
            volatile LAS int* qslot = (volatile LAS int*)(ring + MISC_OFF + 32);
            for (;;) {
                __syncthreads();
                if (mytid(args.wave) == 0) *qslot = (int)atomicAdd((unsigned*)(wsl + WS_CTL) + CW_QUEUE + 64 * l, 1u);
                __syncthreads();
                const int uq = *qslot;
                if (uq >= 1232) break;
                if (uq >= 64 && uq < 72) {
                    pg8::Gemm g{(const bf16_t*)(wsl + WS_MEMB), (const bf16_t*)(wsl + WS_WXKV), NMEM, 2048, D_, 0, 0}; pg8::StaticOrder S; S.init(NMEM, 2048, 8, uq - 64);
                    EpiKV E{(const float*)(wsl + WS_RSTDM), (bf16_t*)(wsl + WS_KM), (bf16_t*)(wsl + WS_VMT)};
                    pg8::gemm_phase<EpiKV, pg8::StaticOrder>(ring, g, S, E, args.wave); }
                else if (uq < 64) {
                    pg8::Gemm g{(const bf16_t*)(wsl + WS_XB), (const bf16_t*)(wsl + WS_WIN) + (size_t)(NIN - 256) * D_, S_, 256, D_, 0, 0}; pg8::StaticOrder S; S.init(S_, 256, 64, uq);
                    EpiIn E{(const float*)(wsl + WS_SSQ), (const float*)(wsl + WS_CS), (bf16_t*)(wsl + WS_SBQ), (bf16_t*)(wsl + WS_SBK), (bf16_t*)(wsl + WS_SBV), (bf16_t*)(wsl + WS_DSQ), (bf16_t*)(wsl + WS_IXQ), (bf16_t*)(wsl + WS_DSK), (bf16_t*)(wsl + WS_IXK),
                            (bf16_t*)(wsl + WS_DSV), (bf16_t*)(wsl + WS_GLQ), (bf16_t*)(wsl + WS_GLK), (bf16_t*)(wsl + WS_GLV), (bf16_t*)(wsl + WS_GLO), (bf16_t*)(wsl + WS_GATES), (float*)(wsl + WS_SMALL), (bf16_t*)(wsl + WS_SBVT), 20, (bf16_t*)(wsl + WS_GLVT)};
                    pg8::gemm_phase<EpiIn, pg8::StaticOrder>(ring, g, S, E, args.wave); }
                else if (uq < 584) dsa_unit(ring, args, 583 - uq);
                else if (uq < 848) { const int c0 = CONV_EARLY + 2 * (uq - 584); conv_range(ring, args, l, c0, c0 + 2, 0, 1); }
                else if (uq < 976) { TICK(args, 0); sb_unit(ring, args, 975 - uq); TICK(args, 6); }
                else { TICK(args, 0); gla1_unit(ring, args, l, uq - 976); TICK(args, 7); }
            }
            SEAM(pb + 2);
        }
        if (PH_EN(3) && IN(pb + 3)) { unsigned char* wsl = opq(ws); (void)wsl; const int bid = obid(), Gl = ogrid(); (void)bid; (void)Gl; gla2_phase(ring, args);
            if (bid >= 128) for (int sb = bid - 128; sb < 128; sb += Gl - 128) glvt_slab(ring, args, sb);
            SEAM(pb + 3); }
        if (PH_EN(4) && IN(pb + 4)) { unsigned char* wsl = opq(ws); (void)wsl; const int bid = obid(), Gl = ogrid(); (void)bid; (void)Gl; for (int c = bid; c < 256; c += Gl) gla3_unit(ring, args, l, c); SEAM(pb + 4); }
        if (PH_EN(5) && IN(pb + 5)) { unsigned char* wsl = opq(ws); (void)wsl; const int bid = obid(), Gl = ogrid(); (void)bid; (void)Gl;
            pg8::Gemm g{(const bf16_t*)(wsl + WS_OA), (const bf16_t*)(wsl + WS_WBR), S_, D_, 256, (size_t)(WS_OB - WS_OA), (size_t)1024 * 256 * 2}; pg8::TripleOrder S; S.init(S_, D_, Gl, bid);
            EpiMerge E{(const bf16_t*)(wsl + WS_GATES), (bf16_t*)(wsl + WS_MERGED)}; pg8::gemm_phase<EpiMerge, pg8::TripleOrder>(ring, g, S, E, args.wave);
            SEAM(pb + 5);
        }
        if (PH_EN(6) && IN(pb + 6)) { unsigned char* wsl = opq(ws); (void)wsl; const int bid = obid(), Gl = ogrid(); (void)bid; (void)Gl; pg8::Gemm g{(const bf16_t*)(wsl + WS_MERGED), (const bf16_t*)(wsl + WS_WMIX), S_, D_, D_, 0, 0}; pg8::StaticOrder S; S.init(S_, D_, Gl, bid);
            EpiRes E{(float*)nullptr, (bf16_t*)(wsl + WS_XB), (float*)(wsl + WS_SSQ)}; pg8::gemm_phase<EpiRes, pg8::StaticOrder>(ring, g, S, E, args.wave); SEAM(pb + 6); }
        if (PH_EN(7) && IN(pb + 7)) { unsigned char* wsl = opq(ws); (void)wsl; const int bid = obid(), Gl = ogrid(); (void)bid; (void)Gl; pg8::Gemm g{(const bf16_t*)(wsl + WS_XB), (const bf16_t*)(wsl + WS_WXQ), S_, D_, D_, 0, 0}; pg8::StaticOrder S; S.init(S_, D_, Gl, bid);
            EpiXq E{(const float*)(wsl + WS_SSQ), (bf16_t*)(wsl + WS_XQ)}; pg8::gemm_phase<EpiXq, pg8::StaticOrder>(ring, g, S, E, args.wave);
            __syncthreads();
            xattn_phase(ring, args, S); SEAM(pb + 7); }
        if (PH_EN(8) && IN(pb + 8)) { unsigned char* wsl = opq(ws); (void)wsl; const int bid = obid(), Gl = ogrid(); (void)bid; (void)Gl; pg8::Gemm g{(const bf16_t*)(wsl + WS_AO), (const bf16_t*)(wsl + WS_WXO), S_, D_, D_, 0, 0}; pg8::StaticOrder S; S.init(S_, D_, Gl, bid);
            EpiRes E{(float*)nullptr, (bf16_t*)(wsl + WS_XB), (float*)(wsl + WS_SSQ)}; pg8::gemm_phase<EpiRes, pg8::StaticOrder>(ring, g, S, E, args.wave); SEAM(pb + 8); }
        if (PH_EN(9) && IN(pb + 9)) { unsigned char* wsl = opq(ws); (void)wsl; const int bid = obid(), Gl = ogrid(); (void)bid; (void)Gl; pg8::Gemm g{(const bf16_t*)(wsl + WS_XB), (const bf16_t*)(wsl + WS_WFI), S_, NFF, D_, 0, 0}; pg8::StaticOrder S; S.init(S_, NFF, Gl, bid);
            EpiFfnIn E{(const float*)(wsl + WS_SSQ), (bf16_t*)(wsl + WS_HID)}; pg8::gemm_phase<EpiFfnIn, pg8::StaticOrder>(ring, g, S, E, args.wave);
            if (l + 1 < DEPTH) {
                const int nun = (S_ / 256) * (NFF / 256), nmax = (nun + Gl - 1) / Gl; int fi = nun - (nmax - 1) * Gl; if (fi >= Gl) fi = 0;
                __syncthreads();
                if (bid >= fi) conv_range(ring, args, l + 1, 0, CONV_EARLY, bid - fi, Gl - fi); }
            SEAM(pb + 9); }
        if (PH_EN(10) && IN(pb + 10)) { unsigned char* wsl = opq(ws); (void)wsl; const int bid = obid(), Gl = ogrid(); (void)bid; (void)Gl; pg8::Gemm g{(const bf16_t*)(wsl + WS_HID), (const bf16_t*)(wsl + WS_WFO), S_, D_, DFF, 0, 0}; pg8::StaticOrder S; S.init(S_, D_, Gl, bid);
            EpiRes E{(float*)nullptr, (bf16_t*)(wsl + WS_XB), (float*)(wsl + WS_SSQ)}; pg8::gemm_phase<EpiRes, pg8::StaticOrder>(ring, g, S, E, args.wave); SEAM(pb + 10); }
    }
    if (PH_EN(101) && IN(N_PHASES - 1)) { final_norm(args); __syncthreads(); STAMP(N_PHASES); }
#if DBG_MODE == 3
    if (obid() == 0 && mytid(args.wave) == 0) { volatile LAS unsigned long long* st = (volatile LAS unsigned long long*)(ring + MISC_OFF + 2048); unsigned long long T = 0;
        if (STAMP_A == 40) { const unsigned long long cyc = clock64() - clk0_; const unsigned long long rt = st[N_PHASES] - st[0]; T = (cyc * 1000ull / rt) * 10ull; }
        else if (STAMP_A == 30) T = ((volatile LAS unsigned long long*)(ring + MISC_OFF + 2560))[10] / 20ull;
        else if (STAMP_A >= 20) T = ((volatile LAS unsigned long long*)(ring + MISC_OFF + 2560))[STAMP_A - 20];
        else if (STAMP_A < PH_PER_LAYER) { for (int l = 0; l < DEPTH; ++l) T += st[2 + PH_PER_LAYER * l + STAMP_A] - st[1 + PH_PER_LAYER * l + STAMP_A]; } else if (STAMP_A == 12) T = st[1] - st[0]; else T = st[N_PHASES] - st[N_PHASES - 1];
        const unsigned long long t0 = __builtin_amdgcn_s_memrealtime(); while (__builtin_amdgcn_s_memrealtime() - t0 < T * STAMP_MUL) __builtin_amdgcn_s_sleep(8); }
#endif
#undef IN
#undef SEAM
}

#if DBG_MODE == 1
constexpr size_t WS_DBGSC = WS_DBGEND;
constexpr size_t WS_DBGFL = WS_DBGSC + 1 * MB;
constexpr size_t WS_DBGEND2 = WS_DBGFL + 256 * 1024;
__device__ __forceinline__ int dbg_row(int i) { if (i == 0) return 0; if (i == 1) return 63; if (i == 2) return 64; if (i == 3) return 255; if (i == 4) return 256; if (i == 5) return S_ - 1; if (i == 6) return 300; if (i == 7) return 16000; return (int)((((unsigned)i * 2654435761u) >> 14) % (unsigned)S_); }
__device__ __forceinline__ void dbg_err(float* dbg, int stage, float got, float ex, float atol, float rtol) { float e = fabsf(got - ex) / (atol + rtol * fabsf(ex)); if (!(e == e)) e = 1e30f; atomicMax((unsigned*)(dbg + stage), __float_as_uint(e)); }
__device__ __forceinline__ void dbg_sincos(float angf, double& c, double& s) {
    double a = (double)angf; const double k = floor(a / 6.283185307179586476925286766559); a -= k * 6.283185307179586476925286766559; if (a > 3.14159265358979323846) a -= 6.283185307179586476925286766559;
    double term = a, sn = a, a2 = a * a; for (int i = 1; i < 20; ++i) { term *= -a2 / ((2 * i) * (2 * i + 1)); sn += term; }
    term = 1.0; double cn = 1.0; for (int i = 1; i < 20; ++i) { term *= -a2 / ((2 * i - 1) * (2 * i)); cn += term; }
    c = cn; s = sn; }
__global__ void __launch_bounds__(512) dbg_inproj(const float* x, const float* g, const float* win, unsigned char* ws) {
    __shared__ float xs[1024]; __shared__ float z[INW]; __shared__ float red[8];
    float* dbg = (float*)(ws + WS_DBG); const int r = dbg_row(blockIdx.x), tid = threadIdx.x;
    float sq = 0.f; for (int k = tid; k < 1024; k += 512) { const float v = x[(size_t)r * 1024 + k]; sq += v * v; xs[k] = v * g[k]; }
    for (int o = 32; o >= 1; o >>= 1) sq += __shfl_xor(sq, o);
    if ((tid & 63) == 0) red[tid >> 6] = sq;
    __syncthreads();
    float tot = 0.f; for (int i = 0; i < 8; ++i) tot += red[i];
    const float rstd = rsqrtf(tot * (1.0f / 1024.0f) + EPS);
    if (tid == 0) dbg_err(dbg, 20, row_rstd((const float*)(ws + WS_SSQ), r), rstd, 0.f, 1e-4f);
    for (int n = tid; n < INW; n += 512) { float acc = 0.f; for (int k = 0; k < 1024; ++k) acc += xs[k] * win[(size_t)k * INW + n]; z[n] = acc * rstd; }
    __syncthreads();
    const bf16_t* SBQ = (const bf16_t*)(ws + WS_SBQ); const bf16_t* SBK = (const bf16_t*)(ws + WS_SBK); const bf16_t* SBV = (const bf16_t*)(ws + WS_SBV);
    const bf16_t* DSQ = (const bf16_t*)(ws + WS_DSQ); const bf16_t* IXQ = (const bf16_t*)(ws + WS_IXQ); const bf16_t* DSK = (const bf16_t*)(ws + WS_DSK); const bf16_t* IXK = (const bf16_t*)(ws + WS_IXK); const bf16_t* DSV = (const bf16_t*)(ws + WS_DSV);
    const float* SM = (const float*)(ws + WS_SMALL); const bf16_t* GLQ = (const bf16_t*)(ws + WS_GLQ); const bf16_t* GLK = (const bf16_t*)(ws + WS_GLK); const bf16_t* GLV = (const bf16_t*)(ws + WS_GLV); const bf16_t* GLO = (const bf16_t*)(ws + WS_GLO); const bf16_t* GT = (const bf16_t*)(ws + WS_GATES);
    const float AT = 0.04f, RT = 0.02f;
    for (int n = tid; n < INW; n += 512) {
        const float zn = z[n];
        if (n < 768) { const int w = n >> 8, c = n & 255; const bf16_t* B = w == 0 ? SBQ : (w == 1 ? SBK : SBV); dbg_err(dbg, 1 + w, bf2f(B[(size_t)r * 256 + c]), zn * (w == 0 ? SBQ_SCALE : 1.0f), AT, RT); }
        else if (n < 1152 && !(n >= 1088) || (n >= 1152 && n < 1472)) {
            int base, stage, ld, col; float sc; const bf16_t* B;
            if (n < 1024) { base = 768; stage = 4; ld = 256; sc = DSQ_SCALE; B = DSQ; } else if (n < 1088) { base = 1024; stage = 5; ld = 64; sc = 1.f; B = DSK; }
            else if (n < 1408) { base = 1152; stage = 7; ld = 256; sc = IXQ_SCALE; B = IXQ; } else { base = 1408; stage = 8; ld = 64; sc = 1.f; B = IXK; }
            col = n - base; const int d = col & 63, dd = d & 31; double c, s_; dbg_sincos((float)r * c_inv_freq[dd], c, s_);
            const float ex = d < 32 ? (float)(zn * c - z[n + 32] * s_) : (float)(zn * c + z[n - 32] * s_);
            dbg_err(dbg, stage, bf2f(B[(size_t)r * ld + col]), ex * sc, AT, RT); }
        else if (n < 1152) dbg_err(dbg, 6, bf2f(DSV[(size_t)r * 64 + n - 1088]), zn, AT, RT);
        else if (n < 1476) dbg_err(dbg, 9, SM[(size_t)r * 64 + n - 1472], zn, AT, RT);
        else if (n < 1604) dbg_err(dbg, 10, bf2f(GLQ[(size_t)r * 128 + n - 1476]), zn * GLQ_SCALE, AT, RT);
        else if (n < 1732) dbg_err(dbg, 11, bf2f(GLK[(size_t)r * 128 + n - 1604]), zn, AT, RT);
        else if (n < 1988) dbg_err(dbg, 12, bf2f(GLV[(size_t)r * 256 + n - 1732]), zn, AT, RT);
        else if (n < 2004) dbg_err(dbg, 13, SM[(size_t)r * 64 + 4 + n - 1988], zn, AT, RT);
        else if (n < 2260) dbg_err(dbg, 14, bf2f(GLO[(size_t)r * 256 + n - 2004]), zn / (1.0f + expf(-zn)), AT, RT);
        else dbg_err(dbg, 15, bf2f(GT[(size_t)r * 3072 + n - 2260]), 1.0f / (1.0f + expf(-zn)), AT, RT);
    }
}
__global__ void __launch_bounds__(64) dbg_sb(unsigned char* ws) {
    float* dbg = (float*)(ws + WS_DBG); const int i = threadIdx.x, t = dbg_row(i), h = i & 3;
    const bf16_t* Q = (const bf16_t*)(ws + WS_SBQ); const bf16_t* K = (const bf16_t*)(ws + WS_SBK); const bf16_t* V = (const bf16_t*)(ws + WS_SBV); const bf16_t* O = (const bf16_t*)(ws + WS_OA);
    float q[64], acc[64];
#pragma unroll
    for (int d8 = 0; d8 < 8; ++d8) { float v[8]; ld_bf16x8(Q + (size_t)t * 256 + 64 * h + 8 * d8, v);
#pragma unroll
        for (int j = 0; j < 8; ++j) { q[8 * d8 + j] = v[j] * (1.0f / LOG2E); acc[8 * d8 + j] = 0.f; } }
    float run = 0.f;
    for (int s = t - 1; s >= 0; --s) { float z = 0.f;
#pragma unroll
        for (int d8 = 0; d8 < 8; ++d8) { float v[8]; ld_bf16x8(K + (size_t)s * 256 + 64 * h + 8 * d8, v);
#pragma unroll
            for (int j = 0; j < 8; ++j) z += q[8 * d8 + j] * v[j]; }
        const float lb = z >= 0.f ? -log1pf(expf(-z)) : z - log1pf(expf(z)); const float lk = lb - z; const float w = expf(lb + run);
#pragma unroll
        for (int d8 = 0; d8 < 8; ++d8) { float v[8]; ld_bf16x8(V + (size_t)s * 256 + 64 * h + 8 * d8, v);
#pragma unroll
            for (int j = 0; j < 8; ++j) acc[8 * d8 + j] += w * v[j]; }
        run += lk; }
#pragma unroll
    for (int d8 = 0; d8 < 8; ++d8) { float v[8]; ld_bf16x8(O + (size_t)t * 256 + 64 * h + 8 * d8, v);
#pragma unroll
        for (int j = 0; j < 8; ++j) dbg_err(dbg, 16, v[j], acc[8 * d8 + j], 0.02f, 0.02f); }
}
__global__ void __launch_bounds__(512) dbg_dsa(unsigned char* ws) {
    __shared__ float qi[256]; __shared__ float dq[256]; __shared__ float pp[4][256]; __shared__ float wsm[4]; __shared__ int mism; __shared__ float mxs[4], sms[4];
    float* dbg = (float*)(ws + WS_DBG); const int tid = threadIdx.x, t = dbg_row(blockIdx.x), N = ((t >> 6) + 1) * 64, nsel = N < 256 ? N : 256;
    const bf16_t* IQ = (const bf16_t*)(ws + WS_IXQ); const bf16_t* IK = (const bf16_t*)(ws + WS_IXK); const float* SM = (const float*)(ws + WS_SMALL);
    const bf16_t* DQ = (const bf16_t*)(ws + WS_DSQ); const bf16_t* DK = (const bf16_t*)(ws + WS_DSK); const bf16_t* DV = (const bf16_t*)(ws + WS_DSV); const bf16_t* OB = (const bf16_t*)(ws + WS_OB);
    const unsigned short* msel = (const unsigned short*)(ws + WS_DBGSEL) + (size_t)t * 256;
    float* sc = (float*)(ws + WS_DBGSC) + (size_t)blockIdx.x * 16384; int* fl = (int*)(ws + WS_DBGFL) + (size_t)blockIdx.x * 16384;
    if (tid < 256) { qi[tid] = bf2f(IQ[(size_t)t * 256 + tid]); dq[tid] = bf2f(DQ[(size_t)t * 256 + tid]); } if (tid < 4) wsm[tid] = SM[(size_t)t * 64 + tid] * 0.5f; if (tid == 0) mism = 0;
    __syncthreads();
    for (int s = tid; s < N; s += 512) { float tot = 0.f;
#pragma unroll 1
        for (int h = 0; h < 4; ++h) { float a = 0.f;
#pragma unroll 4
            for (int d = 0; d < 64; ++d) a += qi[64 * h + d] * bf2f(IK[(size_t)s * 64 + d]); tot += wsm[h] * fmaxf(a, 0.f); } sc[s] = tot + 0.0f; }
    __threadfence_block(); __syncthreads();
    { float mine[32]; int rank[32];
#pragma unroll
      for (int k = 0; k < 32; ++k) { const int s = tid + 512 * k; mine[k] = s < N ? sc[s] : 0.f; rank[k] = 0; }
      for (int j = 0; j < N; ++j) { const float v = sc[j];
#pragma unroll
          for (int k = 0; k < 32; ++k) { const int s = tid + 512 * k; rank[k] += (v > mine[k] || (v == mine[k] && j < s)) ? 1 : 0; } }
#pragma unroll
      for (int k = 0; k < 32; ++k) { const int s = tid + 512 * k; if (s < N) fl[s] = (N <= 256 || rank[k] < 256) ? 1 : 0; } }
    __threadfence_block(); __syncthreads();
    if (tid < nsel) { const int key = msel[tid]; bool ok = key < N; if (ok) ok = atomicExch(fl + key, 2) == 1; if (!ok) atomicAdd(&mism, 1); }
    __syncthreads();
    if (tid == 0) dbg_err(dbg, 17, (float)mism, 0.f, 6.0f, 0.f);
    if (tid < 256) { const bool valid = tid < nsel; const int key = valid ? (int)msel[tid] : 0; const int kk = key < S_ ? key : 0;
#pragma unroll 1
        for (int h = 0; h < 4; ++h) { float a = 0.f;
#pragma unroll 4
            for (int d = 0; d < 64; ++d) a += dq[64 * h + d] * bf2f(DK[(size_t)kk * 64 + d]);
            pp[h][tid] = valid ? a : -INFINITY; } }
    __syncthreads();
    if (tid < 4) { float mx = -INFINITY; for (int i = 0; i < 256; ++i) mx = fmaxf(mx, pp[tid][i]); float sm = 0.f; for (int i = 0; i < 256; ++i) sm += exp2f(pp[tid][i] - mx); mxs[tid] = mx; sms[tid] = sm; }
    __syncthreads();
    if (tid < 256) { const int h = tid >> 6, d = tid & 63; float o = 0.f;
#pragma unroll 2
        for (int i = 0; i < nsel; ++i) { const int key = msel[i] < S_ ? msel[i] : 0; o += exp2f(pp[h][i] - mxs[h]) * bf2f(DV[(size_t)key * 64 + d]); }
        dbg_err(dbg, 18, bf2f(OB[(size_t)t * 256 + tid]), o / sms[h], 0.02f, 0.02f); }
}
__global__ void __launch_bounds__(512) dbg_gla(const float* wup, const float* gb, const float* gn, unsigned char* ws) {
    __shared__ float qs[32], ks[32], al[32], vs[64], part[32][65], os[64];
    float* dbg = (float*)(ws + WS_DBG); const int tid = threadIdx.x, h = blockIdx.x, d = tid >> 4, e0 = (tid & 15) * 4;
    const float* SM = (const float*)(ws + WS_SMALL); const bf16_t* GQ = (const bf16_t*)(ws + WS_GLQ); const bf16_t* GK = (const bf16_t*)(ws + WS_GLK); const bf16_t* GV = (const bf16_t*)(ws + WS_GLV); const bf16_t* GO = (const bf16_t*)(ws + WS_GLO); const bf16_t* OC = (const bf16_t*)(ws + WS_OC);
    float st[4] = {0.f, 0.f, 0.f, 0.f}; float emax = 0.f;
    for (int t = 0; t < S_; ++t) {
        if (tid < 32) { qs[tid] = bf2f(GQ[(size_t)t * 128 + 32 * h + tid]); ks[tid] = bf2f(GK[(size_t)t * 128 + 32 * h + tid]);
            float x = gb[32 * h + tid]; for (int r = 0; r < 16; ++r) x += SM[(size_t)t * 64 + 4 + r] * wup[r * 128 + 32 * h + tid];
            const float ls = x >= 0.f ? -log1pf(expf(-x)) : x - log1pf(expf(x)); al[tid] = expf(ls * (1.0f / 16.0f)); }
        else if (tid < 96) vs[tid - 32] = bf2f(GV[(size_t)t * 256 + 64 * h + tid - 32]);
        __syncthreads();
#pragma unroll
        for (int i = 0; i < 4; ++i) { st[i] = al[d] * st[i] + ks[d] * vs[e0 + i]; part[d][e0 + i] = qs[d] * st[i]; }
        __syncthreads();
        if (tid < 64) { float o = 0.f; for (int dd = 0; dd < 32; ++dd) o += part[dd][tid]; float sq = o * o; for (int m = 32; m >= 1; m >>= 1) sq += __shfl_xor(sq, m);
            const float ex = o * rsqrtf(sq * (1.0f / 64.0f) + EPS) * gn[tid] * bf2f(GO[(size_t)t * 256 + 64 * h + tid]);
            float e = fabsf(bf2f(OC[(size_t)t * 256 + 64 * h + tid]) - ex) / (0.08f + 0.06f * fabsf(ex)); if (!(e == e)) e = 1e30f; emax = fmaxf(emax, e); }
        __syncthreads();
    }
    if (tid < 64) atomicMax((unsigned*)(dbg + 19), __float_as_uint(emax));
}
constexpr size_t WS_DBGCK = WS_DBGEND2;
constexpr size_t WS_DBGEND3 = WS_DBGCK + 2 * 64 * 1024 * 4;
__device__ __forceinline__ float dbg_dot(const float* arow, const float* W, int ldw, int K, int n) { float a = 0.f; for (int k = 0; k < K; ++k) a += arow[k] * W[(size_t)k * ldw + n]; return a; }
__global__ void __launch_bounds__(512) dbg_merge(const float* wa, const float* wb, const float* wc, unsigned char* ws) {
    __shared__ float oa[256], ob[256], oc[256]; float* dbg = (float*)(ws + WS_DBG); const int r = dbg_row(blockIdx.x), tid = threadIdx.x;
    if (tid < 256) { oa[tid] = bf2f(((const bf16_t*)(ws + WS_OA))[(size_t)r * 256 + tid]); ob[tid] = bf2f(((const bf16_t*)(ws + WS_OB))[(size_t)r * 256 + tid]); oc[tid] = bf2f(((const bf16_t*)(ws + WS_OC))[(size_t)r * 256 + tid]); }
    __syncthreads();
    const bf16_t* G = (const bf16_t*)(ws + WS_GATES) + (size_t)r * 3072; const bf16_t* M = (const bf16_t*)(ws + WS_MERGED) + (size_t)r * 1024;
    for (int c = tid; c < 1024; c += 512) { const float ex = bf2f(G[c]) * dbg_dot(oa, wa, 1024, 256, c) + bf2f(G[1024 + c]) * dbg_dot(ob, wb, 1024, 256, c) + bf2f(G[2048 + c]) * dbg_dot(oc, wc, 1024, 256, c);
        dbg_err(dbg, 21, bf2f(M[c]), ex, 0.03f, 0.03f); }
}
__global__ void __launch_bounds__(512) dbg_resid(const float* xin, int xin_ld_is_ck, const float* W, int K, size_t abuf_off, const float* out, unsigned char* ws, int st, int ckslot) {
    __shared__ float arow[2816]; __shared__ float red[8]; float* dbg = (float*)(ws + WS_DBG); const int smp = blockIdx.x, r = dbg_row(smp), tid = threadIdx.x;
    const bf16_t* Ab = (const bf16_t*)(ws + abuf_off) + (size_t)r * K; for (int k = tid; k < K; k += 512) arow[k] = bf2f(Ab[k]);
    __syncthreads();
    const float* xrow = xin_ld_is_ck ? xin + (size_t)smp * 1024 : xin + (size_t)r * 1024; float* ck = (float*)(ws + WS_DBGCK) + ((size_t)ckslot * 64 + smp) * 1024;
    float sq = 0.f;
    for (int c = tid; c < 1024; c += 512) { const float ex = xrow[c] + dbg_dot(arow, W, 1024, K, c); const float got = out[(size_t)r * 1024 + c];
        dbg_err(dbg, st, got, ex, 0.03f, 0.02f); dbg_err(dbg, st + 1, bf2f(((const bf16_t*)(ws + WS_XB))[(size_t)r * 1024 + c]), got, 0.001f, 0.01f); sq += got * got; ck[c] = got; }
    for (int o = 32; o >= 1; o >>= 1) sq += __shfl_xor(sq, o);
    if ((tid & 63) == 0) red[tid >> 6] = sq;
    __syncthreads();
    if (tid == 0) { float tot = 0.f; for (int i = 0; i < 8; ++i) tot += red[i]; const float* sp = (const float*)(ws + WS_SSQ) + (size_t)r * 16; float got = 0.f; for (int i = 0; i < 16; ++i) got += sp[i]; dbg_err(dbg, st + 2, got, tot, 0.f, 1e-3f); }
}
__global__ void __launch_bounds__(512) dbg_normproj(const float* x, const float* gain, const float* W, int mode, unsigned char* ws, int st) {
    __shared__ float xs[1024]; __shared__ float red[8]; float* dbg = (float*)(ws + WS_DBG); const int r = dbg_row(blockIdx.x), tid = threadIdx.x;
    float sq = 0.f; for (int k = tid; k < 1024; k += 512) { const float v = x[(size_t)r * 1024 + k]; sq += v * v; xs[k] = v * gain[k]; }
    for (int o = 32; o >= 1; o >>= 1) sq += __shfl_xor(sq, o);
    if ((tid & 63) == 0) red[tid >> 6] = sq;
    __syncthreads();
    float tot = 0.f; for (int i = 0; i < 8; ++i) tot += red[i]; const float rstd = rsqrtf(tot * (1.0f / 1024.0f) + EPS);
    if (mode == 0) { for (int c = tid; c < 1024; c += 512) dbg_err(dbg, st, bf2f(((const bf16_t*)(ws + WS_XQ))[(size_t)r * 1024 + c]), rstd * dbg_dot(xs, W, 1024, 1024, c) * XQ_SCALE, 0.03f, 0.02f); }
    else { for (int j = tid; j < DFF; j += 512) { const float g = rstd * dbg_dot(xs, W, NFF, 1024, j), up = rstd * dbg_dot(xs, W, NFF, 1024, DFF + j);
            dbg_err(dbg, st, bf2f(((const bf16_t*)(ws + WS_HID))[(size_t)r * DFF + j]), g / (1.0f + expf(-g)) * up, 0.03f, 0.03f); } }
}
__global__ void __launch_bounds__(512) dbg_kv(const float* mem, const float* gain, const float* W, unsigned char* ws, int st) {
    __shared__ float xs[1024]; __shared__ float red[8]; float* dbg = (float*)(ws + WS_DBG); const int r = blockIdx.x * 4 + 1, tid = threadIdx.x;
    float sq = 0.f; for (int k = tid; k < 1024; k += 512) { const float v = mem[(size_t)r * 1024 + k]; sq += v * v; xs[k] = v * gain[k]; }
    for (int o = 32; o >= 1; o >>= 1) sq += __shfl_xor(sq, o);
    if ((tid & 63) == 0) red[tid >> 6] = sq;
    __syncthreads();
    float tot = 0.f; for (int i = 0; i < 8; ++i) tot += red[i]; const float rstd = rsqrtf(tot * (1.0f / 1024.0f) + EPS);
    const int pos = (r & ~31) + 8 * ((r >> 2) & 3) + 4 * ((r >> 4) & 1) + (r & 3);
    for (int n = tid; n < 2048; n += 512) { const float ex = rstd * dbg_dot(xs, W, 2048, 1024, n);
        if (n < 1024) dbg_err(dbg, st, bf2f(((const bf16_t*)(ws + WS_KM))[(size_t)r * 1024 + n]), ex, 0.03f, 0.02f);
        else dbg_err(dbg, st + 1, bf2f(((const bf16_t*)(ws + WS_VMT))[(size_t)(n - 1024) * 256 + pos]), ex, 0.03f, 0.02f); }
}
__global__ void __launch_bounds__(512) dbg_xattn(unsigned char* ws, int st) {
    __shared__ float q[1024]; __shared__ float sc[256]; float* dbg = (float*)(ws + WS_DBG); const int r = dbg_row(blockIdx.x), tid = threadIdx.x;
    const bf16_t* XQ = (const bf16_t*)(ws + WS_XQ); const bf16_t* KM = (const bf16_t*)(ws + WS_KM); const bf16_t* VMT = (const bf16_t*)(ws + WS_VMT); const bf16_t* AO = (const bf16_t*)(ws + WS_AO);
    for (int k = tid; k < 1024; k += 512) q[k] = bf2f(XQ[(size_t)r * 1024 + k]);
    for (int h = 0; h < 4; ++h) {
        __syncthreads();
        if (tid < 256) { float a = 0.f; for (int d = 0; d < 256; ++d) a += q[256 * h + d] * bf2f(KM[(size_t)tid * 1024 + 256 * h + d]); sc[tid] = a; }
        __syncthreads();
        float mx = -INFINITY; for (int i = 0; i < 256; ++i) mx = fmaxf(mx, sc[i]); float sm = 0.f; for (int i = 0; i < 256; ++i) sm += exp2f(sc[i] - mx);
        if (tid < 256) { float o = 0.f; for (int key = 0; key < 256; ++key) { const int pos = (key & ~31) + 8 * ((key >> 2) & 3) + 4 * ((key >> 4) & 1) + (key & 3); o += exp2f(sc[key] - mx) * bf2f(VMT[(size_t)(256 * h + tid) * 256 + pos]); }
            dbg_err(dbg, st, bf2f(AO[(size_t)r * 1024 + 256 * h + tid]), o / sm, 0.02f, 0.02f); }
    }
}
__global__ void dbg_encode(unsigned char* ws, float* out, int nstage) {
    const float* dbg = (const float*)(ws + WS_DBG); int first = 0; for (int i = 1; i <= nstage; ++i) if (dbg[i] > 1.0f) { first = i; break; }
#ifdef DBG_PROBE
    { float e = dbg[DBG_PROBE] * 100.0f; first = e > 98.0f ? 98 : (int)(e + 0.5f); }
#endif
    const float c = sqrtf(10.0f * (float)first);
    for (size_t i = (size_t)blockIdx.x * blockDim.x + threadIdx.x; i < (size_t)S_ * D_; i += (size_t)gridDim.x * blockDim.x) out[i] = c;
}
#endif
extern "C" void kernel_launch(void* const* d_in, const int* in_sizes, int n_in, void* d_out, int out_size, void* d_ws, size_t ws_size, hipStream_t stream) {
    static int grid = 0;
    if (grid == 0) {
        if (n_in != 20 || out_size != S_ * D_ || ws_size < WS_END) { fprintf(stderr, "kernel_launch: unexpected shapes (n_in %d out %d ws %zu need %zu)\n", n_in, out_size, ws_size, (size_t)WS_END); grid = -1; return; }
        int dev = 0, cus = 0, per_cu = 0;
        if (hipGetDevice(&dev) != hipSuccess || hipDeviceGetAttribute(&cus, hipDeviceAttributeMultiprocessorCount, dev) != hipSuccess) { grid = -1; return; }
        if (hipFuncSetAttribute((const void*)mk_fwd, hipFuncAttributeMaxDynamicSharedMemorySize, LDS_BYTES) != hipSuccess) { fprintf(stderr, "kernel_launch: hipFuncSetAttribute failed\n"); grid = -1; return; }
        if (hipOccupancyMaxActiveBlocksPerMultiprocessor(&per_cu, (const void*)mk_fwd, NTHREADS, LDS_BYTES) != hipSuccess || per_cu < 1) { fprintf(stderr, "kernel_launch: occupancy query says %d\n", per_cu); }
        (void)hipGetLastError();
        grid = cus;
    }
    if (grid < 0) return;
    (void)hipMemsetAsync((char*)d_ws + WS_CTL, 0, CTL_ZERO_BYTES, stream);
    const float* p[20];
    for (int i = 0; i < 20; ++i) p[i] = (const float*)d_in[i];
#define MK_LAUNCH(LO, HI) hipLaunchKernelGGL(mk_fwd, dim3(grid), dim3(NTHREADS), LDS_BYTES, stream, p[0], p[1], p[2], p[3], p[4], p[5], p[6], p[7], p[8], p[9], p[10], p[11], p[12], p[13], p[14], p[15], p[16], p[17], p[18], p[19], \
        (float*)d_out, (unsigned char*)d_ws, (int)(LO), (int)(HI))
#if DBG_MODE == 1
    if (ws_size < WS_DBGEND3) { fprintf(stderr, "debug build: workspace too small\n"); return; }
    (void)hipMemsetAsync((char*)d_ws + WS_DBG, 0, 65536, stream);
    for (int ph = 0; ph <= 5; ++ph) MK_LAUNCH(ph, ph + 1);
    unsigned char* W8 = (unsigned char*)d_ws;
    hipLaunchKernelGGL(dbg_inproj, dim3(64), dim3(512), 0, stream, p[I_X], p[I_MIXG], p[I_WIN], W8);
    hipLaunchKernelGGL(dbg_sb, dim3(1), dim3(64), 0, stream, W8);
    hipLaunchKernelGGL(dbg_dsa, dim3(16), dim3(512), 0, stream, W8);
    hipLaunchKernelGGL(dbg_gla, dim3(4), dim3(512), 0, stream, p[I_GUP], p[I_GB], p[I_GNG], W8);
    hipLaunchKernelGGL(dbg_kv, dim3(64), dim3(512), 0, stream, p[I_MEM], p[I_MG], p[I_WXKV], W8, 26);
    MK_LAUNCH(6, 7);
    hipLaunchKernelGGL(dbg_merge, dim3(64), dim3(512), 0, stream, p[I_WBA], p[I_WBB], p[I_WBC], W8);
    MK_LAUNCH(7, 8);
    hipLaunchKernelGGL(dbg_resid, dim3(64), dim3(512), 0, stream, p[I_X], 0, p[I_WMIX], 1024, (size_t)WS_MERGED, (const float*)d_out, W8, 22, 0);
    MK_LAUNCH(8, 9);
    hipLaunchKernelGGL(dbg_normproj, dim3(64), dim3(512), 0, stream, (const float*)d_out, p[I_XG], p[I_WXQ], 0, W8, 25);
    hipLaunchKernelGGL(dbg_xattn, dim3(64), dim3(512), 0, stream, W8, 28);
    MK_LAUNCH(9, 10);
    hipLaunchKernelGGL(dbg_resid, dim3(64), dim3(512), 0, stream, (const float*)((char*)d_ws + WS_DBGCK), 1, p[I_WXO], 1024, (size_t)WS_AO, (const float*)d_out, W8, 29, 1);
    MK_LAUNCH(10, 11);
    hipLaunchKernelGGL(dbg_normproj, dim3(64), dim3(512), 0, stream, (const float*)d_out, p[I_FG], p[I_WFI], 1, W8, 32);
    MK_LAUNCH(11, 12);
    hipLaunchKernelGGL(dbg_resid, dim3(64), dim3(512), 0, stream, (const float*)((char*)d_ws + WS_DBGCK) + 64 * 1024, 1, p[I_WFO], DFF, (size_t)WS_HID, (const float*)d_out, W8, 33, 0);
    hipLaunchKernelGGL(dbg_encode, dim3(1024), dim3(256), 0, stream, W8, (float*)d_out, 35);
#elif N_LAUNCH_MODE == 1
    MK_LAUNCH(0, N_PHASES);
#else
    for (int ph = 0; ph < N_PHASES; ++ph) MK_LAUNCH(ph, ph + 1);
#endif
}
```

```cpp
#include <hip/hip_runtime.h>
#include <stdint.h>
#include <stdio.h>

#define LAS __attribute__((address_space(3)))
typedef unsigned short bf16_t;
typedef short bf16x8 __attribute__((ext_vector_type(8)));
typedef float f32x4 __attribute__((ext_vector_type(4)));
typedef float f32x2 __attribute__((ext_vector_type(2)));
typedef unsigned u32x4 __attribute__((ext_vector_type(4)));
typedef unsigned u32x2 __attribute__((ext_vector_type(2)));
typedef short s16x4 __attribute__((ext_vector_type(4)));

#ifndef DBG_MODE
#define DBG_MODE 0
#endif
#ifndef STAMP_A
#define STAMP_A 0
#endif
#define STAMP_MUL 4
#ifndef ONLY
#define ONLY -1
#endif
#define PH_EN(k) (ONLY < 0 || ONLY == (k))
#ifndef N_LAUNCH_MODE
#define N_LAUNCH_MODE 1
#endif

constexpr int S_ = 16384, D_ = 1024, NIN = 5376, INW = 5332, DFF = 2816, NFF = 5632, NMEM = 256, DEPTH = 4;
constexpr int NTHREADS = 512;
constexpr int LDS_BYTES = 147456;
constexpr int MISC_OFF = 143360;
constexpr float EPS = 1e-6f;
constexpr float LOG2E = 1.4426950408889634f;
constexpr float SBQ_SCALE = 0.125f * LOG2E;
constexpr float DSQ_SCALE = 0.125f * LOG2E;
constexpr float IXQ_SCALE = 0.125f;
constexpr float GLQ_SCALE = 0.17677669529663687f;
constexpr float XQ_SCALE = 0.0625f * LOG2E;

constexpr size_t MB = 1u << 20;
constexpr size_t WS_CTL = 0;
constexpr size_t WS_CS = 65536;
constexpr size_t WS_SSQ = WS_CS + 4 * MB;
constexpr size_t WS_MEMB = WS_SSQ + 1 * MB;
constexpr size_t WS_RSTDM = WS_MEMB + 512 * 1024;
constexpr size_t WS_KM = WS_RSTDM + 4096;
constexpr size_t WS_VMT = WS_KM + 512 * 1024;
constexpr size_t WS_WIN = WS_VMT + 512 * 1024;
constexpr size_t WS_WBR = WS_WIN + (size_t)NIN * 1024 * 2;
constexpr size_t WS_WMIX = WS_WBR + 3 * 1024 * 256 * 2;
constexpr size_t WS_WXQ = WS_WMIX + 2 * MB;
constexpr size_t WS_WXKV = WS_WXQ + 2 * MB;
constexpr size_t WS_WXO = WS_WXKV + 4 * MB;
constexpr size_t WS_WFI = WS_WXO + 2 * MB;
constexpr size_t WS_WFO = WS_WFI + (size_t)NFF * 1024 * 2;
constexpr size_t WS_XB = WS_WFO + (size_t)1024 * DFF * 2;
constexpr size_t WS_SBQ = WS_XB + 32 * MB;
constexpr size_t WS_SBK = WS_SBQ + 8 * MB;
constexpr size_t WS_SBV = WS_SBK + 8 * MB;
constexpr size_t WS_DSQ = WS_SBV + 8 * MB;
constexpr size_t WS_IXQ = WS_DSQ + 8 * MB;
constexpr size_t WS_DSK = WS_IXQ + 8 * MB;
constexpr size_t WS_IXK = WS_DSK + 2 * MB;
constexpr size_t WS_DSV = WS_IXK + 2 * MB;
constexpr size_t WS_SMALL = WS_DSV + 2 * MB;
constexpr size_t WS_GLQ = WS_SMALL + 4 * MB;
constexpr size_t WS_GLK = WS_GLQ + 4 * MB;
constexpr size_t WS_GLV = WS_GLK + 4 * MB;
constexpr size_t WS_GLO = WS_GLV + 8 * MB;
constexpr size_t WS_OA = WS_GLO + 8 * MB;
constexpr size_t WS_OB = WS_OA + 8 * MB;
constexpr size_t WS_OC = WS_OB + 8 * MB;
constexpr size_t WS_BC = WS_OC + 8 * MB;
constexpr size_t WS_UC = WS_BC + 8 * MB;
constexpr size_t WS_ST = WS_UC + 8 * MB;
constexpr size_t WS_AC = WS_ST + 8 * MB;
constexpr size_t WS_SBVT = WS_AC + 128 * 1024;
constexpr size_t WS_GLVT = WS_SBVT + 8 * MB;
constexpr size_t WS_MERGED = WS_GLVT + 8 * MB;
constexpr size_t WS_GATES = WS_MERGED + 32 * MB;
constexpr size_t WS_XQ = WS_GATES;
constexpr size_t WS_AO = WS_GATES + 32 * MB;
constexpr size_t WS_HID = WS_GATES;
constexpr size_t WS_END = WS_GATES + 96 * MB;
constexpr size_t WS_DBG = WS_END;
constexpr size_t WS_DBGSEL = WS_DBG + 65536;
constexpr size_t WS_DBGEND = WS_DBGSEL + 8 * MB;
constexpr size_t CTL_ZERO_BYTES = 65536;
constexpr int CW_BAR = 0;
constexpr int CW_QUEUE = 4096;

typedef __bf16 bf16x2_t __attribute__((ext_vector_type(2)));
__device__ __forceinline__ unsigned cvt_pk_bf16(float lo, float hi) { const f32x2 v = {lo, hi}; return __builtin_bit_cast(unsigned, __builtin_convertvector(v, bf16x2_t)); }
__device__ __forceinline__ bf16_t f2bf(float f) { return (bf16_t)(cvt_pk_bf16(f, 0.f) & 0xffffu); }
__device__ __forceinline__ float bf2f(unsigned b) { return __uint_as_float(b << 16); }
__device__ __forceinline__ float bflo(unsigned w) { return __uint_as_float(w << 16); }
__device__ __forceinline__ float bfhi(unsigned w) { return __uint_as_float(w & 0xffff0000u); }
__device__ __forceinline__ void st_bf16x8(bf16_t* p, const float (&v)[8]) {
    u32x4 w; w.x = cvt_pk_bf16(v[0], v[1]); w.y = cvt_pk_bf16(v[2], v[3]); w.z = cvt_pk_bf16(v[4], v[5]); w.w = cvt_pk_bf16(v[6], v[7]); *(u32x4*)p = w; }
__device__ __forceinline__ void ld_bf16x8(const bf16_t* p, float (&v)[8]) {
    const u32x4 w = *(const u32x4*)p; v[0] = bflo(w.x); v[1] = bfhi(w.x); v[2] = bflo(w.y); v[3] = bfhi(w.y); v[4] = bflo(w.z); v[5] = bfhi(w.z); v[6] = bflo(w.w); v[7] = bfhi(w.w); }
__device__ __forceinline__ float row_rstd(const float* ssq, int r) {
    const f32x4* p = (const f32x4*)(ssq + (size_t)r * 16); const f32x4 a = p[0], b = p[1], c = p[2], d = p[3];
    const float s = ((a.x + a.y) + (a.z + a.w)) + ((b.x + b.y) + (b.z + b.w)) + ((c.x + c.y) + (c.z + c.w)) + ((d.x + d.y) + (d.z + d.w));
    return rsqrtf(s * (1.0f / 1024.0f) + EPS); }
__device__ __forceinline__ float sigmoidf_(float v) { return __builtin_amdgcn_rcpf(1.0f + __builtin_amdgcn_exp2f(-v * LOG2E)); }
__device__ __forceinline__ float shx(float v, int m, int lane) { return __int_as_float(__builtin_amdgcn_ds_bpermute((lane ^ m) << 2, __float_as_int(v))); }
__device__ __forceinline__ unsigned shdn(unsigned v, int off, int lane) { return (unsigned)__builtin_amdgcn_ds_bpermute((lane + off) << 2, (int)v); }
__device__ __forceinline__ float wave_sum(float v, int lane) { for (int o = 32; o >= 1; o >>= 1) v += shx(v, o, lane); return v; }
__device__ __forceinline__ float wave_max(float v, int lane) { for (int o = 32; o >= 1; o >>= 1) v = fmaxf(v, shx(v, o, lane)); return v; }

__device__ __forceinline__ int mytid(int wave) { int lane; asm volatile("v_mbcnt_lo_u32_b32 %0, -1, 0\n\tv_mbcnt_hi_u32_b32 %0, -1, %0" : "=v"(lane)); asm volatile("" : "+s"(wave)); return wave * 64 + lane; }

#define XB_TMO      128
#define XB_XCNT(j)  (256  + 64 * (j))
#define XB_XSUB(j)  (1280 + 64 * (j))
#define XB_XGEN(j)  (2304 + 64 * (j))
#define XB_TOP      3328
#define XB_TOPGEN   3392
#define XCD_BAR_WORDS 3456
#define XB_SPIN_CAP (1u << 22)
__device__ __forceinline__ unsigned xb_ld(unsigned* p)              { return __hip_atomic_load(p, __ATOMIC_RELAXED, __HIP_MEMORY_SCOPE_AGENT); }
__device__ __forceinline__ unsigned xb_add(unsigned* p, unsigned v) { return __hip_atomic_fetch_add(p, v, __ATOMIC_RELAXED, __HIP_MEMORY_SCOPE_AGENT); }
__device__ __forceinline__ unsigned xb_xcc_id() { return (unsigned)__builtin_amdgcn_s_getreg((3 << 11) | 20) & 0xFu; }
#define XB_SPIN(cond, bar) do { unsigned _sp = 0; while (cond) { __builtin_amdgcn_s_sleep(1); \
    if ((++_sp & 255u) == 0u) { if (xb_ld(&(bar)[XB_TMO])) break; if (_sp > XB_SPIN_CAP) { atomicAdd(&(bar)[XB_TMO], 1u); break; } } } } while (0)
struct XcdBarrier { unsigned* bar; unsigned x; volatile LAS unsigned* st; };
__device__ __forceinline__ XcdBarrier xcd_barrier_post(unsigned* bar, volatile LAS unsigned* st, int wave_s) {
    XcdBarrier b; b.bar = bar; b.x = xb_xcc_id(); b.st = st;
    if (mytid(wave_s) == 0) (void)xb_add(&bar[XB_XCNT(b.x)], 1u);
    return b;
}
__device__ __forceinline__ void xcd_barrier_complete(unsigned* bar, unsigned x, unsigned& nloc, unsigned& nx) {
    const unsigned G = gridDim.x * gridDim.y * gridDim.z;
    unsigned sum, cnt, mine, sp = 0u;
    for (;;) {
        sum = 0u; cnt = 0u; mine = 0u;
#pragma unroll
        for (unsigned j = 0; j < 16; ++j) { const unsigned c = xb_ld(&bar[XB_XCNT(j)]); sum += c; cnt += (c > 0u) ? 1u : 0u; mine = (j == x) ? c : mine; }
        if (sum == G) break;
        __builtin_amdgcn_s_sleep(1);
        if ((++sp & 255u) == 0u) { if (xb_ld(&bar[XB_TMO])) break; if (sp > XB_SPIN_CAP) { atomicAdd(&bar[XB_TMO], 1u); break; } }
    }
    nloc = mine > 0u ? mine : 1u; nx = cnt > 0u ? cnt : 1u;
}
__device__ __forceinline__ void xcd_barrier(const XcdBarrier& b, int wave_s) {
    asm volatile("s_waitcnt vmcnt(0)" ::: "memory");
    __syncthreads();
    if (mytid(wave_s) == 0) {
        unsigned* bar = b.bar;
        __builtin_amdgcn_s_waitcnt(0);
        unsigned nloc = b.st[0], nx = b.st[1];
        if (nloc == 0u) { xcd_barrier_complete(bar, b.x, nloc, nx); b.st[0] = nloc; b.st[1] = nx; }
        const unsigned old = xb_add(&bar[XB_XSUB(b.x)], 1u);
        const unsigned gen = old / nloc;
        if (old + 1u == (gen + 1u) * nloc) {
            __builtin_amdgcn_fence(__ATOMIC_RELEASE, "agent");
            asm volatile("s_waitcnt vmcnt(0)" ::: "memory");
            const unsigned og = xb_add(&bar[XB_TOP], 1u);
            const unsigned tg = og / nx;
            if (og + 1u == (tg + 1u) * nx) xb_add(&bar[XB_TOPGEN], 1u);
            else XB_SPIN(xb_ld(&bar[XB_TOPGEN]) == tg, bar);
            __builtin_amdgcn_fence(__ATOMIC_ACQUIRE, "agent");
            xb_add(&bar[XB_XGEN(b.x)], 1u);
            asm volatile("s_waitcnt vmcnt(0)" ::: "memory");
        } else {
            XB_SPIN(xb_ld(&bar[XB_XGEN(b.x)]) == gen, bar);
            __builtin_amdgcn_fence(__ATOMIC_ACQUIRE, "agent");
            asm volatile("s_waitcnt vmcnt(0)" ::: "memory");
        }
    }
    __syncthreads();
}

#if DBG_MODE == 3
#define TICKR(ring_, wave_, i) do { if (blockIdx.x == 0 && mytid(wave_) == 0) { volatile LAS unsigned long long* _a = (volatile LAS unsigned long long*)((ring_) + MISC_OFF + 2560); const unsigned long long _n = __builtin_amdgcn_s_memrealtime(); if ((i) > 0) _a[(i)] += _n - _a[0]; _a[0] = _n; } } while (0)
#else
#define TICKR(ring_, wave_, i) do { } while (0)
#endif
namespace pg8 {
constexpr int BM = 256, BK = 64, HALF = 128, HTB = HALF * BK * 2, STAGE_BYTES = 8 * HTB, NXCD = 8, WGM = 8;
__host__ __device__ __forceinline__ int lds_byte(int r, int c) { const int st = (r >> 4) * 2 + (c >> 5), rr = r & 15, cc = c & 31, ob = rr * 64 + cc * 2; return st * 1024 + (ob ^ (((ob >> 9) & 1) << 5)); }
__host__ __device__ __forceinline__ void stage_rc(int b, int& R, int& C) { const int st = b / 1024, sb = b % 1024, swz = sb ^ (((sb >> 9) & 1) << 5); R = (st >> 1) * 16 + swz / 64; C = (st & 1) * 32 + (swz % 64) / 2; }
__host__ __device__ __forceinline__ int perm32(int rho) { const int n = rho >> 4, i = rho & 15; return 8 * (i >> 2) + 4 * n + (i & 3); }
struct Unit { int pm, pn, z; };
struct Gemm { const bf16_t* A; const bf16_t* Bt; int M, N, K; size_t azstep, bzstep; };
struct StaticOrder {
    int nM, nN, nwg, G, c;
    __host__ __device__ void init(int M, int N, int G_, int c_) { nM = M / BM; nN = N / BM; nwg = nM * nN; G = G_; c = c_; }
    __host__ __device__ bool next(int i, Unit& u) const {
        const long L = (long)i * G + c; if (L >= nwg) return false;
        int wgid = (int)L; { const int q = nwg / NXCD, r = nwg % NXCD, xcd = wgid % NXCD, off = wgid / NXCD; wgid = (xcd < r ? xcd * (q + 1) : r * (q + 1) + (xcd - r) * q) + off; }
        const int nig = WGM * nN, gid = wgid / nig, fm = gid * WGM, gsz = (nM - fm) < WGM ? (nM - fm) : WGM;
        u.pm = fm + ((wgid % nig) % gsz); u.pn = (wgid % nig) / gsz; u.z = 0; return true;
    }
    __device__ __forceinline__ void a_ready(const Unit&) const {}
    __device__ __forceinline__ void done(const Unit&) const {}
};
struct TripleOrder : StaticOrder {
    __host__ __device__ bool next(int i, Unit& u) const { const int b = i / 3; if (!StaticOrder::next(b, u)) return false; u.z = i - 3 * b; return true; }
};
template <class Epi, class Sched>
__device__ __forceinline__ void gemm_phase(LAS unsigned char* lds, const Gemm g, const Sched& S, const Epi& E, int wave_s) {
    const int tid_l = mytid(wave_s);
    const int tid = tid_l, wid = __builtin_amdgcn_readfirstlane(tid >> 6), lane = tid & 63, wr = wid >> 2, wc = wid & 3, fr = lane & 15, fq = lane >> 4;
    const int K = g.K, nt = K / BK;
    unsigned voffA[2], voffB[2];
#pragma unroll
    for (int i = 0; i < 2; ++i) { int R, C; stage_rc(tid * 16 + i * 8192, R, C); const int Rb = Epi::PERM ? ((R & ~31) + perm32(R & 31)) : R;
        voffA[i] = (unsigned)(R * K + C) * 2u; voffB[i] = (unsigned)(Rb * K + C) * 2u; }
    const size_t kstep = (size_t)(BK * 2);
    const size_t hstep = (size_t)HALF * K * 2;
    const size_t tstep = 2 * hstep;
    const unsigned ldsw = (unsigned)wid * 1024u;
    const int aoff = lds_byte(wr * 64 + fr, fq * 8), boff = lds_byte(wc * 32 + fr, fq * 8);
#define PG8_SA(b, h) (((b) * 2 + (h)) * HTB)
#define PG8_SB(b, h) ((4 + (b) * 2 + (h)) * HTB)
#define PG8_STAGE(bufoff, gbase, voff) do { _Pragma("unroll") for (int _i = 0; _i < 2; ++_i) \
        __builtin_amdgcn_global_load_lds((const unsigned*)((const char*)(gbase) + (voff)[_i]), (LAS unsigned*)(lds + (bufoff) + ldsw + _i * 8192), 16, 0, 0); } while (0)
#define PG8_LDA(dst, b, h) do { _Pragma("unroll") for (int m = 0; m < 4; ++m) _Pragma("unroll") for (int k = 0; k < 2; ++k) dst[m][k] = *(const LAS bf16x8*)(lds + PG8_SA(b, h) + aoff + m * 2048 + k * 1024); } while (0)
#define PG8_LDB(dst, b, h) do { _Pragma("unroll") for (int n = 0; n < 2; ++n) _Pragma("unroll") for (int k = 0; k < 2; ++k) dst[n][k] = *(const LAS bf16x8*)(lds + PG8_SB(b, h) + boff + n * 2048 + k * 1024); } while (0)
#define PG8_MMA(ai, bj, At, Bt) do { __builtin_amdgcn_s_setprio(1); _Pragma("unroll") for (int m = 0; m < 4; ++m) _Pragma("unroll") for (int n = 0; n < 2; ++n) _Pragma("unroll") for (int k = 0; k < 2; ++k) \
        acc[ai][bj][m][n] = __builtin_amdgcn_mfma_f32_16x16x32_bf16(Bt[n][k], At[m][k], acc[ai][bj][m][n], 0, 0, 0); __builtin_amdgcn_s_setprio(0); } while (0)
#define PG8_WAIT_V(n) asm volatile("s_waitcnt vmcnt(" #n ")" ::: "memory")
#define PG8_WAIT_L(n) asm volatile("s_waitcnt lgkmcnt(" #n ")" ::: "memory")
#define PG8_BAR __builtin_amdgcn_s_barrier()
#define PG8_SCHED __builtin_amdgcn_sched_barrier(0)
    Unit cur, nxt; int ui = 0;
    if (!S.next(0, cur)) return;
    TICKR(lds, wave_s, 0);
#if DBG_MODE == 3
    if (blockIdx.x == 0 && mytid(wave_s) == 0) ((volatile LAS unsigned long long*)(lds + MISC_OFF + 2560))[11] = clock64();
#endif
    cur.pm = __builtin_amdgcn_readfirstlane(cur.pm); cur.pn = __builtin_amdgcn_readfirstlane(cur.pn); cur.z = __builtin_amdgcn_readfirstlane(cur.z);
    f32x4 acc[2][2][4][2];
#pragma unroll
    for (int a = 0; a < 2; ++a)
#pragma unroll
        for (int b = 0; b < 2; ++b)
#pragma unroll
            for (int m = 0; m < 4; ++m)
#pragma unroll
                for (int n = 0; n < 2; ++n) acc[a][b][m][n] = (f32x4){0.f, 0.f, 0.f, 0.f};
    bf16x8 At[4][2], B0[2][2], B1[2][2];
    const char* cA = (const char*)g.A + (size_t)cur.pm * tstep + (size_t)cur.z * g.azstep; const char* cB = (const char*)g.Bt + (size_t)cur.pn * tstep + (size_t)cur.z * g.bzstep;
    S.a_ready(cur);
    PG8_STAGE(PG8_SB(0, 0), cB, voffB); PG8_STAGE(PG8_SA(0, 0), cA, voffA); PG8_STAGE(PG8_SB(0, 1), cB + hstep, voffB); PG8_STAGE(PG8_SA(0, 1), cA + hstep, voffA);
    if (wr == 1) PG8_BAR;
    PG8_WAIT_V(4); PG8_BAR;
    PG8_STAGE(PG8_SB(1, 0), cB + kstep, voffB); PG8_STAGE(PG8_SA(1, 0), cA + kstep, voffA); PG8_STAGE(PG8_SB(1, 1), cB + hstep + kstep, voffB);
    PG8_WAIT_V(6); PG8_BAR;
    for (;;) {
        const bool has_next = S.next(ui + 1, nxt);
        nxt.pm = __builtin_amdgcn_readfirstlane(nxt.pm); nxt.pn = __builtin_amdgcn_readfirstlane(nxt.pn); nxt.z = __builtin_amdgcn_readfirstlane(nxt.z);
        const char* nA = has_next ? (const char*)g.A + (size_t)nxt.pm * tstep + (size_t)nxt.z * g.azstep : cA; const char* nB = has_next ? (const char*)g.Bt + (size_t)nxt.pn * tstep + (size_t)nxt.z * g.bzstep : cB;
        for (int t = 0; t < nt; t += 2) {
            const bool last = (t == nt - 2);
            const char* a1 = cA + (size_t)(t + 1) * kstep;
            const char* a2 = last ? nA : cA + (size_t)(t + 2) * kstep; const char* b2 = last ? nB : cB + (size_t)(t + 2) * kstep;
            const char* a3 = a2 + kstep; const char* b3 = b2 + kstep;
            if (last && has_next) S.a_ready(nxt);
            PG8_LDB(B0, 0, 0); PG8_SCHED; PG8_LDA(At, 0, 0); PG8_STAGE(PG8_SA(1, 1), a1 + hstep, voffA);
            PG8_WAIT_L(8); PG8_BAR; PG8_WAIT_L(0); PG8_MMA(0, 0, At, B0); PG8_BAR; PG8_SCHED;
            PG8_LDB(B1, 0, 1); PG8_STAGE(PG8_SB(0, 0), b2, voffB);
            PG8_BAR; PG8_WAIT_L(0); PG8_MMA(0, 1, At, B1); PG8_BAR;
            PG8_LDA(At, 0, 1); PG8_STAGE(PG8_SA(0, 0), a2, voffA);
            PG8_BAR; PG8_WAIT_L(0); PG8_MMA(1, 0, At, B0); PG8_BAR; PG8_SCHED;
            PG8_STAGE(PG8_SB(0, 1), b2 + hstep, voffB);
            PG8_WAIT_V(6); PG8_BAR; PG8_MMA(1, 1, At, B1); PG8_BAR;
            PG8_LDB(B0, 1, 0); PG8_SCHED; PG8_LDA(At, 1, 0); PG8_STAGE(PG8_SA(0, 1), a2 + hstep, voffA);
            PG8_WAIT_L(8); PG8_BAR; PG8_WAIT_L(0); PG8_MMA(0, 0, At, B0); PG8_BAR; PG8_SCHED;
            PG8_LDB(B1, 1, 1); PG8_STAGE(PG8_SB(1, 0), b3, voffB);
            PG8_BAR; PG8_WAIT_L(0); PG8_MMA(0, 1, At, B1); PG8_BAR;
            PG8_LDA(At, 1, 1); PG8_STAGE(PG8_SA(1, 0), a3, voffA);
            PG8_BAR; PG8_WAIT_L(0); PG8_MMA(1, 0, At, B0); PG8_BAR; PG8_SCHED;
            PG8_STAGE(PG8_SB(1, 1), b3 + hstep, voffB);
            PG8_WAIT_V(6); PG8_BAR; PG8_MMA(1, 1, At, B1); PG8_BAR;
        }
        TICKR(lds, wave_s, 8);
#if DBG_MODE == 3
        if (blockIdx.x == 0 && mytid(wave_s) == 0) { volatile LAS unsigned long long* _a = (volatile LAS unsigned long long*)(lds + MISC_OFF + 2560); const unsigned long long _c = clock64(); _a[10] += _c - _a[11]; }
#endif
        { const int l2 = mytid(wave_s) & 63; E(acc, cur, wr, wc, l2 >> 2, l2 & 3); }
        TICKR(lds, wave_s, 9);
#if DBG_MODE == 3
        if (blockIdx.x == 0 && mytid(wave_s) == 0) ((volatile LAS unsigned long long*)(lds + MISC_OFF + 2560))[11] = clock64();
#endif
        if (!has_next) break;
#pragma unroll
        for (int a = 0; a < 2; ++a)
#pragma unroll
            for (int b = 0; b < 2; ++b)
#pragma unroll
                for (int m = 0; m < 4; ++m)
#pragma unroll
                    for (int n = 0; n < 2; ++n) acc[a][b][m][n] = (f32x4){0.f, 0.f, 0.f, 0.f};
        cur = nxt; cA = nA; cB = nB; ++ui;
    }
    PG8_WAIT_V(0);
    if (wr == 0) PG8_BAR;
    PG8_BAR;
#undef PG8_SA
#undef PG8_SB
#undef PG8_STAGE
#undef PG8_LDA
#undef PG8_LDB
#undef PG8_MMA
#undef PG8_WAIT_V
#undef PG8_WAIT_L
#undef PG8_BAR
#undef PG8_SCHED
}
}

#define GAS __attribute__((address_space(1)))
struct Args { float* out; unsigned char* ws; LAS unsigned char* ring; int wave; };
__device__ __forceinline__ unsigned char* opq(unsigned char* p) { unsigned z = 0; asm volatile("" : "+s"(z)); return p + z; }
__device__ __forceinline__ int obid() { int b = blockIdx.x; asm volatile("" : "+s"(b)); return b; }
__device__ __forceinline__ int ogrid() { int b = gridDim.x; asm volatile("" : "+s"(b)); return b; }
constexpr int ARGV_OFF = MISC_OFF + 3072;
__device__ __forceinline__ const GAS float* ldarg(const Args& A, int i) {
    volatile LAS unsigned* p = (volatile LAS unsigned*)(A.ring + ARGV_OFF) + 2 * i; unsigned lo = p[0], hi = p[1];
    lo = __builtin_amdgcn_readfirstlane(lo); hi = __builtin_amdgcn_readfirstlane(hi);
    return (const GAS float*)(((unsigned long long)hi << 32) | lo); }
#if DBG_MODE == 3
#define TICK(A_, i) do { if (obid() == 0 && mytid((A_).wave) == 0) { volatile LAS unsigned long long* _a = (volatile LAS unsigned long long*)((A_).ring + MISC_OFF + 2560); const unsigned long long _n = __builtin_amdgcn_s_memrealtime(); if ((i) > 0) _a[(i)] += _n - _a[0]; _a[0] = _n; } } while (0)
#else
#define TICK(A_, i) do { } while (0)
#endif
enum { I_X = 0, I_MEM, I_MIXG, I_WIN, I_GUP, I_GB, I_GNG, I_WBA, I_WBB, I_WBC, I_WMIX, I_XG, I_MG, I_WXQ, I_WXKV, I_WXO, I_FG, I_WFI, I_WFO, I_FING };

typedef const f32x4 (&AccRef)[2][2][4][2];
#define EPI_XPOSE(a_, b_) do { const int xa_ = (fq * 16 + fr) << 2; _Pragma("unroll") for (int i = 0; i < 8; ++i) { a_[i] = __int_as_float(__builtin_amdgcn_ds_bpermute(xa_, __float_as_int(a_[i]))); b_[i] = __int_as_float(__builtin_amdgcn_ds_bpermute(xa_, __float_as_int(b_[i]))); } } while (0)
#define EPI_ROWS_BEGIN _Pragma("unroll") for (int ai = 0; ai < 2; ++ai) _Pragma("unroll") for (int m = 0; m < 4; ++m) { \
    const int r = u.pm * 256 + ai * 128 + wr * 64 + m * 16 + fr; float a[8], b[8]; \
    _Pragma("unroll") for (int i = 0; i < 8; ++i) { a[i] = acc[ai][0][m][i >> 2][i & 3]; b[i] = acc[ai][1][m][i >> 2][i & 3]; } EPI_XPOSE(a, b);
#define EPI_ROWS_END asm volatile("" ::: "memory"); }

#define EPI_AB(ai_, m_) float a[8], b[8]; _Pragma("unroll") for (int i = 0; i < 8; ++i) { a[i] = acc[ai_][0][m_][i >> 2][i & 3]; b[i] = acc[ai_][1][m_][i >> 2][i & 3]; } EPI_XPOSE(a, b);
#define EPI_ROWOF(ai_, m_) (u.pm * 256 + (ai_) * 128 + wr * 64 + (m_) * 16 + fr)
#define EPI_RSTD4(ssq_, ai_, rs_) do { f32x4 q_[4]; _Pragma("unroll") for (int m = 0; m < 4; ++m) q_[m] = *(const f32x4*)((ssq_) + (size_t)EPI_ROWOF(ai_, m) * 16 + 4 * fq);        \
    _Pragma("unroll") for (int m = 0; m < 4; ++m) { float t_ = (q_[m].x + q_[m].y) + (q_[m].z + q_[m].w); t_ += shx(t_, 1, 4 * fr + fq); t_ += shx(t_, 2, 4 * fr + fq); rs_[m] = rsqrtf(t_ * (1.0f / 1024.0f) + EPS); } } while (0)
#define EPI_AB0(ai_, m_) float a[8], b[8]; _Pragma("unroll") for (int i = 0; i < 8; ++i) { a[i] = acc[ai_][0][m_][i >> 2][i & 3]; b[i] = acc[ai_][1][m_][i >> 2][i & 3]; }
#define EPI_RS_ORIG(rs_, rso_) do { const int ra_ = (4 * ((4 * fr + fq) & 15)) << 2; _Pragma("unroll") for (int m = 0; m < 4; ++m) rso_[m] = __int_as_float(__builtin_amdgcn_ds_bpermute(ra_, __float_as_int(rs_[m]))); } while (0)
__device__ __forceinline__ void st_bf16x8_x(bf16_t* p, const float (&v)[8], int xa) {
    u32x4 w; w.x = (unsigned)__builtin_amdgcn_ds_bpermute(xa, (int)cvt_pk_bf16(v[0], v[1])); w.y = (unsigned)__builtin_amdgcn_ds_bpermute(xa, (int)cvt_pk_bf16(v[2], v[3]));
    w.z = (unsigned)__builtin_amdgcn_ds_bpermute(xa, (int)cvt_pk_bf16(v[4], v[5])); w.w = (unsigned)__builtin_amdgcn_ds_bpermute(xa, (int)cvt_pk_bf16(v[6], v[7])); *(u32x4*)p = w; }
struct EpiIn {
    static constexpr bool PERM = true;
    const float* ssq; const float* cs;
    bf16_t *sbq, *sbk, *sbv, *dsq, *ixq, *dsk, *ixk, *dsv, *glq, *glk, *glv, *glo, *gates; float* small; bf16_t* sbvt; int pn_off; bf16_t* glvt;
    __device__ __forceinline__ void operator()(AccRef acc, const pg8::Unit& u, int wr, int wc, int fr, int fq) const {
        const int pn = u.pn + pn_off;
        int mode = 0, ld = 256, off0 = wc * 32, off1 = 128 + wc * 32; float sc0 = 1.0f, sc1 = 1.0f; bf16_t* O0 = sbq; bf16_t* O1 = sbq;
        if (pn == 0) { O0 = O1 = sbq; sc0 = sc1 = SBQ_SCALE; }
        else if (pn == 1) { O0 = O1 = sbk; }
        else if (pn == 2) { O0 = O1 = sbv; }
        else if (pn == 3) { O0 = O1 = dsq; mode = 1; sc0 = sc1 = DSQ_SCALE; off0 = wc * 64; off1 = wc * 64 + 32; }
        else if (pn == 4) { O0 = O1 = ixq; mode = 1; sc0 = sc1 = IXQ_SCALE; off0 = wc * 64; off1 = wc * 64 + 32; }
        else if (pn == 5) { ld = 64; off0 = 0; off1 = 32;
            if (wc == 0) { O0 = O1 = dsk; mode = 1; } else if (wc == 1) { O0 = O1 = ixk; mode = 1; } else if (wc == 2) { O0 = O1 = dsv; } else { O0 = O1 = (bf16_t*)small; mode = 4; } }
        else if (pn == 6) { O0 = glq; O1 = glk; ld = 128; off1 = wc * 32; sc0 = GLQ_SCALE; }
        else if (pn == 7) { O0 = O1 = glv; }
        else if (pn == 8) { O0 = O1 = glo; mode = 2; }
        else { O0 = O1 = gates + (pn - 9) * 256; ld = 3072; mode = 3; }
        if (mode == 1 || mode == 4) {
#pragma unroll
        for (int ai = 0; ai < 2; ++ai) {
            float rs4[4]; EPI_RSTD4(ssq, ai, rs4);
#pragma unroll
            for (int m = 0; m < 4; ++m) { const int r = EPI_ROWOF(ai, m); EPI_AB(ai, m)
                const float rs = rs4[m];
#pragma unroll
                for (int i = 0; i < 8; ++i) { a[i] *= rs * sc0; b[i] *= rs * sc1; }
                if (mode == 1) {
                    const f32x4* cp = (const f32x4*)(cs + ((size_t)r * 32 + fq * 8) * 2);
#pragma unroll
                    for (int i2 = 0; i2 < 4; ++i2) { const f32x4 q = cp[i2];
                        const float a0 = a[2 * i2], b0 = b[2 * i2], a1 = a[2 * i2 + 1], b1 = b[2 * i2 + 1];
                        a[2 * i2] = a0 * q.x - b0 * q.y; b[2 * i2] = b0 * q.x + a0 * q.y; a[2 * i2 + 1] = a1 * q.z - b1 * q.w; b[2 * i2 + 1] = b1 * q.z + a1 * q.w; }
                }
                if (mode == 4) { float* p = (float*)O0 + (size_t)r * 64 + fq * 8;
                    *(f32x4*)p = (f32x4){a[0], a[1], a[2], a[3]}; *(f32x4*)(p + 4) = (f32x4){a[4], a[5], a[6], a[7]};
                    *(f32x4*)(p + 32) = (f32x4){b[0], b[1], b[2], b[3]}; *(f32x4*)(p + 36) = (f32x4){b[4], b[5], b[6], b[7]}; }
                else { st_bf16x8(O0 + (size_t)r * ld + off0 + fq * 8, a); st_bf16x8(O1 + (size_t)r * ld + off1 + fq * 8, b); }
            }
            asm volatile("" ::: "memory");
        }
        } else {
        const int xa = (fq * 16 + fr) << 2;
#pragma unroll
        for (int ai = 0; ai < 2; ++ai) {
            float rs4[4], rso[4]; EPI_RSTD4(ssq, ai, rs4); EPI_RS_ORIG(rs4, rso);
#pragma unroll
            for (int m = 0; m < 4; ++m) { const int r = EPI_ROWOF(ai, m); EPI_AB0(ai, m)
                const float rs = rso[m];
#pragma unroll
                for (int i = 0; i < 8; ++i) { a[i] *= rs * sc0; b[i] *= rs * sc1; }
                if (mode == 2) {
#pragma unroll
                    for (int i = 0; i < 8; ++i) { a[i] = a[i] * sigmoidf_(a[i]); b[i] = b[i] * sigmoidf_(b[i]); }
                } else if (mode == 3) {
#pragma unroll
                    for (int i = 0; i < 8; ++i) { a[i] = sigmoidf_(a[i]); b[i] = sigmoidf_(b[i]); }
                }
                st_bf16x8_x(O0 + (size_t)r * ld + off0 + fq * 8, a, xa); st_bf16x8_x(O1 + (size_t)r * ld + off1 + fq * 8, b, xa);
            }
            asm volatile("" ::: "memory");
        }
        }
    }
};
struct EpiKV {
    static constexpr bool PERM = true;
    const float* rstdm; bf16_t* km; bf16_t* vmt;
    __device__ __forceinline__ void operator()(AccRef acc, const pg8::Unit& u, int wr, int wc, int fr, int fq) const {
        const int c8 = wc * 32 + fq * 8, pn = u.pn;
        EPI_ROWS_BEGIN
            const float rs = rstdm[r];
#pragma unroll
            for (int i = 0; i < 8; ++i) { a[i] *= rs; b[i] *= rs; }
            if (pn < 4) { st_bf16x8(km + (size_t)r * 1024 + pn * 256 + c8, a); st_bf16x8(km + (size_t)r * 1024 + pn * 256 + 128 + c8, b); }
            else {
                const int pos = (r & ~31) + 8 * ((r >> 2) & 3) + 4 * ((r >> 4) & 1) + (r & 3);
                const int d0 = (pn - 4) * 256 + c8;
#pragma unroll
                for (int i = 0; i < 8; ++i) { vmt[(size_t)(d0 + i) * 256 + pos] = f2bf(a[i]); vmt[(size_t)(d0 + 128 + i) * 256 + pos] = f2bf(b[i]); }
            }
        EPI_ROWS_END
    }
};
struct EpiMerge {
    static constexpr bool PERM = true;
    const bf16_t* gates; bf16_t* merged;
    __device__ __forceinline__ void operator()(AccRef acc, const pg8::Unit& u, int wr, int wc, int fr, int fq) const {
        const int c = u.pn * 256 + wc * 32 + fq * 8, br = u.z;
#pragma unroll
        for (int ai = 0; ai < 2; ++ai) {
            u32x4 gw[4][2], mw[4][2];
#pragma unroll
            for (int m = 0; m < 4; ++m) { const int r = EPI_ROWOF(ai, m); const bf16_t* gp = gates + (size_t)r * 3072 + br * 1024 + c; gw[m][0] = *(const u32x4*)gp; gw[m][1] = *(const u32x4*)(gp + 128);
                if (br > 0) { const bf16_t* mp = merged + (size_t)r * 1024 + c; mw[m][0] = *(const u32x4*)mp; mw[m][1] = *(const u32x4*)(mp + 128); } }
#pragma unroll
            for (int m = 0; m < 4; ++m) { const int r = EPI_ROWOF(ai, m); EPI_AB(ai, m)
                const unsigned g0[4] = {gw[m][0].x, gw[m][0].y, gw[m][0].z, gw[m][0].w}, g1[4] = {gw[m][1].x, gw[m][1].y, gw[m][1].z, gw[m][1].w};
#pragma unroll
                for (int i = 0; i < 4; ++i) { a[2 * i] *= bflo(g0[i]); a[2 * i + 1] *= bfhi(g0[i]); b[2 * i] *= bflo(g1[i]); b[2 * i + 1] *= bfhi(g1[i]); }
                if (br > 0) { const unsigned m0[4] = {mw[m][0].x, mw[m][0].y, mw[m][0].z, mw[m][0].w}, m1[4] = {mw[m][1].x, mw[m][1].y, mw[m][1].z, mw[m][1].w};
#pragma unroll
                    for (int i = 0; i < 4; ++i) { a[2 * i] += bflo(m0[i]); a[2 * i + 1] += bfhi(m0[i]); b[2 * i] += bflo(m1[i]); b[2 * i + 1] += bfhi(m1[i]); } }
                bf16_t* mp = merged + (size_t)r * 1024 + c; st_bf16x8(mp, a); st_bf16x8(mp + 128, b); }
            asm volatile("" ::: "memory");
        }
    }
};
struct EpiRes {
    static constexpr bool PERM = true;
    float* x; bf16_t* xb; float* ssq;
    __device__ __forceinline__ void operator()(AccRef acc, const pg8::Unit& u, int wr, int wc, int fr, int fq) const {
        const int c8 = wc * 32 + fq * 8;
#pragma unroll
        for (int ai = 0; ai < 2; ++ai) {
            u32x4 xv[4][2];
#pragma unroll
            for (int m = 0; m < 4; ++m) { const bf16_t* xp = xb + (size_t)EPI_ROWOF(ai, m) * 1024 + u.pn * 256 + c8; xv[m][0] = *(const u32x4*)xp; xv[m][1] = *(const u32x4*)(xp + 128); }
#pragma unroll
            for (int m = 0; m < 4; ++m) { const int r = EPI_ROWOF(ai, m); EPI_AB(ai, m)
                a[0] += bflo(xv[m][0].x); a[1] += bfhi(xv[m][0].x); a[2] += bflo(xv[m][0].y); a[3] += bfhi(xv[m][0].y); a[4] += bflo(xv[m][0].z); a[5] += bfhi(xv[m][0].z); a[6] += bflo(xv[m][0].w); a[7] += bfhi(xv[m][0].w);
                b[0] += bflo(xv[m][1].x); b[1] += bfhi(xv[m][1].x); b[2] += bflo(xv[m][1].y); b[3] += bfhi(xv[m][1].y); b[4] += bflo(xv[m][1].z); b[5] += bfhi(xv[m][1].z); b[6] += bflo(xv[m][1].w); b[7] += bfhi(xv[m][1].w);
                if (x) { float* xp = x + (size_t)r * 1024 + u.pn * 256 + c8;
                    *(f32x4*)xp = (f32x4){a[0], a[1], a[2], a[3]}; *(f32x4*)(xp + 4) = (f32x4){a[4], a[5], a[6], a[7]};
                    *(f32x4*)(xp + 128) = (f32x4){b[0], b[1], b[2], b[3]}; *(f32x4*)(xp + 132) = (f32x4){b[4], b[5], b[6], b[7]}; }
                else { bf16_t* bp = xb + (size_t)r * 1024 + u.pn * 256 + c8; st_bf16x8(bp, a); st_bf16x8(bp + 128, b); }
                float sq = 0.f;
#pragma unroll
                for (int i = 0; i < 8; ++i) sq += a[i] * a[i] + b[i] * b[i];
                sq += shx(sq, 1, 4 * fr + fq); sq += shx(sq, 2, 4 * fr + fq);
                if (fq == 0) ssq[(size_t)r * 16 + u.pn * 4 + wc] = sq; }
            asm volatile("" ::: "memory");
        }
    }
};
struct EpiXq {
    static constexpr bool PERM = true;
    const float* ssq; bf16_t* xq;
    __device__ __forceinline__ void operator()(AccRef acc, const pg8::Unit& u, int wr, int wc, int fr, int fq) const {
        const int c8 = wc * 32 + fq * 8, xa = (fq * 16 + fr) << 2;
#pragma unroll
        for (int ai = 0; ai < 2; ++ai) {
            float rs4[4], rso[4]; EPI_RSTD4(ssq, ai, rs4); EPI_RS_ORIG(rs4, rso);
#pragma unroll
            for (int m = 0; m < 4; ++m) { const int r = EPI_ROWOF(ai, m); EPI_AB0(ai, m)
                const float rs = rso[m] * XQ_SCALE;
#pragma unroll
                for (int i = 0; i < 8; ++i) { a[i] *= rs; b[i] *= rs; }
                bf16_t* O = xq + (size_t)r * 1024 + u.pn * 256 + c8; st_bf16x8_x(O, a, xa); st_bf16x8_x(O + 128, b, xa); }
            asm volatile("" ::: "memory");
        }
    }
};
struct EpiFfnIn {
    static constexpr bool PERM = true;
    const float* ssq; bf16_t* hid;
    __device__ __forceinline__ void operator()(AccRef acc, const pg8::Unit& u, int wr, int wc, int fr, int fq) const {
        const int c8 = wc * 32 + fq * 8, xa = (fq * 16 + fr) << 2;
#pragma unroll
        for (int ai = 0; ai < 2; ++ai) {
            float rs4[4], rso[4]; EPI_RSTD4(ssq, ai, rs4); EPI_RS_ORIG(rs4, rso);
#pragma unroll
            for (int m = 0; m < 4; ++m) { const int r = EPI_ROWOF(ai, m); EPI_AB0(ai, m)
                const float rs = rso[m];
#pragma unroll
                for (int i = 0; i < 8; ++i) { const float g = a[i] * rs, up = b[i] * rs; a[i] = g * sigmoidf_(g) * up; }
                st_bf16x8_x(hid + (size_t)r * DFF + u.pn * 128 + c8, a, xa); }
            asm volatile("" ::: "memory");
        }
    }
};

__device__ __forceinline__ int nlog_win(int n) {
    const int t = n >> 8, p = n & 255;
    if (t < 3) return n;
    if (t == 3 || t == 4) { const int bj = p >> 7, hh = (p & 127) >> 5, dd = p & 31; return (t == 3 ? 768 : 1152) + 64 * hh + 32 * bj + dd; }
    if (t == 5) { const int bj = p >> 7, g = (p & 127) >> 5, dd = p & 31, j = 32 * bj + dd;
        if (g == 0) return 1024 + j; if (g == 1) return 1408 + j; if (g == 2) return 1088 + j;
        if (j < 4) return 1472 + j; if (j < 20) return 1988 + (j - 4); return -1; }
    if (t == 6) return (p < 128) ? 1476 + p : 1604 + (p - 128);
    if (t == 7) return 1732 + p;
    if (t == 8) return 2004 + p;
    return 2260 + (t - 9) * 256 + p;
}
__device__ __forceinline__ int nlog_ffn(int n) { const int j = n >> 8, p = n & 255; return (p >> 7) * DFF + 128 * j + (p & 127); }
struct ConvJob { const GAS float* W; const GAS float* gain; bf16_t* Bt; int ldw, K, map, kt, ns; };
__device__ __forceinline__ ConvJob conv_job(const Args& A, unsigned char* ws, int l, int t) {
    ConvJob j; int tt = t; j.gain = nullptr; j.map = 0;
    if (tt < 336) { j.W = ldarg(A, I_WIN) + (size_t)l * 1024 * INW; j.ldw = INW; j.K = 1024; j.map = 1; j.gain = ldarg(A, I_MIXG) + l * 1024; j.Bt = (bf16_t*)(ws + WS_WIN); j.kt = tt & 15; j.ns = tt >> 4; }
    else if ((tt -= 336) < 128) { j.W = ldarg(A, I_WXKV) + (size_t)l * 2097152; j.ldw = 2048; j.K = 1024; j.gain = ldarg(A, I_MG) + l * 1024; j.Bt = (bf16_t*)(ws + WS_WXKV); j.kt = tt & 15; j.ns = tt >> 4; }
    else if ((tt -= 128) < 48) { const int b = tt >> 4, q = tt & 15; const GAS float* w0 = ldarg(A, I_WBA); const GAS float* w1 = ldarg(A, I_WBB); const GAS float* w2 = ldarg(A, I_WBC); j.W = (b == 0 ? w0 : (b == 1 ? w1 : w2)) + (size_t)l * 256 * 1024; j.ldw = 1024; j.K = 256; j.Bt = (bf16_t*)(ws + WS_WBR) + (size_t)b * 262144; j.kt = q & 3; j.ns = q >> 2; }
    else if ((tt -= 48) < 64) { j.W = ldarg(A, I_WMIX) + (size_t)l * 1048576; j.ldw = 1024; j.K = 1024; j.Bt = (bf16_t*)(ws + WS_WMIX); j.kt = tt & 15; j.ns = tt >> 4; }
    else if ((tt -= 64) < 64) { j.W = ldarg(A, I_WXQ) + (size_t)l * 1048576; j.ldw = 1024; j.K = 1024; j.gain = ldarg(A, I_XG) + l * 1024; j.Bt = (bf16_t*)(ws + WS_WXQ); j.kt = tt & 15; j.ns = tt >> 4; }
    else if ((tt -= 64) < 64) { j.W = ldarg(A, I_WXO) + (size_t)l * 1048576; j.ldw = 1024; j.K = 1024; j.Bt = (bf16_t*)(ws + WS_WXO); j.kt = tt & 15; j.ns = tt >> 4; }
    else if ((tt -= 64) < 352) { j.W = ldarg(A, I_WFI) + (size_t)l * 1024 * NFF; j.ldw = NFF; j.K = 1024; j.map = 2; j.gain = ldarg(A, I_FG) + l * 1024; j.Bt = (bf16_t*)(ws + WS_WFI); j.kt = tt & 15; j.ns = tt >> 4; }
    else { tt -= 352; j.W = ldarg(A, I_WFO) + (size_t)l * DFF * 1024; j.ldw = 1024; j.K = DFF; j.Bt = (bf16_t*)(ws + WS_WFO); j.kt = tt % 44; j.ns = tt / 44; }
    return j;
}
#define CONV_LOAD(j_, v_, g_) do { const int nn_ = tid & 255, kq_ = tid >> 8, n_ = (j_).ns * 256 + nn_; const int nl_ = (j_).map == 0 ? n_ : ((j_).map == 1 ? nlog_win(n_) : nlog_ffn(n_)); \
        _Pragma("unroll") for (int i = 0; i < 32; ++i) { const int kk_ = (j_).kt * 64 + kq_ + 2 * i; v_[i] = nl_ >= 0 ? (j_).W[(size_t)kk_ * (j_).ldw + nl_] : 0.f; g_[i] = (j_).gain ? (j_).gain[kk_] : 1.0f; } } while (0)
#define CONV_WRITE(tile_, v_, g_) do { const int nn_ = tid & 255, kq_ = tid >> 8; _Pragma("unroll") for (int i = 0; i < 32; ++i) (tile_)[(kq_ + 2 * i) * 257 + nn_] = v_[i] * g_[i]; } while (0)
#define CONV_STORE(tile_, j_) do { const int nn_ = tid >> 1, kh_ = tid & 1; _Pragma("unroll") for (int jj = 0; jj < 4; ++jj) { float o_[8]; \
        _Pragma("unroll") for (int i = 0; i < 8; ++i) o_[i] = (tile_)[(32 * kh_ + 8 * jj + i) * 257 + nn_]; \
        st_bf16x8((j_).Bt + (size_t)((j_).ns * 256 + nn_) * (j_).K + (j_).kt * 64 + 32 * kh_ + 8 * jj, o_); } } while (0)
constexpr int CONV_EARLY = 704, CONV_ALL = 1232;
__device__ __forceinline__ void conv_range(LAS unsigned char* lds, const Args& A, int l, int first, int end, int widx, int nw) {
    unsigned char* ws = opq(A.ws);
    const int Gl = nw, tid = mytid(A.wave);
    LAS float* t0 = (LAS float*)lds; LAS float* t1 = (LAS float*)(lds + 65792);
    float va[32], ga[32], vb[32], gb[32];
    int t = first + widx; if (t >= end) return;
    ConvJob ja = conv_job(A, ws, l, t), jb = ja;
    CONV_LOAD(ja, va, ga);
    for (;;) {
        CONV_WRITE(t0, va, ga);
        const bool hb = t + Gl < end; if (hb) { jb = conv_job(A, ws, l, t + Gl); CONV_LOAD(jb, vb, gb); }
        __syncthreads();
        CONV_STORE(t0, ja);
        if (!hb) break;
        t += Gl;
        CONV_WRITE(t1, vb, gb);
        const bool ha = t + Gl < end; if (ha) { ja = conv_job(A, ws, l, t + Gl); CONV_LOAD(ja, va, ga); }
        __syncthreads();
        CONV_STORE(t1, jb);
        if (!ha) break;
        t += Gl;
    }
    __syncthreads();
}
#undef CONV_LOAD
#undef CONV_WRITE
#undef CONV_STORE

__constant__ float c_inv_freq[32] = {1.000000000e+00f, 7.498942018e-01f, 5.623413324e-01f, 4.216965139e-01f, 3.162277639e-01f, 2.371373922e-01f, 1.778279394e-01f, 1.333521456e-01f,
    1.000000015e-01f, 7.498941571e-02f, 5.623412877e-02f, 4.216964915e-02f, 3.162277862e-02f, 2.371373586e-02f, 1.778279431e-02f, 1.333521493e-02f,
    9.999999776e-03f, 7.498942316e-03f, 5.623413250e-03f, 4.216964822e-03f, 3.162277862e-03f, 2.371373819e-03f, 1.778279431e-03f, 1.333521446e-03f,
    1.000000047e-03f, 7.498941850e-04f, 5.623413017e-04f, 4.216965463e-04f, 3.162277862e-04f, 2.371373848e-04f, 1.778279402e-04f, 1.333521504e-04f};
__device__ __forceinline__ void prologue(LAS unsigned char* lds, const Args& A) {
    unsigned char* ws = opq(A.ws); const int tid = mytid(A.wave), lane = tid & 63, wave = tid >> 6; const int bid = obid(), Gl = ogrid();
    { const GAS float* x = ldarg(A, I_X); bf16_t* xb = (bf16_t*)(ws + WS_XB); float* ssq = (float*)(ws + WS_SSQ);
      for (int r = bid * 8 + wave; r < S_; r += Gl * 8) {
          const GAS float* xr = x + (size_t)r * 1024 + lane * 16; float v[16]; float sq = 0.f;
#pragma unroll
          for (int i = 0; i < 4; ++i) { const f32x4 q = *(const GAS f32x4*)(xr + 4 * i); v[4 * i] = q.x; v[4 * i + 1] = q.y; v[4 * i + 2] = q.z; v[4 * i + 3] = q.w; }
#pragma unroll
          for (int i = 0; i < 16; ++i) sq += v[i] * v[i];
          sq = wave_sum(sq, lane);
          float v0[8], v1[8];
#pragma unroll
          for (int i = 0; i < 8; ++i) { v0[i] = v[i]; v1[i] = v[8 + i]; }
          st_bf16x8(xb + (size_t)r * 1024 + lane * 16, v0); st_bf16x8(xb + (size_t)r * 1024 + lane * 16 + 8, v1);
          if (lane < 16) ssq[(size_t)r * 16 + lane] = lane == 0 ? sq : 0.f;
      } }
    { const GAS float* mem = ldarg(A, I_MEM); bf16_t* memb = (bf16_t*)(ws + WS_MEMB); float* rstdm = (float*)(ws + WS_RSTDM);
      for (int r = bid * 8 + wave; r < NMEM; r += Gl * 8) {
          const GAS float* xr = mem + (size_t)r * 1024 + lane * 16; float v0[8], v1[8]; float sq = 0.f;
#pragma unroll
          for (int i = 0; i < 8; ++i) { v0[i] = xr[i]; v1[i] = xr[8 + i]; sq += v0[i] * v0[i] + v1[i] * v1[i]; }
          sq = wave_sum(sq, lane);
          st_bf16x8(memb + (size_t)r * 1024 + lane * 16, v0); st_bf16x8(memb + (size_t)r * 1024 + lane * 16 + 8, v1);
          if (lane == 0) rstdm[r] = rsqrtf(sq * (1.0f / 1024.0f) + EPS);
      } }
    { float* cs = (float*)(ws + WS_CS);
      for (int i = bid * NTHREADS + tid; i < S_ * 32; i += Gl * NTHREADS) {
          const int pos = i >> 5, dd = i & 31; const float angf = (float)pos * c_inv_freq[dd]; const double a = (double)angf;
          const double kk = rint(a * 0.63661977236758134); double rr = fma(-kk, 1.5707963267948966, a); rr = fma(-kk, 6.123233995736766e-17, rr);
          const double r2 = rr * rr;
          const double sn = rr * (1.0 + r2 * (-1.0 / 6 + r2 * (1.0 / 120 + r2 * (-1.0 / 5040 + r2 * (1.0 / 362880 + r2 * (-1.0 / 39916800 + r2 * (1.0 / 6227020800.0)))))));
          const double cn = 1.0 + r2 * (-0.5 + r2 * (1.0 / 24 + r2 * (-1.0 / 720 + r2 * (1.0 / 40320 + r2 * (-1.0 / 3628800 + r2 * (1.0 / 479001600.0))))));
          const int q = ((int)kk) & 3; double c, s;
          if (q == 0) { c = cn; s = sn; } else if (q == 1) { c = -sn; s = cn; } else if (q == 2) { c = -cn; s = -sn; } else { c = sn; s = -cn; }
          cs[2 * i] = (float)c; cs[2 * i + 1] = (float)s;
      } }
}

__device__ __forceinline__ void sb_unit(LAS unsigned char* lds, const Args& A, int u) {
    unsigned char* ws = opq(A.ws); const int tid_l = mytid(A.wave); const int tid = tid_l, lane = tid & 63, wave = __builtin_amdgcn_readfirstlane(tid >> 6), fr = lane & 15, fq = lane >> 4;
    const bf16_t* Q = (const bf16_t*)(ws + WS_SBQ); const bf16_t* Kp = (const bf16_t*)(ws + WS_SBK); const bf16_t* Vp = (const bf16_t*)(ws + WS_SBV); bf16_t* O = (bf16_t*)(ws + WS_OA);
    LAS unsigned char* vst = lds + wave * 4608;
    const int vrow = 8 * ((lane >> 3) & 3) + 4 * ((lane >> 5) & 1) + ((lane >> 1) & 3), vhalf = lane & 1;
    const int h = wave & 3, qw = u * 128 + 64 * (wave >> 2);
    bf16x8 qf[4][2];
#pragma unroll
    for (int g = 0; g < 4; ++g)
#pragma unroll
        for (int s = 0; s < 2; ++s) qf[g][s] = *(const bf16x8*)(Q + (size_t)(qw + 16 * g + fr) * 256 + 64 * h + 32 * s + 8 * fq);
    f32x4 oacc[4][4];
#pragma unroll
    for (int g = 0; g < 4; ++g)
#pragma unroll
        for (int dg = 0; dg < 4; ++dg) oacc[g][dg] = (f32x4){0.f, 0.f, 0.f, 0.f};
    float runp[4] = {1.f, 1.f, 1.f, 1.f};
    const bool inc1 = (fq & 1) == 0, inc2 = (fq & 2) == 0, inc3 = (fq & 2) == 0;
    const int a1 = (lane ^ 16) << 2, a2 = (lane ^ 32) << 2, a3 = (lane ^ 48) << 2;
    bf16x8 nkf[2][2]; u32x4 nvr[4];
#define SB_LOAD(kb_) do { _Pragma("unroll") for (int a_ = 0; a_ < 2; ++a_) _Pragma("unroll") for (int s_ = 0; s_ < 2; ++s_) nkf[a_][s_] = *(const bf16x8*)(Kp + (size_t)((kb_) + 16 * a_ + fr) * 256 + 64 * h + 32 * s_ + 8 * fq); \
        _Pragma("unroll") for (int i_ = 0; i_ < 4; ++i_) nvr[i_] = *(const u32x4*)(Vp + (size_t)((kb_) + (lane >> 1)) * 256 + 64 * h + 32 * vhalf + 8 * i_); } while (0)
    SB_LOAD(qw + 32);
    for (int kb = qw + 32; kb >= 0; kb -= 32) {
        bf16x8 kf[2][2], vf[4];
#pragma unroll
        for (int a_ = 0; a_ < 2; ++a_)
#pragma unroll
            for (int s_ = 0; s_ < 2; ++s_) kf[a_][s_] = nkf[a_][s_];
#pragma unroll
        for (int i = 0; i < 4; ++i) *(LAS u32x4*)(vst + vrow * 144 + 64 * vhalf + 16 * i) = nvr[i];
        if (kb >= 32) SB_LOAD(kb - 32);
#pragma unroll
        for (int dg = 0; dg < 4; ++dg) { const s16x4 lo_ = __builtin_amdgcn_ds_read_tr16_b64_v4i16((LAS s16x4*)(vst + (8 * fq + (fr >> 2)) * 144 + 32 * dg + 8 * (fr & 3)));
            const s16x4 hi_ = __builtin_amdgcn_ds_read_tr16_b64_v4i16((LAS s16x4*)(vst + (8 * fq + 4 + (fr >> 2)) * 144 + 32 * dg + 8 * (fr & 3)));
            vf[dg] = __builtin_shufflevector(lo_, hi_, 0, 1, 2, 3, 4, 5, 6, 7); }
        bool alldone = true;
#pragma unroll
        for (int g = 0; g < 4; ++g) {
            const int qg = qw + 16 * g;
            if (kb >= qg + 15) { alldone = false; continue; }
            if (__all(runp[g] == 0.f)) continue;
            alldone = false;
            f32x4 sa[2];
#pragma unroll
            for (int a_ = 0; a_ < 2; ++a_) { sa[a_] = __builtin_amdgcn_mfma_f32_16x16x32_bf16(kf[a_][0], qf[g][0], (f32x4){0.f, 0.f, 0.f, 0.f}, 0, 0, 0); sa[a_] = __builtin_amdgcn_mfma_f32_16x16x32_bf16(kf[a_][1], qf[g][1], sa[a_], 0, 0, 0); }
            const bool diag = kb + 31 >= qg; const int t = qg + fr;
            float w[2][4];
#pragma unroll
            for (int ai = 1; ai >= 0; --ai) {
                float kp[4], bt[4];
#pragma unroll
                for (int r = 0; r < 4; ++r) { const float e = __builtin_amdgcn_exp2f(fminf(sa[ai][r], 120.0f)); kp[r] = __builtin_amdgcn_rcpf(1.0f + e); bt[r] = e * kp[r]; }
                if (diag) {
#pragma unroll
                    for (int r = 0; r < 4; ++r) { const bool valid = kb + 16 * ai + 4 * fq + r < t; kp[r] = valid ? kp[r] : 1.0f; bt[r] = valid ? bt[r] : 0.0f; } }
                const float pl = (kp[0] * kp[1]) * (kp[2] * kp[3]);
                const float x1 = __int_as_float(__builtin_amdgcn_ds_bpermute(a1, __float_as_int(pl))), x2 = __int_as_float(__builtin_amdgcn_ds_bpermute(a2, __float_as_int(pl))), x3 = __int_as_float(__builtin_amdgcn_ds_bpermute(a3, __float_as_int(pl)));
                float pref = runp[g] * (inc1 ? x1 : 1.0f) * (inc2 ? x2 : 1.0f) * (inc3 ? x3 : 1.0f);
                w[ai][3] = bt[3] * pref; pref *= kp[3]; w[ai][2] = bt[2] * pref; pref *= kp[2]; w[ai][1] = bt[1] * pref; pref *= kp[1]; w[ai][0] = bt[0] * pref;
                runp[g] *= (pl * x1) * (x2 * x3);
            }
            u32x4 pw; pw.x = cvt_pk_bf16(w[0][0], w[0][1]); pw.y = cvt_pk_bf16(w[0][2], w[0][3]); pw.z = cvt_pk_bf16(w[1][0], w[1][1]); pw.w = cvt_pk_bf16(w[1][2], w[1][3]);
            const bf16x8 pf = __builtin_bit_cast(bf16x8, pw);
#pragma unroll
            for (int dg = 0; dg < 4; ++dg) oacc[g][dg] = __builtin_amdgcn_mfma_f32_16x16x32_bf16(vf[dg], pf, oacc[g][dg], 0, 0, 0);
        }
        if (alldone) break;
    }
#undef SB_LOAD
#pragma unroll
    for (int g = 0; g < 4; ++g)
#pragma unroll
        for (int dg = 0; dg < 4; ++dg) { u32x2 w2; w2.x = cvt_pk_bf16(oacc[g][dg].x, oacc[g][dg].y); w2.y = cvt_pk_bf16(oacc[g][dg].z, oacc[g][dg].w);
            *(u32x2*)(O + (size_t)(qw + 16 * g + fr) * 256 + 64 * h + 16 * dg + 4 * fq) = w2; }
}

__device__ __forceinline__ void gla1_unit(LAS unsigned char* lds, const Args& A, int l, int c) {
    unsigned char* ws = opq(A.ws); const int tid_l = mytid(A.wave); const int tid = tid_l;
    const float* small = (const float*)(ws + WS_SMALL); const bf16_t* GK = (const bf16_t*)(ws + WS_GLK); const bf16_t* GV = (const bf16_t*)(ws + WS_GLV);
    float* BC = (float*)(ws + WS_BC); float* UC = (float*)(ws + WS_UC); float* AC = (float*)(ws + WS_AC);
    const GAS float* wup = ldarg(A, I_GUP) + l * 16 * 128; const GAS float* gb = ldarg(A, I_GB) + l * 128;
    LAS float* la = (LAS float*)lds;
    LAS float* kh = (LAS float*)(lds + 32768);
    LAS float* vv = (LAS float*)(lds + 65536);
    const int row0 = c * 64;
    float kLog2e = LOG2E, kLn2 = 0.6931471805599453f; asm volatile("" : "+v"(kLog2e), "+v"(kLn2));
    LAS float* wl = (LAS float*)(lds + 131072);
    for (int i = tid; i < 2048 + 128; i += NTHREADS) wl[i] = i < 2048 ? wup[i] : gb[i - 2048];
    __syncthreads();
    { const int t = tid >> 3, jg = tid & 7; float g[16];
#pragma unroll
      for (int i = 0; i < 4; ++i) { const f32x4 q = *(const f32x4*)(small + (size_t)(row0 + t) * 64 + 4 + 4 * i); g[4 * i] = q.x; g[4 * i + 1] = q.y; g[4 * i + 2] = q.z; g[4 * i + 3] = q.w; }
      for (int jj = 0; jj < 16; ++jj) { const int j = 16 * jg + jj; float x = wl[2048 + j];
#pragma unroll
          for (int r = 0; r < 16; ++r) x += g[r] * wl[r * 128 + j];
          const float ls = fminf(x, 0.f) - __builtin_amdgcn_logf(1.0f + __builtin_amdgcn_exp2f(-fabsf(x) * kLog2e)) * kLn2;
          la[t * 128 + j] = ls * (1.0f / 16.0f); } }
    for (int i = tid; i < 64 * 32; i += NTHREADS) { const int t = i >> 5, c8 = (i & 31) * 8; float v[8]; ld_bf16x8(GV + (size_t)(row0 + t) * 256 + c8, v);
#pragma unroll
        for (int j = 0; j < 8; ++j) vv[t * 256 + c8 + j] = v[j]; }
    __syncthreads();
    if (tid < 128) { float run = 0.f; for (int t = 0; t < 64; ++t) { run += la[t * 128 + tid]; la[t * 128 + tid] = run; BC[(size_t)(row0 + t) * 128 + tid] = run; } AC[c * 128 + tid] = __builtin_amdgcn_exp2f(run * kLog2e); }
    __syncthreads();
    for (int i = tid; i < 64 * 128; i += NTHREADS) { const int t = i >> 7, j = i & 127; kh[i] = bf2f(GK[(size_t)(row0 + t) * 128 + j]) * __builtin_amdgcn_exp2f((la[63 * 128 + j] - la[i]) * kLog2e); }
    __syncthreads();
    { const int hd = tid >> 2, eg = tid & 3, hh = hd >> 5; float a[16];
#pragma unroll
      for (int i = 0; i < 16; ++i) a[i] = 0.f;
      for (int t = 0; t < 64; ++t) { const float kk = kh[t * 128 + hd]; const LAS float* vp = vv + t * 256 + 64 * hh + 16 * eg;
#pragma unroll
          for (int i = 0; i < 16; ++i) a[i] += kk * vp[i]; }
      float* up = UC + (size_t)c * 8192 + hd * 64 + 16 * eg;
#pragma unroll
      for (int i = 0; i < 4; ++i) *(f32x4*)(up + 4 * i) = (f32x4){a[4 * i], a[4 * i + 1], a[4 * i + 2], a[4 * i + 3]}; }
    __syncthreads();
}
__device__ __forceinline__ void gla2_phase(LAS unsigned char* lds, const Args& A) {
    unsigned char* ws = opq(A.ws); const float* UC = (const float*)(ws + WS_UC); const float* AC = (const float*)(ws + WS_AC); float* ST = (float*)(ws + WS_ST);
    const int tid = mytid(A.wave), lane = tid & 63, seg = tid >> 6, bid = obid(); if (bid >= 128) return;
    const int gid = bid * 64 + lane, hd = bid;
    LAS float* Ls = (LAS float*)lds; LAS float* Ps = Ls + 512;
    float u[32], a[32];
#pragma unroll
    for (int i = 0; i < 32; ++i) { const int c = 32 * seg + i; u[i] = UC[(size_t)c * 8192 + gid]; a[i] = AC[c * 128 + hd]; }
    float L = 0.f, P = 1.f;
#pragma unroll
    for (int i = 0; i < 32; ++i) { L = a[i] * L + u[i]; P *= a[i]; }
    Ls[seg * 64 + lane] = L; Ps[seg * 64 + lane] = P;
    __syncthreads();
    float st = 0.f;
    for (int s2 = 0; s2 < seg; ++s2) st = Ps[s2 * 64 + lane] * st + Ls[s2 * 64 + lane];
#pragma unroll
    for (int i = 0; i < 32; ++i) { ST[(size_t)(32 * seg + i) * 8192 + gid] = st; st = a[i] * st + u[i]; }
}
__device__ __forceinline__ void glvt_slab(LAS unsigned char* lds, const Args& A, int sb) {
    unsigned char* ws = opq(A.ws); const int tid = mytid(A.wave); const bf16_t* GV = (const bf16_t*)(ws + WS_GLV); bf16_t* GVT = (bf16_t*)(ws + WS_GLVT);
    const int t0 = sb * 128;
#pragma unroll
    for (int i = 0; i < 8; ++i) { const int idx = tid + 512 * i, row = idx >> 5, c8 = (idx & 31) * 8; *(LAS u32x4*)(lds + row * 528 + c8 * 2) = *(const u32x4*)(GV + (size_t)(t0 + row) * 256 + c8); }
    __syncthreads();
#pragma unroll
    for (int i = 0; i < 8; ++i) { const int idx = tid + 512 * i, col = idx & 255, g = idx >> 8; float v[8];
#pragma unroll
        for (int k = 0; k < 8; ++k) { const int tok = 32 * (g >> 2) + 16 * (k >> 2) + 4 * (g & 3) + (k & 3); v[k] = bf2f(*(const LAS bf16_t*)(lds + tok * 528 + col * 2)); }
        st_bf16x8(GVT + (size_t)col * S_ + t0 + 8 * g, v); }
    __syncthreads();
}
__device__ __forceinline__ void gla3_unit(LAS unsigned char* lds, const Args& A, int l, int c) {
    unsigned char* ws = opq(A.ws); const int tid_l = mytid(A.wave); const int tid = tid_l, lane = tid & 63, wave = __builtin_amdgcn_readfirstlane(tid >> 6), fr = lane & 15, fq = lane >> 4;
    const bf16_t* GQ = (const bf16_t*)(ws + WS_GLQ); const bf16_t* GK = (const bf16_t*)(ws + WS_GLK); const bf16_t* GVT = (const bf16_t*)(ws + WS_GLVT); const bf16_t* GO = (const bf16_t*)(ws + WS_GLO);
    const float* BC = (const float*)(ws + WS_BC); const float* ST = (const float*)(ws + WS_ST) + (size_t)c * 8192; bf16_t* OC = (bf16_t*)(ws + WS_OC);
    const GAS float* gn = ldarg(A, I_GNG) + l * 64;
    LAS unsigned char* qb = lds;
    LAS unsigned char* kb = lds + 17408;
    LAS unsigned char* sb = lds + 34816;
    const int row0 = c * 64;
    float kLog2e = LOG2E; asm volatile("" : "+v"(kLog2e));
    for (int i = tid; i < 1024; i += NTHREADS) { const int t = i >> 4, j8 = (i & 15) * 8; float qv[8], kv[8];
        ld_bf16x8(GQ + (size_t)(row0 + t) * 128 + j8, qv); ld_bf16x8(GK + (size_t)(row0 + t) * 128 + j8, kv);
        const f32x4 b0 = *(const f32x4*)(BC + (size_t)(row0 + t) * 128 + j8), b1 = *(const f32x4*)(BC + (size_t)(row0 + t) * 128 + j8 + 4);
        const float bb[8] = {b0.x, b0.y, b0.z, b0.w, b1.x, b1.y, b1.z, b1.w};
#pragma unroll
        for (int k = 0; k < 8; ++k) { const float e = bb[k] * kLog2e; qv[k] *= __builtin_amdgcn_exp2f(e); kv[k] *= __builtin_amdgcn_exp2f(-e); }
        u32x4 wq4, wk4; wq4.x = cvt_pk_bf16(qv[0], qv[1]); wq4.y = cvt_pk_bf16(qv[2], qv[3]); wq4.z = cvt_pk_bf16(qv[4], qv[5]); wq4.w = cvt_pk_bf16(qv[6], qv[7]);
        wk4.x = cvt_pk_bf16(kv[0], kv[1]); wk4.y = cvt_pk_bf16(kv[2], kv[3]); wk4.z = cvt_pk_bf16(kv[4], kv[5]); wk4.w = cvt_pk_bf16(kv[6], kv[7]);
        *(LAS u32x4*)(qb + t * 272 + j8 * 2) = wq4; *(LAS u32x4*)(kb + t * 272 + j8 * 2) = wk4; }
    for (int i = tid; i < 2048; i += NTHREADS) { const int hd = i >> 4, e4 = (i & 15) * 4, hh = hd >> 5, d = hd & 31; const f32x4 v = *(const f32x4*)(ST + hd * 64 + e4);
        LAS bf16_t* p = (LAS bf16_t*)(sb + ((hh * 64 + e4) * 40 + d) * 2); p[0] = f2bf(v.x); p[40] = f2bf(v.y); p[80] = f2bf(v.z); p[120] = f2bf(v.w); }
    __syncthreads();
    const int h = wave & 3, th = wave >> 2;
#pragma unroll
    for (int tbl = 0; tbl < 2; ++tbl) { const int tb = 2 * th + tbl;
        const bf16x8 qf = *(const LAS bf16x8*)(qb + (16 * tb + fr) * 272 + (32 * h + 8 * fq) * 2);
        f32x4 sa[4];
#pragma unroll
        for (int jb = 0; jb < 4; ++jb) { sa[jb] = (f32x4){0.f, 0.f, 0.f, 0.f};
            if (jb <= tb) { const bf16x8 kf = *(const LAS bf16x8*)(kb + (16 * jb + fr) * 272 + (32 * h + 8 * fq) * 2); sa[jb] = __builtin_amdgcn_mfma_f32_16x16x32_bf16(kf, qf, sa[jb], 0, 0, 0); }
            if (jb == tb) {
#pragma unroll
                for (int r = 0; r < 4; ++r) if (4 * fq + r > fr) sa[jb][r] = 0.f; } }
        bf16x8 pf[2];
#pragma unroll
        for (int s2 = 0; s2 < 2; ++s2) { u32x4 w; w.x = cvt_pk_bf16(sa[2 * s2].x, sa[2 * s2].y); w.y = cvt_pk_bf16(sa[2 * s2].z, sa[2 * s2].w); w.z = cvt_pk_bf16(sa[2 * s2 + 1].x, sa[2 * s2 + 1].y); w.w = cvt_pk_bf16(sa[2 * s2 + 1].z, sa[2 * s2 + 1].w); pf[s2] = __builtin_bit_cast(bf16x8, w); }
        f32x4 oacc[4]; float sq = 0.f;
#pragma unroll
        for (int eb = 0; eb < 4; ++eb) {
            const bf16x8 sf = *(const LAS bf16x8*)(sb + ((h * 64 + 16 * eb + fr) * 40 + 8 * fq) * 2);
            f32x4 acc = __builtin_amdgcn_mfma_f32_16x16x32_bf16(sf, qf, (f32x4){0.f, 0.f, 0.f, 0.f}, 0, 0, 0);
            { const bf16x8 vf = *(const bf16x8*)(GVT + (size_t)(64 * h + 16 * eb + fr) * S_ + row0 + 8 * fq); acc = __builtin_amdgcn_mfma_f32_16x16x32_bf16(vf, pf[0], acc, 0, 0, 0); }
            if (tb >= 2) { const bf16x8 vf = *(const bf16x8*)(GVT + (size_t)(64 * h + 16 * eb + fr) * S_ + row0 + 32 + 8 * fq); acc = __builtin_amdgcn_mfma_f32_16x16x32_bf16(vf, pf[1], acc, 0, 0, 0); }
            oacc[eb] = acc; sq += (acc.x * acc.x + acc.y * acc.y) + (acc.z * acc.z + acc.w * acc.w); }
        sq += shx(sq, 16, lane); sq += shx(sq, 32, lane);
        const float rs = rsqrtf(sq * (1.0f / 64.0f) + EPS);
        const int t = row0 + 16 * tb + fr;
#pragma unroll
        for (int eb = 0; eb < 4; ++eb) { const int e0 = 16 * eb + 4 * fq; const f32x4 g4 = *(const GAS f32x4*)(gn + e0); const u32x2 gw = *(const u32x2*)(GO + (size_t)t * 256 + 64 * h + e0);
            u32x2 w2; w2.x = cvt_pk_bf16(oacc[eb].x * rs * g4.x * bflo(gw.x), oacc[eb].y * rs * g4.y * bfhi(gw.x)); w2.y = cvt_pk_bf16(oacc[eb].z * rs * g4.z * bflo(gw.y), oacc[eb].w * rs * g4.w * bfhi(gw.y));
            *(u32x2*)(OC + (size_t)t * 256 + 64 * h + e0) = w2; }
    }
    __syncthreads();
}

constexpr int DS_CAND = 384;
#ifdef FORCE_SLOW
constexpr int DS_TRIM = 12;
#else
constexpr int DS_TRIM = 256;
#endif
constexpr int DS_OFF_ZC = 65536;
constexpr int DS_OFF_CK = 65536;
constexpr int DS_OFF_CU = 90112;
constexpr int DS_OFF_SEL = 81920;
constexpr int DS_OFF_CTL = MISC_OFF + 128;
typedef short s16x2 __attribute__((ext_vector_type(2)));
typedef unsigned short u16x2 __attribute__((ext_vector_type(2)));
typedef __fp16 h16x2 __attribute__((ext_vector_type(2)));
__device__ __forceinline__ unsigned ds_bins2(float a, float b) {
    const s16x2 hs = __builtin_bit_cast(s16x2, __builtin_amdgcn_cvt_pkrtz(a, b)); const s16x2 sm = hs >> (s16x2){15, 15};
    const unsigned mono = __builtin_bit_cast(unsigned, hs) ^ (__builtin_bit_cast(unsigned, sm) | 0x80008000u);
    return __builtin_bit_cast(unsigned, __builtin_bit_cast(u16x2, mono) >> (u16x2){6, 6});
}
__device__ __forceinline__ float ds_h2f(unsigned hbits) { return (float)__builtin_bit_cast(__fp16, (unsigned short)hbits); }
__device__ __forceinline__ float ds_edge(int b) {
    if (b <= 0) return -INFINITY; if (b >= 1024) return INFINITY;
    if (b >= 512) return ds_h2f(((unsigned)b << 6) ^ 0x8000u);
    const float v = ds_h2f(~(((unsigned)b << 6) - 1u) & 0xffffu);
    return __uint_as_float(__float_as_uint(v) - 1u);
}
__device__ __forceinline__ void ds_compact(LAS unsigned char* lds, int qq, int need, int lane) {
    volatile LAS unsigned short* ck = (volatile LAS unsigned short*)(lds + DS_OFF_CK) + qq * DS_CAND; volatile LAS unsigned* cu = (volatile LAS unsigned*)(lds + DS_OFF_CU) + qq * DS_CAND;
    volatile LAS int* ctl = (volatile LAS int*)(lds + DS_OFF_CTL);
    const int n = ctl[32 + qq];
    if (n <= need) return;
    if (n <= 64) {
        const unsigned mu = lane < n ? cu[lane] : 0u, mk = lane < n ? (unsigned)ck[lane] : 0xffffffffu; int rank = 0;
        for (int j = 0; j < n; ++j) { const unsigned uj = (unsigned)__builtin_amdgcn_readlane((int)mu, j), kj = (unsigned)__builtin_amdgcn_readlane((int)mk, j); rank += (uj > mu || (uj == mu && kj < mk)) ? 1 : 0; }
        const bool keep = lane < n && rank < need; const unsigned long long mask = __ballot(keep); const int pos = __popcll(mask & ((1ull << lane) - 1ull));
        if (keep) { ck[pos] = (unsigned short)mk; cu[pos] = mu; if (rank == need - 1) { ctl[128 + qq] = (int)mu; ctl[160 + qq] = (int)mk; } }
        if (lane == 0) ctl[32 + qq] = need;
        return; }
    if (n <= 128) {
        const unsigned mu0 = cu[lane], mk0 = (unsigned)ck[lane]; const bool v1 = lane + 64 < n; const unsigned mu1 = v1 ? cu[lane + 64] : 0u, mk1 = v1 ? (unsigned)ck[lane + 64] : 0xffffffffu; int r0 = 0, r1 = 0;
        for (int j = 0; j < 64; ++j) { const unsigned uj = (unsigned)__builtin_amdgcn_readlane((int)mu0, j), kj = (unsigned)__builtin_amdgcn_readlane((int)mk0, j);
            r0 += (uj > mu0 || (uj == mu0 && kj < mk0)) ? 1 : 0; r1 += (uj > mu1 || (uj == mu1 && kj < mk1)) ? 1 : 0; }
        for (int j = 0; j < n - 64; ++j) { const unsigned uj = (unsigned)__builtin_amdgcn_readlane((int)mu1, j), kj = (unsigned)__builtin_amdgcn_readlane((int)mk1, j);
            r0 += (uj > mu0 || (uj == mu0 && kj < mk0)) ? 1 : 0; r1 += (uj > mu1 || (uj == mu1 && kj < mk1)) ? 1 : 0; }
        const bool k0 = r0 < need, k1 = v1 && r1 < need; const unsigned long long m0 = __ballot(k0), m1 = __ballot(k1); const unsigned long long below = (1ull << lane) - 1ull;
        const int p0 = __popcll(m0 & below), p1 = __popcll(m0) + __popcll(m1 & below);
        __builtin_amdgcn_s_waitcnt(0);
        if (k0) { ck[p0] = (unsigned short)mk0; cu[p0] = mu0; if (r0 == need - 1) { ctl[128 + qq] = (int)mu0; ctl[160 + qq] = (int)mk0; } }
        if (k1) { ck[p1] = (unsigned short)mk1; cu[p1] = mu1; if (r1 == need - 1) { ctl[128 + qq] = (int)mu1; ctl[160 + qq] = (int)mk1; } }
        if (lane == 0) ctl[32 + qq] = need;
        return; }
    unsigned mu[6], mk[6]; int rank[6];
#pragma unroll
    for (int ii = 0; ii < 6; ++ii) { const int i = lane + 64 * ii; mu[ii] = i < n ? cu[i] : 0u; mk[ii] = i < n ? (unsigned)ck[i] : 0xffffffffu; rank[ii] = 0; }
    const LAS unsigned short* ckn = (const LAS unsigned short*)(lds + DS_OFF_CK) + qq * DS_CAND; const LAS unsigned* cun = (const LAS unsigned*)(lds + DS_OFF_CU) + qq * DS_CAND;
#pragma unroll 4
    for (int j = 0; j < n; ++j) { const unsigned uj = cun[j], kj = ckn[j];
#pragma unroll
        for (int ii = 0; ii < 6; ++ii) rank[ii] += (uj > mu[ii] || (uj == mu[ii] && kj < mk[ii])) ? 1 : 0; }
    __builtin_amdgcn_s_waitcnt(0);
    int base = 0;
#pragma unroll
    for (int ii = 0; ii < 6; ++ii) { const int i = lane + 64 * ii; const bool keep = i < n && rank[ii] < need;
        const unsigned long long mask = __ballot(keep); const int pos = base + __popcll(mask & ((1ull << lane) - 1ull));
        if (keep) { ck[pos] = (unsigned short)mk[ii]; cu[pos] = mu[ii]; if (rank[ii] == need - 1) { ctl[128 + qq] = (int)mu[ii]; ctl[160 + qq] = (int)mk[ii]; } }
        base += __popcll(mask); }
    if (lane == 0) ctl[32 + qq] = need;
}
__device__ __forceinline__ void dsa_unit(LAS unsigned char* lds, const Args& A, int u) {
    unsigned char* ws = opq(A.ws); const int tid_l = mytid(A.wave); const int tid = tid_l, lane = tid & 63, wave = __builtin_amdgcn_readfirstlane(tid >> 6);
    const bf16_t* IQ = (const bf16_t*)(ws + WS_IXQ); const bf16_t* IK = (const bf16_t*)(ws + WS_IXK); const float* small = (const float*)(ws + WS_SMALL);
    const bf16_t* DQ = (const bf16_t*)(ws + WS_DSQ); const bf16_t* DK = (const bf16_t*)(ws + WS_DSK); const bf16_t* DV = (const bf16_t*)(ws + WS_DSV); bf16_t* OB = (bf16_t*)(ws + WS_OB);
    const int q0 = u * 32, N = ((q0 >> 6) + 1) * 64;
    volatile LAS unsigned* hist = (volatile LAS unsigned*)lds;
    volatile LAS unsigned short* sel = (volatile LAS unsigned short*)(lds + DS_OFF_SEL);
    volatile LAS unsigned short* ck = (volatile LAS unsigned short*)(lds + DS_OFF_CK); volatile LAS unsigned* cu = (volatile LAS unsigned*)(lds + DS_OFF_CU);
    volatile LAS int* ctl = (volatile LAS int*)(lds + DS_OFF_CTL);
    volatile LAS float* ctf = (volatile LAS float*)(lds + DS_OFF_CTL);
    const int fr = lane & 15, fq = lane >> 4;
    TICK(A, 0);
    if (N <= 256) {
        for (int i = tid; i < 32 * 256; i += NTHREADS) sel[i] = (unsigned short)(i & 255);
        __syncthreads();
    } else {
        volatile LAS unsigned* zc = (volatile LAS unsigned*)(lds + 131072);
        bf16x8 qf[2][4][2]; float wq[2][4];
#pragma unroll
        for (int g = 0; g < 2; ++g)
#pragma unroll
            for (int h = 0; h < 4; ++h) { wq[g][h] = small[(size_t)(q0 + 16 * g + fr) * 64 + h] * 0.5f;
#pragma unroll
                for (int s = 0; s < 2; ++s) qf[g][h][s] = *(const bf16x8*)(IQ + (size_t)(q0 + 16 * g + fr) * 256 + 64 * h + 32 * s + 8 * fq); }
        const int ntiles = (N + 127) >> 7;
        float pinf = INFINITY; asm volatile("" : "+v"(pinf));
#pragma unroll
        for (int g = 0; g < 2; ++g)
#pragma unroll
            for (int h = 0; h < 4; ++h) { asm volatile("" : "+v"(wq[g][h]));
#pragma unroll
                for (int s2 = 0; s2 < 2; ++s2) asm volatile("" : "+v"(qf[g][h][s2])); }
        const unsigned klane = (unsigned)fr * 128u + 16u * (unsigned)fq, kmaxoff = (unsigned)(N - 1) * 128u + 16u * (unsigned)fq;
#define DS_LOADK(kbase, d0, d1) do { const unsigned _o = min((unsigned)(kbase) * 128u + klane, kmaxoff); \
            asm volatile("global_load_dwordx4 %0, %2, %3\n\tglobal_load_dwordx4 %1, %2, %3 offset:64" : "+v"(d0), "+v"(d1) : "v"(_o), "s"(IK) : "memory"); } while (0)
#define DS_WAITK(d0, d1) asm volatile("s_waitcnt vmcnt(4)" : "+v"(d0), "+v"(d1) :: "memory")
#define DS_SCORES(kf0, kf1) f32x4 c4[2][4]; _Pragma("unroll") for (int g = 0; g < 2; ++g) _Pragma("unroll") for (int h = 0; h < 4; ++h) c4[g][h] = __builtin_amdgcn_mfma_f32_16x16x32_bf16(kf0, qf[g][h][0], (f32x4){0.f, 0.f, 0.f, 0.f}, 0, 0, 0); \
        _Pragma("unroll") for (int g = 0; g < 2; ++g) _Pragma("unroll") for (int h = 0; h < 4; ++h) c4[g][h] = __builtin_amdgcn_mfma_f32_16x16x32_bf16(kf1, qf[g][h][1], c4[g][h], 0, 0, 0); \
        float sc[2][4]; _Pragma("unroll") for (int g = 0; g < 2; ++g) _Pragma("unroll") for (int r = 0; r < 4; ++r) { float a_ = 0.f; _Pragma("unroll") for (int h = 0; h < 4; ++h) { a_ += wq[g][h] * __builtin_amdgcn_fmed3f(c4[g][h][r], 0.f, pinf); asm("" : "+v"(a_)); } sc[g][r] = a_; }
        for (int i = tid; i < 32 * 1024 + 32 * 32; i += NTHREADS) hist[i] = 0u;
        if (tid == 0) ctl[224] = 0;
        __syncthreads();
#define DS_P0_BODY(kf0, kf1, tile_) do { const int kb = (tile_) * 128 + 16 * wave; DS_WAITK(kf0, kf1); if (kb < N) { DS_SCORES(kf0, kf1) \
            _Pragma("unroll") for (int g = 0; g < 2; ++g) { LAS unsigned* hq = (LAS unsigned*)lds + (16 * g + fr) * 1024; \
                const unsigned p01 = ds_bins2(sc[g][0], sc[g][1]), p23 = ds_bins2(sc[g][2], sc[g][3]); \
                __hip_atomic_fetch_add(hq + (p01 & 0xffffu), 1u, __ATOMIC_RELAXED, __HIP_MEMORY_SCOPE_WORKGROUP); __hip_atomic_fetch_add(hq + (p01 >> 16), 1u, __ATOMIC_RELAXED, __HIP_MEMORY_SCOPE_WORKGROUP); \
                __hip_atomic_fetch_add(hq + (p23 & 0xffffu), 1u, __ATOMIC_RELAXED, __HIP_MEMORY_SCOPE_WORKGROUP); __hip_atomic_fetch_add(hq + (p23 >> 16), 1u, __ATOMIC_RELAXED, __HIP_MEMORY_SCOPE_WORKGROUP); \
                const unsigned nz = 4u - ((min(__float_as_uint(sc[g][0]), 1u) + min(__float_as_uint(sc[g][1]), 1u)) + (min(__float_as_uint(sc[g][2]), 1u) + min(__float_as_uint(sc[g][3]), 1u)));        \
                nzacc[g] |= nz << (8 * ((tile_) & 3)); } } \
            if (((tile_) & 3) == 3) { _Pragma("unroll") for (int g = 0; g < 2; ++g) { if (nzacc[g]) __hip_atomic_fetch_add((LAS unsigned*)&zc[(16 * g + fr) * 32 + ((tile_) >> 2)], nzacc[g], __ATOMIC_RELAXED, __HIP_MEMORY_SCOPE_WORKGROUP); nzacc[g] = 0u; } }        \
            DS_LOADK(kb + 384, kf0, kf1); } while (0)
        { bf16x8 ka0 = qf[0][0][0], ka1 = ka0, kb0 = ka0, kb1 = ka0, kc0 = ka0, kc1 = ka0; unsigned nzacc[2] = {0u, 0u}; int tile = 0;
          DS_LOADK(16 * wave, ka0, ka1); DS_LOADK(128 + 16 * wave, kb0, kb1); DS_LOADK(256 + 16 * wave, kc0, kc1);
          for (; tile < ntiles; tile += 3) {
              DS_P0_BODY(ka0, ka1, tile); DS_P0_BODY(kb0, kb1, tile + 1); DS_P0_BODY(kc0, kc1, tile + 2);
          }
#pragma unroll
          for (int g = 0; g < 2; ++g) if (nzacc[g]) __hip_atomic_fetch_add((LAS unsigned*)&zc[(16 * g + fr) * 32 + ((tile - 1) >> 2)], nzacc[g], __ATOMIC_RELAXED, __HIP_MEMORY_SCOPE_WORKGROUP);
          asm volatile("s_waitcnt vmcnt(0)" : "+v"(ka0), "+v"(ka1), "+v"(kb0), "+v"(kb1), "+v"(kc0), "+v"(kc1) :: "memory"); }
#undef DS_P0_BODY
        __syncthreads();
        TICK(A, 1);
        unsigned cntq[4][16], Tq[4];
        { const LAS unsigned* histn = (const LAS unsigned*)lds;
#pragma unroll
          for (int k = 0; k < 4; ++k) { unsigned s = 0;
#pragma unroll
              for (int i = 0; i < 16; ++i) { cntq[k][i] = histn[(4 * wave + k) * 1024 + 16 * lane + i]; s += cntq[k][i]; }
              Tq[k] = s; }
#pragma unroll
          for (int off = 1; off < 64; off <<= 1) {
#pragma unroll
              for (int k = 0; k < 4; ++k) { const unsigned v = shdn(Tq[k], off, lane); if (lane + off < 64) Tq[k] += v; } } }
#pragma unroll
        for (int k = 0; k < 4; ++k) { const int qq = 4 * wave + k; const unsigned (&cnt)[16] = cntq[k]; const unsigned T = Tq[k];
            const unsigned long long mask = __ballot(T >= 256u); const int L = 63 - __builtin_clzll(mask);
            const unsigned Tn = shdn(T, 1, lane); const unsigned above = lane == 63 ? 0u : Tn;
            int b1 = 0, G1 = 0; unsigned C1 = 0;
            { unsigned cum = above; bool found = false;
#pragma unroll
              for (int b = 15; b >= 0; --b) { if (!found && cum + cnt[b] >= 256u) { b1 = 16 * lane + b; G1 = (int)cum; C1 = cnt[b]; found = true; } if (!found) cum += cnt[b]; } }
            b1 = __builtin_amdgcn_readlane(b1, L); G1 = __builtin_amdgcn_readlane(G1, L); C1 = (unsigned)__builtin_amdgcn_readlane((int)C1, L);
            int need = 256 - G1, tl = -1;
            if (b1 == 512) {
                const LAS unsigned* zcn = (const LAS unsigned*)(lds + 131072);
                const unsigned w0 = zcn[qq * 32 + (lane >> 2)], w1 = zcn[qq * 32 + 16 + (lane >> 2)];
                const unsigned z0 = lane < ntiles ? (w0 >> (8 * (lane & 3))) & 0xffu : 0u, z1 = lane + 64 < ntiles ? (w1 >> (8 * (lane & 3))) & 0xffu : 0u;
                unsigned p0 = z0, p1 = z1;
#pragma unroll
                for (int off = 1; off < 64; off <<= 1) { const unsigned v0 = (unsigned)__builtin_amdgcn_ds_bpermute((lane - off) << 2, (int)p0), v1 = (unsigned)__builtin_amdgcn_ds_bpermute((lane - off) << 2, (int)p1); if (lane >= off) { p0 += v0; p1 += v1; } }
                const unsigned tot0 = (unsigned)__builtin_amdgcn_readlane((int)p0, 63), tot1 = (unsigned)__builtin_amdgcn_readlane((int)p1, 63);
                if (tot0 + tot1 == C1) {
                    p1 += tot0;
                    const unsigned long long m0 = __ballot(p0 >= (unsigned)need), m1 = __ballot(p1 >= (unsigned)need);
                    unsigned cz;
                    if (m0) { tl = __builtin_ctzll(m0); cz = (unsigned)__builtin_amdgcn_readlane((int)(p0 - z0), tl); }
                    else { const int t1 = __builtin_ctzll(m1); tl = 64 + t1; cz = (unsigned)__builtin_amdgcn_readlane((int)(p1 - z1), t1); }
                    need -= (int)cz; } }
            if (lane == 0) {
#ifdef FORCE_SLOW
                if (tl < 0) ctl[224] = 1;
#else
                if (tl < 0 && C1 > (unsigned)DS_CAND) ctl[224] = 1;
#endif
                ctl[64 + qq] = b1; ctl[96 + qq] = need; ctl[192 + qq] = tl; ctf[225 + qq] = ds_edge(b1); ctf[257 + qq] = ds_edge(b1 + 1); }
        }
        __syncthreads();
        TICK(A, 2);
        for (int i = tid; i < 32 * 512; i += NTHREADS) hist[i] = 0u;
        if (tid < 32) { ctl[32 + tid] = 0; ctl[128 + tid] = 0; ctl[160 + tid] = -1; }
        __syncthreads();
        { float flo[2], fhi[2]; int tlo[2];
#pragma unroll
          for (int g = 0; g < 2; ++g) { flo[g] = ctf[225 + 16 * g + fr]; fhi[g] = ctf[257 + 16 * g + fr]; tlo[g] = ctl[192 + 16 * g + fr]; flo[g] = tlo[g] < 0 ? flo[g] : fhi[g]; }
          const bool slow = ctl[224] != 0;
#define DS_P1_BODY(kf0, kf1, tile_) do { const int kb = (tile_) * 128 + 16 * wave; DS_WAITK(kf0, kf1); if (kb < N) { DS_SCORES(kf0, kf1) \
            unsigned accD = 0u, accC = 0u;        \
            _Pragma("unroll") for (int g = 1; g >= 0; --g) { \
                const float tD = (tile_) < tlo[g] ? 0.0f : fhi[g], tC = (tile_) <= tlo[g] ? 0.0f : flo[g];        \
                _Pragma("unroll") for (int r = 3; r >= 0; --r) { accD = __builtin_amdgcn_alignbit(accD, __float_as_uint(sc[g][r] - tD), 31u); accC = __builtin_amdgcn_alignbit(accC, __float_as_uint(sc[g][r] - tC), 31u); } } \
            unsigned cbits = accD & ~accC; \
            _Pragma("unroll") for (int g = 0; g < 2; ++g) { const int qq = 16 * g + fr; \
                const unsigned nib = (~accD >> (4 * g)) & 15u; \
                __hip_atomic_fetch_or((LAS unsigned*)&hist[qq * 512 + (((kb >> 5) + qq) & 511)], nib << ((kb & 31) + 4 * fq), __ATOMIC_RELAXED, __HIP_MEMORY_SCOPE_WORKGROUP); } \
            while (__ballot(cbits != 0u)) {         \
                if (cbits) { const int ix = __builtin_ctz(cbits); cbits &= cbits - 1u; const int g = ix >> 2, r = ix & 3; \
                    float sv = sc[0][0]; sv = ix == 1 ? sc[0][1] : sv; sv = ix == 2 ? sc[0][2] : sv; sv = ix == 3 ? sc[0][3] : sv; sv = ix == 4 ? sc[1][0] : sv; sv = ix == 5 ? sc[1][1] : sv; sv = ix == 6 ? sc[1][2] : sv; sv = ix == 7 ? sc[1][3] : sv; \
                    const int qq = 16 * g + fr, key = kb + 4 * fq + r; \
                    const unsigned ub = __float_as_uint(sv), mono = ub ^ ((unsigned)((int)ub >> 31) | 0x80000000u); \
                    bool ok = true; if (slow) { const unsigned tu = (unsigned)ctl[128 + qq], tk = (unsigned)ctl[160 + qq]; ok = mono > tu || (mono == tu && (unsigned)key < tk); } \
                    if (ok) { const int slot = __hip_atomic_fetch_add((LAS int*)&ctl[32 + qq], 1, __ATOMIC_RELAXED, __HIP_MEMORY_SCOPE_WORKGROUP); ck[qq * DS_CAND + slot] = (unsigned short)key; cu[qq * DS_CAND + slot] = mono; } } } } \
            DS_LOADK(kb + 384, kf0, kf1); \
            if (slow) { __syncthreads();         \
                for (int k = 0; k < 4; ++k) { const int qq = 4 * wave + k; if (ctl[32 + qq] > DS_TRIM) ds_compact(lds, qq, ctl[96 + qq], lane); } \
                __syncthreads(); } } while (0)
          bf16x8 ka0 = qf[0][0][0], ka1 = ka0, kb0 = ka0, kb1 = ka0, kc0 = ka0, kc1 = ka0;
          DS_LOADK(16 * wave, ka0, ka1); DS_LOADK(128 + 16 * wave, kb0, kb1); DS_LOADK(256 + 16 * wave, kc0, kc1);
          for (int tile = 0; tile < ntiles; tile += 3) {
              DS_P1_BODY(ka0, ka1, tile); DS_P1_BODY(kb0, kb1, tile + 1); DS_P1_BODY(kc0, kc1, tile + 2);
          }
          asm volatile("s_waitcnt vmcnt(0)" : "+v"(ka0), "+v"(ka1), "+v"(kb0), "+v"(kb1), "+v"(kc0), "+v"(kc1) :: "memory"); }
#undef DS_P1_BODY
        __syncthreads();
#undef DS_LOADK
#undef DS_WAITK
#undef DS_SCORES
        TICK(A, 3);
        for (int k = 0; k < 4; ++k) { const int qq = 4 * wave + k; const int need = ctl[96 + qq]; ds_compact(lds, qq, need, lane);
            __builtin_amdgcn_s_waitcnt(0);
            for (int i = lane; i < need; i += 64) { const int key = ck[qq * DS_CAND + i]; __hip_atomic_fetch_or((LAS unsigned*)&hist[qq * 512 + (((key >> 5) + qq) & 511)], 1u << (key & 31), __ATOMIC_RELAXED, __HIP_MEMORY_SCOPE_WORKGROUP); } }
        __syncthreads();
        { const LAS unsigned* histn = (const LAS unsigned*)lds;
          LAS unsigned short* offs = (LAS unsigned short*)(lds + 98304 + wave * 4096);
          unsigned wd[4][8], c8[4], incl[4];
#pragma unroll
          for (int k = 0; k < 4; ++k) { const int qq = 4 * wave + k; c8[k] = 0;
#pragma unroll
              for (int i = 0; i < 8; ++i) { wd[k][i] = histn[qq * 512 + ((8 * lane + i + qq) & 511)]; c8[k] += __popc(wd[k][i]); }
              incl[k] = c8[k]; }
#pragma unroll
          for (int off = 1; off < 64; off <<= 1) {
#pragma unroll
              for (int k = 0; k < 4; ++k) { const unsigned v = (unsigned)__builtin_amdgcn_ds_bpermute((lane - off) << 2, (int)incl[k]); if (lane >= off) incl[k] += v; } }
#pragma unroll
          for (int k = 0; k < 4; ++k) { unsigned pos = incl[k] - c8[k];
#pragma unroll
              for (int i = 0; i < 8; ++i) { offs[k * 512 + 8 * lane + i] = (unsigned short)pos; pos += __popc(wd[k][i]); } }
#pragma unroll 1
          for (int k = 0; k < 4; ++k) { const int qq = 4 * wave + k; unsigned bw[8], pw[8];
#pragma unroll
              for (int i = 0; i < 8; ++i) { const int w = 64 * i + lane; bw[i] = histn[qq * 512 + ((w + qq) & 511)]; pw[i] = offs[k * 512 + w]; }
#pragma unroll
              for (int i = 0; i < 8; ++i) { const int w = 64 * i + lane; unsigned bits = bw[i], p = pw[i];
                  while (bits) { const int bpos = __builtin_ctz(bits); bits &= bits - 1u; if (p < 256u) sel[qq * 256 + p] = (unsigned short)(w * 32 + bpos); ++p; } } }
          __builtin_amdgcn_s_waitcnt(0); }
        __syncthreads();
    }
    TICK(A, 4);
    const int nsel = N < 256 ? N : 256;
    LAS unsigned char* vst = lds + wave * 9216;
#define AT_SELQ(qq_) ((const LAS unsigned short*)(lds + DS_OFF_SEL) + (qq_) * 256)
#define AT_ISSUE_K(buf, sq_, b_) do { _Pragma("unroll") for (int i8 = 0; i8 < 8; ++i8) { const int key_ = (sq_)[64 * (b_) + 8 * i8 + (lane >> 3)]; buf[i8] = *(const u32x4*)(DK + (size_t)key_ * 64 + 8 * (lane & 7)); } } while (0)
#define AT_ISSUE_V(buf, sq_, c_) do { _Pragma("unroll") for (int i8 = 0; i8 < 8; ++i8) { const int key_ = (sq_)[64 * (c_) + 8 * i8 + (lane >> 3)]; buf[i8] = *(const u32x4*)(DV + (size_t)key_ * 64 + 8 * (lane & 7)); } } while (0)
#define AT_QK(buf, b_) do { _Pragma("unroll") for (int i8 = 0; i8 < 8; ++i8) *(LAS u32x4*)(vst + (8 * i8 + (lane >> 3)) * 144 + 16 * (lane & 7)) = buf[i8]; \
        _Pragma("unroll") for (int g4 = 0; g4 < 4; ++g4) { const f32x4 c4_ = __builtin_amdgcn_mfma_f32_16x16x32_bf16(*(const LAS bf16x8*)(vst + (16 * g4 + fr) * 144 + 16 * fq), qf[0], (f32x4){0.f, 0.f, 0.f, 0.f}, 0, 0, 0); \
        sacc[4 * (b_) + g4] = __builtin_amdgcn_mfma_f32_16x16x32_bf16(*(const LAS bf16x8*)(vst + (16 * g4 + fr) * 144 + 64 + 16 * fq), qf[1], c4_, 0, 0, 0); } } while (0)
#define AT_PV(buf, c_) do { _Pragma("unroll") for (int i8 = 0; i8 < 8; ++i8) { const int row_ = 32 * (i8 >> 2) + 16 * (i8 & 1) + 4 * ((i8 >> 1) & 1) + 8 * (lane >> 5) + ((lane >> 3) & 3); \
            *(LAS u32x4*)(vst + row_ * 144 + 16 * (lane & 7)) = buf[i8]; } \
        _Pragma("unroll") for (int s2 = 0; s2 < 2; ++s2) _Pragma("unroll") for (int dg = 0; dg < 4; ++dg) { \
            const s16x4 lo_ = __builtin_amdgcn_ds_read_tr16_b64_v4i16((LAS s16x4*)(vst + (32 * s2 + 8 * fq + (fr >> 2)) * 144 + 32 * dg + 8 * (fr & 3))); \
            const s16x4 hi_ = __builtin_amdgcn_ds_read_tr16_b64_v4i16((LAS s16x4*)(vst + (32 * s2 + 8 * fq + 4 + (fr >> 2)) * 144 + 32 * dg + 8 * (fr & 3))); \
            const bf16x8 vf_ = __builtin_shufflevector(lo_, hi_, 0, 1, 2, 3, 4, 5, 6, 7); \
            oacc[dg] = __builtin_amdgcn_mfma_f32_16x16x32_bf16(vf_, pf[2 * (c_) + s2], oacc[dg], 0, 0, 0); } } while (0)
    u32x4 B0[8], B1[8], B2[8]; bf16x8 qf[2];
    { const int t0 = q0 + 4 * wave;
#pragma unroll
      for (int s2 = 0; s2 < 2; ++s2) qf[s2] = *(const bf16x8*)(DQ + (size_t)t0 * 256 + 64 * (fr & 3) + 32 * s2 + 8 * fq);
      AT_ISSUE_K(B0, AT_SELQ(4 * wave), 0); AT_ISSUE_K(B1, AT_SELQ(4 * wave), 1); }
#define AT_QUERY(k_, X, Y, Z) do { const int qq = 4 * wave + (k_), t = q0 + qq; const LAS unsigned short* selq = AT_SELQ(qq); f32x4 sacc[16]; \
        AT_ISSUE_K(Z, selq, 2); AT_QK(X, 0); \
        AT_ISSUE_K(X, selq, 3); AT_QK(Y, 1); \
        AT_ISSUE_V(Y, selq, 0); AT_QK(Z, 2); \
        AT_ISSUE_V(Z, selq, 1); AT_QK(X, 3); \
        if ((k_) < 3) { _Pragma("unroll") for (int s2 = 0; s2 < 2; ++s2) qf[s2] = *(const bf16x8*)(DQ + (size_t)(t + 1) * 256 + 64 * (fr & 3) + 32 * s2 + 8 * fq); } \
        if (nsel < 256) { _Pragma("unroll") for (int g = 0; g < 16; ++g) _Pragma("unroll") for (int r = 0; r < 4; ++r) if (16 * g + 4 * fq + r >= nsel) sacc[g][r] = -INFINITY; } \
        float mx = -INFINITY; \
        _Pragma("unroll") for (int g = 0; g < 16; ++g) mx = fmaxf(mx, fmaxf(fmaxf(sacc[g].x, sacc[g].y), fmaxf(sacc[g].z, sacc[g].w))); \
        mx = fmaxf(mx, shx(mx, 16, lane)); mx = fmaxf(mx, shx(mx, 32, lane)); \
        float sm = 0.f; \
        _Pragma("unroll") for (int g = 0; g < 16; ++g) { sacc[g].x = __builtin_amdgcn_exp2f(sacc[g].x - mx); sacc[g].y = __builtin_amdgcn_exp2f(sacc[g].y - mx); sacc[g].z = __builtin_amdgcn_exp2f(sacc[g].z - mx); sacc[g].w = __builtin_amdgcn_exp2f(sacc[g].w - mx); \
            sm += (sacc[g].x + sacc[g].y) + (sacc[g].z + sacc[g].w); } \
        sm += shx(sm, 16, lane); sm += shx(sm, 32, lane); \
        const float inv = 1.0f / sm; \
        bf16x8 pf[8]; \
        _Pragma("unroll") for (int s2 = 0; s2 < 8; ++s2) { u32x4 w; w.x = cvt_pk_bf16(sacc[2 * s2].x * inv, sacc[2 * s2].y * inv); w.y = cvt_pk_bf16(sacc[2 * s2].z * inv, sacc[2 * s2].w * inv); \
            w.z = cvt_pk_bf16(sacc[2 * s2 + 1].x * inv, sacc[2 * s2 + 1].y * inv); w.w = cvt_pk_bf16(sacc[2 * s2 + 1].z * inv, sacc[2 * s2 + 1].w * inv); pf[s2] = __builtin_bit_cast(bf16x8, w); } \
        f32x4 oacc[4]; \
        _Pragma("unroll") for (int dg = 0; dg < 4; ++dg) oacc[dg] = (f32x4){0.f, 0.f, 0.f, 0.f}; \
        AT_ISSUE_V(X, selq, 2); AT_PV(Y, 0); \
        AT_ISSUE_V(Y, selq, 3); AT_PV(Z, 1); \
        if ((k_) < 3) AT_ISSUE_K(Z, AT_SELQ(qq + 1), 0); \
        AT_PV(X, 2); \
        if ((k_) < 3) AT_ISSUE_K(X, AT_SELQ(qq + 1), 1); \
        AT_PV(Y, 3); \
        if (fr < 4) { _Pragma("unroll") for (int dg = 0; dg < 4; ++dg) { u32x2 w2; w2.x = cvt_pk_bf16(oacc[dg].x, oacc[dg].y); w2.y = cvt_pk_bf16(oacc[dg].z, oacc[dg].w); \
                *(u32x2*)(OB + (size_t)t * 256 + 64 * fr + 16 * dg + 4 * fq) = w2; } } } while (0)
    AT_QUERY(0, B0, B1, B2); AT_QUERY(1, B2, B0, B1); AT_QUERY(2, B1, B2, B0); AT_QUERY(3, B0, B1, B2);
#undef AT_QUERY
#undef AT_SELQ
#undef AT_ISSUE_K
#undef AT_ISSUE_V
#undef AT_QK
#undef AT_PV
    __syncthreads();
    TICK(A, 5);
#if DBG_MODE == 1
    { unsigned short* ds = (unsigned short*)(opq(A.ws) + WS_DBGSEL) + (size_t)u * 8192; for (int i = mytid(A.wave); i < 32 * 256; i += NTHREADS) ds[i] = sel[i]; }
    __syncthreads();
#endif
}

__device__ __forceinline__ void xattn_phase(LAS unsigned char* lds, const Args& A, const pg8::StaticOrder& S) {
    unsigned char* ws = opq(A.ws); const int tid_l = mytid(A.wave); const int tid = tid_l, lane = tid & 63, wave = __builtin_amdgcn_readfirstlane(tid >> 6), fr = lane & 15, fq = lane >> 4;
    const bf16_t* XQ = (const bf16_t*)(ws + WS_XQ); const bf16_t* KM = (const bf16_t*)(ws + WS_KM); const bf16_t* VMT = (const bf16_t*)(ws + WS_VMT); bf16_t* AO = (bf16_t*)(ws + WS_AO);
    for (int ui = 0;; ++ui) { pg8::Unit un; if (!S.next(ui, un)) break;
        const int hh = __builtin_amdgcn_readfirstlane(un.pn), rb = __builtin_amdgcn_readfirstlane(un.pm);
        __syncthreads();
#pragma unroll
        for (int b8 = 0; b8 < 2; ++b8) { u32x4 t8[8];
#pragma unroll
            for (int i = 0; i < 8; ++i) { const int idx = tid + 512 * (8 * b8 + i); t8[i] = *(const u32x4*)(KM + (size_t)(idx >> 5) * 1024 + 256 * hh + 8 * (idx & 31)); }
#pragma unroll
            for (int i = 0; i < 8; ++i) { const int idx = tid + 512 * (8 * b8 + i); *(LAS u32x4*)(lds + (idx >> 5) * 528 + 16 * (idx & 31)) = t8[i]; } }
        __syncthreads();
        bf16x8 pf[2][8];
        { bf16x8 qf[2][8]; f32x4 sacc[2][16];
#pragma unroll
          for (int j = 0; j < 2; ++j) { const int row = rb * 256 + 128 * j + 16 * wave + fr;
#pragma unroll
              for (int s2 = 0; s2 < 8; ++s2) qf[j][s2] = *(const bf16x8*)(XQ + (size_t)row * 1024 + 256 * hh + 32 * s2 + 8 * fq); }
#pragma unroll
          for (int g = 0; g < 16; ++g) { f32x4 c0 = (f32x4){0.f, 0.f, 0.f, 0.f}, c1 = c0;
#pragma unroll
              for (int s2 = 0; s2 < 8; ++s2) { const bf16x8 kf = *(const LAS bf16x8*)(lds + (16 * g + fr) * 528 + (32 * s2 + 8 * fq) * 2);
                  c0 = __builtin_amdgcn_mfma_f32_16x16x32_bf16(kf, qf[0][s2], c0, 0, 0, 0); c1 = __builtin_amdgcn_mfma_f32_16x16x32_bf16(kf, qf[1][s2], c1, 0, 0, 0); }
              sacc[0][g] = c0; sacc[1][g] = c1; asm volatile("" ::: "memory"); }
#pragma unroll
          for (int j = 0; j < 2; ++j) {
            float mx = -INFINITY;
#pragma unroll
            for (int g = 0; g < 16; ++g) mx = fmaxf(mx, fmaxf(fmaxf(sacc[j][g].x, sacc[j][g].y), fmaxf(sacc[j][g].z, sacc[j][g].w)));
            mx = fmaxf(mx, shx(mx, 16, lane)); mx = fmaxf(mx, shx(mx, 32, lane));
            float sm = 0.f;
#pragma unroll
            for (int g = 0; g < 16; ++g) { sacc[j][g].x = __builtin_amdgcn_exp2f(sacc[j][g].x - mx); sacc[j][g].y = __builtin_amdgcn_exp2f(sacc[j][g].y - mx); sacc[j][g].z = __builtin_amdgcn_exp2f(sacc[j][g].z - mx); sacc[j][g].w = __builtin_amdgcn_exp2f(sacc[j][g].w - mx);
                sm += (sacc[j][g].x + sacc[j][g].y) + (sacc[j][g].z + sacc[j][g].w); }
            sm += shx(sm, 16, lane); sm += shx(sm, 32, lane);
            const float inv = 1.0f / sm;
#pragma unroll
            for (int s2 = 0; s2 < 8; ++s2) { u32x4 w; w.x = cvt_pk_bf16(sacc[j][2 * s2].x * inv, sacc[j][2 * s2].y * inv); w.y = cvt_pk_bf16(sacc[j][2 * s2].z * inv, sacc[j][2 * s2].w * inv);
                w.z = cvt_pk_bf16(sacc[j][2 * s2 + 1].x * inv, sacc[j][2 * s2 + 1].y * inv); w.w = cvt_pk_bf16(sacc[j][2 * s2 + 1].z * inv, sacc[j][2 * s2 + 1].w * inv); pf[j][s2] = __builtin_bit_cast(bf16x8, w); }
            asm volatile("" ::: "memory");
          } }
        __syncthreads();
        const int tid2 = mytid(A.wave), lane2 = tid2 & 63, wave2 = __builtin_amdgcn_readfirstlane(tid2 >> 6), fr2 = lane2 & 15, fq2 = lane2 >> 4; unsigned char* ws2 = opq(A.ws);
        const bf16_t* VMT2 = (const bf16_t*)(ws2 + WS_VMT); bf16_t* AO2 = (bf16_t*)(ws2 + WS_AO);
#pragma unroll
        for (int b8 = 0; b8 < 2; ++b8) { u32x4 t8[8];
#pragma unroll
            for (int i = 0; i < 8; ++i) { const int idx = tid2 + 512 * (8 * b8 + i); t8[i] = *(const u32x4*)(VMT2 + (size_t)(256 * hh + (idx >> 5)) * 256 + 8 * (idx & 31)); }
#pragma unroll
            for (int i = 0; i < 8; ++i) { const int idx = tid2 + 512 * (8 * b8 + i); *(LAS u32x4*)(lds + (idx >> 5) * 528 + 16 * (idx & 31)) = t8[i]; } }
        __syncthreads();
        { const int row0 = rb * 256 + 16 * wave2 + fr2;
#pragma unroll
            for (int dg = 0; dg < 16; ++dg) { f32x4 c0 = (f32x4){0.f, 0.f, 0.f, 0.f}, c1 = c0;
#pragma unroll
                for (int s2 = 0; s2 < 8; ++s2) { const bf16x8 vf = *(const LAS bf16x8*)(lds + (16 * dg + fr2) * 528 + (32 * s2 + 8 * fq2) * 2);
                    c0 = __builtin_amdgcn_mfma_f32_16x16x32_bf16(vf, pf[0][s2], c0, 0, 0, 0); c1 = __builtin_amdgcn_mfma_f32_16x16x32_bf16(vf, pf[1][s2], c1, 0, 0, 0); }
                u32x2 w; w.x = cvt_pk_bf16(c0.x, c0.y); w.y = cvt_pk_bf16(c0.z, c0.w);
                *(u32x2*)(AO2 + (size_t)row0 * 1024 + 256 * hh + 16 * dg + 4 * fq2) = w;
                w.x = cvt_pk_bf16(c1.x, c1.y); w.y = cvt_pk_bf16(c1.z, c1.w);
                *(u32x2*)(AO2 + (size_t)(row0 + 128) * 1024 + 256 * hh + 16 * dg + 4 * fq2) = w; if (dg & 1) asm volatile("" ::: "memory"); } }
    }
    __syncthreads();
}

__device__ __forceinline__ void final_norm(const Args& A) {
    const int tid = mytid(A.wave), lane = tid & 63, wave = tid >> 6; const int bid = obid(), Gl = ogrid(); unsigned char* ws = opq(A.ws); const float* ssq = (const float*)(ws + WS_SSQ); const bf16_t* xb = (const bf16_t*)(ws + WS_XB); const GAS float* g = ldarg(A, I_FING);
    for (int r = bid * 8 + wave; r < S_; r += Gl * 8) { const float rs = row_rstd(ssq, r); float* xr = (float*)opq((unsigned char*)A.out) + (size_t)r * 1024 + lane * 16;
        float v[16]; { float v0[8], v1[8]; ld_bf16x8(xb + (size_t)r * 1024 + lane * 16, v0); ld_bf16x8(xb + (size_t)r * 1024 + lane * 16 + 8, v1);
#pragma unroll
            for (int i = 0; i < 8; ++i) { v[i] = v0[i]; v[8 + i] = v1[i]; } }
#pragma unroll
        for (int i = 0; i < 4; ++i) { const f32x4 gg = *(const GAS f32x4*)(g + lane * 16 + 4 * i); *(f32x4*)(xr + 4 * i) = (f32x4){v[4 * i] * rs * gg.x, v[4 * i + 1] * rs * gg.y, v[4 * i + 2] * rs * gg.z, v[4 * i + 3] * rs * gg.w}; } }
}

constexpr int PH_PER_LAYER = 11, N_PHASES = 2 + PH_PER_LAYER * DEPTH;
__global__ void __launch_bounds__(NTHREADS, 2) mk_fwd(const float* i0, const float* i1, const float* i2, const float* i3, const float* i4, const float* i5, const float* i6, const float* i7, const float* i8, const float* i9,
                                                      const float* i10, const float* i11, const float* i12, const float* i13, const float* i14, const float* i15, const float* i16, const float* i17, const float* i18, const float* i19,
                                                      float* outp, unsigned char* wsp, int ph_lo, int ph_hi) {
    extern __shared__ __attribute__((aligned(16))) unsigned char lds[];
    LAS unsigned char* ring = (LAS unsigned char*)lds;
    Args args; args.out = outp; args.ws = wsp; args.ring = ring; args.wave = __builtin_amdgcn_readfirstlane(threadIdx.x >> 6);
    const int tid = threadIdx.x;
    unsigned char* ws = args.ws;
    unsigned* ctl = (unsigned*)(ws + WS_CTL);
    volatile LAS unsigned* misc = (volatile LAS unsigned*)(ring + MISC_OFF);
    if (tid < 16) misc[tid] = 0u;
#if DBG_MODE == 3
    if (tid < 32) ((volatile LAS unsigned long long*)(ring + MISC_OFF + 2560))[tid] = 0ull;
#endif
    if (tid == 0) { volatile LAS unsigned long long* av = (volatile LAS unsigned long long*)(ring + ARGV_OFF);
        av[0] = (unsigned long long)i0; av[1] = (unsigned long long)i1; av[2] = (unsigned long long)i2; av[3] = (unsigned long long)i3; av[4] = (unsigned long long)i4;
        av[5] = (unsigned long long)i5; av[6] = (unsigned long long)i6; av[7] = (unsigned long long)i7; av[8] = (unsigned long long)i8; av[9] = (unsigned long long)i9;
        av[10] = (unsigned long long)i10; av[11] = (unsigned long long)i11; av[12] = (unsigned long long)i12; av[13] = (unsigned long long)i13; av[14] = (unsigned long long)i14;
        av[15] = (unsigned long long)i15; av[16] = (unsigned long long)i16; av[17] = (unsigned long long)i17; av[18] = (unsigned long long)i18; av[19] = (unsigned long long)i19; }
    __syncthreads();
    const bool one = (ph_hi - ph_lo) > 1;
    XcdBarrier bar; bar.bar = ctl + CW_BAR; bar.x = 0; bar.st = misc;
    if (one) bar = xcd_barrier_post(ctl + CW_BAR, misc, args.wave);
    const int lo = ph_lo, hi = ph_hi, G = gridDim.x;
#define IN(k) (lo <= (k) && (k) < hi)
#if DBG_MODE == 3
#define STAMP(k) do { if (obid() == 0 && mytid(args.wave) == 0) ((volatile LAS unsigned long long*)(ring + MISC_OFF + 2048))[(k)] = __builtin_amdgcn_s_memrealtime(); } while (0)
#else
#define STAMP(k) do { } while (0)
#endif
#define SEAM(k) do { if (IN((k) + 1)) xcd_barrier(bar, args.wave); STAMP((k) + 1); } while (0)

#if DBG_MODE == 3
    const unsigned long long clk0_ = clock64();
#endif
    STAMP(0);
    if (PH_EN(100) && IN(0)) { prologue(ring, args); __syncthreads(); STAMP(1); }

    for (int l = 0; l < DEPTH; ++l) {
        const int pb = 1 + PH_PER_LAYER * l;
        if (l == 0) { if (PH_EN(0) && IN(pb + 0)) { const int bid = obid(), Gl = ogrid(); conv_range(ring, args, 0, 0, CONV_EARLY, bid, Gl); SEAM(pb + 0); } }
        else STAMP(pb + 1);
        if (PH_EN(1) && IN(pb + 1)) { unsigned char* wsl = opq(ws); (void)wsl; const int bid = obid(), Gl = ogrid(); (void)bid; (void)Gl;
            { pg8::Gemm g{(const bf16_t*)(wsl + WS_XB), (const bf16_t*)(wsl + WS_WIN), S_, NIN - 256, D_, 0, 0}; pg8::StaticOrder S; S.init(S_, NIN - 256, Gl, bid);
              EpiIn E{(const float*)(wsl + WS_SSQ), (const float*)(wsl + WS_CS), (bf16_t*)(wsl + WS_SBQ), (bf16_t*)(wsl + WS_SBK), (bf16_t*)(wsl + WS_SBV), (bf16_t*)(wsl + WS_DSQ), (bf16_t*)(wsl + WS_IXQ), (bf16_t*)(wsl + WS_DSK), (bf16_t*)(wsl + WS_IXK),
                      (bf16_t*)(wsl + WS_DSV), (bf16_t*)(wsl + WS_GLQ), (bf16_t*)(wsl + WS_GLK), (bf16_t*)(wsl + WS_GLV), (bf16_t*)(wsl + WS_GLO), (bf16_t*)(wsl + WS_GATES), (float*)(wsl + WS_SMALL), (bf16_t*)(wsl + WS_SBVT), 0, (bf16_t*)(wsl + WS_GLVT)};
              pg8::gemm_phase<EpiIn, pg8::StaticOrder>(ring, g, S, E, args.wave); }
            SEAM(pb + 1);
        }
        if (PH_EN(2) && IN(pb + 2)) { unsigned char* wsl = opq(ws); (void)wsl; const int bid = obid(), Gl = ogrid(); (void)bid; (void)Gl;
            volatile LAS int* qslot = (volatile LAS int*)(ring + MISC_OFF + 32);
            for (;;) {
                __syncthreads();
                if (mytid(args.wave) == 0) *qslot = (int)atomicAdd((unsigned*)(wsl + WS_CTL) + CW_QUEUE + 64 * l, 1u);
                __syncthreads();
                const int uq = *qslot;
                if (uq >= 1232) break;
                if (uq >= 64 && uq < 72) {
                    pg8::Gemm g{(const bf16_t*)(wsl + WS_MEMB), (const bf16_t*)(wsl + WS_WXKV), NMEM, 2048, D_, 0, 0}; pg8::StaticOrder S; S.init(NMEM, 2048, 8, uq - 64);
                    EpiKV E{(const float*)(wsl + WS_RSTDM), (bf16_t*)(wsl + WS_KM), (bf16_t*)(wsl + WS_VMT)};
                    pg8::gemm_phase<EpiKV, pg8::StaticOrder>(ring, g, S, E, args.wave); }
                else if (uq < 64) {
                    pg8::Gemm g{(const bf16_t*)(wsl + WS_XB), (const bf16_t*)(wsl + WS_WIN) + (size_t)(NIN - 256) * D_, S_, 256, D_, 0, 0}; pg8::StaticOrder S; S.init(S_, 256, 64, uq);
                    EpiIn E{(const float*)(wsl + WS_SSQ), (const float*)(wsl + WS_CS), (bf16_t*)(wsl + WS_SBQ), (bf16_t*)(wsl + WS_SBK), (bf16_t*)(wsl + WS_SBV), (bf16_t*)(wsl + WS_DSQ), (bf16_t*)(wsl + WS_IXQ), (bf16_t*)(wsl + WS_DSK), (bf16_t*)(wsl + WS_IXK),
                            (bf16_t*)(wsl + WS_DSV), (bf16_t*)(wsl + WS_GLQ), (bf16_t*)(wsl + WS_GLK), (bf16_t*)(wsl + WS_GLV), (bf16_t*)(wsl + WS_GLO), (bf16_t*)(wsl + WS_GATES), (float*)(wsl + WS_SMALL), (bf16_t*)(wsl + WS_SBVT), 20, (bf16_t*)(wsl + WS_GLVT)};
                    pg8::gemm_phase<EpiIn, pg8::StaticOrder>(ring, g, S, E, args.wave); }
                else if (uq < 584) dsa_unit(ring, args, 583 - uq);
                else if (uq < 848) { const int c0 = CONV_EARLY + 2 * (uq - 584); conv_range(ring, args, l, c0, c0 + 2, 0, 1); }
                else if (uq < 976) { TICK(args, 0); sb_unit(ring, args, 975 - uq); TICK(args, 6); }
                else { TICK(args, 0); gla1_unit(ring, args, l, uq - 976); TICK(args, 7); }
            }
            SEAM(pb + 2);
        }
        if (PH_EN(3) && IN(pb + 3)) { unsigned char* wsl = opq(ws); (void)wsl; const int bid = obid(), Gl = ogrid(); (void)bid; (void)Gl; gla2_phase(ring, args);
            if (bid >= 128) for (int sb = bid - 128; sb < 128; sb += Gl - 128) glvt_slab(ring, args, sb);
            SEAM(pb + 3); }
        if (PH_EN(4) && IN(pb + 4)) { unsigned char* wsl = opq(ws); (void)wsl; const int bid = obid(), Gl = ogrid(); (void)bid; (void)Gl; for (int c = bid; c < 256; c += Gl) gla3_unit(ring, args, l, c); SEAM(pb + 4); }
        if (PH_EN(5) && IN(pb + 5)) { unsigned char* wsl = opq(ws); (void)wsl; const int bid = obid(), Gl = ogrid(); (void)bid; (void)Gl;
            pg8::Gemm g{(const bf16_t*)(wsl + WS_OA), (const bf16_t*)(wsl + WS_WBR), S_, D_, 256, (size_t)(WS_OB - WS_OA), (size_t)1024 * 256 * 2}; pg8::TripleOrder S; S.init(S_, D_, Gl, bid);
            EpiMerge E{(const bf16_t*)(wsl + WS_GATES), (bf16_t*)(wsl + WS_MERGED)}; pg8::gemm_phase<EpiMerge, pg8::TripleOrder>(ring, g, S, E, args.wave);
            SEAM(pb + 5);
        }
        if (PH_EN(6) && IN(pb + 6)) { unsigned char* wsl = opq(ws); (void)wsl; const int bid = obid(), Gl = ogrid(); (void)bid; (void)Gl; pg8::Gemm g{(const bf16_t*)(wsl + WS_MERGED), (const bf16_t*)(wsl + WS_WMIX), S_, D_, D_, 0, 0}; pg8::StaticOrder S; S.init(S_, D_, Gl, bid);
            EpiRes E{(float*)nullptr, (bf16_t*)(wsl + WS_XB), (float*)(wsl + WS_SSQ)}; pg8::gemm_phase<EpiRes, pg8::StaticOrder>(ring, g, S, E, args.wave); SEAM(pb + 6); }
        if (PH_EN(7) && IN(pb + 7)) { unsigned char* wsl = opq(ws); (void)wsl; const int bid = obid(), Gl = ogrid(); (void)bid; (void)Gl; pg8::Gemm g{(const bf16_t*)(wsl + WS_XB), (const bf16_t*)(wsl + WS_WXQ), S_, D_, D_, 0, 0}; pg8::StaticOrder S; S.init(S_, D_, Gl, bid);
            EpiXq E{(const float*)(wsl + WS_SSQ), (bf16_t*)(wsl + WS_XQ)}; pg8::gemm_phase<EpiXq, pg8::StaticOrder>(ring, g, S, E, args.wave);
            __syncthreads();
            xattn_phase(ring, args, S); SEAM(pb + 7); }
        if (PH_EN(8) && IN(pb + 8)) { unsigned char* wsl = opq(ws); (void)wsl; const int bid = obid(), Gl = ogrid(); (void)bid; (void)Gl; pg8::Gemm g{(const bf16_t*)(wsl + WS_AO), (const bf16_t*)(wsl + WS_WXO), S_, D_, D_, 0, 0}; pg8::StaticOrder S; S.init(S_, D_, Gl, bid);
            EpiRes E{(float*)nullptr, (bf16_t*)(wsl + WS_XB), (float*)(wsl + WS_SSQ)}; pg8::gemm_phase<EpiRes, pg8::StaticOrder>(ring, g, S, E, args.wave); SEAM(pb + 8); }
        if (PH_EN(9) && IN(pb + 9)) { unsigned char* wsl = opq(ws); (void)wsl; const int bid = obid(), Gl = ogrid(); (void)bid; (void)Gl; pg8::Gemm g{(const bf16_t*)(wsl + WS_XB), (const bf16_t*)(wsl + WS_WFI), S_, NFF, D_, 0, 0}; pg8::StaticOrder S; S.init(S_, NFF, Gl, bid);
            EpiFfnIn E{(const float*)(wsl + WS_SSQ), (bf16_t*)(wsl + WS_HID)}; pg8::gemm_phase<EpiFfnIn, pg8::StaticOrder>(ring, g, S, E, args.wave);
            if (l + 1 < DEPTH) {
                const int nun = (S_ / 256) * (NFF / 256), nmax = (nun + Gl - 1) / Gl; int fi = nun - (nmax - 1) * Gl; if (fi >= Gl) fi = 0;
                __syncthreads();
                if (bid >= fi) conv_range(ring, args, l + 1, 0, CONV_EARLY, bid - fi, Gl - fi); }
            SEAM(pb + 9); }
        if (PH_EN(10) && IN(pb + 10)) { unsigned char* wsl = opq(ws); (void)wsl; const int bid = obid(), Gl = ogrid(); (void)bid; (void)Gl; pg8::Gemm g{(const bf16_t*)(wsl + WS_HID), (const bf16_t*)(wsl + WS_WFO), S_, D_, DFF, 0, 0}; pg8::StaticOrder S; S.init(S_, D_, Gl, bid);
            EpiRes E{(float*)nullptr, (bf16_t*)(wsl + WS_XB), (float*)(wsl + WS_SSQ)}; pg8::gemm_phase<EpiRes, pg8::StaticOrder>(ring, g, S, E, args.wave); SEAM(pb + 10); }
    }
    if (PH_EN(101) && IN(N_PHASES - 1)) { final_norm(args); __syncthreads(); STAMP(N_PHASES); }
#if DBG_MODE == 3
    if (obid() == 0 && mytid(args.wave) == 0) { volatile LAS unsigned long long* st = (volatile LAS unsigned long long*)(ring + MISC_OFF + 2048); unsigned long long T = 0;
        if (STAMP_A == 40) { const unsigned long long cyc = clock64() - clk0_; const unsigned long long rt = st[N_PHASES] - st[0]; T = (cyc * 1000ull / rt) * 10ull; }
        else if (STAMP_A == 30) T = ((volatile LAS unsigned long long*)(ring + MISC_OFF + 2560))[10] / 20ull;
        else if (STAMP_A >= 20) T = ((volatile LAS unsigned long long*)(ring + MISC_OFF + 2560))[STAMP_A - 20];
        else if (STAMP_A < PH_PER_LAYER) { for (int l = 0; l < DEPTH; ++l) T += st[2 + PH_PER_LAYER * l + STAMP_A] - st[1 + PH_PER_LAYER * l + STAMP_A]; } else if (STAMP_A == 12) T = st[1] - st[0]; else T = st[N_PHASES] - st[N_PHASES - 1];
        const unsigned long long t0 = __builtin_amdgcn_s_memrealtime(); while (__builtin_amdgcn_s_memrealtime() - t0 < T * STAMP_MUL) __builtin_amdgcn_s_sleep(8); }
#endif
#undef IN
#undef SEAM
}

#if DBG_MODE == 1
constexpr size_t WS_DBGSC = WS_DBGEND;
constexpr size_t WS_DBGFL = WS_DBGSC + 1 * MB;
constexpr size_t WS_DBGEND2 = WS_DBGFL + 256 * 1024;
__device__ __forceinline__ int dbg_row(int i) { if (i == 0) return 0; if (i == 1) return 63; if (i == 2) return 64; if (i == 3) return 255; if (i == 4) return 256; if (i == 5) return S_ - 1; if (i == 6) return 300; if (i == 7) return 16000; return (int)((((unsigned)i * 2654435761u) >> 14) % (unsigned)S_); }
__device__ __forceinline__ void dbg_err(float* dbg, int stage, float got, float ex, float atol, float rtol) { float e = fabsf(got - ex) / (atol + rtol * fabsf(ex)); if (!(e == e)) e = 1e30f; atomicMax((unsigned*)(dbg + stage), __float_as_uint(e)); }
__device__ __forceinline__ void dbg_sincos(float angf, double& c, double& s) {
    double a = (double)angf; const double k = floor(a / 6.283185307179586476925286766559); a -= k * 6.283185307179586476925286766559; if (a > 3.14159265358979323846) a -= 6.283185307179586476925286766559;
    double term = a, sn = a, a2 = a * a; for (int i = 1; i < 20; ++i) { term *= -a2 / ((2 * i) * (2 * i + 1)); sn += term; }
    term = 1.0; double cn = 1.0; for (int i = 1; i < 20; ++i) { term *= -a2 / ((2 * i - 1) * (2 * i)); cn += term; }
    c = cn; s = sn; }
__global__ void __launch_bounds__(512) dbg_inproj(const float* x, const float* g, const float* win, unsigned char* ws) {
    __shared__ float xs[1024]; __shared__ float z[INW]; __shared__ float red[8];
    float* dbg = (float*)(ws + WS_DBG); const int r = dbg_row(blockIdx.x), tid = threadIdx.x;
    float sq = 0.f; for (int k = tid; k < 1024; k += 512) { const float v = x[(size_t)r * 1024 + k]; sq += v * v; xs[k] = v * g[k]; }
    for (int o = 32; o >= 1; o >>= 1) sq += __shfl_xor(sq, o);
    if ((tid & 63) == 0) red[tid >> 6] = sq;
    __syncthreads();
    float tot = 0.f; for (int i = 0; i < 8; ++i) tot += red[i];
    const float rstd = rsqrtf(tot * (1.0f / 1024.0f) + EPS);
    if (tid == 0) dbg_err(dbg, 20, row_rstd((const float*)(ws + WS_SSQ), r), rstd, 0.f, 1e-4f);
    for (int n = tid; n < INW; n += 512) { float acc = 0.f; for (int k = 0; k < 1024; ++k) acc += xs[k] * win[(size_t)k * INW + n]; z[n] = acc * rstd; }
    __syncthreads();
    const bf16_t* SBQ = (const bf16_t*)(ws + WS_SBQ); const bf16_t* SBK = (const bf16_t*)(ws + WS_SBK); const bf16_t* SBV = (const bf16_t*)(ws + WS_SBV);
    const bf16_t* DSQ = (const bf16_t*)(ws + WS_DSQ); const bf16_t* IXQ = (const bf16_t*)(ws + WS_IXQ); const bf16_t* DSK = (const bf16_t*)(ws + WS_DSK); const bf16_t* IXK = (const bf16_t*)(ws + WS_IXK); const bf16_t* DSV = (const bf16_t*)(ws + WS_DSV);
    const float* SM = (const float*)(ws + WS_SMALL); const bf16_t* GLQ = (const bf16_t*)(ws + WS_GLQ); const bf16_t* GLK = (const bf16_t*)(ws + WS_GLK); const bf16_t* GLV = (const bf16_t*)(ws + WS_GLV); const bf16_t* GLO = (const bf16_t*)(ws + WS_GLO); const bf16_t* GT = (const bf16_t*)(ws + WS_GATES);
    const float AT = 0.04f, RT = 0.02f;
    for (int n = tid; n < INW; n += 512) {
        const float zn = z[n];
        if (n < 768) { const int w = n >> 8, c = n & 255; const bf16_t* B = w == 0 ? SBQ : (w == 1 ? SBK : SBV); dbg_err(dbg, 1 + w, bf2f(B[(size_t)r * 256 + c]), zn * (w == 0 ? SBQ_SCALE : 1.0f), AT, RT); }
        else if (n < 1152 && !(n >= 1088) || (n >= 1152 && n < 1472)) {
            int base, stage, ld, col; float sc; const bf16_t* B;
            if (n < 1024) { base = 768; stage = 4; ld = 256; sc = DSQ_SCALE; B = DSQ; } else if (n < 1088) { base = 1024; stage = 5; ld = 64; sc = 1.f; B = DSK; }
            else if (n < 1408) { base = 1152; stage = 7; ld = 256; sc = IXQ_SCALE; B = IXQ; } else { base = 1408; stage = 8; ld = 64; sc = 1.f; B = IXK; }
            col = n - base; const int d = col & 63, dd = d & 31; double c, s_; dbg_sincos((float)r * c_inv_freq[dd], c, s_);
            const float ex = d < 32 ? (float)(zn * c - z[n + 32] * s_) : (float)(zn * c + z[n - 32] * s_);
            dbg_err(dbg, stage, bf2f(B[(size_t)r * ld + col]), ex * sc, AT, RT); }
        else if (n < 1152) dbg_err(dbg, 6, bf2f(DSV[(size_t)r * 64 + n - 1088]), zn, AT, RT);
        else if (n < 1476) dbg_err(dbg, 9, SM[(size_t)r * 64 + n - 1472], zn, AT, RT);
        else if (n < 1604) dbg_err(dbg, 10, bf2f(GLQ[(size_t)r * 128 + n - 1476]), zn * GLQ_SCALE, AT, RT);
        else if (n < 1732) dbg_err(dbg, 11, bf2f(GLK[(size_t)r * 128 + n - 1604]), zn, AT, RT);
        else if (n < 1988) dbg_err(dbg, 12, bf2f(GLV[(size_t)r * 256 + n - 1732]), zn, AT, RT);
        else if (n < 2004) dbg_err(dbg, 13, SM[(size_t)r * 64 + 4 + n - 1988], zn, AT, RT);
        else if (n < 2260) dbg_err(dbg, 14, bf2f(GLO[(size_t)r * 256 + n - 2004]), zn / (1.0f + expf(-zn)), AT, RT);
        else dbg_err(dbg, 15, bf2f(GT[(size_t)r * 3072 + n - 2260]), 1.0f / (1.0f + expf(-zn)), AT, RT);
    }
}
__global__ void __launch_bounds__(64) dbg_sb(unsigned char* ws) {
    float* dbg = (float*)(ws + WS_DBG); const int i = threadIdx.x, t = dbg_row(i), h = i & 3;
    const bf16_t* Q = (const bf16_t*)(ws + WS_SBQ); const bf16_t* K = (const bf16_t*)(ws + WS_SBK); const bf16_t* V = (const bf16_t*)(ws + WS_SBV); const bf16_t* O = (const bf16_t*)(ws + WS_OA);
    float q[64], acc[64];
#pragma unroll
    for (int d8 = 0; d8 < 8; ++d8) { float v[8]; ld_bf16x8(Q + (size_t)t * 256 + 64 * h + 8 * d8, v);
#pragma unroll
        for (int j = 0; j < 8; ++j) { q[8 * d8 + j] = v[j] * (1.0f / LOG2E); acc[8 * d8 + j] = 0.f; } }
    float run = 0.f;
    for (int s = t - 1; s >= 0; --s) { float z = 0.f;
#pragma unroll
        for (int d8 = 0; d8 < 8; ++d8) { float v[8]; ld_bf16x8(K + (size_t)s * 256 + 64 * h + 8 * d8, v);
#pragma unroll
            for (int j = 0; j < 8; ++j) z += q[8 * d8 + j] * v[j]; }
        const float lb = z >= 0.f ? -log1pf(expf(-z)) : z - log1pf(expf(z)); const float lk = lb - z; const float w = expf(lb + run);
#pragma unroll
        for (int d8 = 0; d8 < 8; ++d8) { float v[8]; ld_bf16x8(V + (size_t)s * 256 + 64 * h + 8 * d8, v);
#pragma unroll
            for (int j = 0; j < 8; ++j) acc[8 * d8 + j] += w * v[j]; }
        run += lk; }
#pragma unroll
    for (int d8 = 0; d8 < 8; ++d8) { float v[8]; ld_bf16x8(O + (size_t)t * 256 + 64 * h + 8 * d8, v);
#pragma unroll
        for (int j = 0; j < 8; ++j) dbg_err(dbg, 16, v[j], acc[8 * d8 + j], 0.02f, 0.02f); }
}
__global__ void __launch_bounds__(512) dbg_dsa(unsigned char* ws) {
    __shared__ float qi[256]; __shared__ float dq[256]; __shared__ float pp[4][256]; __shared__ float wsm[4]; __shared__ int mism; __shared__ float mxs[4], sms[4];
    float* dbg = (float*)(ws + WS_DBG); const int tid = threadIdx.x, t = dbg_row(blockIdx.x), N = ((t >> 6) + 1) * 64, nsel = N < 256 ? N : 256;
    const bf16_t* IQ = (const bf16_t*)(ws + WS_IXQ); const bf16_t* IK = (const bf16_t*)(ws + WS_IXK); const float* SM = (const float*)(ws + WS_SMALL);
    const bf16_t* DQ = (const bf16_t*)(ws + WS_DSQ); const bf16_t* DK = (const bf16_t*)(ws + WS_DSK); const bf16_t* DV = (const bf16_t*)(ws + WS_DSV); const bf16_t* OB = (const bf16_t*)(ws + WS_OB);
    const unsigned short* msel = (const unsigned short*)(ws + WS_DBGSEL) + (size_t)t * 256;
    float* sc = (float*)(ws + WS_DBGSC) + (size_t)blockIdx.x * 16384; int* fl = (int*)(ws + WS_DBGFL) + (size_t)blockIdx.x * 16384;
    if (tid < 256) { qi[tid] = bf2f(IQ[(size_t)t * 256 + tid]); dq[tid] = bf2f(DQ[(size_t)t * 256 + tid]); } if (tid < 4) wsm[tid] = SM[(size_t)t * 64 + tid] * 0.5f; if (tid == 0) mism = 0;
    __syncthreads();
    for (int s = tid; s < N; s += 512) { float tot = 0.f;
#pragma unroll 1
        for (int h = 0; h < 4; ++h) { float a = 0.f;
#pragma unroll 4
            for (int d = 0; d < 64; ++d) a += qi[64 * h + d] * bf2f(IK[(size_t)s * 64 + d]); tot += wsm[h] * fmaxf(a, 0.f); } sc[s] = tot + 0.0f; }
    __threadfence_block(); __syncthreads();
    { float mine[32]; int rank[32];
#pragma unroll
      for (int k = 0; k < 32; ++k) { const int s = tid + 512 * k; mine[k] = s < N ? sc[s] : 0.f; rank[k] = 0; }
      for (int j = 0; j < N; ++j) { const float v = sc[j];
#pragma unroll
          for (int k = 0; k < 32; ++k) { const int s = tid + 512 * k; rank[k] += (v > mine[k] || (v == mine[k] && j < s)) ? 1 : 0; } }
#pragma unroll
      for (int k = 0; k < 32; ++k) { const int s = tid + 512 * k; if (s < N) fl[s] = (N <= 256 || rank[k] < 256) ? 1 : 0; } }
    __threadfence_block(); __syncthreads();
    if (tid < nsel) { const int key = msel[tid]; bool ok = key < N; if (ok) ok = atomicExch(fl + key, 2) == 1; if (!ok) atomicAdd(&mism, 1); }
    __syncthreads();
    if (tid == 0) dbg_err(dbg, 17, (float)mism, 0.f, 6.0f, 0.f);
    if (tid < 256) { const bool valid = tid < nsel; const int key = valid ? (int)msel[tid] : 0; const int kk = key < S_ ? key : 0;
#pragma unroll 1
        for (int h = 0; h < 4; ++h) { float a = 0.f;
#pragma unroll 4
            for (int d = 0; d < 64; ++d) a += dq[64 * h + d] * bf2f(DK[(size_t)kk * 64 + d]);
            pp[h][tid] = valid ? a : -INFINITY; } }
    __syncthreads();
    if (tid < 4) { float mx = -INFINITY; for (int i = 0; i < 256; ++i) mx = fmaxf(mx, pp[tid][i]); float sm = 0.f; for (int i = 0; i < 256; ++i) sm += exp2f(pp[tid][i] - mx); mxs[tid] = mx; sms[tid] = sm; }
    __syncthreads();
    if (tid < 256) { const int h = tid >> 6, d = tid & 63; float o = 0.f;
#pragma unroll 2
        for (int i = 0; i < nsel; ++i) { const int key = msel[i] < S_ ? msel[i] : 0; o += exp2f(pp[h][i] - mxs[h]) * bf2f(DV[(size_t)key * 64 + d]); }
        dbg_err(dbg, 18, bf2f(OB[(size_t)t * 256 + tid]), o / sms[h], 0.02f, 0.02f); }
}
__global__ void __launch_bounds__(512) dbg_gla(const float* wup, const float* gb, const float* gn, unsigned char* ws) {
    __shared__ float qs[32], ks[32], al[32], vs[64], part[32][65], os[64];
    float* dbg = (float*)(ws + WS_DBG); const int tid = threadIdx.x, h = blockIdx.x, d = tid >> 4, e0 = (tid & 15) * 4;
    const float* SM = (const float*)(ws + WS_SMALL); const bf16_t* GQ = (const bf16_t*)(ws + WS_GLQ); const bf16_t* GK = (const bf16_t*)(ws + WS_GLK); const bf16_t* GV = (const bf16_t*)(ws + WS_GLV); const bf16_t* GO = (const bf16_t*)(ws + WS_GLO); const bf16_t* OC = (const bf16_t*)(ws + WS_OC);
    float st[4] = {0.f, 0.f, 0.f, 0.f}; float emax = 0.f;
    for (int t = 0; t < S_; ++t) {
        if (tid < 32) { qs[tid] = bf2f(GQ[(size_t)t * 128 + 32 * h + tid]); ks[tid] = bf2f(GK[(size_t)t * 128 + 32 * h + tid]);
            float x = gb[32 * h + tid]; for (int r = 0; r < 16; ++r) x += SM[(size_t)t * 64 + 4 + r] * wup[r * 128 + 32 * h + tid];
            const float ls = x >= 0.f ? -log1pf(expf(-x)) : x - log1pf(expf(x)); al[tid] = expf(ls * (1.0f / 16.0f)); }
        else if (tid < 96) vs[tid - 32] = bf2f(GV[(size_t)t * 256 + 64 * h + tid - 32]);
        __syncthreads();
#pragma unroll
        for (int i = 0; i < 4; ++i) { st[i] = al[d] * st[i] + ks[d] * vs[e0 + i]; part[d][e0 + i] = qs[d] * st[i]; }
        __syncthreads();
        if (tid < 64) { float o = 0.f; for (int dd = 0; dd < 32; ++dd) o += part[dd][tid]; float sq = o * o; for (int m = 32; m >= 1; m >>= 1) sq += __shfl_xor(sq, m);
            const float ex = o * rsqrtf(sq * (1.0f / 64.0f) + EPS) * gn[tid] * bf2f(GO[(size_t)t * 256 + 64 * h + tid]);
            float e = fabsf(bf2f(OC[(size_t)t * 256 + 64 * h + tid]) - ex) / (0.08f + 0.06f * fabsf(ex)); if (!(e == e)) e = 1e30f; emax = fmaxf(emax, e); }
        __syncthreads();
    }
    if (tid < 64) atomicMax((unsigned*)(dbg + 19), __float_as_uint(emax));
}
constexpr size_t WS_DBGCK = WS_DBGEND2;
constexpr size_t WS_DBGEND3 = WS_DBGCK + 2 * 64 * 1024 * 4;
__device__ __forceinline__ float dbg_dot(const float* arow, const float* W, int ldw, int K, int n) { float a = 0.f; for (int k = 0; k < K; ++k) a += arow[k] * W[(size_t)k * ldw + n]; return a; }
__global__ void __launch_bounds__(512) dbg_merge(const float* wa, const float* wb, const float* wc, unsigned char* ws) {
    __shared__ float oa[256], ob[256], oc[256]; float* dbg = (float*)(ws + WS_DBG); const int r = dbg_row(blockIdx.x), tid = threadIdx.x;
    if (tid < 256) { oa[tid] = bf2f(((const bf16_t*)(ws + WS_OA))[(size_t)r * 256 + tid]); ob[tid] = bf2f(((const bf16_t*)(ws + WS_OB))[(size_t)r * 256 + tid]); oc[tid] = bf2f(((const bf16_t*)(ws + WS_OC))[(size_t)r * 256 + tid]); }
    __syncthreads();
    const bf16_t* G = (const bf16_t*)(ws + WS_GATES) + (size_t)r * 3072; const bf16_t* M = (const bf16_t*)(ws + WS_MERGED) + (size_t)r * 1024;
    for (int c = tid; c < 1024; c += 512) { const float ex = bf2f(G[c]) * dbg_dot(oa, wa, 1024, 256, c) + bf2f(G[1024 + c]) * dbg_dot(ob, wb, 1024, 256, c) + bf2f(G[2048 + c]) * dbg_dot(oc, wc, 1024, 256, c);
        dbg_err(dbg, 21, bf2f(M[c]), ex, 0.03f, 0.03f); }
}
__global__ void __launch_bounds__(512) dbg_resid(const float* xin, int xin_ld_is_ck, const float* W, int K, size_t abuf_off, const float* out, unsigned char* ws, int st, int ckslot) {
    __shared__ float arow[2816]; __shared__ float red[8]; float* dbg = (float*)(ws + WS_DBG); const int smp = blockIdx.x, r = dbg_row(smp), tid = threadIdx.x;
    const bf16_t* Ab = (const bf16_t*)(ws + abuf_off) + (size_t)r * K; for (int k = tid; k < K; k += 512) arow[k] = bf2f(Ab[k]);
    __syncthreads();
    const float* xrow = xin_ld_is_ck ? xin + (size_t)smp * 1024 : xin + (size_t)r * 1024; float* ck = (float*)(ws + WS_DBGCK) + ((size_t)ckslot * 64 + smp) * 1024;
    float sq = 0.f;
    for (int c = tid; c < 1024; c += 512) { const float ex = xrow[c] + dbg_dot(arow, W, 1024, K, c); const float got = out[(size_t)r * 1024 + c];
        dbg_err(dbg, st, got, ex, 0.03f, 0.02f); dbg_err(dbg, st + 1, bf2f(((const bf16_t*)(ws + WS_XB))[(size_t)r * 1024 + c]), got, 0.001f, 0.01f); sq += got * got; ck[c] = got; }
    for (int o = 32; o >= 1; o >>= 1) sq += __shfl_xor(sq, o);
    if ((tid & 63) == 0) red[tid >> 6] = sq;
    __syncthreads();
    if (tid == 0) { float tot = 0.f; for (int i = 0; i < 8; ++i) tot += red[i]; const float* sp = (const float*)(ws + WS_SSQ) + (size_t)r * 16; float got = 0.f; for (int i = 0; i < 16; ++i) got += sp[i]; dbg_err(dbg, st + 2, got, tot, 0.f, 1e-3f); }
}
__global__ void __launch_bounds__(512) dbg_normproj(const float* x, const float* gain, const float* W, int mode, unsigned char* ws, int st) {
    __shared__ float xs[1024]; __shared__ float red[8]; float* dbg = (float*)(ws + WS_DBG); const int r = dbg_row(blockIdx.x), tid = threadIdx.x;
    float sq = 0.f; for (int k = tid; k < 1024; k += 512) { const float v = x[(size_t)r * 1024 + k]; sq += v * v; xs[k] = v * gain[k]; }
    for (int o = 32; o >= 1; o >>= 1) sq += __shfl_xor(sq, o);
    if ((tid & 63) == 0) red[tid >> 6] = sq;
    __syncthreads();
    float tot = 0.f; for (int i = 0; i < 8; ++i) tot += red[i]; const float rstd = rsqrtf(tot * (1.0f / 1024.0f) + EPS);
    if (mode == 0) { for (int c = tid; c < 1024; c += 512) dbg_err(dbg, st, bf2f(((const bf16_t*)(ws + WS_XQ))[(size_t)r * 1024 + c]), rstd * dbg_dot(xs, W, 1024, 1024, c) * XQ_SCALE, 0.03f, 0.02f); }
    else { for (int j = tid; j < DFF; j += 512) { const float g = rstd * dbg_dot(xs, W, NFF, 1024, j), up = rstd * dbg_dot(xs, W, NFF, 1024, DFF + j);
            dbg_err(dbg, st, bf2f(((const bf16_t*)(ws + WS_HID))[(size_t)r * DFF + j]), g / (1.0f + expf(-g)) * up, 0.03f, 0.03f); } }
}
__global__ void __launch_bounds__(512) dbg_kv(const float* mem, const float* gain, const float* W, unsigned char* ws, int st) {
    __shared__ float xs[1024]; __shared__ float red[8]; float* dbg = (float*)(ws + WS_DBG); const int r = blockIdx.x * 4 + 1, tid = threadIdx.x;
    float sq = 0.f; for (int k = tid; k < 1024; k += 512) { const float v = mem[(size_t)r * 1024 + k]; sq += v * v; xs[k] = v * gain[k]; }
    for (int o = 32; o >= 1; o >>= 1) sq += __shfl_xor(sq, o);
    if ((tid & 63) == 0) red[tid >> 6] = sq;
    __syncthreads();
    float tot = 0.f; for (int i = 0; i < 8; ++i) tot += red[i]; const float rstd = rsqrtf(tot * (1.0f / 1024.0f) + EPS);
    const int pos = (r & ~31) + 8 * ((r >> 2) & 3) + 4 * ((r >> 4) & 1) + (r & 3);
    for (int n = tid; n < 2048; n += 512) { const float ex = rstd * dbg_dot(xs, W, 2048, 1024, n);
        if (n < 1024) dbg_err(dbg, st, bf2f(((const bf16_t*)(ws + WS_KM))[(size_t)r * 1024 + n]), ex, 0.03f, 0.02f);
        else dbg_err(dbg, st + 1, bf2f(((const bf16_t*)(ws + WS_VMT))[(size_t)(n - 1024) * 256 + pos]), ex, 0.03f, 0.02f); }
}
__global__ void __launch_bounds__(512) dbg_xattn(unsigned char* ws, int st) {
    __shared__ float q[1024]; __shared__ float sc[256]; float* dbg = (float*)(ws + WS_DBG); const int r = dbg_row(blockIdx.x), tid = threadIdx.x;
    const bf16_t* XQ = (const bf16_t*)(ws + WS_XQ); const bf16_t* KM = (const bf16_t*)(ws + WS_KM); const bf16_t* VMT = (const bf16_t*)(ws + WS_VMT); const bf16_t* AO = (const bf16_t*)(ws + WS_AO);
    for (int k = tid; k < 1024; k += 512) q[k] = bf2f(XQ[(size_t)r * 1024 + k]);
    for (int h = 0; h < 4; ++h) {
        __syncthreads();
        if (tid < 256) { float a = 0.f; for (int d = 0; d < 256; ++d) a += q[256 * h + d] * bf2f(KM[(size_t)tid * 1024 + 256 * h + d]); sc[tid] = a; }
        __syncthreads();
        float mx = -INFINITY; for (int i = 0; i < 256; ++i) mx = fmaxf(mx, sc[i]); float sm = 0.f; for (int i = 0; i < 256; ++i) sm += exp2f(sc[i] - mx);
        if (tid < 256) { float o = 0.f; for (int key = 0; key < 256; ++key) { const int pos = (key & ~31) + 8 * ((key >> 2) & 3) + 4 * ((key >> 4) & 1) + (key & 3); o += exp2f(sc[key] - mx) * bf2f(VMT[(size_t)(256 * h + tid) * 256 + pos]); }
            dbg_err(dbg, st, bf2f(AO[(size_t)r * 1024 + 256 * h + tid]), o / sm, 0.02f, 0.02f); }
    }
}
__global__ void dbg_encode(unsigned char* ws, float* out, int nstage) {
    const float* dbg = (const float*)(ws + WS_DBG); int first = 0; for (int i = 1; i <= nstage; ++i) if (dbg[i] > 1.0f) { first = i; break; }
#ifdef DBG_PROBE
    { float e = dbg[DBG_PROBE] * 100.0f; first = e > 98.0f ? 98 : (int)(e + 0.5f); }
#endif
    const float c = sqrtf(10.0f * (float)first);
    for (size_t i = (size_t)blockIdx.x * blockDim.x + threadIdx.x; i < (size_t)S_ * D_; i += (size_t)gridDim.x * blockDim.x) out[i] = c;
}
#endif
extern "C" void kernel_launch(void* const* d_in, const int* in_sizes, int n_in, void* d_out, int out_size, void* d_ws, size_t ws_size, hipStream_t stream) {
    static int grid = 0;
    if (grid == 0) {
        if (n_in != 20 || out_size != S_ * D_ || ws_size < WS_END) { fprintf(stderr, "kernel_launch: unexpected shapes (n_in %d out %d ws %zu need %zu)\n", n_in, out_size, ws_size, (size_t)WS_END); grid = -1; return; }
        int dev = 0, cus = 0, per_cu = 0;
        if (hipGetDevice(&dev) != hipSuccess || hipDeviceGetAttribute(&cus, hipDeviceAttributeMultiprocessorCount, dev) != hipSuccess) { grid = -1; return; }
        if (hipFuncSetAttribute((const void*)mk_fwd, hipFuncAttributeMaxDynamicSharedMemorySize, LDS_BYTES) != hipSuccess) { fprintf(stderr, "kernel_launch: hipFuncSetAttribute failed\n"); grid = -1; return; }
        if (hipOccupancyMaxActiveBlocksPerMultiprocessor(&per_cu, (const void*)mk_fwd, NTHREADS, LDS_BYTES) != hipSuccess || per_cu < 1) { fprintf(stderr, "kernel_launch: occupancy query says %d\n", per_cu); }
        (void)hipGetLastError();
        grid = cus;
    }
    if (grid < 0) return;
    (void)hipMemsetAsync((char*)d_ws + WS_CTL, 0, CTL_ZERO_BYTES, stream);
    const float* p[20];
    for (int i = 0; i < 20; ++i) p[i] = (const float*)d_in[i];
#define MK_LAUNCH(LO, HI) hipLaunchKernelGGL(mk_fwd, dim3(grid), dim3(NTHREADS), LDS_BYTES, stream, p[0], p[1], p[2], p[3], p[4], p[5], p[6], p[7], p[8], p[9], p[10], p[11], p[12], p[13], p[14], p[15], p[16], p[17], p[18], p[19], \
        (float*)d_out, (unsigned char*)d_ws, (int)(LO), (int)(HI))
#if DBG_MODE == 1
    if (ws_size < WS_DBGEND3) { fprintf(stderr, "debug build: workspace too small\n"); return; }
    (void)hipMemsetAsync((char*)d_ws + WS_DBG, 0, 65536, stream);
    for (int ph = 0; ph <= 5; ++ph) MK_LAUNCH(ph, ph + 1);
    unsigned char* W8 = (unsigned char*)d_ws;
    hipLaunchKernelGGL(dbg_inproj, dim3(64), dim3(512), 0, stream, p[I_X], p[I_MIXG], p[I_WIN], W8);
    hipLaunchKernelGGL(dbg_sb, dim3(1), dim3(64), 0, stream, W8);
    hipLaunchKernelGGL(dbg_dsa, dim3(16), dim3(512), 0, stream, W8);
    hipLaunchKernelGGL(dbg_gla, dim3(4), dim3(512), 0, stream, p[I_GUP], p[I_GB], p[I_GNG], W8);
    hipLaunchKernelGGL(dbg_kv, dim3(64), dim3(512), 0, stream, p[I_MEM], p[I_MG], p[I_WXKV], W8, 26);
    MK_LAUNCH(6, 7);
    hipLaunchKernelGGL(dbg_merge, dim3(64), dim3(512), 0, stream, p[I_WBA], p[I_WBB], p[I_WBC], W8);
    MK_LAUNCH(7, 8);
    hipLaunchKernelGGL(dbg_resid, dim3(64), dim3(512), 0, stream, p[I_X], 0, p[I_WMIX], 1024, (size_t)WS_MERGED, (const float*)d_out, W8, 22, 0);
    MK_LAUNCH(8, 9);
    hipLaunchKernelGGL(dbg_normproj, dim3(64), dim3(512), 0, stream, (const float*)d_out, p[I_XG], p[I_WXQ], 0, W8, 25);
    hipLaunchKernelGGL(dbg_xattn, dim3(64), dim3(512), 0, stream, W8, 28);
    MK_LAUNCH(9, 10);
    hipLaunchKernelGGL(dbg_resid, dim3(64), dim3(512), 0, stream, (const float*)((char*)d_ws + WS_DBGCK), 1, p[I_WXO], 1024, (size_t)WS_AO, (const float*)d_out, W8, 29, 1);
    MK_LAUNCH(10, 11);
    hipLaunchKernelGGL(dbg_normproj, dim3(64), dim3(512), 0, stream, (const float*)d_out, p[I_FG], p[I_WFI], 1, W8, 32);
    MK_LAUNCH(11, 12);
    hipLaunchKernelGGL(dbg_resid, dim3(64), dim3(512), 0, stream, (const float*)((char*)d_ws + WS_DBGCK) + 64 * 1024, 1, p[I_WFO], DFF, (size_t)WS_HID, (const float*)d_out, W8, 33, 0);
    hipLaunchKernelGGL(dbg_encode, dim3(1024), dim3(256), 0, stream, W8, (float*)d_out, 35);
#elif N_LAUNCH_MODE == 1
    MK_LAUNCH(0, N_PHASES);
#else
    for (int ph = 0; ph < N_PHASES; ++ph) MK_LAUNCH(ph, ph + 1);
#endif
}
```

```cpp
#include <hip/hip_runtime.h>
#include <stdint.h>
#include <stdio.h>

#define LAS __attribute__((address_space(3)))
typedef unsigned short bf16_t;
typedef short bf16x8 __attribute__((ext_vector_type(8)));
typedef float f32x4 __attribute__((ext_vector_type(4)));
typedef float f32x2 __attribute__((ext_vector_type(2)));
typedef unsigned u32x4 __attribute__((ext_vector_type(4)));
typedef unsigned u32x2 __attribute__((ext_vector_type(2)));
typedef short s16x4 __attribute__((ext_vector_type(4)));

#ifndef DBG_MODE
#define DBG_MODE 0
#endif
#ifndef STAMP_A
#define STAMP_A 0
#endif
#define STAMP_MUL 4
#ifndef ONLY
#define ONLY -1
#endif
#define PH_EN(k) (ONLY < 0 || ONLY == (k))
#ifndef N_LAUNCH_MODE
#define N_LAUNCH_MODE 1
#endif

constexpr int S_ = 16384, D_ = 1024, NIN = 5376, INW = 5332, DFF = 2816, NFF = 5632, NMEM = 256, DEPTH = 4;
constexpr int NTHREADS = 512;
constexpr int LDS_BYTES = 147456;
constexpr int MISC_OFF = 143360;
constexpr float EPS = 1e-6f;
constexpr float LOG2E = 1.4426950408889634f;
constexpr float SBQ_SCALE = 0.125f * LOG2E;
constexpr float DSQ_SCALE = 0.125f * LOG2E;
constexpr float IXQ_SCALE = 0.125f;
constexpr float GLQ_SCALE = 0.17677669529663687f;
constexpr float XQ_SCALE = 0.0625f * LOG2E;

constexpr size_t MB = 1u << 20;
constexpr size_t WS_CTL = 0;
constexpr size_t WS_CS = 65536;
constexpr size_t WS_SSQ = WS_CS + 4 * MB;
constexpr size_t WS_MEMB = WS_SSQ + 1 * MB;
constexpr size_t WS_RSTDM = WS_MEMB + 512 * 1024;
constexpr size_t WS_KM = WS_RSTDM + 4096;
constexpr size_t WS_VMT = WS_KM + 512 * 1024;
constexpr size_t WS_WIN = WS_VMT + 512 * 1024;
constexpr size_t WS_WBR = WS_WIN + (size_t)NIN * 1024 * 2;
constexpr size_t WS_WMIX = WS_WBR + 3 * 1024 * 256 * 2;
constexpr size_t WS_WXQ = WS_WMIX + 2 * MB;
constexpr size_t WS_WXKV = WS_WXQ + 2 * MB;
constexpr size_t WS_WXO = WS_WXKV + 4 * MB;
constexpr size_t WS_WFI = WS_WXO + 2 * MB;
constexpr size_t WS_WFO = WS_WFI + (size_t)NFF * 1024 * 2;
constexpr size_t WS_XB = WS_WFO + (size_t)1024 * DFF * 2;
constexpr size_t WS_SBQ = WS_XB + 32 * MB;
constexpr size_t WS_SBK = WS_SBQ + 8 * MB;
constexpr size_t WS_SBV = WS_SBK + 8 * MB;
constexpr size_t WS_DSQ = WS_SBV + 8 * MB;
constexpr size_t WS_IXQ = WS_DSQ + 8 * MB;
constexpr size_t WS_DSK = WS_IXQ + 8 * MB;
constexpr size_t WS_IXK = WS_DSK + 2 * MB;
constexpr size_t WS_DSV = WS_IXK + 2 * MB;
constexpr size_t WS_SMALL = WS_DSV + 2 * MB;
constexpr size_t WS_GLQ = WS_SMALL + 4 * MB;
constexpr size_t WS_GLK = WS_GLQ + 4 * MB;
constexpr size_t WS_GLV = WS_GLK + 4 * MB;
constexpr size_t WS_GLO = WS_GLV + 8 * MB;
constexpr size_t WS_OA = WS_GLO + 8 * MB;
constexpr size_t WS_OB = WS_OA + 8 * MB;
constexpr size_t WS_OC = WS_OB + 8 * MB;
constexpr size_t WS_BC = WS_OC + 8 * MB;
constexpr size_t WS_UC = WS_BC + 8 * MB;
constexpr size_t WS_ST = WS_UC + 8 * MB;
constexpr size_t WS_AC = WS_ST + 8 * MB;
constexpr size_t WS_SBVT = WS_AC + 128 * 1024;
constexpr size_t WS_GLVT = WS_SBVT + 8 * MB;
constexpr size_t WS_MERGED = WS_GLVT + 8 * MB;
constexpr size_t WS_GATES = WS_MERGED + 32 * MB;
constexpr size_t WS_XQ = WS_GATES;
constexpr size_t WS_AO = WS_GATES + 32 * MB;
constexpr size_t WS_HID = WS_GATES;
constexpr size_t WS_END = WS_GATES + 96 * MB;
constexpr size_t WS_DBG = WS_END;
constexpr size_t WS_DBGSEL = WS_DBG + 65536;
constexpr size_t WS_DBGEND = WS_DBGSEL + 8 * MB;
constexpr size_t CTL_ZERO_BYTES = 65536;
constexpr int CW_BAR = 0;
constexpr int CW_QUEUE = 4096;

typedef __bf16 bf16x2_t __attribute__((ext_vector_type(2)));
__device__ __forceinline__ unsigned cvt_pk_bf16(float lo, float hi) { const f32x2 v = {lo, hi}; return __builtin_bit_cast(unsigned, __builtin_convertvector(v, bf16x2_t)); }
__device__ __forceinline__ bf16_t f2bf(float f) { return (bf16_t)(cvt_pk_bf16(f, 0.f) & 0xffffu); }
__device__ __forceinline__ float bf2f(unsigned b) { return __uint_as_float(b << 16); }
__device__ __forceinline__ float bflo(unsigned w) { return __uint_as_float(w << 16); }
__device__ __forceinline__ float bfhi(unsigned w) { return __uint_as_float(w & 0xffff0000u); }
__device__ __forceinline__ void st_bf16x8(bf16_t* p, const float (&v)[8]) {
    u32x4 w; w.x = cvt_pk_bf16(v[0], v[1]); w.y = cvt_pk_bf16(v[2], v[3]); w.z = cvt_pk_bf16(v[4], v[5]); w.w = cvt_pk_bf16(v[6], v[7]); *(u32x4*)p = w; }
__device__ __forceinline__ void ld_bf16x8(const bf16_t* p, float (&v)[8]) {
    const u32x4 w = *(const u32x4*)p; v[0] = bflo(w.x); v[1] = bfhi(w.x); v[2] = bflo(w.y); v[3] = bfhi(w.y); v[4] = bflo(w.z); v[5] = bfhi(w.z); v[6] = bflo(w.w); v[7] = bfhi(w.w); }
__device__ __forceinline__ float row_rstd(const float* ssq, int r) {
    const f32x4* p = (const f32x4*)(ssq + (size_t)r * 16); const f32x4 a = p[0], b = p[1], c = p[2], d = p[3];
    const float s = ((a.x + a.y) + (a.z + a.w)) + ((b.x + b.y) + (b.z + b.w)) + ((c.x + c.y) + (c.z + c.w)) + ((d.x + d.y) + (d.z + d.w));
    return rsqrtf(s * (1.0f / 1024.0f) + EPS); }
__device__ __forceinline__ float sigmoidf_(float v) { return __builtin_amdgcn_rcpf(1.0f + __builtin_amdgcn_exp2f(-v * LOG2E)); }
__device__ __forceinline__ float shx(float v, int m, int lane) { return __int_as_float(__builtin_amdgcn_ds_bpermute((lane ^ m) << 2, __float_as_int(v))); }
__device__ __forceinline__ unsigned shdn(unsigned v, int off, int lane) { return (unsigned)__builtin_amdgcn_ds_bpermute((lane + off) << 2, (int)v); }
__device__ __forceinline__ float wave_sum(float v, int lane) { for (int o = 32; o >= 1; o >>= 1) v += shx(v, o, lane); return v; }
__device__ __forceinline__ float wave_max(float v, int lane) { for (int o = 32; o >= 1; o >>= 1) v = fmaxf(v, shx(v, o, lane)); return v; }

__device__ __forceinline__ int mytid(int wave) { int lane; asm volatile("v_mbcnt_lo_u32_b32 %0, -1, 0\n\tv_mbcnt_hi_u32_b32 %0, -1, %0" : "=v"(lane)); asm volatile("" : "+s"(wave)); return wave * 64 + lane; }

#define XB_TMO      128
#define XB_XCNT(j)  (256  + 64 * (j))
#define XB_XSUB(j)  (1280 + 64 * (j))
#define XB_XGEN(j)  (2304 + 64 * (j))
#define XB_TOP      3328
#define XB_TOPGEN   3392
#define XCD_BAR_WORDS 3456
#define XB_SPIN_CAP (1u << 22)
__device__ __forceinline__ unsigned xb_ld(unsigned* p)              { return __hip_atomic_load(p, __ATOMIC_RELAXED, __HIP_MEMORY_SCOPE_AGENT); }
__device__ __forceinline__ unsigned xb_add(unsigned* p, unsigned v) { return __hip_atomic_fetch_add(p, v, __ATOMIC_RELAXED, __HIP_MEMORY_SCOPE_AGENT); }
__device__ __forceinline__ unsigned xb_xcc_id() { return (unsigned)__builtin_amdgcn_s_getreg((3 << 11) | 20) & 0xFu; }
#define XB_SPIN(cond, bar) do { unsigned _sp = 0; while (cond) { __builtin_amdgcn_s_sleep(1); \
    if ((++_sp & 255u) == 0u) { if (xb_ld(&(bar)[XB_TMO])) break; if (_sp > XB_SPIN_CAP) { atomicAdd(&(bar)[XB_TMO], 1u); break; } } } } while (0)
struct XcdBarrier { unsigned* bar; unsigned x; volatile LAS unsigned* st; };
__device__ __forceinline__ XcdBarrier xcd_barrier_post(unsigned* bar, volatile LAS unsigned* st, int wave_s) {
    XcdBarrier b; b.bar = bar; b.x = xb_xcc_id(); b.st = st;
    if (mytid(wave_s) == 0) (void)xb_add(&bar[XB_XCNT(b.x)], 1u);
    return b;
}
__device__ __forceinline__ void xcd_barrier_complete(unsigned* bar, unsigned x, unsigned& nloc, unsigned& nx) {
    const unsigned G = gridDim.x * gridDim.y * gridDim.z;
    unsigned sum, cnt, mine, sp = 0u;
    for (;;) {
        sum = 0u; cnt = 0u; mine = 0u;
#pragma unroll
        for (unsigned j = 0; j < 16; ++j) { const unsigned c = xb_ld(&bar[XB_XCNT(j)]); sum += c; cnt += (c > 0u) ? 1u : 0u; mine = (j == x) ? c : mine; }
        if (sum == G) break;
        __builtin_amdgcn_s_sleep(1);
        if ((++sp & 255u) == 0u) { if (xb_ld(&bar[XB_TMO])) break; if (sp > XB_SPIN_CAP) { atomicAdd(&bar[XB_TMO], 1u); break; } }
    }
    nloc = mine > 0u ? mine : 1u; nx = cnt > 0u ? cnt : 1u;
}
__device__ __forceinline__ void xcd_barrier(const XcdBarrier& b, int wave_s) {
    asm volatile("s_waitcnt vmcnt(0)" ::: "memory");
    __syncthreads();
    if (mytid(wave_s) == 0) {
        unsigned* bar = b.bar;
        __builtin_amdgcn_s_waitcnt(0);
        unsigned nloc = b.st[0], nx = b.st[1];
        if (nloc == 0u) { xcd_barrier_complete(bar, b.x, nloc, nx); b.st[0] = nloc; b.st[1] = nx; }
        const unsigned old = xb_add(&bar[XB_XSUB(b.x)], 1u);
        const unsigned gen = old / nloc;
        if (old + 1u == (gen + 1u) * nloc) {
            __builtin_amdgcn_fence(__ATOMIC_RELEASE, "agent");
            asm volatile("s_waitcnt vmcnt(0)" ::: "memory");
            const unsigned og = xb_add(&bar[XB_TOP], 1u);
            const unsigned tg = og / nx;
            if (og + 1u == (tg + 1u) * nx) xb_add(&bar[XB_TOPGEN], 1u);
            else XB_SPIN(xb_ld(&bar[XB_TOPGEN]) == tg, bar);
            __builtin_amdgcn_fence(__ATOMIC_ACQUIRE, "agent");
            xb_add(&bar[XB_XGEN(b.x)], 1u);
            asm volatile("s_waitcnt vmcnt(0)" ::: "memory");
        } else {
            XB_SPIN(xb_ld(&bar[XB_XGEN(b.x)]) == gen, bar);
            __builtin_amdgcn_fence(__ATOMIC_ACQUIRE, "agent");
            asm volatile("s_waitcnt vmcnt(0)" ::: "memory");
        }
    }
    __syncthreads();
}

#if DBG_MODE == 3
#define TICKR(ring_, wave_, i) do { if (blockIdx.x == 0 && mytid(wave_) == 0) { volatile LAS unsigned long long* _a = (volatile LAS unsigned long long*)((ring_) + MISC_OFF + 2560); const unsigned long long _n = __builtin_amdgcn_s_memrealtime(); if ((i) > 0) _a[(i)] += _n - _a[0]; _a[0] = _n; } } while (0)
#else
#define TICKR(ring_, wave_, i) do { } while (0)
#endif
namespace pg8 {
constexpr int BM = 256, BK = 64, HALF = 128, HTB = HALF * BK * 2, STAGE_BYTES = 8 * HTB, NXCD = 8, WGM = 8;
__host__ __device__ __forceinline__ int lds_byte(int r, int c) { const int st = (r >> 4) * 2 + (c >> 5), rr = r & 15, cc = c & 31, ob = rr * 64 + cc * 2; return st * 1024 + (ob ^ (((ob >> 9) & 1) << 5)); }
__host__ __device__ __forceinline__ void stage_rc(int b, int& R, int& C) { const int st = b / 1024, sb = b % 1024, swz = sb ^ (((sb >> 9) & 1) << 5); R = (st >> 1) * 16 + swz / 64; C = (st & 1) * 32 + (swz % 64) / 2; }
__host__ __device__ __forceinline__ int perm32(int rho) { const int n = rho >> 4, i = rho & 15; return 8 * (i >> 2) + 4 * n + (i & 3); }
struct Unit { int pm, pn, z; };
struct Gemm { const bf16_t* A; const bf16_t* Bt; int M, N, K; size_t azstep, bzstep; };
struct StaticOrder {
    int nM, nN, nwg, G, c;
    __host__ __device__ void init(int M, int N, int G_, int c_) { nM = M / BM; nN = N / BM; nwg = nM * nN; G = G_; c = c_; }
    __host__ __device__ bool next(int i, Unit& u) const {
        const long L = (long)i * G + c; if (L >= nwg) return false;
        int wgid = (int)L; { const int q = nwg / NXCD, r = nwg % NXCD, xcd = wgid % NXCD, off = wgid / NXCD; wgid = (xcd < r ? xcd * (q + 1) : r * (q + 1) + (xcd - r) * q) + off; }
        const int nig = WGM * nN, gid = wgid / nig, fm = gid * WGM, gsz = (nM - fm) < WGM ? (nM - fm) : WGM;
        u.pm = fm + ((wgid % nig) % gsz); u.pn = (wgid % nig) / gsz; u.z = 0; return true;
    }
    __device__ __forceinline__ void a_ready(const Unit&) const {}
    __device__ __forceinline__ void done(const Unit&) const {}
};
struct TripleOrder : StaticOrder {
    __host__ __device__ bool next(int i, Unit& u) const { const int b = i / 3; if (!StaticOrder::next(b, u)) return false; u.z = i - 3 * b; return true; }
};
template <class Epi, class Sched>
__device__ __forceinline__ void gemm_phase(LAS unsigned char* lds, const Gemm g, const Sched& S, const Epi& E, int wave_s) {
    const int tid_l = mytid(wave_s);
    const int tid = tid_l, wid = __builtin_amdgcn_readfirstlane(tid >> 6), lane = tid & 63, wr = wid >> 2, wc = wid & 3, fr = lane & 15, fq = lane >> 4;
    const int K = g.K, nt = K / BK;
    unsigned voffA[2], voffB[2];
#pragma unroll
    for (int i = 0; i < 2; ++i) { int R, C; stage_rc(tid * 16 + i * 8192, R, C); const int Rb = Epi::PERM ? ((R & ~31) + perm32(R & 31)) : R;
        voffA[i] = (unsigned)(R * K + C) * 2u; voffB[i] = (unsigned)(Rb * K + C) * 2u; }
    const size_t kstep = (size_t)(BK * 2);
    const size_t hstep = (size_t)HALF * K * 2;
    const size_t tstep = 2 * hstep;
    const unsigned ldsw = (unsigned)wid * 1024u;
    const int aoff = lds_byte(wr * 64 + fr, fq * 8), boff = lds_byte(wc * 32 + fr, fq * 8);
#define PG8_SA(b, h) (((b) * 2 + (h)) * HTB)
#define PG8_SB(b, h) ((4 + (b) * 2 + (h)) * HTB)
#define PG8_STAGE(bufoff, gbase, voff) do { _Pragma("unroll") for (int _i = 0; _i < 2; ++_i) \
        __builtin_amdgcn_global_load_lds((const unsigned*)((const char*)(gbase) + (voff)[_i]), (LAS unsigned*)(lds + (bufoff) + ldsw + _i * 8192), 16, 0, 0); } while (0)
#define PG8_LDA(dst, b, h) do { _Pragma("unroll") for (int m = 0; m < 4; ++m) _Pragma("unroll") for (int k = 0; k < 2; ++k) dst[m][k] = *(const LAS bf16x8*)(lds + PG8_SA(b, h) + aoff + m * 2048 + k * 1024); } while (0)
#define PG8_LDB(dst, b, h) do { _Pragma("unroll") for (int n = 0; n < 2; ++n) _Pragma("unroll") for (int k = 0; k < 2; ++k) dst[n][k] = *(const LAS bf16x8*)(lds + PG8_SB(b, h) + boff + n * 2048 + k * 1024); } while (0)
#define PG8_MMA(ai, bj, At, Bt) do { __builtin_amdgcn_s_setprio(1); _Pragma("unroll") for (int m = 0; m < 4; ++m) _Pragma("unroll") for (int n = 0; n < 2; ++n) _Pragma("unroll") for (int k = 0; k < 2; ++k) \
        acc[ai][bj][m][n] = __builtin_amdgcn_mfma_f32_16x16x32_bf16(Bt[n][k], At[m][k], acc[ai][bj][m][n], 0, 0, 0); __builtin_amdgcn_s_setprio(0); } while (0)
#define PG8_WAIT_V(n) asm volatile("s_waitcnt vmcnt(" #n ")" ::: "memory")
#define PG8_WAIT_L(n) asm volatile("s_waitcnt lgkmcnt(" #n ")" ::: "memory")
#define PG8_BAR __builtin_amdgcn_s_barrier()
#define PG8_SCHED __builtin_amdgcn_sched_barrier(0)
    Unit cur, nxt; int ui = 0;
    if (!S.next(0, cur)) return;
    TICKR(lds, wave_s, 0);
#if DBG_MODE == 3
    if (blockIdx.x == 0 && mytid(wave_s) == 0) ((volatile LAS unsigned long long*)(lds + MISC_OFF + 2560))[11] = clock64();
#endif
    cur.pm = __builtin_amdgcn_readfirstlane(cur.pm); cur.pn = __builtin_amdgcn_readfirstlane(cur.pn); cur.z = __builtin_amdgcn_readfirstlane(cur.z);
    f32x4 acc[2][2][4][2];
#pragma unroll
    for (int a = 0; a < 2; ++a)
#pragma unroll
        for (int b = 0; b < 2; ++b)
#pragma unroll
            for (int m = 0; m < 4; ++m)
#pragma unroll
                for (int n = 0; n < 2; ++n) acc[a][b][m][n] = (f32x4){0.f, 0.f, 0.f, 0.f};
    bf16x8 At[4][2], B0[2][2], B1[2][2];
    const char* cA = (const char*)g.A + (size_t)cur.pm * tstep + (size_t)cur.z * g.azstep; const char* cB = (const char*)g.Bt + (size_t)cur.pn * tstep + (size_t)cur.z * g.bzstep;
    S.a_ready(cur);
    PG8_STAGE(PG8_SB(0, 0), cB, voffB); PG8_STAGE(PG8_SA(0, 0), cA, voffA); PG8_STAGE(PG8_SB(0, 1), cB + hstep, voffB); PG8_STAGE(PG8_SA(0, 1), cA + hstep, voffA);
    if (wr == 1) PG8_BAR;
    PG8_WAIT_V(4); PG8_BAR;
    PG8_STAGE(PG8_SB(1, 0), cB + kstep, voffB); PG8_STAGE(PG8_SA(1, 0), cA + kstep, voffA); PG8_STAGE(PG8_SB(1, 1), cB + hstep + kstep, voffB);
    PG8_WAIT_V(6); PG8_BAR;
    for (;;) {
        const bool has_next = S.next(ui + 1, nxt);
        nxt.pm = __builtin_amdgcn_readfirstlane(nxt.pm); nxt.pn = __builtin_amdgcn_readfirstlane(nxt.pn); nxt.z = __builtin_amdgcn_readfirstlane(nxt.z);
        const char* nA = has_next ? (const char*)g.A + (size_t)nxt.pm * tstep + (size_t)nxt.z * g.azstep : cA; const char* nB = has_next ? (const char*)g.Bt + (size_t)nxt.pn * tstep + (size_t)nxt.z * g.bzstep : cB;
        for (int t = 0; t < nt; t += 2) {
            const bool last = (t == nt - 2);
            const char* a1 = cA + (size_t)(t + 1) * kstep;
            const char* a2 = last ? nA : cA + (size_t)(t + 2) * kstep; const char* b2 = last ? nB : cB + (size_t)(t + 2) * kstep;
            const char* a3 = a2 + kstep; const char* b3 = b2 + kstep;
            if (last && has_next) S.a_ready(nxt);
            PG8_LDB(B0, 0, 0); PG8_SCHED; PG8_LDA(At, 0, 0); PG8_STAGE(PG8_SA(1, 1), a1 + hstep, voffA);
            PG8_WAIT_L(8); PG8_BAR; PG8_WAIT_L(0); PG8_MMA(0, 0, At, B0); PG8_BAR; PG8_SCHED;
            PG8_LDB(B1, 0, 1); PG8_STAGE(PG8_SB(0, 0), b2, voffB);
            PG8_BAR; PG8_WAIT_L(0); PG8_MMA(0, 1, At, B1); PG8_BAR;
            PG8_LDA(At, 0, 1); PG8_STAGE(PG8_SA(0, 0), a2, voffA);
            PG8_BAR; PG8_WAIT_L(0); PG8_MMA(1, 0, At, B0); PG8_BAR; PG8_SCHED;
            PG8_STAGE(PG8_SB(0, 1), b2 + hstep, voffB);
            PG8_WAIT_V(6); PG8_BAR; PG8_MMA(1, 1, At, B1); PG8_BAR;
            PG8_LDB(B0, 1, 0); PG8_SCHED; PG8_LDA(At, 1, 0); PG8_STAGE(PG8_SA(0, 1), a2 + hstep, voffA);
            PG8_WAIT_L(8); PG8_BAR; PG8_WAIT_L(0); PG8_MMA(0, 0, At, B0); PG8_BAR; PG8_SCHED;
            PG8_LDB(B1, 1, 1); PG8_STAGE(PG8_SB(1, 0), b3, voffB);
            PG8_BAR; PG8_WAIT_L(0); PG8_MMA(0, 1, At, B1); PG8_BAR;
            PG8_LDA(At, 1, 1); PG8_STAGE(PG8_SA(1, 0), a3, voffA);
            PG8_BAR; PG8_WAIT_L(0); PG8_MMA(1, 0, At, B0); PG8_BAR; PG8_SCHED;
            PG8_STAGE(PG8_SB(1, 1), b3 + hstep, voffB);
            PG8_WAIT_V(6); PG8_BAR; PG8_MMA(1, 1, At, B1); PG8_BAR;
        }
        TICKR(lds, wave_s, 8);
#if DBG_MODE == 3
        if (blockIdx.x == 0 && mytid(wave_s) == 0) { volatile LAS unsigned long long* _a = (volatile LAS unsigned long long*)(lds + MISC_OFF + 2560); const unsigned long long _c = clock64(); _a[10] += _c - _a[11]; }
#endif
        { const int l2 = mytid(wave_s) & 63; E(acc, cur, wr, wc, l2 >> 2, l2 & 3); }
        TICKR(lds, wave_s, 9);
#if DBG_MODE == 3
        if (blockIdx.x == 0 && mytid(wave_s) == 0) ((volatile LAS unsigned long long*)(lds + MISC_OFF + 2560))[11] = clock64();
#endif
        if (!has_next) break;
        if (!E.keep(cur)) {
#pragma unroll
        for (int a = 0; a < 2; ++a)
#pragma unroll
            for (int b = 0; b < 2; ++b)
#pragma unroll
                for (int m = 0; m < 4; ++m)
#pragma unroll
                    for (int n = 0; n < 2; ++n) acc[a][b][m][n] = (f32x4){0.f, 0.f, 0.f, 0.f};
        }
        cur = nxt; cA = nA; cB = nB; ++ui;
    }
    PG8_WAIT_V(0);
    if (wr == 0) PG8_BAR;
    PG8_BAR;
#undef PG8_SA
#undef PG8_SB
#undef PG8_STAGE
#undef PG8_LDA
#undef PG8_LDB
#undef PG8_MMA
#undef PG8_WAIT_V
#undef PG8_WAIT_L
#undef PG8_BAR
#undef PG8_SCHED
}
}

#define GAS __attribute__((address_space(1)))
struct Args { float* out; unsigned char* ws; LAS unsigned char* ring; int wave; };
__device__ __forceinline__ unsigned char* opq(unsigned char* p) { unsigned z = 0; asm volatile("" : "+s"(z)); return p + z; }
__device__ __forceinline__ int obid() { int b = blockIdx.x; asm volatile("" : "+s"(b)); return b; }
__device__ __forceinline__ int ogrid() { int b = gridDim.x; asm volatile("" : "+s"(b)); return b; }
constexpr int ARGV_OFF = MISC_OFF + 3072;
__device__ __forceinline__ const GAS float* ldarg(const Args& A, int i) {
    volatile LAS unsigned* p = (volatile LAS unsigned*)(A.ring + ARGV_OFF) + 2 * i; unsigned lo = p[0], hi = p[1];
    lo = __builtin_amdgcn_readfirstlane(lo); hi = __builtin_amdgcn_readfirstlane(hi);
    return (const GAS float*)(((unsigned long long)hi << 32) | lo); }
#if DBG_MODE == 3
#define TICK(A_, i) do { if (obid() == 0 && mytid((A_).wave) == 0) { volatile LAS unsigned long long* _a = (volatile LAS unsigned long long*)((A_).ring + MISC_OFF + 2560); const unsigned long long _n = __builtin_amdgcn_s_memrealtime(); if ((i) > 0) _a[(i)] += _n - _a[0]; _a[0] = _n; } } while (0)
#else
#define TICK(A_, i) do { } while (0)
#endif
enum { I_X = 0, I_MEM, I_MIXG, I_WIN, I_GUP, I_GB, I_GNG, I_WBA, I_WBB, I_WBC, I_WMIX, I_XG, I_MG, I_WXQ, I_WXKV, I_WXO, I_FG, I_WFI, I_WFO, I_FING };

typedef f32x4 (&AccRef)[2][2][4][2];
#define EPI_XPOSE(a_, b_) do { const int xa_ = (fq * 16 + fr) << 2; _Pragma("unroll") for (int i = 0; i < 8; ++i) { a_[i] = __int_as_float(__builtin_amdgcn_ds_bpermute(xa_, __float_as_int(a_[i]))); b_[i] = __int_as_float(__builtin_amdgcn_ds_bpermute(xa_, __float_as_int(b_[i]))); } } while (0)
#define EPI_ROWS_BEGIN _Pragma("unroll") for (int ai = 0; ai < 2; ++ai) _Pragma("unroll") for (int m = 0; m < 4; ++m) { \
    const int r = u.pm * 256 + ai * 128 + wr * 64 + m * 16 + fr; float a[8], b[8]; \
    _Pragma("unroll") for (int i = 0; i < 8; ++i) { a[i] = acc[ai][0][m][i >> 2][i & 3]; b[i] = acc[ai][1][m][i >> 2][i & 3]; } EPI_XPOSE(a, b);
#define EPI_ROWS_END asm volatile("" ::: "memory"); }

#define EPI_AB(ai_, m_) float a[8], b[8]; _Pragma("unroll") for (int i = 0; i < 8; ++i) { a[i] = acc[ai_][0][m_][i >> 2][i & 3]; b[i] = acc[ai_][1][m_][i >> 2][i & 3]; } EPI_XPOSE(a, b);
#define EPI_ROWOF(ai_, m_) (u.pm * 256 + (ai_) * 128 + wr * 64 + (m_) * 16 + fr)
#define EPI_RSTD4(ssq_, ai_, rs_) do { f32x4 q_[4]; _Pragma("unroll") for (int m = 0; m < 4; ++m) q_[m] = *(const f32x4*)((ssq_) + (size_t)EPI_ROWOF(ai_, m) * 16 + 4 * fq);        \
    _Pragma("unroll") for (int m = 0; m < 4; ++m) { float t_ = (q_[m].x + q_[m].y) + (q_[m].z + q_[m].w); t_ += shx(t_, 1, 4 * fr + fq); t_ += shx(t_, 2, 4 * fr + fq); rs_[m] = rsqrtf(t_ * (1.0f / 1024.0f) + EPS); } } while (0)
#define EPI_AB0(ai_, m_) float a[8], b[8]; _Pragma("unroll") for (int i = 0; i < 8; ++i) { a[i] = acc[ai_][0][m_][i >> 2][i & 3]; b[i] = acc[ai_][1][m_][i >> 2][i & 3]; }
#define EPI_RS_ORIG(rs_, rso_) do { const int ra_ = (4 * ((4 * fr + fq) & 15)) << 2; _Pragma("unroll") for (int m = 0; m < 4; ++m) rso_[m] = __int_as_float(__builtin_amdgcn_ds_bpermute(ra_, __float_as_int(rs_[m]))); } while (0)
__device__ __forceinline__ void st_bf16x8_x(bf16_t* p, const float (&v)[8], int xa) {
    u32x4 w; w.x = (unsigned)__builtin_amdgcn_ds_bpermute(xa, (int)cvt_pk_bf16(v[0], v[1])); w.y = (unsigned)__builtin_amdgcn_ds_bpermute(xa, (int)cvt_pk_bf16(v[2], v[3]));
    w.z = (unsigned)__builtin_amdgcn_ds_bpermute(xa, (int)cvt_pk_bf16(v[4], v[5])); w.w = (unsigned)__builtin_amdgcn_ds_bpermute(xa, (int)cvt_pk_bf16(v[6], v[7])); *(u32x4*)p = w; }
struct EpiIn {
    static constexpr bool PERM = true;
    __device__ __forceinline__ bool keep(const pg8::Unit&) const { return false; }
    const float* ssq; const float* cs;
    bf16_t *sbq, *sbk, *sbv, *dsq, *ixq, *dsk, *ixk, *dsv, *glq, *glk, *glv, *glo, *gates; float* small; bf16_t* sbvt; int pn_off; bf16_t* glvt;
    __device__ __forceinline__ void operator()(AccRef acc, const pg8::Unit& u, int wr, int wc, int fr, int fq) const {
        const int pn = u.pn + pn_off;
        int mode = 0, ld = 256, off0 = wc * 32, off1 = 128 + wc * 32; float sc0 = 1.0f, sc1 = 1.0f; bf16_t* O0 = sbq; bf16_t* O1 = sbq;
        if (pn == 0) { O0 = O1 = sbq; sc0 = sc1 = SBQ_SCALE; }
        else if (pn == 1) { O0 = O1 = sbk; }
        else if (pn == 2) { O0 = O1 = sbv; }
        else if (pn == 3) { O0 = O1 = dsq; mode = 1; sc0 = sc1 = DSQ_SCALE; off0 = wc * 64; off1 = wc * 64 + 32; }
        else if (pn == 4) { O0 = O1 = ixq; mode = 1; sc0 = sc1 = IXQ_SCALE; off0 = wc * 64; off1 = wc * 64 + 32; }
        else if (pn == 5) { ld = 64; off0 = 0; off1 = 32;
            if (wc == 0) { O0 = O1 = dsk; mode = 1; } else if (wc == 1) { O0 = O1 = ixk; mode = 1; } else if (wc == 2) { O0 = O1 = dsv; } else { O0 = O1 = (bf16_t*)small; mode = 4; } }
        else if (pn == 6) { O0 = glq; O1 = glk; ld = 128; off1 = wc * 32; sc0 = GLQ_SCALE; }
        else if (pn == 7) { O0 = O1 = glv; }
        else if (pn == 8) { O0 = O1 = glo; mode = 2; }
        else { O0 = O1 = gates + (pn - 9) * 256; ld = 3072; mode = 3; }
        if (mode == 1 || mode == 4) {
#pragma unroll
        for (int ai = 0; ai < 2; ++ai) {
            float rs4[4]; EPI_RSTD4(ssq, ai, rs4);
#pragma unroll
            for (int m = 0; m < 4; ++m) { const int r = EPI_ROWOF(ai, m); EPI_AB(ai, m)
                const float rs = rs4[m];
#pragma unroll
                for (int i = 0; i < 8; ++i) { a[i] *= rs * sc0; b[i] *= rs * sc1; }
                if (mode == 1) {
                    const f32x4* cp = (const f32x4*)(cs + ((size_t)r * 32 + fq * 8) * 2);
#pragma unroll
                    for (int i2 = 0; i2 < 4; ++i2) { const f32x4 q = cp[i2];
                        const float a0 = a[2 * i2], b0 = b[2 * i2], a1 = a[2 * i2 + 1], b1 = b[2 * i2 + 1];
                        a[2 * i2] = a0 * q.x - b0 * q.y; b[2 * i2] = b0 * q.x + a0 * q.y; a[2 * i2 + 1] = a1 * q.z - b1 * q.w; b[2 * i2 + 1] = b1 * q.z + a1 * q.w; }
                }
                if (mode == 4) { float* p = (float*)O0 + (size_t)r * 64 + fq * 8;
                    *(f32x4*)p = (f32x4){a[0], a[1], a[2], a[3]}; *(f32x4*)(p + 4) = (f32x4){a[4], a[5], a[6], a[7]};
                    *(f32x4*)(p + 32) = (f32x4){b[0], b[1], b[2], b[3]}; *(f32x4*)(p + 36) = (f32x4){b[4], b[5], b[6], b[7]}; }
                else { st_bf16x8(O0 + (size_t)r * ld + off0 + fq * 8, a); st_bf16x8(O1 + (size_t)r * ld + off1 + fq * 8, b); }
            }
            asm volatile("" ::: "memory");
        }
        } else {
        const int xa = (fq * 16 + fr) << 2;
#pragma unroll
        for (int ai = 0; ai < 2; ++ai) {
            float rs4[4], rso[4]; EPI_RSTD4(ssq, ai, rs4); EPI_RS_ORIG(rs4, rso);
#pragma unroll
            for (int m = 0; m < 4; ++m) { const int r = EPI_ROWOF(ai, m); EPI_AB0(ai, m)
                const float rs = rso[m];
#pragma unroll
                for (int i = 0; i < 8; ++i) { a[i] *= rs * sc0; b[i] *= rs * sc1; }
                if (mode == 2) {
#pragma unroll
                    for (int i = 0; i < 8; ++i) { a[i] = a[i] * sigmoidf_(a[i]); b[i] = b[i] * sigmoidf_(b[i]); }
                } else if (mode == 3) {
#pragma unroll
                    for (int i = 0; i < 8; ++i) { a[i] = sigmoidf_(a[i]); b[i] = sigmoidf_(b[i]); }
                }
                st_bf16x8_x(O0 + (size_t)r * ld + off0 + fq * 8, a, xa); st_bf16x8_x(O1 + (size_t)r * ld + off1 + fq * 8, b, xa);
            }
            asm volatile("" ::: "memory");
        }
        }
    }
};
struct EpiKV {
    static constexpr bool PERM = true;
    __device__ __forceinline__ bool keep(const pg8::Unit&) const { return false; }
    const float* rstdm; bf16_t* km; bf16_t* vmt;
    __device__ __forceinline__ void operator()(AccRef acc, const pg8::Unit& u, int wr, int wc, int fr, int fq) const {
        const int c8 = wc * 32 + fq * 8, pn = u.pn;
        EPI_ROWS_BEGIN
            const float rs = rstdm[r];
#pragma unroll
            for (int i = 0; i < 8; ++i) { a[i] *= rs; b[i] *= rs; }
            if (pn < 4) { st_bf16x8(km + (size_t)r * 1024 + pn * 256 + c8, a); st_bf16x8(km + (size_t)r * 1024 + pn * 256 + 128 + c8, b); }
            else {
                const int pos = (r & ~31) + 8 * ((r >> 2) & 3) + 4 * ((r >> 4) & 1) + (r & 3);
                const int d0 = (pn - 4) * 256 + c8;
#pragma unroll
                for (int i = 0; i < 8; ++i) { vmt[(size_t)(d0 + i) * 256 + pos] = f2bf(a[i]); vmt[(size_t)(d0 + 128 + i) * 256 + pos] = f2bf(b[i]); }
            }
        EPI_ROWS_END
    }
};
struct EpiMerge {
    static constexpr bool PERM = true;
    const bf16_t* gates; bf16_t* merged;
    __device__ __forceinline__ bool keep(const pg8::Unit& u) const { return u.z < 2; }
    __device__ __forceinline__ void operator()(AccRef acc, const pg8::Unit& u, int wr, int wc, int fr, int fq) const {
        const int c = u.pn * 256 + wc * 32 + fq * 8, br = u.z;
        if (br < 2) {
            const int lane = 4 * fr + fq, ia = (4 * (lane & 15) + (lane >> 4)) << 2;
#pragma unroll
            for (int ai = 0; ai < 2; ++ai) {
                u32x4 gn[4][2], gd[4][2];
#pragma unroll
                for (int m = 0; m < 4; ++m) { const int r = EPI_ROWOF(ai, m); const bf16_t* gp = gates + (size_t)r * 3072 + br * 1024 + c;
                    gn[m][0] = *(const u32x4*)gp; gn[m][1] = *(const u32x4*)(gp + 128); gd[m][0] = *(const u32x4*)(gp + 1024); gd[m][1] = *(const u32x4*)(gp + 1024 + 128); }
#pragma unroll
                for (int m = 0; m < 4; ++m) {
#pragma unroll
                    for (int bj = 0; bj < 2; ++bj) { const unsigned n4[4] = {gn[m][bj].x, gn[m][bj].y, gn[m][bj].z, gn[m][bj].w}, d4[4] = {gd[m][bj].x, gd[m][bj].y, gd[m][bj].z, gd[m][bj].w};
#pragma unroll
                        for (int i = 0; i < 4; ++i) {
                            const float num0 = br == 0 ? bflo(n4[i]) : fmaxf(bflo(n4[i]), 1e-30f), num1 = br == 0 ? bfhi(n4[i]) : fmaxf(bfhi(n4[i]), 1e-30f);
                            float r0 = num0 * __builtin_amdgcn_rcpf(fmaxf(bflo(d4[i]), 1e-30f)), r1 = num1 * __builtin_amdgcn_rcpf(fmaxf(bfhi(d4[i]), 1e-30f));
                            r0 = __int_as_float(__builtin_amdgcn_ds_bpermute(ia, __float_as_int(r0))); r1 = __int_as_float(__builtin_amdgcn_ds_bpermute(ia, __float_as_int(r1)));
                            acc[ai][bj][m][(2 * i) >> 2][(2 * i) & 3] *= r0; acc[ai][bj][m][(2 * i + 1) >> 2][(2 * i + 1) & 3] *= r1; } } }
                asm volatile("" ::: "memory");
            }
        } else {
#pragma unroll
            for (int ai = 0; ai < 2; ++ai) {
                u32x4 gw[4][2];
#pragma unroll
                for (int m = 0; m < 4; ++m) { const int r = EPI_ROWOF(ai, m); const bf16_t* gp = gates + (size_t)r * 3072 + 2 * 1024 + c; gw[m][0] = *(const u32x4*)gp; gw[m][1] = *(const u32x4*)(gp + 128); }
#pragma unroll
                for (int m = 0; m < 4; ++m) { const int r = EPI_ROWOF(ai, m); EPI_AB(ai, m)
                    const unsigned g0[4] = {gw[m][0].x, gw[m][0].y, gw[m][0].z, gw[m][0].w}, g1[4] = {gw[m][1].x, gw[m][1].y, gw[m][1].z, gw[m][1].w};
#pragma unroll
                    for (int i = 0; i < 4; ++i) { a[2 * i] *= fmaxf(bflo(g0[i]), 1e-30f); a[2 * i + 1] *= fmaxf(bfhi(g0[i]), 1e-30f); b[2 * i] *= fmaxf(bflo(g1[i]), 1e-30f); b[2 * i + 1] *= fmaxf(bfhi(g1[i]), 1e-30f); }
                    bf16_t* mp = merged + (size_t)r * 1024 + c; st_bf16x8(mp, a); st_bf16x8(mp + 128, b); }
                asm volatile("" ::: "memory");
            }
        }
    }
};
struct EpiRes {
    static constexpr bool PERM = true;
    __device__ __forceinline__ bool keep(const pg8::Unit&) const { return false; }
    float* x; bf16_t* xb; float* ssq;
    __device__ __forceinline__ void operator()(AccRef acc, const pg8::Unit& u, int wr, int wc, int fr, int fq) const {
        const int c8 = wc * 32 + fq * 8;
#pragma unroll
        for (int ai = 0; ai < 2; ++ai) {
            u32x4 xv[4][2];
#pragma unroll
            for (int m = 0; m < 4; ++m) { const bf16_t* xp = xb + (size_t)EPI_ROWOF(ai, m) * 1024 + u.pn * 256 + c8; xv[m][0] = *(const u32x4*)xp; xv[m][1] = *(const u32x4*)(xp + 128); }
#pragma unroll
            for (int m = 0; m < 4; ++m) { const int r = EPI_ROWOF(ai, m); EPI_AB(ai, m)
                a[0] += bflo(xv[m][0].x); a[1] += bfhi(xv[m][0].x); a[2] += bflo(xv[m][0].y); a[3] += bfhi(xv[m][0].y); a[4] += bflo(xv[m][0].z); a[5] += bfhi(xv[m][0].z); a[6] += bflo(xv[m][0].w); a[7] += bfhi(xv[m][0].w);
                b[0] += bflo(xv[m][1].x); b[1] += bfhi(xv[m][1].x); b[2] += bflo(xv[m][1].y); b[3] += bfhi(xv[m][1].y); b[4] += bflo(xv[m][1].z); b[5] += bfhi(xv[m][1].z); b[6] += bflo(xv[m][1].w); b[7] += bfhi(xv[m][1].w);
                if (x) { float* xp = x + (size_t)r * 1024 + u.pn * 256 + c8;
                    *(f32x4*)xp = (f32x4){a[0], a[1], a[2], a[3]}; *(f32x4*)(xp + 4) = (f32x4){a[4], a[5], a[6], a[7]};
                    *(f32x4*)(xp + 128) = (f32x4){b[0], b[1], b[2], b[3]}; *(f32x4*)(xp + 132) = (f32x4){b[4], b[5], b[6], b[7]}; }
                else { bf16_t* bp = xb + (size_t)r * 1024 + u.pn * 256 + c8; st_bf16x8(bp, a); st_bf16x8(bp + 128, b); }
                float sq = 0.f;
#pragma unroll
                for (int i = 0; i < 8; ++i) sq += a[i] * a[i] + b[i] * b[i];
                sq += shx(sq, 1, 4 * fr + fq); sq += shx(sq, 2, 4 * fr + fq);
                if (fq == 0) ssq[(size_t)r * 16 + u.pn * 4 + wc] = sq; }
            asm volatile("" ::: "memory");
        }
    }
};
struct EpiXq {
    static constexpr bool PERM = true;
    __device__ __forceinline__ bool keep(const pg8::Unit&) const { return false; }
    const float* ssq; bf16_t* xq;
    __device__ __forceinline__ void operator()(AccRef acc, const pg8::Unit& u, int wr, int wc, int fr, int fq) const {
        const int c8 = wc * 32 + fq * 8, xa = (fq * 16 + fr) << 2;
#pragma unroll
        for (int ai = 0; ai < 2; ++ai) {
            float rs4[4], rso[4]; EPI_RSTD4(ssq, ai, rs4); EPI_RS_ORIG(rs4, rso);
#pragma unroll
            for (int m = 0; m < 4; ++m) { const int r = EPI_ROWOF(ai, m); EPI_AB0(ai, m)
                const float rs = rso[m] * XQ_SCALE;
#pragma unroll
                for (int i = 0; i < 8; ++i) { a[i] *= rs; b[i] *= rs; }
                bf16_t* O = xq + (size_t)r * 1024 + u.pn * 256 + c8; st_bf16x8_x(O, a, xa); st_bf16x8_x(O + 128, b, xa); }
            asm volatile("" ::: "memory");
        }
    }
};
struct EpiFfnIn {
    static constexpr bool PERM = true;
    __device__ __forceinline__ bool keep(const pg8::Unit&) const { return false; }
    const float* ssq; bf16_t* hid;
    __device__ __forceinline__ void operator()(AccRef acc, const pg8::Unit& u, int wr, int wc, int fr, int fq) const {
        const int c8 = wc * 32 + fq * 8, xa = (fq * 16 + fr) << 2;
#pragma unroll
        for (int ai = 0; ai < 2; ++ai) {
            float rs4[4], rso[4]; EPI_RSTD4(ssq, ai, rs4); EPI_RS_ORIG(rs4, rso);
#pragma unroll
            for (int m = 0; m < 4; ++m) { const int r = EPI_ROWOF(ai, m); EPI_AB0(ai, m)
                const float rs = rso[m];
#pragma unroll
                for (int i = 0; i < 8; ++i) { const float g = a[i] * rs, up = b[i] * rs; a[i] = g * sigmoidf_(g) * up; }
                st_bf16x8_x(hid + (size_t)r * DFF + u.pn * 128 + c8, a, xa); }
            asm volatile("" ::: "memory");
        }
    }
};

__device__ __forceinline__ int nlog_win(int n) {
    const int t = n >> 8, p = n & 255;
    if (t < 3) return n;
    if (t == 3 || t == 4) { const int bj = p >> 7, hh = (p & 127) >> 5, dd = p & 31; return (t == 3 ? 768 : 1152) + 64 * hh + 32 * bj + dd; }
    if (t == 5) { const int bj = p >> 7, g = (p & 127) >> 5, dd = p & 31, j = 32 * bj + dd;
        if (g == 0) return 1024 + j; if (g == 1) return 1408 + j; if (g == 2) return 1088 + j;
        if (j < 4) return 1472 + j; if (j < 20) return 1988 + (j - 4); return -1; }
    if (t == 6) return (p < 128) ? 1476 + p : 1604 + (p - 128);
    if (t == 7) return 1732 + p;
    if (t == 8) return 2004 + p;
    return 2260 + (t - 9) * 256 + p;
}
__device__ __forceinline__ int nlog_ffn(int n) { const int j = n >> 8, p = n & 255; return (p >> 7) * DFF + 128 * j + (p & 127); }
struct ConvJob { const GAS float* W; const GAS float* gain; bf16_t* Bt; int ldw, K, map, kt, ns; };
__device__ __forceinline__ ConvJob conv_job(const Args& A, unsigned char* ws, int l, int t) {
    ConvJob j; int tt = t; j.gain = nullptr; j.map = 0;
    if (tt < 336) { j.W = ldarg(A, I_WIN) + (size_t)l * 1024 * INW; j.ldw = INW; j.K = 1024; j.map = 1; j.gain = ldarg(A, I_MIXG) + l * 1024; j.Bt = (bf16_t*)(ws + WS_WIN); j.kt = tt & 15; j.ns = tt >> 4; }
    else if ((tt -= 336) < 128) { j.W = ldarg(A, I_WXKV) + (size_t)l * 2097152; j.ldw = 2048; j.K = 1024; j.gain = ldarg(A, I_MG) + l * 1024; j.Bt = (bf16_t*)(ws + WS_WXKV); j.kt = tt & 15; j.ns = tt >> 4; }
    else if ((tt -= 128) < 48) { const int b = tt >> 4, q = tt & 15; const GAS float* w0 = ldarg(A, I_WBA); const GAS float* w1 = ldarg(A, I_WBB); const GAS float* w2 = ldarg(A, I_WBC); j.W = (b == 0 ? w0 : (b == 1 ? w1 : w2)) + (size_t)l * 256 * 1024; j.ldw = 1024; j.K = 256; j.Bt = (bf16_t*)(ws + WS_WBR) + (size_t)b * 262144; j.kt = q & 3; j.ns = q >> 2; }
    else if ((tt -= 48) < 64) { j.W = ldarg(A, I_WMIX) + (size_t)l * 1048576; j.ldw = 1024; j.K = 1024; j.Bt = (bf16_t*)(ws + WS_WMIX); j.kt = tt & 15; j.ns = tt >> 4; }
    else if ((tt -= 64) < 64) { j.W = ldarg(A, I_WXQ) + (size_t)l * 1048576; j.ldw = 1024; j.K = 1024; j.gain = ldarg(A, I_XG) + l * 1024; j.Bt = (bf16_t*)(ws + WS_WXQ); j.kt = tt & 15; j.ns = tt >> 4; }
    else if ((tt -= 64) < 64) { j.W = ldarg(A, I_WXO) + (size_t)l * 1048576; j.ldw = 1024; j.K = 1024; j.Bt = (bf16_t*)(ws + WS_WXO); j.kt = tt & 15; j.ns = tt >> 4; }
    else if ((tt -= 64) < 352) { j.W = ldarg(A, I_WFI) + (size_t)l * 1024 * NFF; j.ldw = NFF; j.K = 1024; j.map = 2; j.gain = ldarg(A, I_FG) + l * 1024; j.Bt = (bf16_t*)(ws + WS_WFI); j.kt = tt & 15; j.ns = tt >> 4; }
    else { tt -= 352; j.W = ldarg(A, I_WFO) + (size_t)l * DFF * 1024; j.ldw = 1024; j.K = DFF; j.Bt = (bf16_t*)(ws + WS_WFO); j.kt = tt % 44; j.ns = tt / 44; }
    return j;
}
#define CONV_LOAD(j_, v_, g_) do { const int nn_ = tid & 255, kq_ = tid >> 8, n_ = (j_).ns * 256 + nn_; const int nl_ = (j_).map == 0 ? n_ : ((j_).map == 1 ? nlog_win(n_) : nlog_ffn(n_)); \
        _Pragma("unroll") for (int i = 0; i < 32; ++i) { const int kk_ = (j_).kt * 64 + kq_ + 2 * i; v_[i] = nl_ >= 0 ? (j_).W[(size_t)kk_ * (j_).ldw + nl_] : 0.f; g_[i] = (j_).gain ? (j_).gain[kk_] : 1.0f; } } while (0)
#define CONV_WRITE(tile_, v_, g_) do { const int nn_ = tid & 255, kq_ = tid >> 8; _Pragma("unroll") for (int i = 0; i < 32; ++i) (tile_)[(kq_ + 2 * i) * 257 + nn_] = v_[i] * g_[i]; } while (0)
#define CONV_STORE(tile_, j_) do { const int nn_ = tid >> 1, kh_ = tid & 1; _Pragma("unroll") for (int jj = 0; jj < 4; ++jj) { float o_[8]; \
        _Pragma("unroll") for (int i = 0; i < 8; ++i) o_[i] = (tile_)[(32 * kh_ + 8 * jj + i) * 257 + nn_]; \
        st_bf16x8((j_).Bt + (size_t)((j_).ns * 256 + nn_) * (j_).K + (j_).kt * 64 + 32 * kh_ + 8 * jj, o_); } } while (0)
constexpr int CONV_EARLY = 704, CONV_ALL = 1232;
__device__ __forceinline__ void conv_range(LAS unsigned char* lds, const Args& A, int l, int first, int end, int widx, int nw) {
    unsigned char* ws = opq(A.ws);
    const int Gl = nw, tid = mytid(A.wave);
    LAS float* t0 = (LAS float*)lds; LAS float* t1 = (LAS float*)(lds + 65792);
    float va[32], ga[32], vb[32], gb[32];
    int t = first + widx; if (t >= end) return;
    ConvJob ja = conv_job(A, ws, l, t), jb = ja;
    CONV_LOAD(ja, va, ga);
    for (;;) {
        CONV_WRITE(t0, va, ga);
        const bool hb = t + Gl < end; if (hb) { jb = conv_job(A, ws, l, t + Gl); CONV_LOAD(jb, vb, gb); }
        __syncthreads();
        CONV_STORE(t0, ja);
        if (!hb) break;
        t += Gl;
        CONV_WRITE(t1, vb, gb);
        const bool ha = t + Gl < end; if (ha) { ja = conv_job(A, ws, l, t + Gl); CONV_LOAD(ja, va, ga); }
        __syncthreads();
        CONV_STORE(t1, jb);
        if (!ha) break;
        t += Gl;
    }
    __syncthreads();
}
#undef CONV_LOAD
#undef CONV_WRITE
#undef CONV_STORE

__constant__ float c_inv_freq[32] = {1.000000000e+00f, 7.498942018e-01f, 5.623413324e-01f, 4.216965139e-01f, 3.162277639e-01f, 2.371373922e-01f, 1.778279394e-01f, 1.333521456e-01f,
    1.000000015e-01f, 7.498941571e-02f, 5.623412877e-02f, 4.216964915e-02f, 3.162277862e-02f, 2.371373586e-02f, 1.778279431e-02f, 1.333521493e-02f,
    9.999999776e-03f, 7.498942316e-03f, 5.623413250e-03f, 4.216964822e-03f, 3.162277862e-03f, 2.371373819e-03f, 1.778279431e-03f, 1.333521446e-03f,
    1.000000047e-03f, 7.498941850e-04f, 5.623413017e-04f, 4.216965463e-04f, 3.162277862e-04f, 2.371373848e-04f, 1.778279402e-04f, 1.333521504e-04f};
__device__ __forceinline__ void prologue(LAS unsigned char* lds, const Args& A) {
    unsigned char* ws = opq(A.ws); const int tid = mytid(A.wave), lane = tid & 63, wave = tid >> 6; const int bid = obid(), Gl = ogrid();
    { const GAS float* x = ldarg(A, I_X); bf16_t* xb = (bf16_t*)(ws + WS_XB); float* ssq = (float*)(ws + WS_SSQ);
      for (int r = bid * 8 + wave; r < S_; r += Gl * 8) {
          const GAS float* xr = x + (size_t)r * 1024 + lane * 16; float v[16]; float sq = 0.f;
#pragma unroll
          for (int i = 0; i < 4; ++i) { const f32x4 q = *(const GAS f32x4*)(xr + 4 * i); v[4 * i] = q.x; v[4 * i + 1] = q.y; v[4 * i + 2] = q.z; v[4 * i + 3] = q.w; }
#pragma unroll
          for (int i = 0; i < 16; ++i) sq += v[i] * v[i];
          sq = wave_sum(sq, lane);
          float v0[8], v1[8];
#pragma unroll
          for (int i = 0; i < 8; ++i) { v0[i] = v[i]; v1[i] = v[8 + i]; }
          st_bf16x8(xb + (size_t)r * 1024 + lane * 16, v0); st_bf16x8(xb + (size_t)r * 1024 + lane * 16 + 8, v1);
          if (lane < 16) ssq[(size_t)r * 16 + lane] = lane == 0 ? sq : 0.f;
      } }
    { const GAS float* mem = ldarg(A, I_MEM); bf16_t* memb = (bf16_t*)(ws + WS_MEMB); float* rstdm = (float*)(ws + WS_RSTDM);
      for (int r = bid * 8 + wave; r < NMEM; r += Gl * 8) {
          const GAS float* xr = mem + (size_t)r * 1024 + lane * 16; float v0[8], v1[8]; float sq = 0.f;
#pragma unroll
          for (int i = 0; i < 8; ++i) { v0[i] = xr[i]; v1[i] = xr[8 + i]; sq += v0[i] * v0[i] + v1[i] * v1[i]; }
          sq = wave_sum(sq, lane);
          st_bf16x8(memb + (size_t)r * 1024 + lane * 16, v0); st_bf16x8(memb + (size_t)r * 1024 + lane * 16 + 8, v1);
          if (lane == 0) rstdm[r] = rsqrtf(sq * (1.0f / 1024.0f) + EPS);
      } }
    { float* cs = (float*)(ws + WS_CS);
      for (int i = bid * NTHREADS + tid; i < S_ * 32; i += Gl * NTHREADS) {
          const int pos = i >> 5, dd = i & 31; const float angf = (float)pos * c_inv_freq[dd]; const double a = (double)angf;
          const double kk = rint(a * 0.63661977236758134); double rr = fma(-kk, 1.5707963267948966, a); rr = fma(-kk, 6.123233995736766e-17, rr);
          const double r2 = rr * rr;
          const double sn = rr * (1.0 + r2 * (-1.0 / 6 + r2 * (1.0 / 120 + r2 * (-1.0 / 5040 + r2 * (1.0 / 362880 + r2 * (-1.0 / 39916800 + r2 * (1.0 / 6227020800.0)))))));
          const double cn = 1.0 + r2 * (-0.5 + r2 * (1.0 / 24 + r2 * (-1.0 / 720 + r2 * (1.0 / 40320 + r2 * (-1.0 / 3628800 + r2 * (1.0 / 479001600.0))))));
          const int q = ((int)kk) & 3; double c, s;
          if (q == 0) { c = cn; s = sn; } else if (q == 1) { c = -sn; s = cn; } else if (q == 2) { c = -cn; s = -sn; } else { c = sn; s = -cn; }
          cs[2 * i] = (float)c; cs[2 * i + 1] = (float)s;
      } }
}

__device__ __forceinline__ void sb_unit(LAS unsigned char* lds, const Args& A, int u) {
    unsigned char* ws = opq(A.ws); const int tid_l = mytid(A.wave); const int tid = tid_l, lane = tid & 63, wave = __builtin_amdgcn_readfirstlane(tid >> 6), fr = lane & 15, fq = lane >> 4;
    const bf16_t* Q = (const bf16_t*)(ws + WS_SBQ); const bf16_t* Kp = (const bf16_t*)(ws + WS_SBK); const bf16_t* Vp = (const bf16_t*)(ws + WS_SBV); bf16_t* O = (bf16_t*)(ws + WS_OA);
    LAS unsigned char* vst = lds + wave * 4608;
    const int vrow = 8 * ((lane >> 3) & 3) + 4 * ((lane >> 5) & 1) + ((lane >> 1) & 3), vhalf = lane & 1;
    const int h = wave & 3, qw = u * 128 + 64 * (wave >> 2);
    bf16x8 qf[4][2];
#pragma unroll
    for (int g = 0; g < 4; ++g)
#pragma unroll
        for (int s = 0; s < 2; ++s) qf[g][s] = *(const bf16x8*)(Q + (size_t)(qw + 16 * g + fr) * 256 + 64 * h + 32 * s + 8 * fq);
    f32x4 oacc[4][4];
#pragma unroll
    for (int g = 0; g < 4; ++g)
#pragma unroll
        for (int dg = 0; dg < 4; ++dg) oacc[g][dg] = (f32x4){0.f, 0.f, 0.f, 0.f};
    float runp[4] = {1.f, 1.f, 1.f, 1.f};
    const bool inc1 = (fq & 1) == 0, inc2 = (fq & 2) == 0, inc3 = (fq & 2) == 0;
    const int a1 = (lane ^ 16) << 2, a2 = (lane ^ 32) << 2, a3 = (lane ^ 48) << 2;
    bf16x8 nkf[2][2]; u32x4 nvr[4];
#define SB_LOAD(kb_) do { _Pragma("unroll") for (int a_ = 0; a_ < 2; ++a_) _Pragma("unroll") for (int s_ = 0; s_ < 2; ++s_) nkf[a_][s_] = *(const bf16x8*)(Kp + (size_t)((kb_) + 16 * a_ + fr) * 256 + 64 * h + 32 * s_ + 8 * fq); \
        _Pragma("unroll") for (int i_ = 0; i_ < 4; ++i_) nvr[i_] = *(const u32x4*)(Vp + (size_t)((kb_) + (lane >> 1)) * 256 + 64 * h + 32 * vhalf + 8 * i_); } while (0)
    SB_LOAD(qw + 32);
    for (int kb = qw + 32; kb >= 0; kb -= 32) {
        bf16x8 kf[2][2], vf[4];
#pragma unroll
        for (int a_ = 0; a_ < 2; ++a_)
#pragma unroll
            for (int s_ = 0; s_ < 2; ++s_) kf[a_][s_] = nkf[a_][s_];
#pragma unroll
        for (int i = 0; i < 4; ++i) *(LAS u32x4*)(vst + vrow * 144 + 64 * vhalf + 16 * i) = nvr[i];
        if (kb >= 32) SB_LOAD(kb - 32);
#pragma unroll
        for (int dg = 0; dg < 4; ++dg) { const s16x4 lo_ = __builtin_amdgcn_ds_read_tr16_b64_v4i16((LAS s16x4*)(vst + (8 * fq + (fr >> 2)) * 144 + 32 * dg + 8 * (fr & 3)));
            const s16x4 hi_ = __builtin_amdgcn_ds_read_tr16_b64_v4i16((LAS s16x4*)(vst + (8 * fq + 4 + (fr >> 2)) * 144 + 32 * dg + 8 * (fr & 3)));
            vf[dg] = __builtin_shufflevector(lo_, hi_, 0, 1, 2, 3, 4, 5, 6, 7); }
        bool alldone = true;
#pragma unroll
        for (int g = 0; g < 4; ++g) {
            const int qg = qw + 16 * g;
            if (kb >= qg + 15) { alldone = false; continue; }
            if (__all(runp[g] == 0.f)) continue;
            alldone = false;
            f32x4 sa[2];
#pragma unroll
            for (int a_ = 0; a_ < 2; ++a_) { sa[a_] = __builtin_amdgcn_mfma_f32_16x16x32_bf16(kf[a_][0], qf[g][0], (f32x4){0.f, 0.f, 0.f, 0.f}, 0, 0, 0); sa[a_] = __builtin_amdgcn_mfma_f32_16x16x32_bf16(kf[a_][1], qf[g][1], sa[a_], 0, 0, 0); }
            const bool diag = kb + 31 >= qg; const int t = qg + fr;
            float w[2][4];
#pragma unroll
            for (int ai = 1; ai >= 0; --ai) {
                float kp[4], bt[4];
#pragma unroll
                for (int r = 0; r < 4; ++r) { const float e = __builtin_amdgcn_exp2f(fminf(sa[ai][r], 120.0f)); kp[r] = __builtin_amdgcn_rcpf(1.0f + e); bt[r] = e * kp[r]; }
                if (diag) {
#pragma unroll
                    for (int r = 0; r < 4; ++r) { const bool valid = kb + 16 * ai + 4 * fq + r < t; kp[r] = valid ? kp[r] : 1.0f; bt[r] = valid ? bt[r] : 0.0f; } }
                const float pl = (kp[0] * kp[1]) * (kp[2] * kp[3]);
                const float x1 = __int_as_float(__builtin_amdgcn_ds_bpermute(a1, __float_as_int(pl))), x2 = __int_as_float(__builtin_amdgcn_ds_bpermute(a2, __float_as_int(pl))), x3 = __int_as_float(__builtin_amdgcn_ds_bpermute(a3, __float_as_int(pl)));
                float pref = runp[g] * (inc1 ? x1 : 1.0f) * (inc2 ? x2 : 1.0f) * (inc3 ? x3 : 1.0f);
                w[ai][3] = bt[3] * pref; pref *= kp[3]; w[ai][2] = bt[2] * pref; pref *= kp[2]; w[ai][1] = bt[1] * pref; pref *= kp[1]; w[ai][0] = bt[0] * pref;
                runp[g] *= (pl * x1) * (x2 * x3);
            }
            u32x4 pw; pw.x = cvt_pk_bf16(w[0][0], w[0][1]); pw.y = cvt_pk_bf16(w[0][2], w[0][3]); pw.z = cvt_pk_bf16(w[1][0], w[1][1]); pw.w = cvt_pk_bf16(w[1][2], w[1][3]);
            const bf16x8 pf = __builtin_bit_cast(bf16x8, pw);
#pragma unroll
            for (int dg = 0; dg < 4; ++dg) oacc[g][dg] = __builtin_amdgcn_mfma_f32_16x16x32_bf16(vf[dg], pf, oacc[g][dg], 0, 0, 0);
        }
        if (alldone) break;
    }
#undef SB_LOAD
#pragma unroll
    for (int g = 0; g < 4; ++g)
#pragma unroll
        for (int dg = 0; dg < 4; ++dg) { u32x2 w2; w2.x = cvt_pk_bf16(oacc[g][dg].x, oacc[g][dg].y); w2.y = cvt_pk_bf16(oacc[g][dg].z, oacc[g][dg].w);
            *(u32x2*)(O + (size_t)(qw + 16 * g + fr) * 256 + 64 * h + 16 * dg + 4 * fq) = w2; }
}

__device__ __forceinline__ void gla1_unit(LAS unsigned char* lds, const Args& A, int l, int c) {
    unsigned char* ws = opq(A.ws); const int tid_l = mytid(A.wave); const int tid = tid_l;
    const float* small = (const float*)(ws + WS_SMALL); const bf16_t* GK = (const bf16_t*)(ws + WS_GLK); const bf16_t* GV = (const bf16_t*)(ws + WS_GLV);
    float* BC = (float*)(ws + WS_BC); float* UC = (float*)(ws + WS_UC); float* AC = (float*)(ws + WS_AC);
    const GAS float* wup = ldarg(A, I_GUP) + l * 16 * 128; const GAS float* gb = ldarg(A, I_GB) + l * 128;
    LAS float* la = (LAS float*)lds;
    LAS float* kh = (LAS float*)(lds + 32768);
    LAS float* vv = (LAS float*)(lds + 65536);
    const int row0 = c * 64;
    float kLog2e = LOG2E, kLn2 = 0.6931471805599453f; asm volatile("" : "+v"(kLog2e), "+v"(kLn2));
    LAS float* wl = (LAS float*)(lds + 131072);
    f32x4 gq[4]; u32x4 vraw[4], kraw[2];
#pragma unroll
    for (int i = 0; i < 4; ++i) gq[i] = *(const f32x4*)(small + (size_t)(row0 + (tid >> 3)) * 64 + 4 + 4 * i);
#pragma unroll
    for (int i = 0; i < 4; ++i) { const int it = tid + NTHREADS * i; vraw[i] = *(const u32x4*)(GV + (size_t)(row0 + (it >> 5)) * 256 + (it & 31) * 8); }
#pragma unroll
    for (int i = 0; i < 2; ++i) { const int it = tid + NTHREADS * i; kraw[i] = *(const u32x4*)(GK + (size_t)(row0 + (it >> 4)) * 128 + (it & 15) * 8); }
    for (int i = tid; i < 2048 + 128; i += NTHREADS) wl[i] = i < 2048 ? wup[i] : gb[i - 2048];
    __syncthreads();
    { const int t = tid >> 3, jg = tid & 7; float g[16];
#pragma unroll
      for (int i = 0; i < 4; ++i) { const f32x4 q = gq[i]; g[4 * i] = q.x; g[4 * i + 1] = q.y; g[4 * i + 2] = q.z; g[4 * i + 3] = q.w; }
      for (int jj = 0; jj < 16; ++jj) { const int j = 16 * jg + jj; float x = wl[2048 + j];
#pragma unroll
          for (int r = 0; r < 16; ++r) x += g[r] * wl[r * 128 + j];
          const float ls = fminf(x, 0.f) - __builtin_amdgcn_logf(1.0f + __builtin_amdgcn_exp2f(-fabsf(x) * kLog2e)) * kLn2;
          la[t * 128 + j] = ls * (1.0f / 16.0f); } }
#pragma unroll
    for (int ii = 0; ii < 4; ++ii) { const int i = tid + NTHREADS * ii; const int t = i >> 5, c8 = (i & 31) * 8; const u32x4 w = vraw[ii];
        const float v[8] = {bflo(w.x), bfhi(w.x), bflo(w.y), bfhi(w.y), bflo(w.z), bfhi(w.z), bflo(w.w), bfhi(w.w)};
#pragma unroll
        for (int j = 0; j < 8; ++j) vv[t * 256 + c8 + j] = v[j]; }
    __syncthreads();
    if (tid < 128) { float lv[64];
#pragma unroll
        for (int t = 0; t < 64; ++t) lv[t] = la[t * 128 + tid];
        float run = 0.f;
#pragma unroll
        for (int t = 0; t < 64; ++t) { run += lv[t]; la[t * 128 + tid] = run; BC[(size_t)(row0 + t) * 128 + tid] = run; }
        AC[c * 128 + tid] = __builtin_amdgcn_exp2f(run * kLog2e); }
    __syncthreads();
#pragma unroll
    for (int ii = 0; ii < 2; ++ii) { const int it = tid + NTHREADS * ii; const int t = it >> 4, j8 = (it & 15) * 8; const u32x4 w = kraw[ii];
        const float kv[8] = {bflo(w.x), bfhi(w.x), bflo(w.y), bfhi(w.y), bflo(w.z), bfhi(w.z), bflo(w.w), bfhi(w.w)};
#pragma unroll
        for (int j4 = 0; j4 < 2; ++j4) { const f32x4 le = *(const LAS f32x4*)(la + 63 * 128 + j8 + 4 * j4), lt = *(const LAS f32x4*)(la + t * 128 + j8 + 4 * j4);
            *(LAS f32x4*)(kh + t * 128 + j8 + 4 * j4) = (f32x4){kv[4 * j4] * __builtin_amdgcn_exp2f((le.x - lt.x) * kLog2e), kv[4 * j4 + 1] * __builtin_amdgcn_exp2f((le.y - lt.y) * kLog2e),
                                                                kv[4 * j4 + 2] * __builtin_amdgcn_exp2f((le.z - lt.z) * kLog2e), kv[4 * j4 + 3] * __builtin_amdgcn_exp2f((le.w - lt.w) * kLog2e)}; } }
    __syncthreads();
    { const int hd = tid >> 2, eg = tid & 3, hh = hd >> 5; float a[16];
#pragma unroll
      for (int i = 0; i < 16; ++i) a[i] = 0.f;
      for (int t = 0; t < 64; ++t) { const float kk = kh[t * 128 + hd]; const LAS float* vp = vv + t * 256 + 64 * hh + 16 * eg;
#pragma unroll
          for (int i = 0; i < 16; ++i) a[i] += kk * vp[i]; }
      float* up = UC + (size_t)c * 8192 + hd * 64 + 16 * eg;
#pragma unroll
      for (int i = 0; i < 4; ++i) *(f32x4*)(up + 4 * i) = (f32x4){a[4 * i], a[4 * i + 1], a[4 * i + 2], a[4 * i + 3]}; }
    __syncthreads();
}
__device__ __forceinline__ void gla2_phase(LAS unsigned char* lds, const Args& A) {
    unsigned char* ws = opq(A.ws); const float* UC = (const float*)(ws + WS_UC); const float* AC = (const float*)(ws + WS_AC); float* ST = (float*)(ws + WS_ST);
    const int tid = mytid(A.wave), lane = tid & 63, seg = tid >> 6, bid = obid(); if (bid >= 128) return;
    const int gid = bid * 64 + lane, hd = bid;
    LAS float* Ls = (LAS float*)lds; LAS float* Ps = Ls + 512;
    float u[32], a[32];
#pragma unroll
    for (int i = 0; i < 32; ++i) { const int c = 32 * seg + i; u[i] = UC[(size_t)c * 8192 + gid]; a[i] = AC[c * 128 + hd]; }
    float L = 0.f, P = 1.f;
#pragma unroll
    for (int i = 0; i < 32; ++i) { L = a[i] * L + u[i]; P *= a[i]; }
    Ls[seg * 64 + lane] = L; Ps[seg * 64 + lane] = P;
    __syncthreads();
    float st = 0.f;
    for (int s2 = 0; s2 < seg; ++s2) st = Ps[s2 * 64 + lane] * st + Ls[s2 * 64 + lane];
#pragma unroll
    for (int i = 0; i < 32; ++i) { ST[(size_t)(32 * seg + i) * 8192 + gid] = st; st = a[i] * st + u[i]; }
}
__device__ __forceinline__ void glvt_slab(LAS unsigned char* lds, const Args& A, int sb) {
    unsigned char* ws = opq(A.ws); const int tid = mytid(A.wave); const bf16_t* GV = (const bf16_t*)(ws + WS_GLV); bf16_t* GVT = (bf16_t*)(ws + WS_GLVT);
    const int t0 = sb * 128;
#pragma unroll
    for (int i = 0; i < 8; ++i) { const int idx = tid + 512 * i, row = idx >> 5, c8 = (idx & 31) * 8; *(LAS u32x4*)(lds + row * 528 + c8 * 2) = *(const u32x4*)(GV + (size_t)(t0 + row) * 256 + c8); }
    __syncthreads();
#pragma unroll
    for (int i = 0; i < 8; ++i) { const int idx = tid + 512 * i, col = idx & 255, g = idx >> 8; float v[8];
#pragma unroll
        for (int k = 0; k < 8; ++k) { const int tok = 32 * (g >> 2) + 16 * (k >> 2) + 4 * (g & 3) + (k & 3); v[k] = bf2f(*(const LAS bf16_t*)(lds + tok * 528 + col * 2)); }
        st_bf16x8(GVT + (size_t)col * S_ + t0 + 8 * g, v); }
    __syncthreads();
}
__device__ __forceinline__ void gla3_unit(LAS unsigned char* lds, const Args& A, int l, int c) {
    unsigned char* ws = opq(A.ws); const int tid_l = mytid(A.wave); const int tid = tid_l, lane = tid & 63, wave = __builtin_amdgcn_readfirstlane(tid >> 6), fr = lane & 15, fq = lane >> 4;
    const bf16_t* GQ = (const bf16_t*)(ws + WS_GLQ); const bf16_t* GK = (const bf16_t*)(ws + WS_GLK); const bf16_t* GVT = (const bf16_t*)(ws + WS_GLVT); const bf16_t* GO = (const bf16_t*)(ws + WS_GLO);
    const float* BC = (const float*)(ws + WS_BC); const float* ST = (const float*)(ws + WS_ST) + (size_t)c * 8192; bf16_t* OC = (bf16_t*)(ws + WS_OC);
    const GAS float* gn = ldarg(A, I_GNG) + l * 64;
    LAS unsigned char* qb = lds;
    LAS unsigned char* kb = lds + 17408;
    LAS unsigned char* sb = lds + 34816;
    const int row0 = c * 64;
    const int h = wave & 3, th = wave >> 2;
    bf16x8 vf0[4], vf1[4]; u32x2 gwp[2][4]; f32x4 g4p[4];
#pragma unroll
    for (int eb = 0; eb < 4; ++eb) { const bf16_t* vp = GVT + (size_t)(64 * h + 16 * eb + fr) * S_ + row0 + 8 * fq; vf0[eb] = *(const bf16x8*)vp; vf1[eb] = *(const bf16x8*)(vp + 32);
        g4p[eb] = *(const GAS f32x4*)(gn + 16 * eb + 4 * fq);
#pragma unroll
        for (int tbl = 0; tbl < 2; ++tbl) gwp[tbl][eb] = *(const u32x2*)(GO + (size_t)(row0 + 16 * (2 * th + tbl) + fr) * 256 + 64 * h + 16 * eb + 4 * fq); }
    float kLog2e = LOG2E; asm volatile("" : "+v"(kLog2e));
    for (int i = tid; i < 1024; i += NTHREADS) { const int t = i >> 4, j8 = (i & 15) * 8; float qv[8], kv[8];
        ld_bf16x8(GQ + (size_t)(row0 + t) * 128 + j8, qv); ld_bf16x8(GK + (size_t)(row0 + t) * 128 + j8, kv);
        const f32x4 b0 = *(const f32x4*)(BC + (size_t)(row0 + t) * 128 + j8), b1 = *(const f32x4*)(BC + (size_t)(row0 + t) * 128 + j8 + 4);
        const float bb[8] = {b0.x, b0.y, b0.z, b0.w, b1.x, b1.y, b1.z, b1.w};
#pragma unroll
        for (int k = 0; k < 8; ++k) { const float e = bb[k] * kLog2e; qv[k] *= __builtin_amdgcn_exp2f(e); kv[k] *= __builtin_amdgcn_exp2f(-e); }
        u32x4 wq4, wk4; wq4.x = cvt_pk_bf16(qv[0], qv[1]); wq4.y = cvt_pk_bf16(qv[2], qv[3]); wq4.z = cvt_pk_bf16(qv[4], qv[5]); wq4.w = cvt_pk_bf16(qv[6], qv[7]);
        wk4.x = cvt_pk_bf16(kv[0], kv[1]); wk4.y = cvt_pk_bf16(kv[2], kv[3]); wk4.z = cvt_pk_bf16(kv[4], kv[5]); wk4.w = cvt_pk_bf16(kv[6], kv[7]);
        *(LAS u32x4*)(qb + t * 272 + j8 * 2) = wq4; *(LAS u32x4*)(kb + t * 272 + j8 * 2) = wk4; }
    for (int i = tid; i < 2048; i += NTHREADS) { const int hd = i >> 4, e4 = (i & 15) * 4, hh = hd >> 5, d = hd & 31; const f32x4 v = *(const f32x4*)(ST + hd * 64 + e4);
        LAS bf16_t* p = (LAS bf16_t*)(sb + ((hh * 64 + e4) * 40 + d) * 2); p[0] = f2bf(v.x); p[40] = f2bf(v.y); p[80] = f2bf(v.z); p[120] = f2bf(v.w); }
    __syncthreads();
#pragma unroll
    for (int tbl = 0; tbl < 2; ++tbl) { const int tb = 2 * th + tbl;
        const bf16x8 qf = *(const LAS bf16x8*)(qb + (16 * tb + fr) * 272 + (32 * h + 8 * fq) * 2);
        f32x4 sa[4];
#pragma unroll
        for (int jb = 0; jb < 4; ++jb) { sa[jb] = (f32x4){0.f, 0.f, 0.f, 0.f};
            if (jb <= tb) { const bf16x8 kf = *(const LAS bf16x8*)(kb + (16 * jb + fr) * 272 + (32 * h + 8 * fq) * 2); sa[jb] = __builtin_amdgcn_mfma_f32_16x16x32_bf16(kf, qf, sa[jb], 0, 0, 0); }
            if (jb == tb) {
#pragma unroll
                for (int r = 0; r < 4; ++r) if (4 * fq + r > fr) sa[jb][r] = 0.f; } }
        bf16x8 pf[2];
#pragma unroll
        for (int s2 = 0; s2 < 2; ++s2) { u32x4 w; w.x = cvt_pk_bf16(sa[2 * s2].x, sa[2 * s2].y); w.y = cvt_pk_bf16(sa[2 * s2].z, sa[2 * s2].w); w.z = cvt_pk_bf16(sa[2 * s2 + 1].x, sa[2 * s2 + 1].y); w.w = cvt_pk_bf16(sa[2 * s2 + 1].z, sa[2 * s2 + 1].w); pf[s2] = __builtin_bit_cast(bf16x8, w); }
        f32x4 oacc[4]; float sq = 0.f;
#pragma unroll
        for (int eb = 0; eb < 4; ++eb) {
            const bf16x8 sf = *(const LAS bf16x8*)(sb + ((h * 64 + 16 * eb + fr) * 40 + 8 * fq) * 2);
            f32x4 acc = __builtin_amdgcn_mfma_f32_16x16x32_bf16(sf, qf, (f32x4){0.f, 0.f, 0.f, 0.f}, 0, 0, 0);
            acc = __builtin_amdgcn_mfma_f32_16x16x32_bf16(vf0[eb], pf[0], acc, 0, 0, 0);
            if (tb >= 2) acc = __builtin_amdgcn_mfma_f32_16x16x32_bf16(vf1[eb], pf[1], acc, 0, 0, 0);
            oacc[eb] = acc; sq += (acc.x * acc.x + acc.y * acc.y) + (acc.z * acc.z + acc.w * acc.w); }
        sq += shx(sq, 16, lane); sq += shx(sq, 32, lane);
        const float rs = rsqrtf(sq * (1.0f / 64.0f) + EPS);
        const int t = row0 + 16 * tb + fr;
#pragma unroll
        for (int eb = 0; eb < 4; ++eb) { const int e0 = 16 * eb + 4 * fq; const f32x4 g4 = g4p[eb]; const u32x2 gw = gwp[tbl][eb];
            u32x2 w2; w2.x = cvt_pk_bf16(oacc[eb].x * rs * g4.x * bflo(gw.x), oacc[eb].y * rs * g4.y * bfhi(gw.x)); w2.y = cvt_pk_bf16(oacc[eb].z * rs * g4.z * bflo(gw.y), oacc[eb].w * rs * g4.w * bfhi(gw.y));
            *(u32x2*)(OC + (size_t)t * 256 + 64 * h + e0) = w2; }
    }
    __syncthreads();
}

constexpr int DS_CAND = 384;
#ifdef FORCE_SLOW
constexpr int DS_TRIM = 12;
#else
constexpr int DS_TRIM = 256;
#endif
constexpr int DS_OFF_ZC = 65536;
constexpr int DS_OFF_CK = 65536;
constexpr int DS_OFF_CU = 90112;
constexpr int DS_OFF_SEL = 81920;
constexpr int DS_OFF_CTL = MISC_OFF + 128;
typedef short s16x2 __attribute__((ext_vector_type(2)));
typedef unsigned short u16x2 __attribute__((ext_vector_type(2)));
typedef __fp16 h16x2 __attribute__((ext_vector_type(2)));
__device__ __forceinline__ unsigned ds_bins2(float a, float b) {
    const s16x2 hs = __builtin_bit_cast(s16x2, __builtin_amdgcn_cvt_pkrtz(a, b)); const s16x2 sm = hs >> (s16x2){15, 15};
    const unsigned mono = __builtin_bit_cast(unsigned, hs) ^ (__builtin_bit_cast(unsigned, sm) | 0x80008000u);
    return __builtin_bit_cast(unsigned, __builtin_bit_cast(u16x2, mono) >> (u16x2){6, 6});
}
__device__ __forceinline__ float ds_h2f(unsigned hbits) { return (float)__builtin_bit_cast(__fp16, (unsigned short)hbits); }
__device__ __forceinline__ float ds_edge(int b) {
    if (b <= 0) return -INFINITY; if (b >= 1024) return INFINITY;
    if (b >= 512) return ds_h2f(((unsigned)b << 6) ^ 0x8000u);
    const float v = ds_h2f(~(((unsigned)b << 6) - 1u) & 0xffffu);
    return __uint_as_float(__float_as_uint(v) - 1u);
}
__device__ __forceinline__ void ds_compact(LAS unsigned char* lds, int qq, int need, int lane) {
    volatile LAS unsigned short* ck = (volatile LAS unsigned short*)(lds + DS_OFF_CK) + qq * DS_CAND; volatile LAS unsigned* cu = (volatile LAS unsigned*)(lds + DS_OFF_CU) + qq * DS_CAND;
    volatile LAS int* ctl = (volatile LAS int*)(lds + DS_OFF_CTL);
    const int n = ctl[32 + qq];
    if (n <= need) return;
    if (n <= 64) {
        const unsigned mu = lane < n ? cu[lane] : 0u, mk = lane < n ? (unsigned)ck[lane] : 0xffffffffu; int rank = 0;
        const unsigned lo = 0xffffu - (mk & 0xffffu); const unsigned long long mine = ((unsigned long long)mu << 32) | lo;
        for (int j = 0; j < n; ++j) { const unsigned long long cj = ((unsigned long long)(unsigned)__builtin_amdgcn_readlane((int)mu, j) << 32) | (unsigned)__builtin_amdgcn_readlane((int)lo, j); rank += cj > mine ? 1 : 0; }
        const bool keep = lane < n && rank < need; const unsigned long long mask = __ballot(keep); const int pos = __popcll(mask & ((1ull << lane) - 1ull));
        if (keep) { ck[pos] = (unsigned short)mk; cu[pos] = mu; if (rank == need - 1) { ctl[128 + qq] = (int)mu; ctl[160 + qq] = (int)mk; } }
        if (lane == 0) ctl[32 + qq] = need;
        return; }
    if (n <= 128) {
        const unsigned mu0 = cu[lane], mk0 = (unsigned)ck[lane]; const bool v1 = lane + 64 < n; const unsigned mu1 = v1 ? cu[lane + 64] : 0u, mk1 = v1 ? (unsigned)ck[lane + 64] : 0xffffffffu; int r0 = 0, r1 = 0;
        const unsigned lo0 = 0xffffu - (mk0 & 0xffffu), lo1 = 0xffffu - (mk1 & 0xffffu); const unsigned long long c0 = ((unsigned long long)mu0 << 32) | lo0, c1 = ((unsigned long long)mu1 << 32) | lo1;
        for (int j = 0; j < 64; ++j) { const unsigned long long cj = ((unsigned long long)(unsigned)__builtin_amdgcn_readlane((int)mu0, j) << 32) | (unsigned)__builtin_amdgcn_readlane((int)lo0, j);
            r0 += cj > c0 ? 1 : 0; r1 += cj > c1 ? 1 : 0; }
        for (int j = 0; j < n - 64; ++j) { const unsigned long long cj = ((unsigned long long)(unsigned)__builtin_amdgcn_readlane((int)mu1, j) << 32) | (unsigned)__builtin_amdgcn_readlane((int)lo1, j);
            r0 += cj > c0 ? 1 : 0; r1 += cj > c1 ? 1 : 0; }
        const bool k0 = r0 < need, k1 = v1 && r1 < need; const unsigned long long m0 = __ballot(k0), m1 = __ballot(k1); const unsigned long long below = (1ull << lane) - 1ull;
        const int p0 = __popcll(m0 & below), p1 = __popcll(m0) + __popcll(m1 & below);
        __builtin_amdgcn_s_waitcnt(0);
        if (k0) { ck[p0] = (unsigned short)mk0; cu[p0] = mu0; if (r0 == need - 1) { ctl[128 + qq] = (int)mu0; ctl[160 + qq] = (int)mk0; } }
        if (k1) { ck[p1] = (unsigned short)mk1; cu[p1] = mu1; if (r1 == need - 1) { ctl[128 + qq] = (int)mu1; ctl[160 + qq] = (int)mk1; } }
        if (lane == 0) ctl[32 + qq] = need;
        return; }
    unsigned mu[6], mk[6]; int rank[6];
#pragma unroll
    for (int ii = 0; ii < 6; ++ii) { const int i = lane + 64 * ii; mu[ii] = i < n ? cu[i] : 0u; mk[ii] = i < n ? (unsigned)ck[i] : 0xffffffffu; rank[ii] = 0; }
    const LAS unsigned short* ckn = (const LAS unsigned short*)(lds + DS_OFF_CK) + qq * DS_CAND; const LAS unsigned* cun = (const LAS unsigned*)(lds + DS_OFF_CU) + qq * DS_CAND;
#pragma unroll 4
    for (int j = 0; j < n; ++j) { const unsigned long long cj = ((unsigned long long)cun[j] << 32) | (0xffffu - (unsigned)ckn[j]);
#pragma unroll
        for (int ii = 0; ii < 6; ++ii) rank[ii] += cj > (((unsigned long long)mu[ii] << 32) | (0xffffu - (mk[ii] & 0xffffu))) ? 1 : 0; }
    __builtin_amdgcn_s_waitcnt(0);
    int base = 0;
#pragma unroll
    for (int ii = 0; ii < 6; ++ii) { const int i = lane + 64 * ii; const bool keep = i < n && rank[ii] < need;
        const unsigned long long mask = __ballot(keep); const int pos = base + __popcll(mask & ((1ull << lane) - 1ull));
        if (keep) { ck[pos] = (unsigned short)mk[ii]; cu[pos] = mu[ii]; if (rank[ii] == need - 1) { ctl[128 + qq] = (int)mu[ii]; ctl[160 + qq] = (int)mk[ii]; } }
        base += __popcll(mask); }
    if (lane == 0) ctl[32 + qq] = need;
}
__device__ __forceinline__ unsigned dsa_unit(LAS unsigned char* lds, const Args& A, int u, unsigned* qctr) {
    unsigned char* ws = opq(A.ws); const int tid_l = mytid(A.wave); const int tid = tid_l, lane = tid & 63, wave = __builtin_amdgcn_readfirstlane(tid >> 6);
    const bf16_t* IQ = (const bf16_t*)(ws + WS_IXQ); const bf16_t* IK = (const bf16_t*)(ws + WS_IXK); const float* small = (const float*)(ws + WS_SMALL);
    const bf16_t* DQ = (const bf16_t*)(ws + WS_DSQ); const bf16_t* DK = (const bf16_t*)(ws + WS_DSK); const bf16_t* DV = (const bf16_t*)(ws + WS_DSV); bf16_t* OB = (bf16_t*)(ws + WS_OB);
    const int q0 = u * 32, N = ((q0 >> 6) + 1) * 64;
    volatile LAS unsigned* hist = (volatile LAS unsigned*)lds;
    volatile LAS unsigned short* sel = (volatile LAS unsigned short*)(lds + DS_OFF_SEL);
    volatile LAS unsigned short* ck = (volatile LAS unsigned short*)(lds + DS_OFF_CK); volatile LAS unsigned* cu = (volatile LAS unsigned*)(lds + DS_OFF_CU);
    volatile LAS int* ctl = (volatile LAS int*)(lds + DS_OFF_CTL);
    volatile LAS float* ctf = (volatile LAS float*)(lds + DS_OFF_CTL);
    const int fr = lane & 15, fq = lane >> 4;
    TICK(A, 0);
    if (N <= 256) {
        for (int i = tid; i < 32 * 256; i += NTHREADS) sel[i] = (unsigned short)(i & 255);
        __syncthreads();
    } else {
        volatile LAS unsigned* zc = (volatile LAS unsigned*)(lds + 131072);
        bf16x8 qf[2][4][2]; float wq[2][4];
#pragma unroll
        for (int g = 0; g < 2; ++g)
#pragma unroll
            for (int h = 0; h < 4; ++h) { wq[g][h] = small[(size_t)(q0 + 16 * g + fr) * 64 + h] * 0.5f;
#pragma unroll
                for (int s = 0; s < 2; ++s) qf[g][h][s] = *(const bf16x8*)(IQ + (size_t)(q0 + 16 * g + fr) * 256 + 64 * h + 32 * s + 8 * fq); }
        const int ntiles = (N + 127) >> 7;
        float pinf = INFINITY; asm volatile("" : "+v"(pinf));
        for (int i = tid; i < 32 * 1024 + 32 * 32; i += NTHREADS) hist[i] = 0u;
        if (tid == 0) ctl[224] = 0;
#pragma unroll
        for (int g = 0; g < 2; ++g)
#pragma unroll
            for (int h = 0; h < 4; ++h) { asm volatile("" : "+v"(wq[g][h]));
#pragma unroll
                for (int s2 = 0; s2 < 2; ++s2) asm volatile("" : "+v"(qf[g][h][s2])); }
        const unsigned klane = (unsigned)fr * 128u + 16u * (unsigned)fq, kmaxoff = (unsigned)(N - 1) * 128u + 16u * (unsigned)fq;
#define DS_LOADK(kbase, d0, d1) do { const unsigned _o = min((unsigned)(kbase) * 128u + klane, kmaxoff); \
            asm volatile("global_load_dwordx4 %0, %2, %3\n\tglobal_load_dwordx4 %1, %2, %3 offset:64" : "+v"(d0), "+v"(d1) : "v"(_o), "s"(IK) : "memory"); } while (0)
#define DS_WAITK(d0, d1) asm volatile("s_waitcnt vmcnt(4)" : "+v"(d0), "+v"(d1) :: "memory")
#define DS_SCORES(kf0, kf1) f32x4 c4[2][4]; _Pragma("unroll") for (int g = 0; g < 2; ++g) _Pragma("unroll") for (int h = 0; h < 4; ++h) c4[g][h] = __builtin_amdgcn_mfma_f32_16x16x32_bf16(kf0, qf[g][h][0], (f32x4){0.f, 0.f, 0.f, 0.f}, 0, 0, 0); \
        _Pragma("unroll") for (int g = 0; g < 2; ++g) _Pragma("unroll") for (int h = 0; h < 4; ++h) c4[g][h] = __builtin_amdgcn_mfma_f32_16x16x32_bf16(kf1, qf[g][h][1], c4[g][h], 0, 0, 0); \
        float sc[2][4]; _Pragma("unroll") for (int g = 0; g < 2; ++g) _Pragma("unroll") for (int r = 0; r < 4; ++r) { float a_ = 0.f; _Pragma("unroll") for (int h = 0; h < 4; ++h) { a_ += wq[g][h] * __builtin_amdgcn_fmed3f(c4[g][h][r], 0.f, pinf); asm("" : "+v"(a_)); } sc[g][r] = a_; }
#define DS_P0_BODY(kf0, kf1, tile_) do { const int kb = (tile_) * 128 + 16 * wave; DS_WAITK(kf0, kf1); if (kb < N) { DS_SCORES(kf0, kf1) \
            _Pragma("unroll") for (int g = 0; g < 2; ++g) { LAS unsigned* hq = (LAS unsigned*)lds + (16 * g + fr) * 1024; \
                const unsigned p01 = ds_bins2(sc[g][0], sc[g][1]), p23 = ds_bins2(sc[g][2], sc[g][3]); \
                __hip_atomic_fetch_add(hq + (p01 & 0xffffu), 1u, __ATOMIC_RELAXED, __HIP_MEMORY_SCOPE_WORKGROUP); __hip_atomic_fetch_add(hq + (p01 >> 16), 1u, __ATOMIC_RELAXED, __HIP_MEMORY_SCOPE_WORKGROUP); \
                __hip_atomic_fetch_add(hq + (p23 & 0xffffu), 1u, __ATOMIC_RELAXED, __HIP_MEMORY_SCOPE_WORKGROUP); __hip_atomic_fetch_add(hq + (p23 >> 16), 1u, __ATOMIC_RELAXED, __HIP_MEMORY_SCOPE_WORKGROUP); \
                unsigned f0_, f1_, f2_, f3_;        \
                asm("v_min_u32 %0, 1, %1" : "=v"(f0_) : "v"(__float_as_uint(sc[g][0]))); asm("v_min_u32 %0, 1, %1" : "=v"(f1_) : "v"(__float_as_uint(sc[g][1]))); \
                asm("v_min_u32 %0, 1, %1" : "=v"(f2_) : "v"(__float_as_uint(sc[g][2]))); asm("v_min_u32 %0, 1, %1" : "=v"(f3_) : "v"(__float_as_uint(sc[g][3]))); \
                const unsigned nz = 4u - ((f0_ + f1_) + (f2_ + f3_)); \
                nzacc[g] |= nz << (8 * ((tile_) & 3)); } } \
            if (((tile_) & 3) == 3) { _Pragma("unroll") for (int g = 0; g < 2; ++g) { if (nzacc[g]) __hip_atomic_fetch_add((LAS unsigned*)&zc[(16 * g + fr) * 32 + ((tile_) >> 2)], nzacc[g], __ATOMIC_RELAXED, __HIP_MEMORY_SCOPE_WORKGROUP); nzacc[g] = 0u; } }        \
            DS_LOADK(kb + 384, kf0, kf1); } while (0)
        { bf16x8 ka0 = qf[0][0][0], ka1 = ka0, kb0 = ka0, kb1 = ka0, kc0 = ka0, kc1 = ka0; unsigned nzacc[2] = {0u, 0u}; int tile = 0;
          DS_LOADK(16 * wave, ka0, ka1); DS_LOADK(128 + 16 * wave, kb0, kb1); DS_LOADK(256 + 16 * wave, kc0, kc1);
          __syncthreads();
          for (; tile < ntiles; tile += 3) {
              DS_P0_BODY(ka0, ka1, tile); DS_P0_BODY(kb0, kb1, tile + 1); DS_P0_BODY(kc0, kc1, tile + 2);
          }
#pragma unroll
          for (int g = 0; g < 2; ++g) if (nzacc[g]) __hip_atomic_fetch_add((LAS unsigned*)&zc[(16 * g + fr) * 32 + ((tile - 1) >> 2)], nzacc[g], __ATOMIC_RELAXED, __HIP_MEMORY_SCOPE_WORKGROUP);
          asm volatile("s_waitcnt vmcnt(0)" : "+v"(ka0), "+v"(ka1), "+v"(kb0), "+v"(kb1), "+v"(kc0), "+v"(kc1) :: "memory"); }
#undef DS_P0_BODY
        __syncthreads();
        TICK(A, 1);
        unsigned cntq[4][16], Tq[4];
        { const LAS unsigned* histn = (const LAS unsigned*)lds;
#pragma unroll
          for (int k = 0; k < 4; ++k) { unsigned s = 0;
#pragma unroll
              for (int i = 0; i < 16; ++i) { cntq[k][i] = histn[(4 * wave + k) * 1024 + 16 * lane + i]; s += cntq[k][i]; }
              Tq[k] = s; }
#pragma unroll
          for (int off = 1; off < 64; off <<= 1) {
#pragma unroll
              for (int k = 0; k < 4; ++k) { const unsigned v = shdn(Tq[k], off, lane); if (lane + off < 64) Tq[k] += v; } } }
#pragma unroll
        for (int k = 0; k < 4; ++k) { const int qq = 4 * wave + k; const unsigned (&cnt)[16] = cntq[k]; const unsigned T = Tq[k];
            const unsigned long long mask = __ballot(T >= 256u); const int L = 63 - __builtin_clzll(mask);
            const unsigned Tn = shdn(T, 1, lane); const unsigned above = lane == 63 ? 0u : Tn;
            int b1 = 0, G1 = 0; unsigned C1 = 0;
            { unsigned cum = above; bool found = false;
#pragma unroll
              for (int b = 15; b >= 0; --b) { if (!found && cum + cnt[b] >= 256u) { b1 = 16 * lane + b; G1 = (int)cum; C1 = cnt[b]; found = true; } if (!found) cum += cnt[b]; } }
            b1 = __builtin_amdgcn_readlane(b1, L); G1 = __builtin_amdgcn_readlane(G1, L); C1 = (unsigned)__builtin_amdgcn_readlane((int)C1, L);
            int need = 256 - G1, tl = -1;
            if (b1 == 512) {
                const LAS unsigned* zcn = (const LAS unsigned*)(lds + 131072);
                const unsigned w0 = zcn[qq * 32 + (lane >> 2)], w1 = zcn[qq * 32 + 16 + (lane >> 2)];
                const unsigned z0 = lane < ntiles ? (w0 >> (8 * (lane & 3))) & 0xffu : 0u, z1 = lane + 64 < ntiles ? (w1 >> (8 * (lane & 3))) & 0xffu : 0u;
                unsigned p0 = z0, p1 = z1;
#pragma unroll
                for (int off = 1; off < 64; off <<= 1) { const unsigned v0 = (unsigned)__builtin_amdgcn_ds_bpermute((lane - off) << 2, (int)p0), v1 = (unsigned)__builtin_amdgcn_ds_bpermute((lane - off) << 2, (int)p1); if (lane >= off) { p0 += v0; p1 += v1; } }
                const unsigned tot0 = (unsigned)__builtin_amdgcn_readlane((int)p0, 63), tot1 = (unsigned)__builtin_amdgcn_readlane((int)p1, 63);
                if (tot0 + tot1 == C1) {
                    p1 += tot0;
                    const unsigned long long m0 = __ballot(p0 >= (unsigned)need), m1 = __ballot(p1 >= (unsigned)need);
                    unsigned cz;
                    if (m0) { tl = __builtin_ctzll(m0); cz = (unsigned)__builtin_amdgcn_readlane((int)(p0 - z0), tl); }
                    else { const int t1 = __builtin_ctzll(m1); tl = 64 + t1; cz = (unsigned)__builtin_amdgcn_readlane((int)(p1 - z1), t1); }
                    need -= (int)cz; } }
            if (lane == 0) {
#ifdef FORCE_SLOW
                if (tl < 0) ctl[224] = 1;
#else
                if (tl < 0 && C1 > (unsigned)DS_CAND) ctl[224] = 1;
#endif
                ctl[64 + qq] = b1; ctl[96 + qq] = need; ctl[192 + qq] = tl; ctf[225 + qq] = ds_edge(b1); ctf[257 + qq] = ds_edge(b1 + 1); }
        }
        __syncthreads();
        TICK(A, 2);
        { bf16x8 ka0 = qf[0][0][0], ka1 = ka0, kb0 = ka0, kb1 = ka0, kc0 = ka0, kc1 = ka0;
          DS_LOADK(16 * wave, ka0, ka1); DS_LOADK(128 + 16 * wave, kb0, kb1); DS_LOADK(256 + 16 * wave, kc0, kc1);
          for (int i = tid; i < 32 * 512; i += NTHREADS) hist[i] = 0u;
          if (tid < 32) { ctl[32 + tid] = 0; ctl[128 + tid] = 0; ctl[160 + tid] = -1; }
          __syncthreads();
          float flo[2], fhi[2]; int tlo[2];
#pragma unroll
          for (int g = 0; g < 2; ++g) { flo[g] = ctf[225 + 16 * g + fr]; fhi[g] = ctf[257 + 16 * g + fr]; tlo[g] = ctl[192 + 16 * g + fr]; flo[g] = tlo[g] < 0 ? flo[g] : fhi[g]; }
          const bool slow = ctl[224] != 0;
          const unsigned aq0 = DS_OFF_CTL + 4u * (32u + fr), aq1 = aq0 + 64u, ak0 = DS_OFF_CK + 2u * DS_CAND * fr, ak1 = ak0 + 2u * DS_CAND * 16u, au0 = DS_OFF_CU + 4u * DS_CAND * fr, au1 = au0 + 4u * DS_CAND * 16u;
#define DS_P1_BODY(kf0, kf1, tile_, SLOW_) do { const int kb = (tile_) * 128 + 16 * wave; DS_WAITK(kf0, kf1); if (kb < N) { DS_SCORES(kf0, kf1) \
            unsigned accD = 0u, accC = 0u;        \
            _Pragma("unroll") for (int g = 1; g >= 0; --g) { \
                const float tD = (tile_) < tlo[g] ? 0.0f : fhi[g], tC = (tile_) <= tlo[g] ? 0.0f : flo[g];        \
                _Pragma("unroll") for (int r = 3; r >= 0; --r) { accD = __builtin_amdgcn_alignbit(accD, __float_as_uint(sc[g][r] - tD), 31u); accC = __builtin_amdgcn_alignbit(accC, __float_as_uint(sc[g][r] - tC), 31u); } } \
            unsigned cbits = accD & ~accC; \
            _Pragma("unroll") for (int g = 0; g < 2; ++g) { const int qq = 16 * g + fr; \
                const unsigned nib = (~accD >> (4 * g)) & 15u; \
                __hip_atomic_fetch_or((LAS unsigned*)&hist[qq * 512 + (((kb >> 5) + qq) & 511)], nib << ((kb & 31) + 4 * fq), __ATOMIC_RELAXED, __HIP_MEMORY_SCOPE_WORKGROUP); } \
            while (__ballot(cbits != 0u)) {         \
                if (cbits) { const int ix = __builtin_ctz(cbits); cbits &= cbits - 1u; const int g = ix >> 2, r = ix & 3; \
                    const bool b4_ = ix > 3, b2_ = (ix & 2) != 0, b1_ = (ix & 1) != 0;        \
                    const float t0_ = b4_ ? sc[1][0] : sc[0][0], t1_ = b4_ ? sc[1][1] : sc[0][1], t2_ = b4_ ? sc[1][2] : sc[0][2], t3_ = b4_ ? sc[1][3] : sc[0][3]; const float u0_ = b2_ ? t2_ : t0_, u1_ = b2_ ? t3_ : t1_; const float sv = b1_ ? u1_ : u0_; \
                    const int qq = 16 * g + fr, key = kb + 4 * fq + r; \
                    const unsigned ub = __float_as_uint(sv), mono = ub ^ ((unsigned)((int)ub >> 31) | 0x80000000u); \
                    bool ok = true; if (SLOW_) { const unsigned tu = (unsigned)ctl[128 + qq], tk = (unsigned)ctl[160 + qq]; ok = mono > tu || (mono == tu && (unsigned)key < tk); } \
                    if (ok) { const int slot = __hip_atomic_fetch_add((LAS int*)(lds + (b4_ ? aq1 : aq0)), 1, __ATOMIC_RELAXED, __HIP_MEMORY_SCOPE_WORKGROUP); \
                        *(volatile LAS unsigned short*)(lds + (b4_ ? ak1 : ak0) + 2 * slot) = (unsigned short)key; *(volatile LAS unsigned*)(lds + (b4_ ? au1 : au0) + 4 * slot) = mono; } } } } \
            DS_LOADK(kb + 384, kf0, kf1); \
            if (SLOW_) { __syncthreads();         \
                for (int k = 0; k < 4; ++k) { const int qq = 4 * wave + k; if (ctl[32 + qq] > DS_TRIM) ds_compact(lds, qq, ctl[96 + qq], lane); } \
                __syncthreads(); } } while (0)
          if (slow) {
          for (int tile = 0; tile < ntiles; tile += 3) {
              DS_P1_BODY(ka0, ka1, tile, 1); DS_P1_BODY(kb0, kb1, tile + 1, 1); DS_P1_BODY(kc0, kc1, tile + 2, 1);
          } } else {
          for (int tile = 0; tile < ntiles; tile += 3) {
              DS_P1_BODY(ka0, ka1, tile, 0); DS_P1_BODY(kb0, kb1, tile + 1, 0); DS_P1_BODY(kc0, kc1, tile + 2, 0);
          } }
          asm volatile("s_waitcnt vmcnt(0)" : "+v"(ka0), "+v"(ka1), "+v"(kb0), "+v"(kb1), "+v"(kc0), "+v"(kc1) :: "memory"); }
#undef DS_P1_BODY
        __syncthreads();
#undef DS_LOADK
#undef DS_WAITK
#undef DS_SCORES
        TICK(A, 3);
        for (int k = 0; k < 4; ++k) { const int qq = 4 * wave + k; const int need = ctl[96 + qq]; ds_compact(lds, qq, need, lane);
            __builtin_amdgcn_s_waitcnt(0);
            for (int i = lane; i < need; i += 64) { const int key = ck[qq * DS_CAND + i]; __hip_atomic_fetch_or((LAS unsigned*)&hist[qq * 512 + (((key >> 5) + qq) & 511)], 1u << (key & 31), __ATOMIC_RELAXED, __HIP_MEMORY_SCOPE_WORKGROUP); } }
        __syncthreads();
        { const LAS unsigned* histn = (const LAS unsigned*)lds;
          LAS unsigned short* offs = (LAS unsigned short*)(lds + 98304 + wave * 4096);
          unsigned wd[4][8], c8[4], incl[4];
#pragma unroll
          for (int k = 0; k < 4; ++k) { const int qq = 4 * wave + k; c8[k] = 0;
#pragma unroll
              for (int i = 0; i < 8; ++i) { wd[k][i] = histn[qq * 512 + ((8 * lane + i + qq) & 511)]; c8[k] += __popc(wd[k][i]); }
              incl[k] = c8[k]; }
#pragma unroll
          for (int off = 1; off < 64; off <<= 1) {
#pragma unroll
              for (int k = 0; k < 4; ++k) { const unsigned v = (unsigned)__builtin_amdgcn_ds_bpermute((lane - off) << 2, (int)incl[k]); if (lane >= off) incl[k] += v; } }
#pragma unroll
          for (int k = 0; k < 4; ++k) { unsigned pos = incl[k] - c8[k];
#pragma unroll
              for (int i = 0; i < 8; ++i) { offs[k * 512 + 8 * lane + i] = (unsigned short)pos; pos += __popc(wd[k][i]); } }
#pragma unroll 1
          for (int k = 0; k < 4; ++k) { const int qq = 4 * wave + k; unsigned bw[8], pw[8];
#pragma unroll
              for (int i = 0; i < 8; ++i) { const int w = 64 * i + lane; bw[i] = histn[qq * 512 + ((w + qq) & 511)]; pw[i] = offs[k * 512 + w]; }
#pragma unroll
              for (int i = 0; i < 8; ++i) { const int w = 64 * i + lane; unsigned bits = bw[i], p = pw[i];
                  while (bits) { const int bpos = __builtin_ctz(bits); bits &= bits - 1u; sel[qq * 256 + p] = (unsigned short)(w * 32 + bpos); ++p; } } }
          __builtin_amdgcn_s_waitcnt(0); }
        __syncthreads();
    }
    TICK(A, 4);
    unsigned qnext_ = 0; if (mytid(A.wave) == 0) qnext_ = atomicAdd(qctr, 1u);
    const int nsel = N < 256 ? N : 256;
    LAS unsigned char* vst = lds + wave * 9216;
#define AT_SELQ(qq_) ((const LAS unsigned short*)(lds + DS_OFF_SEL) + (qq_) * 256)
#define AT_ISSUE_K(buf, sq_, b_) do { _Pragma("unroll") for (int i8 = 0; i8 < 8; ++i8) { const int key_ = (sq_)[64 * (b_) + 8 * i8 + (lane >> 3)]; buf[i8] = *(const u32x4*)(DK + (size_t)key_ * 64 + 8 * (lane & 7)); } } while (0)
#define AT_ISSUE_V(buf, sq_, c_) do { _Pragma("unroll") for (int i8 = 0; i8 < 8; ++i8) { const int key_ = (sq_)[64 * (c_) + 8 * i8 + (lane >> 3)]; buf[i8] = *(const u32x4*)(DV + (size_t)key_ * 64 + 8 * (lane & 7)); } } while (0)
#define AT_QK(buf, b_) do { _Pragma("unroll") for (int i8 = 0; i8 < 8; ++i8) *(LAS u32x4*)(vst + (8 * i8 + (lane >> 3)) * 144 + 16 * (lane & 7)) = buf[i8]; \
        _Pragma("unroll") for (int g4 = 0; g4 < 4; ++g4) { const f32x4 c4_ = __builtin_amdgcn_mfma_f32_16x16x32_bf16(*(const LAS bf16x8*)(vst + (16 * g4 + fr) * 144 + 16 * fq), qf[0], (f32x4){0.f, 0.f, 0.f, 0.f}, 0, 0, 0); \
        sacc[4 * (b_) + g4] = __builtin_amdgcn_mfma_f32_16x16x32_bf16(*(const LAS bf16x8*)(vst + (16 * g4 + fr) * 144 + 64 + 16 * fq), qf[1], c4_, 0, 0, 0); } } while (0)
#define AT_PV(buf, c_) do { _Pragma("unroll") for (int i8 = 0; i8 < 8; ++i8) { const int row_ = 32 * (i8 >> 2) + 16 * (i8 & 1) + 4 * ((i8 >> 1) & 1) + 8 * (lane >> 5) + ((lane >> 3) & 3); \
            *(LAS u32x4*)(vst + row_ * 144 + 16 * (lane & 7)) = buf[i8]; } \
        _Pragma("unroll") for (int s2 = 0; s2 < 2; ++s2) _Pragma("unroll") for (int dg = 0; dg < 4; ++dg) { \
            const s16x4 lo_ = __builtin_amdgcn_ds_read_tr16_b64_v4i16((LAS s16x4*)(vst + (32 * s2 + 8 * fq + (fr >> 2)) * 144 + 32 * dg + 8 * (fr & 3))); \
            const s16x4 hi_ = __builtin_amdgcn_ds_read_tr16_b64_v4i16((LAS s16x4*)(vst + (32 * s2 + 8 * fq + 4 + (fr >> 2)) * 144 + 32 * dg + 8 * (fr & 3))); \
            const bf16x8 vf_ = __builtin_shufflevector(lo_, hi_, 0, 1, 2, 3, 4, 5, 6, 7); \
            oacc[dg] = __builtin_amdgcn_mfma_f32_16x16x32_bf16(vf_, pf[2 * (c_) + s2], oacc[dg], 0, 0, 0); } } while (0)
    u32x4 B0[8], B1[8], B2[8]; bf16x8 qf[2];
    { const int t0 = q0 + 4 * wave;
#pragma unroll
      for (int s2 = 0; s2 < 2; ++s2) qf[s2] = *(const bf16x8*)(DQ + (size_t)t0 * 256 + 64 * (fr & 3) + 32 * s2 + 8 * fq);
      AT_ISSUE_K(B0, AT_SELQ(4 * wave), 0); AT_ISSUE_K(B1, AT_SELQ(4 * wave), 1); }
#define AT_QUERY(k_, X, Y, Z) do { const int qq = 4 * wave + (k_), t = q0 + qq; const LAS unsigned short* selq = AT_SELQ(qq); f32x4 sacc[16]; \
        AT_ISSUE_K(Z, selq, 2); AT_QK(X, 0); \
        AT_ISSUE_K(X, selq, 3); AT_QK(Y, 1); \
        AT_ISSUE_V(Y, selq, 0); AT_QK(Z, 2); \
        AT_ISSUE_V(Z, selq, 1); AT_QK(X, 3); \
        if ((k_) < 3) { _Pragma("unroll") for (int s2 = 0; s2 < 2; ++s2) qf[s2] = *(const bf16x8*)(DQ + (size_t)(t + 1) * 256 + 64 * (fr & 3) + 32 * s2 + 8 * fq); } \
        if (nsel < 256) { _Pragma("unroll") for (int g = 0; g < 16; ++g) _Pragma("unroll") for (int r = 0; r < 4; ++r) if (16 * g + 4 * fq + r >= nsel) sacc[g][r] = -INFINITY; } \
        float mx = -INFINITY; \
        _Pragma("unroll") for (int g = 0; g < 16; ++g) mx = fmaxf(fmaxf(mx, fmaxf(fmaxf(sacc[g].x, sacc[g].y), sacc[g].z)), sacc[g].w);        \
        mx = fmaxf(mx, shx(mx, 16, lane)); mx = fmaxf(mx, shx(mx, 32, lane)); \
        float sm = 0.f; \
        _Pragma("unroll") for (int g = 0; g < 16; ++g) { sacc[g].x = __builtin_amdgcn_exp2f(sacc[g].x - mx); sacc[g].y = __builtin_amdgcn_exp2f(sacc[g].y - mx); sacc[g].z = __builtin_amdgcn_exp2f(sacc[g].z - mx); sacc[g].w = __builtin_amdgcn_exp2f(sacc[g].w - mx); \
            sm += (sacc[g].x + sacc[g].y) + (sacc[g].z + sacc[g].w); } \
        sm += shx(sm, 16, lane); sm += shx(sm, 32, lane); \
        const float inv = 1.0f / sm; \
        bf16x8 pf[8]; \
        _Pragma("unroll") for (int s2 = 0; s2 < 8; ++s2) { u32x4 w; w.x = cvt_pk_bf16(sacc[2 * s2].x, sacc[2 * s2].y); w.y = cvt_pk_bf16(sacc[2 * s2].z, sacc[2 * s2].w);        \
            w.z = cvt_pk_bf16(sacc[2 * s2 + 1].x, sacc[2 * s2 + 1].y); w.w = cvt_pk_bf16(sacc[2 * s2 + 1].z, sacc[2 * s2 + 1].w); pf[s2] = __builtin_bit_cast(bf16x8, w); } \
        f32x4 oacc[4]; \
        _Pragma("unroll") for (int dg = 0; dg < 4; ++dg) oacc[dg] = (f32x4){0.f, 0.f, 0.f, 0.f}; \
        AT_ISSUE_V(X, selq, 2); AT_PV(Y, 0); \
        AT_ISSUE_V(Y, selq, 3); AT_PV(Z, 1); \
        if ((k_) < 3) AT_ISSUE_K(Z, AT_SELQ(qq + 1), 0); \
        AT_PV(X, 2); \
        if ((k_) < 3) AT_ISSUE_K(X, AT_SELQ(qq + 1), 1); \
        AT_PV(Y, 3); \
        if (fr < 4) { _Pragma("unroll") for (int dg = 0; dg < 4; ++dg) { u32x2 w2; w2.x = cvt_pk_bf16(oacc[dg].x * inv, oacc[dg].y * inv); w2.y = cvt_pk_bf16(oacc[dg].z * inv, oacc[dg].w * inv); \
                *(u32x2*)(OB + (size_t)t * 256 + 64 * fr + 16 * dg + 4 * fq) = w2; } } } while (0)
    AT_QUERY(0, B0, B1, B2); AT_QUERY(1, B2, B0, B1); AT_QUERY(2, B1, B2, B0); AT_QUERY(3, B0, B1, B2);
#undef AT_QUERY
#undef AT_SELQ
#undef AT_ISSUE_K
#undef AT_ISSUE_V
#undef AT_QK
#undef AT_PV
    __syncthreads();
    TICK(A, 5);
#if DBG_MODE == 1
    { unsigned short* ds = (unsigned short*)(opq(A.ws) + WS_DBGSEL) + (size_t)u * 8192; for (int i = mytid(A.wave); i < 32 * 256; i += NTHREADS) ds[i] = sel[i]; }
    __syncthreads();
#endif
    return qnext_;
}

__device__ __forceinline__ void xattn_phase(LAS unsigned char* lds, const Args& A, const pg8::StaticOrder& S) {
    unsigned char* ws = opq(A.ws); const int tid_l = mytid(A.wave); const int tid = tid_l, lane = tid & 63, wave = __builtin_amdgcn_readfirstlane(tid >> 6), fr = lane & 15, fq = lane >> 4;
    const bf16_t* XQ = (const bf16_t*)(ws + WS_XQ); const bf16_t* KM = (const bf16_t*)(ws + WS_KM); const bf16_t* VMT = (const bf16_t*)(ws + WS_VMT); bf16_t* AO = (bf16_t*)(ws + WS_AO);
    for (int ui = 0;; ++ui) { pg8::Unit un; if (!S.next(ui, un)) break;
        const int hh = __builtin_amdgcn_readfirstlane(un.pn), rb = __builtin_amdgcn_readfirstlane(un.pm);
        __syncthreads();
#pragma unroll
        for (int b8 = 0; b8 < 2; ++b8) { u32x4 t8[8];
#pragma unroll
            for (int i = 0; i < 8; ++i) { const int idx = tid + 512 * (8 * b8 + i); t8[i] = *(const u32x4*)(KM + (size_t)(idx >> 5) * 1024 + 256 * hh + 8 * (idx & 31)); }
#pragma unroll
            for (int i = 0; i < 8; ++i) { const int idx = tid + 512 * (8 * b8 + i); *(LAS u32x4*)(lds + (idx >> 5) * 528 + 16 * (idx & 31)) = t8[i]; } }
        __syncthreads();
        bf16x8 pf[2][8];
        { bf16x8 qf[2][8]; f32x4 sacc[2][16];
#pragma unroll
          for (int j = 0; j < 2; ++j) { const int row = rb * 256 + 128 * j + 16 * wave + fr;
#pragma unroll
              for (int s2 = 0; s2 < 8; ++s2) qf[j][s2] = *(const bf16x8*)(XQ + (size_t)row * 1024 + 256 * hh + 32 * s2 + 8 * fq); }
#pragma unroll
          for (int g = 0; g < 16; ++g) { f32x4 c0 = (f32x4){0.f, 0.f, 0.f, 0.f}, c1 = c0;
#pragma unroll
              for (int s2 = 0; s2 < 8; ++s2) { const bf16x8 kf = *(const LAS bf16x8*)(lds + (16 * g + fr) * 528 + (32 * s2 + 8 * fq) * 2);
                  c0 = __builtin_amdgcn_mfma_f32_16x16x32_bf16(kf, qf[0][s2], c0, 0, 0, 0); c1 = __builtin_amdgcn_mfma_f32_16x16x32_bf16(kf, qf[1][s2], c1, 0, 0, 0); }
              sacc[0][g] = c0; sacc[1][g] = c1; asm volatile("" ::: "memory"); }
#pragma unroll
          for (int j = 0; j < 2; ++j) {
            float mx = -INFINITY;
#pragma unroll
            for (int g = 0; g < 16; ++g) mx = fmaxf(fmaxf(mx, fmaxf(fmaxf(sacc[j][g].x, sacc[j][g].y), sacc[j][g].z)), sacc[j][g].w);
            mx = fmaxf(mx, shx(mx, 16, lane)); mx = fmaxf(mx, shx(mx, 32, lane));
            float sm = 0.f;
#pragma unroll
            for (int g = 0; g < 16; ++g) { sacc[j][g].x = __builtin_amdgcn_exp2f(sacc[j][g].x - mx); sacc[j][g].y = __builtin_amdgcn_exp2f(sacc[j][g].y - mx); sacc[j][g].z = __builtin_amdgcn_exp2f(sacc[j][g].z - mx); sacc[j][g].w = __builtin_amdgcn_exp2f(sacc[j][g].w - mx);
                sm += (sacc[j][g].x + sacc[j][g].y) + (sacc[j][g].z + sacc[j][g].w); }
            sm += shx(sm, 16, lane); sm += shx(sm, 32, lane);
            const float inv = 1.0f / sm;
#pragma unroll
            for (int s2 = 0; s2 < 8; ++s2) { u32x4 w; w.x = cvt_pk_bf16(sacc[j][2 * s2].x * inv, sacc[j][2 * s2].y * inv); w.y = cvt_pk_bf16(sacc[j][2 * s2].z * inv, sacc[j][2 * s2].w * inv);
                w.z = cvt_pk_bf16(sacc[j][2 * s2 + 1].x * inv, sacc[j][2 * s2 + 1].y * inv); w.w = cvt_pk_bf16(sacc[j][2 * s2 + 1].z * inv, sacc[j][2 * s2 + 1].w * inv); pf[j][s2] = __builtin_bit_cast(bf16x8, w); }
            asm volatile("" ::: "memory");
          } }
        __syncthreads();
        const int tid2 = mytid(A.wave), lane2 = tid2 & 63, wave2 = __builtin_amdgcn_readfirstlane(tid2 >> 6), fr2 = lane2 & 15, fq2 = lane2 >> 4; unsigned char* ws2 = opq(A.ws);
        const bf16_t* VMT2 = (const bf16_t*)(ws2 + WS_VMT); bf16_t* AO2 = (bf16_t*)(ws2 + WS_AO);
#pragma unroll
        for (int b8 = 0; b8 < 2; ++b8) { u32x4 t8[8];
#pragma unroll
            for (int i = 0; i < 8; ++i) { const int idx = tid2 + 512 * (8 * b8 + i); t8[i] = *(const u32x4*)(VMT2 + (size_t)(256 * hh + (idx >> 5)) * 256 + 8 * (idx & 31)); }
#pragma unroll
            for (int i = 0; i < 8; ++i) { const int idx = tid2 + 512 * (8 * b8 + i); *(LAS u32x4*)(lds + (idx >> 5) * 528 + 16 * (idx & 31)) = t8[i]; } }
        __syncthreads();
        { const int row0 = rb * 256 + 16 * wave2 + fr2;
#pragma unroll
            for (int dg = 0; dg < 16; ++dg) { f32x4 c0 = (f32x4){0.f, 0.f, 0.f, 0.f}, c1 = c0;
#pragma unroll
                for (int s2 = 0; s2 < 8; ++s2) { const bf16x8 vf = *(const LAS bf16x8*)(lds + (16 * dg + fr2) * 528 + (32 * s2 + 8 * fq2) * 2);
                    c0 = __builtin_amdgcn_mfma_f32_16x16x32_bf16(vf, pf[0][s2], c0, 0, 0, 0); c1 = __builtin_amdgcn_mfma_f32_16x16x32_bf16(vf, pf[1][s2], c1, 0, 0, 0); }
                u32x2 w; w.x = cvt_pk_bf16(c0.x, c0.y); w.y = cvt_pk_bf16(c0.z, c0.w);
                *(u32x2*)(AO2 + (size_t)row0 * 1024 + 256 * hh + 16 * dg + 4 * fq2) = w;
                w.x = cvt_pk_bf16(c1.x, c1.y); w.y = cvt_pk_bf16(c1.z, c1.w);
                *(u32x2*)(AO2 + (size_t)(row0 + 128) * 1024 + 256 * hh + 16 * dg + 4 * fq2) = w; if (dg & 1) asm volatile("" ::: "memory"); } }
    }
    __syncthreads();
}

__device__ __forceinline__ void final_norm(const Args& A) {
    const int tid = mytid(A.wave), lane = tid & 63, wave = tid >> 6; const int bid = obid(), Gl = ogrid(); unsigned char* ws = opq(A.ws); const float* ssq = (const float*)(ws + WS_SSQ); const bf16_t* xb = (const bf16_t*)(ws + WS_XB); const GAS float* g = ldarg(A, I_FING);
    for (int r = bid * 8 + wave; r < S_; r += Gl * 8) { const float rs = row_rstd(ssq, r); float* xr = (float*)opq((unsigned char*)A.out) + (size_t)r * 1024 + lane * 16;
        float v[16]; { float v0[8], v1[8]; ld_bf16x8(xb + (size_t)r * 1024 + lane * 16, v0); ld_bf16x8(xb + (size_t)r * 1024 + lane * 16 + 8, v1);
#pragma unroll
            for (int i = 0; i < 8; ++i) { v[i] = v0[i]; v[8 + i] = v1[i]; } }
#pragma unroll
        for (int i = 0; i < 4; ++i) { const f32x4 gg = *(const GAS f32x4*)(g + lane * 16 + 4 * i); *(f32x4*)(xr + 4 * i) = (f32x4){v[4 * i] * rs * gg.x, v[4 * i + 1] * rs * gg.y, v[4 * i + 2] * rs * gg.z, v[4 * i + 3] * rs * gg.w}; } }
}

constexpr int PH_PER_LAYER = 11, N_PHASES = 2 + PH_PER_LAYER * DEPTH;
__global__ void __launch_bounds__(NTHREADS, 2) mk_fwd(const float* i0, const float* i1, const float* i2, const float* i3, const float* i4, const float* i5, const float* i6, const float* i7, const float* i8, const float* i9,
                                                      const float* i10, const float* i11, const float* i12, const float* i13, const float* i14, const float* i15, const float* i16, const float* i17, const float* i18, const float* i19,
                                                      float* outp, unsigned char* wsp, int ph_lo, int ph_hi) {
    extern __shared__ __attribute__((aligned(16))) unsigned char lds[];
    LAS unsigned char* ring = (LAS unsigned char*)lds;
    Args args; args.out = outp; args.ws = wsp; args.ring = ring; args.wave = __builtin_amdgcn_readfirstlane(threadIdx.x >> 6);
    const int tid = threadIdx.x;
    unsigned char* ws = args.ws;
    unsigned* ctl = (unsigned*)(ws + WS_CTL);
    volatile LAS unsigned* misc = (volatile LAS unsigned*)(ring + MISC_OFF);
    if (tid < 16) misc[tid] = 0u;
#if DBG_MODE == 3
    if (tid < 32) ((volatile LAS unsigned long long*)(ring + MISC_OFF + 2560))[tid] = 0ull;
#endif
    if (tid == 0) { volatile LAS unsigned long long* av = (volatile LAS unsigned long long*)(ring + ARGV_OFF);
        av[0] = (unsigned long long)i0; av[1] = (unsigned long long)i1; av[2] = (unsigned long long)i2; av[3] = (unsigned long long)i3; av[4] = (unsigned long long)i4;
        av[5] = (unsigned long long)i5; av[6] = (unsigned long long)i6; av[7] = (unsigned long long)i7; av[8] = (unsigned long long)i8; av[9] = (unsigned long long)i9;
        av[10] = (unsigned long long)i10; av[11] = (unsigned long long)i11; av[12] = (unsigned long long)i12; av[13] = (unsigned long long)i13; av[14] = (unsigned long long)i14;
        av[15] = (unsigned long long)i15; av[16] = (unsigned long long)i16; av[17] = (unsigned long long)i17; av[18] = (unsigned long long)i18; av[19] = (unsigned long long)i19; }
    __syncthreads();
    const bool one = (ph_hi - ph_lo) > 1;
    XcdBarrier bar; bar.bar = ctl + CW_BAR; bar.x = 0; bar.st = misc;
    if (one) bar = xcd_barrier_post(ctl + CW_BAR, misc, args.wave);
    const int lo = ph_lo, hi = ph_hi, G = gridDim.x;
#define IN(k) (lo <= (k) && (k) < hi)
#if DBG_MODE == 3
#define STAMP(k) do { if (obid() == 0 && mytid(args.wave) == 0) ((volatile LAS unsigned long long*)(ring + MISC_OFF + 2048))[(k)] = __builtin_amdgcn_s_memrealtime(); } while (0)
#else
#define STAMP(k) do { } while (0)
#endif
#define SEAM(k) do { if (IN((k) + 1)) xcd_barrier(bar, args.wave); STAMP((k) + 1); } while (0)

#if DBG_MODE == 3
    const unsigned long long clk0_ = clock64();
#endif
    STAMP(0);
    if (PH_EN(100) && IN(0)) { prologue(ring, args); __syncthreads(); STAMP(1); }

    for (int l = 0; l < DEPTH; ++l) {
        const int pb = 1 + PH_PER_LAYER * l;
        if (l == 0) { if (PH_EN(0) && IN(pb + 0)) { const int bid = obid(), Gl = ogrid(); conv_range(ring, args, 0, 0, CONV_EARLY, bid, Gl); SEAM(pb + 0); } }
        else STAMP(pb + 1);
        if (PH_EN(1) && IN(pb + 1)) { unsigned char* wsl = opq(ws); (void)wsl; const int bid = obid(), Gl = ogrid(); (void)bid; (void)Gl;
            { pg8::Gemm g{(const bf16_t*)(wsl + WS_XB), (const bf16_t*)(wsl + WS_WIN), S_, NIN - 256, D_, 0, 0}; pg8::StaticOrder S; S.init(S_, NIN - 256, Gl, bid);
              EpiIn E{(const float*)(wsl + WS_SSQ), (const float*)(wsl + WS_CS), (bf16_t*)(wsl + WS_SBQ), (bf16_t*)(wsl + WS_SBK), (bf16_t*)(wsl + WS_SBV), (bf16_t*)(wsl + WS_DSQ), (bf16_t*)(wsl + WS_IXQ), (bf16_t*)(wsl + WS_DSK), (bf16_t*)(wsl + WS_IXK),
                      (bf16_t*)(wsl + WS_DSV), (bf16_t*)(wsl + WS_GLQ), (bf16_t*)(wsl + WS_GLK), (bf16_t*)(wsl + WS_GLV), (bf16_t*)(wsl + WS_GLO), (bf16_t*)(wsl + WS_GATES), (float*)(wsl + WS_SMALL), (bf16_t*)(wsl + WS_SBVT), 0, (bf16_t*)(wsl + WS_GLVT)};
              pg8::gemm_phase<EpiIn, pg8::StaticOrder>(ring, g, S, E, args.wave); }
            SEAM(pb + 1);
        }
        if (PH_EN(2) && IN(pb + 2)) { unsigned char* wsl = opq(ws); (void)wsl; const int bid = obid(), Gl = ogrid(); (void)bid; (void)Gl;
            volatile LAS int* qslot = (volatile LAS int*)(ring + MISC_OFF + 32);
            unsigned qnext = 0; bool have = false;
            for (;;) {
                __syncthreads();
                if (mytid(args.wave) == 0) *qslot = have ? (int)qnext : (int)atomicAdd((unsigned*)(opq(ws) + WS_CTL) + CW_QUEUE + 64 * l, 1u);
                __syncthreads();
                const int uqp = *qslot;
                if (uqp >= 1232) break;
                const int uq = uqp < 512 ? uqp + 72 : (uqp < 584 ? uqp - 512 : uqp);
                have = uq >= 584;
                if (have && mytid(args.wave) == 0) qnext = atomicAdd((unsigned*)(opq(ws) + WS_CTL) + CW_QUEUE + 64 * l, 1u);
                if (uq >= 64 && uq < 72) {
                    pg8::Gemm g{(const bf16_t*)(wsl + WS_MEMB), (const bf16_t*)(wsl + WS_WXKV), NMEM, 2048, D_, 0, 0}; pg8::StaticOrder S; S.init(NMEM, 2048, 8, uq - 64);
                    EpiKV E{(const float*)(wsl + WS_RSTDM), (bf16_t*)(wsl + WS_KM), (bf16_t*)(wsl + WS_VMT)};
                    pg8::gemm_phase<EpiKV, pg8::StaticOrder>(ring, g, S, E, args.wave); }
                else if (uq < 64) {
                    pg8::Gemm g{(const bf16_t*)(wsl + WS_XB), (const bf16_t*)(wsl + WS_WIN) + (size_t)(NIN - 256) * D_, S_, 256, D_, 0, 0}; pg8::StaticOrder S; S.init(S_, 256, 64, uq);
                    EpiIn E{(const float*)(wsl + WS_SSQ), (const float*)(wsl + WS_CS), (bf16_t*)(wsl + WS_SBQ), (bf16_t*)(wsl + WS_SBK), (bf16_t*)(wsl + WS_SBV), (bf16_t*)(wsl + WS_DSQ), (bf16_t*)(wsl + WS_IXQ), (bf16_t*)(wsl + WS_DSK), (bf16_t*)(wsl + WS_IXK),
                            (bf16_t*)(wsl + WS_DSV), (bf16_t*)(wsl + WS_GLQ), (bf16_t*)(wsl + WS_GLK), (bf16_t*)(wsl + WS_GLV), (bf16_t*)(wsl + WS_GLO), (bf16_t*)(wsl + WS_GATES), (float*)(wsl + WS_SMALL), (bf16_t*)(wsl + WS_SBVT), 20, (bf16_t*)(wsl + WS_GLVT)};
                    pg8::gemm_phase<EpiIn, pg8::StaticOrder>(ring, g, S, E, args.wave); }
                else if (uq < 584) { qnext = dsa_unit(ring, args, 583 - uq, (unsigned*)(opq(ws) + WS_CTL) + CW_QUEUE + 64 * l); have = true; }
                else if (uq < 840) { TICK(args, 0); gla1_unit(ring, args, l, uq - 584); TICK(args, 7); }
                else if (uq < 968) { TICK(args, 0); sb_unit(ring, args, 967 - uq); TICK(args, 6); }
                else { const int c0 = CONV_EARLY + 2 * (uq - 968); conv_range(ring, args, l, c0, c0 + 2, 0, 1); }
            }
            SEAM(pb + 2);
        }
        if (PH_EN(3) && IN(pb + 3)) { unsigned char* wsl = opq(ws); (void)wsl; const int bid = obid(), Gl = ogrid(); (void)bid; (void)Gl; gla2_phase(ring, args);
            if (bid >= 128) for (int sb = bid - 128; sb < 128; sb += Gl - 128) glvt_slab(ring, args, sb);
            SEAM(pb + 3); }
        if (PH_EN(4) && IN(pb + 4)) { unsigned char* wsl = opq(ws); (void)wsl; const int bid = obid(), Gl = ogrid(); (void)bid; (void)Gl; for (int c = bid; c < 256; c += Gl) gla3_unit(ring, args, l, c); SEAM(pb + 4); }
        if (PH_EN(5) && IN(pb + 5)) { unsigned char* wsl = opq(ws); (void)wsl; const int bid = obid(), Gl = ogrid(); (void)bid; (void)Gl;
            pg8::Gemm g{(const bf16_t*)(wsl + WS_OA), (const bf16_t*)(wsl + WS_WBR), S_, D_, 256, (size_t)(WS_OB - WS_OA), (size_t)1024 * 256 * 2}; pg8::TripleOrder S; S.init(S_, D_, Gl, bid);
            EpiMerge E{(const bf16_t*)(wsl + WS_GATES), (bf16_t*)(wsl + WS_MERGED)}; pg8::gemm_phase<EpiMerge, pg8::TripleOrder>(ring, g, S, E, args.wave);
            SEAM(pb + 5);
        }
        if (PH_EN(6) && IN(pb + 6)) { unsigned char* wsl = opq(ws); (void)wsl; const int bid = obid(), Gl = ogrid(); (void)bid; (void)Gl; pg8::Gemm g{(const bf16_t*)(wsl + WS_MERGED), (const bf16_t*)(wsl + WS_WMIX), S_, D_, D_, 0, 0}; pg8::StaticOrder S; S.init(S_, D_, Gl, bid);
            EpiRes E{(float*)nullptr, (bf16_t*)(wsl + WS_XB), (float*)(wsl + WS_SSQ)}; pg8::gemm_phase<EpiRes, pg8::StaticOrder>(ring, g, S, E, args.wave); SEAM(pb + 6); }
        if (PH_EN(7) && IN(pb + 7)) { unsigned char* wsl = opq(ws); (void)wsl; const int bid = obid(), Gl = ogrid(); (void)bid; (void)Gl; pg8::Gemm g{(const bf16_t*)(wsl + WS_XB), (const bf16_t*)(wsl + WS_WXQ), S_, D_, D_, 0, 0}; pg8::StaticOrder S; S.init(S_, D_, Gl, bid);
            EpiXq E{(const float*)(wsl + WS_SSQ), (bf16_t*)(wsl + WS_XQ)}; pg8::gemm_phase<EpiXq, pg8::StaticOrder>(ring, g, S, E, args.wave);
            __syncthreads();
            xattn_phase(ring, args, S); SEAM(pb + 7); }
        if (PH_EN(8) && IN(pb + 8)) { unsigned char* wsl = opq(ws); (void)wsl; const int bid = obid(), Gl = ogrid(); (void)bid; (void)Gl; pg8::Gemm g{(const bf16_t*)(wsl + WS_AO), (const bf16_t*)(wsl + WS_WXO), S_, D_, D_, 0, 0}; pg8::StaticOrder S; S.init(S_, D_, Gl, bid);
            EpiRes E{(float*)nullptr, (bf16_t*)(wsl + WS_XB), (float*)(wsl + WS_SSQ)}; pg8::gemm_phase<EpiRes, pg8::StaticOrder>(ring, g, S, E, args.wave); SEAM(pb + 8); }
        if (PH_EN(9) && IN(pb + 9)) { unsigned char* wsl = opq(ws); (void)wsl; const int bid = obid(), Gl = ogrid(); (void)bid; (void)Gl; pg8::Gemm g{(const bf16_t*)(wsl + WS_XB), (const bf16_t*)(wsl + WS_WFI), S_, NFF, D_, 0, 0}; pg8::StaticOrder S; S.init(S_, NFF, Gl, bid);
            EpiFfnIn E{(const float*)(wsl + WS_SSQ), (bf16_t*)(wsl + WS_HID)}; pg8::gemm_phase<EpiFfnIn, pg8::StaticOrder>(ring, g, S, E, args.wave);
            if (l + 1 < DEPTH) {
                const int nun = (S_ / 256) * (NFF / 256), nmax = (nun + Gl - 1) / Gl; int fi = nun - (nmax - 1) * Gl; if (fi >= Gl) fi = 0;
                __syncthreads();
                if (bid >= fi) conv_range(ring, args, l + 1, 0, CONV_EARLY, bid - fi, Gl - fi); }
            SEAM(pb + 9); }
        if (PH_EN(10) && IN(pb + 10)) { unsigned char* wsl = opq(ws); (void)wsl; const int bid = obid(), Gl = ogrid(); (void)bid; (void)Gl; pg8::Gemm g{(const bf16_t*)(wsl + WS_HID), (const bf16_t*)(wsl + WS_WFO), S_, D_, DFF, 0, 0}; pg8::StaticOrder S; S.init(S_, D_, Gl, bid);
            EpiRes E{(float*)nullptr, (bf16_t*)(wsl + WS_XB), (float*)(wsl + WS_SSQ)}; pg8::gemm_phase<EpiRes, pg8::StaticOrder>(ring, g, S, E, args.wave); SEAM(pb + 10); }
    }
    if (PH_EN(101) && IN(N_PHASES - 1)) { final_norm(args); __syncthreads(); STAMP(N_PHASES); }
#if DBG_MODE == 3
    if (obid() == 0 && mytid(args.wave) == 0) { volatile LAS unsigned long long* st = (volatile LAS unsigned long long*)(ring + MISC_OFF + 2048); unsigned long long T = 0;
        if (STAMP_A == 40) { const unsigned long long cyc = clock64() - clk0_; const unsigned long long rt = st[N_PHASES] - st[0]; T = (cyc * 1000ull / rt) * 10ull; }
        else if (STAMP_A == 30) T = ((volatile LAS unsigned long long*)(ring + MISC_OFF + 2560))[10] / 20ull;
        else if (STAMP_A >= 20) T = ((volatile LAS unsigned long long*)(ring + MISC_OFF + 2560))[STAMP_A - 20];
        else if (STAMP_A < PH_PER_LAYER) { for (int l = 0; l < DEPTH; ++l) T += st[2 + PH_PER_LAYER * l + STAMP_A] - st[1 + PH_PER_LAYER * l + STAMP_A]; } else if (STAMP_A == 12) T = st[1] - st[0]; else T = st[N_PHASES] - st[N_PHASES - 1];
        const unsigned long long t0 = __builtin_amdgcn_s_memrealtime(); while (__builtin_amdgcn_s_memrealtime() - t0 < T * STAMP_MUL) __builtin_amdgcn_s_sleep(8); }
#endif
#undef IN
#undef SEAM
}

#if DBG_MODE == 1
constexpr size_t WS_DBGSC = WS_DBGEND;
constexpr size_t WS_DBGFL = WS_DBGSC + 1 * MB;
constexpr size_t WS_DBGEND2 = WS_DBGFL + 256 * 1024;
__device__ __forceinline__ int dbg_row(int i) { if (i == 0) return 0; if (i == 1) return 63; if (i == 2) return 64; if (i == 3) return 255; if (i == 4) return 256; if (i == 5) return S_ - 1; if (i == 6) return 300; if (i == 7) return 16000; return (int)((((unsigned)i * 2654435761u) >> 14) % (unsigned)S_); }
__device__ __forceinline__ void dbg_err(float* dbg, int stage, float got, float ex, float atol, float rtol) { float e = fabsf(got - ex) / (atol + rtol * fabsf(ex)); if (!(e == e)) e = 1e30f; atomicMax((unsigned*)(dbg + stage), __float_as_uint(e)); }
__device__ __forceinline__ void dbg_sincos(float angf, double& c, double& s) {
    double a = (double)angf; const double k = floor(a / 6.283185307179586476925286766559); a -= k * 6.283185307179586476925286766559; if (a > 3.14159265358979323846) a -= 6.283185307179586476925286766559;
    double term = a, sn = a, a2 = a * a; for (int i = 1; i < 20; ++i) { term *= -a2 / ((2 * i) * (2 * i + 1)); sn += term; }
    term = 1.0; double cn = 1.0; for (int i = 1; i < 20; ++i) { term *= -a2 / ((2 * i - 1) * (2 * i)); cn += term; }
    c = cn; s = sn; }
__global__ void __launch_bounds__(512) dbg_inproj(const float* x, const float* g, const float* win, unsigned char* ws) {
    __shared__ float xs[1024]; __shared__ float z[INW]; __shared__ float red[8];
    float* dbg = (float*)(ws + WS_DBG); const int r = dbg_row(blockIdx.x), tid = threadIdx.x;
    float sq = 0.f; for (int k = tid; k < 1024; k += 512) { const float v = x[(size_t)r * 1024 + k]; sq += v * v; xs[k] = v * g[k]; }
    for (int o = 32; o >= 1; o >>= 1) sq += __shfl_xor(sq, o);
    if ((tid & 63) == 0) red[tid >> 6] = sq;
    __syncthreads();
    float tot = 0.f; for (int i = 0; i < 8; ++i) tot += red[i];
    const float rstd = rsqrtf(tot * (1.0f / 1024.0f) + EPS);
    if (tid == 0) dbg_err(dbg, 20, row_rstd((const float*)(ws + WS_SSQ), r), rstd, 0.f, 1e-4f);
    for (int n = tid; n < INW; n += 512) { float acc = 0.f; for (int k = 0; k < 1024; ++k) acc += xs[k] * win[(size_t)k * INW + n]; z[n] = acc * rstd; }
    __syncthreads();
    const bf16_t* SBQ = (const bf16_t*)(ws + WS_SBQ); const bf16_t* SBK = (const bf16_t*)(ws + WS_SBK); const bf16_t* SBV = (const bf16_t*)(ws + WS_SBV);
    const bf16_t* DSQ = (const bf16_t*)(ws + WS_DSQ); const bf16_t* IXQ = (const bf16_t*)(ws + WS_IXQ); const bf16_t* DSK = (const bf16_t*)(ws + WS_DSK); const bf16_t* IXK = (const bf16_t*)(ws + WS_IXK); const bf16_t* DSV = (const bf16_t*)(ws + WS_DSV);
    const float* SM = (const float*)(ws + WS_SMALL); const bf16_t* GLQ = (const bf16_t*)(ws + WS_GLQ); const bf16_t* GLK = (const bf16_t*)(ws + WS_GLK); const bf16_t* GLV = (const bf16_t*)(ws + WS_GLV); const bf16_t* GLO = (const bf16_t*)(ws + WS_GLO); const bf16_t* GT = (const bf16_t*)(ws + WS_GATES);
    const float AT = 0.04f, RT = 0.02f;
    for (int n = tid; n < INW; n += 512) {
        const float zn = z[n];
        if (n < 768) { const int w = n >> 8, c = n & 255; const bf16_t* B = w == 0 ? SBQ : (w == 1 ? SBK : SBV); dbg_err(dbg, 1 + w, bf2f(B[(size_t)r * 256 + c]), zn * (w == 0 ? SBQ_SCALE : 1.0f), AT, RT); }
        else if (n < 1152 && !(n >= 1088) || (n >= 1152 && n < 1472)) {
            int base, stage, ld, col; float sc; const bf16_t* B;
            if (n < 1024) { base = 768; stage = 4; ld = 256; sc = DSQ_SCALE; B = DSQ; } else if (n < 1088) { base = 1024; stage = 5; ld = 64; sc = 1.f; B = DSK; }
            else if (n < 1408) { base = 1152; stage = 7; ld = 256; sc = IXQ_SCALE; B = IXQ; } else { base = 1408; stage = 8; ld = 64; sc = 1.f; B = IXK; }
            col = n - base; const int d = col & 63, dd = d & 31; double c, s_; dbg_sincos((float)r * c_inv_freq[dd], c, s_);
            const float ex = d < 32 ? (float)(zn * c - z[n + 32] * s_) : (float)(zn * c + z[n - 32] * s_);
            dbg_err(dbg, stage, bf2f(B[(size_t)r * ld + col]), ex * sc, AT, RT); }
        else if (n < 1152) dbg_err(dbg, 6, bf2f(DSV[(size_t)r * 64 + n - 1088]), zn, AT, RT);
        else if (n < 1476) dbg_err(dbg, 9, SM[(size_t)r * 64 + n - 1472], zn, AT, RT);
        else if (n < 1604) dbg_err(dbg, 10, bf2f(GLQ[(size_t)r * 128 + n - 1476]), zn * GLQ_SCALE, AT, RT);
        else if (n < 1732) dbg_err(dbg, 11, bf2f(GLK[(size_t)r * 128 + n - 1604]), zn, AT, RT);
        else if (n < 1988) dbg_err(dbg, 12, bf2f(GLV[(size_t)r * 256 + n - 1732]), zn, AT, RT);
        else if (n < 2004) dbg_err(dbg, 13, SM[(size_t)r * 64 + 4 + n - 1988], zn, AT, RT);
        else if (n < 2260) dbg_err(dbg, 14, bf2f(GLO[(size_t)r * 256 + n - 2004]), zn / (1.0f + expf(-zn)), AT, RT);
        else dbg_err(dbg, 15, bf2f(GT[(size_t)r * 3072 + n - 2260]), 1.0f / (1.0f + expf(-zn)), AT, RT);
    }
}
__global__ void __launch_bounds__(64) dbg_sb(unsigned char* ws) {
    float* dbg = (float*)(ws + WS_DBG); const int i = threadIdx.x, t = dbg_row(i), h = i & 3;
    const bf16_t* Q = (const bf16_t*)(ws + WS_SBQ); const bf16_t* K = (const bf16_t*)(ws + WS_SBK); const bf16_t* V = (const bf16_t*)(ws + WS_SBV); const bf16_t* O = (const bf16_t*)(ws + WS_OA);
    float q[64], acc[64];
#pragma unroll
    for (int d8 = 0; d8 < 8; ++d8) { float v[8]; ld_bf16x8(Q + (size_t)t * 256 + 64 * h + 8 * d8, v);
#pragma unroll
        for (int j = 0; j < 8; ++j) { q[8 * d8 + j] = v[j] * (1.0f / LOG2E); acc[8 * d8 + j] = 0.f; } }
    float run = 0.f;
    for (int s = t - 1; s >= 0; --s) { float z = 0.f;
#pragma unroll
        for (int d8 = 0; d8 < 8; ++d8) { float v[8]; ld_bf16x8(K + (size_t)s * 256 + 64 * h + 8 * d8, v);
#pragma unroll
            for (int j = 0; j < 8; ++j) z += q[8 * d8 + j] * v[j]; }
        const float lb = z >= 0.f ? -log1pf(expf(-z)) : z - log1pf(expf(z)); const float lk = lb - z; const float w = expf(lb + run);
#pragma unroll
        for (int d8 = 0; d8 < 8; ++d8) { float v[8]; ld_bf16x8(V + (size_t)s * 256 + 64 * h + 8 * d8, v);
#pragma unroll
            for (int j = 0; j < 8; ++j) acc[8 * d8 + j] += w * v[j]; }
        run += lk; }
#pragma unroll
    for (int d8 = 0; d8 < 8; ++d8) { float v[8]; ld_bf16x8(O + (size_t)t * 256 + 64 * h + 8 * d8, v);
#pragma unroll
        for (int j = 0; j < 8; ++j) dbg_err(dbg, 16, v[j], acc[8 * d8 + j], 0.02f, 0.02f); }
}
__global__ void __launch_bounds__(512) dbg_dsa(unsigned char* ws) {
    __shared__ float qi[256]; __shared__ float dq[256]; __shared__ float pp[4][256]; __shared__ float wsm[4]; __shared__ int mism; __shared__ float mxs[4], sms[4];
    float* dbg = (float*)(ws + WS_DBG); const int tid = threadIdx.x, t = dbg_row(blockIdx.x), N = ((t >> 6) + 1) * 64, nsel = N < 256 ? N : 256;
    const bf16_t* IQ = (const bf16_t*)(ws + WS_IXQ); const bf16_t* IK = (const bf16_t*)(ws + WS_IXK); const float* SM = (const float*)(ws + WS_SMALL);
    const bf16_t* DQ = (const bf16_t*)(ws + WS_DSQ); const bf16_t* DK = (const bf16_t*)(ws + WS_DSK); const bf16_t* DV = (const bf16_t*)(ws + WS_DSV); const bf16_t* OB = (const bf16_t*)(ws + WS_OB);
    const unsigned short* msel = (const unsigned short*)(ws + WS_DBGSEL) + (size_t)t * 256;
    float* sc = (float*)(ws + WS_DBGSC) + (size_t)blockIdx.x * 16384; int* fl = (int*)(ws + WS_DBGFL) + (size_t)blockIdx.x * 16384;
    if (tid < 256) { qi[tid] = bf2f(IQ[(size_t)t * 256 + tid]); dq[tid] = bf2f(DQ[(size_t)t * 256 + tid]); } if (tid < 4) wsm[tid] = SM[(size_t)t * 64 + tid] * 0.5f; if (tid == 0) mism = 0;
    __syncthreads();
    for (int s = tid; s < N; s += 512) { float tot = 0.f;
#pragma unroll 1
        for (int h = 0; h < 4; ++h) { float a = 0.f;
#pragma unroll 4
            for (int d = 0; d < 64; ++d) a += qi[64 * h + d] * bf2f(IK[(size_t)s * 64 + d]); tot += wsm[h] * fmaxf(a, 0.f); } sc[s] = tot + 0.0f; }
    __threadfence_block(); __syncthreads();
    { float mine[32]; int rank[32];
#pragma unroll
      for (int k = 0; k < 32; ++k) { const int s = tid + 512 * k; mine[k] = s < N ? sc[s] : 0.f; rank[k] = 0; }
      for (int j = 0; j < N; ++j) { const float v = sc[j];
#pragma unroll
          for (int k = 0; k < 32; ++k) { const int s = tid + 512 * k; rank[k] += (v > mine[k] || (v == mine[k] && j < s)) ? 1 : 0; } }
#pragma unroll
      for (int k = 0; k < 32; ++k) { const int s = tid + 512 * k; if (s < N) fl[s] = (N <= 256 || rank[k] < 256) ? 1 : 0; } }
    __threadfence_block(); __syncthreads();
    if (tid < nsel) { const int key = msel[tid]; bool ok = key < N; if (ok) ok = atomicExch(fl + key, 2) == 1; if (!ok) atomicAdd(&mism, 1); }
    __syncthreads();
    if (tid == 0) dbg_err(dbg, 17, (float)mism, 0.f, 6.0f, 0.f);
    if (tid < 256) { const bool valid = tid < nsel; const int key = valid ? (int)msel[tid] : 0; const int kk = key < S_ ? key : 0;
#pragma unroll 1
        for (int h = 0; h < 4; ++h) { float a = 0.f;
#pragma unroll 4
            for (int d = 0; d < 64; ++d) a += dq[64 * h + d] * bf2f(DK[(size_t)kk * 64 + d]);
            pp[h][tid] = valid ? a : -INFINITY; } }
    __syncthreads();
    if (tid < 4) { float mx = -INFINITY; for (int i = 0; i < 256; ++i) mx = fmaxf(mx, pp[tid][i]); float sm = 0.f; for (int i = 0; i < 256; ++i) sm += exp2f(pp[tid][i] - mx); mxs[tid] = mx; sms[tid] = sm; }
    __syncthreads();
    if (tid < 256) { const int h = tid >> 6, d = tid & 63; float o = 0.f;
#pragma unroll 2
        for (int i = 0; i < nsel; ++i) { const int key = msel[i] < S_ ? msel[i] : 0; o += exp2f(pp[h][i] - mxs[h]) * bf2f(DV[(size_t)key * 64 + d]); }
        dbg_err(dbg, 18, bf2f(OB[(size_t)t * 256 + tid]), o / sms[h], 0.02f, 0.02f); }
}
__global__ void __launch_bounds__(512) dbg_gla(const float* wup, const float* gb, const float* gn, unsigned char* ws) {
    __shared__ float qs[32], ks[32], al[32], vs[64], part[32][65], os[64];
    float* dbg = (float*)(ws + WS_DBG); const int tid = threadIdx.x, h = blockIdx.x, d = tid >> 4, e0 = (tid & 15) * 4;
    const float* SM = (const float*)(ws + WS_SMALL); const bf16_t* GQ = (const bf16_t*)(ws + WS_GLQ); const bf16_t* GK = (const bf16_t*)(ws + WS_GLK); const bf16_t* GV = (const bf16_t*)(ws + WS_GLV); const bf16_t* GO = (const bf16_t*)(ws + WS_GLO); const bf16_t* OC = (const bf16_t*)(ws + WS_OC);
    float st[4] = {0.f, 0.f, 0.f, 0.f}; float emax = 0.f;
    for (int t = 0; t < S_; ++t) {
        if (tid < 32) { qs[tid] = bf2f(GQ[(size_t)t * 128 + 32 * h + tid]); ks[tid] = bf2f(GK[(size_t)t * 128 + 32 * h + tid]);
            float x = gb[32 * h + tid]; for (int r = 0; r < 16; ++r) x += SM[(size_t)t * 64 + 4 + r] * wup[r * 128 + 32 * h + tid];
            const float ls = x >= 0.f ? -log1pf(expf(-x)) : x - log1pf(expf(x)); al[tid] = expf(ls * (1.0f / 16.0f)); }
        else if (tid < 96) vs[tid - 32] = bf2f(GV[(size_t)t * 256 + 64 * h + tid - 32]);
        __syncthreads();
#pragma unroll
        for (int i = 0; i < 4; ++i) { st[i] = al[d] * st[i] + ks[d] * vs[e0 + i]; part[d][e0 + i] = qs[d] * st[i]; }
        __syncthreads();
        if (tid < 64) { float o = 0.f; for (int dd = 0; dd < 32; ++dd) o += part[dd][tid]; float sq = o * o; for (int m = 32; m >= 1; m >>= 1) sq += __shfl_xor(sq, m);
            const float ex = o * rsqrtf(sq * (1.0f / 64.0f) + EPS) * gn[tid] * bf2f(GO[(size_t)t * 256 + 64 * h + tid]);
            float e = fabsf(bf2f(OC[(size_t)t * 256 + 64 * h + tid]) - ex) / (0.08f + 0.06f * fabsf(ex)); if (!(e == e)) e = 1e30f; emax = fmaxf(emax, e); }
        __syncthreads();
    }
    if (tid < 64) atomicMax((unsigned*)(dbg + 19), __float_as_uint(emax));
}
constexpr size_t WS_DBGCK = WS_DBGEND2;
constexpr size_t WS_DBGEND3 = WS_DBGCK + 2 * 64 * 1024 * 4;
__device__ __forceinline__ float dbg_dot(const float* arow, const float* W, int ldw, int K, int n) { float a = 0.f; for (int k = 0; k < K; ++k) a += arow[k] * W[(size_t)k * ldw + n]; return a; }
__global__ void __launch_bounds__(512) dbg_merge(const float* wa, const float* wb, const float* wc, unsigned char* ws) {
    __shared__ float oa[256], ob[256], oc[256]; float* dbg = (float*)(ws + WS_DBG); const int r = dbg_row(blockIdx.x), tid = threadIdx.x;
    if (tid < 256) { oa[tid] = bf2f(((const bf16_t*)(ws + WS_OA))[(size_t)r * 256 + tid]); ob[tid] = bf2f(((const bf16_t*)(ws + WS_OB))[(size_t)r * 256 + tid]); oc[tid] = bf2f(((const bf16_t*)(ws + WS_OC))[(size_t)r * 256 + tid]); }
    __syncthreads();
    const bf16_t* G = (const bf16_t*)(ws + WS_GATES) + (size_t)r * 3072; const bf16_t* M = (const bf16_t*)(ws + WS_MERGED) + (size_t)r * 1024;
    for (int c = tid; c < 1024; c += 512) { const float ex = bf2f(G[c]) * dbg_dot(oa, wa, 1024, 256, c) + bf2f(G[1024 + c]) * dbg_dot(ob, wb, 1024, 256, c) + bf2f(G[2048 + c]) * dbg_dot(oc, wc, 1024, 256, c);
        dbg_err(dbg, 21, bf2f(M[c]), ex, 0.03f, 0.03f); }
}
__global__ void __launch_bounds__(512) dbg_resid(const float* xin, int xin_ld_is_ck, const float* W, int K, size_t abuf_off, const float* out, unsigned char* ws, int st, int ckslot) {
    __shared__ float arow[2816]; __shared__ float red[8]; float* dbg = (float*)(ws + WS_DBG); const int smp = blockIdx.x, r = dbg_row(smp), tid = threadIdx.x;
    const bf16_t* Ab = (const bf16_t*)(ws + abuf_off) + (size_t)r * K; for (int k = tid; k < K; k += 512) arow[k] = bf2f(Ab[k]);
    __syncthreads();
    const float* xrow = xin_ld_is_ck ? xin + (size_t)smp * 1024 : xin + (size_t)r * 1024; float* ck = (float*)(ws + WS_DBGCK) + ((size_t)ckslot * 64 + smp) * 1024;
    float sq = 0.f;
    for (int c = tid; c < 1024; c += 512) { const float ex = xrow[c] + dbg_dot(arow, W, 1024, K, c); const float got = out[(size_t)r * 1024 + c];
        dbg_err(dbg, st, got, ex, 0.03f, 0.02f); dbg_err(dbg, st + 1, bf2f(((const bf16_t*)(ws + WS_XB))[(size_t)r * 1024 + c]), got, 0.001f, 0.01f); sq += got * got; ck[c] = got; }
    for (int o = 32; o >= 1; o >>= 1) sq += __shfl_xor(sq, o);
    if ((tid & 63) == 0) red[tid >> 6] = sq;
    __syncthreads();
    if (tid == 0) { float tot = 0.f; for (int i = 0; i < 8; ++i) tot += red[i]; const float* sp = (const float*)(ws + WS_SSQ) + (size_t)r * 16; float got = 0.f; for (int i = 0; i < 16; ++i) got += sp[i]; dbg_err(dbg, st + 2, got, tot, 0.f, 1e-3f); }
}
__global__ void __launch_bounds__(512) dbg_normproj(const float* x, const float* gain, const float* W, int mode, unsigned char* ws, int st) {
    __shared__ float xs[1024]; __shared__ float red[8]; float* dbg = (float*)(ws + WS_DBG); const int r = dbg_row(blockIdx.x), tid = threadIdx.x;
    float sq = 0.f; for (int k = tid; k < 1024; k += 512) { const float v = x[(size_t)r * 1024 + k]; sq += v * v; xs[k] = v * gain[k]; }
    for (int o = 32; o >= 1; o >>= 1) sq += __shfl_xor(sq, o);
    if ((tid & 63) == 0) red[tid >> 6] = sq;
    __syncthreads();
    float tot = 0.f; for (int i = 0; i < 8; ++i) tot += red[i]; const float rstd = rsqrtf(tot * (1.0f / 1024.0f) + EPS);
    if (mode == 0) { for (int c = tid; c < 1024; c += 512) dbg_err(dbg, st, bf2f(((const bf16_t*)(ws + WS_XQ))[(size_t)r * 1024 + c]), rstd * dbg_dot(xs, W, 1024, 1024, c) * XQ_SCALE, 0.03f, 0.02f); }
    else { for (int j = tid; j < DFF; j += 512) { const float g = rstd * dbg_dot(xs, W, NFF, 1024, j), up = rstd * dbg_dot(xs, W, NFF, 1024, DFF + j);
            dbg_err(dbg, st, bf2f(((const bf16_t*)(ws + WS_HID))[(size_t)r * DFF + j]), g / (1.0f + expf(-g)) * up, 0.03f, 0.03f); } }
}
__global__ void __launch_bounds__(512) dbg_kv(const float* mem, const float* gain, const float* W, unsigned char* ws, int st) {
    __shared__ float xs[1024]; __shared__ float red[8]; float* dbg = (float*)(ws + WS_DBG); const int r = blockIdx.x * 4 + 1, tid = threadIdx.x;
    float sq = 0.f; for (int k = tid; k < 1024; k += 512) { const float v = mem[(size_t)r * 1024 + k]; sq += v * v; xs[k] = v * gain[k]; }
    for (int o = 32; o >= 1; o >>= 1) sq += __shfl_xor(sq, o);
    if ((tid & 63) == 0) red[tid >> 6] = sq;
    __syncthreads();
    float tot = 0.f; for (int i = 0; i < 8; ++i) tot += red[i]; const float rstd = rsqrtf(tot * (1.0f / 1024.0f) + EPS);
    const int pos = (r & ~31) + 8 * ((r >> 2) & 3) + 4 * ((r >> 4) & 1) + (r & 3);
    for (int n = tid; n < 2048; n += 512) { const float ex = rstd * dbg_dot(xs, W, 2048, 1024, n);
        if (n < 1024) dbg_err(dbg, st, bf2f(((const bf16_t*)(ws + WS_KM))[(size_t)r * 1024 + n]), ex, 0.03f, 0.02f);
        else dbg_err(dbg, st + 1, bf2f(((const bf16_t*)(ws + WS_VMT))[(size_t)(n - 1024) * 256 + pos]), ex, 0.03f, 0.02f); }
}
__global__ void __launch_bounds__(512) dbg_xattn(unsigned char* ws, int st) {
    __shared__ float q[1024]; __shared__ float sc[256]; float* dbg = (float*)(ws + WS_DBG); const int r = dbg_row(blockIdx.x), tid = threadIdx.x;
    const bf16_t* XQ = (const bf16_t*)(ws + WS_XQ); const bf16_t* KM = (const bf16_t*)(ws + WS_KM); const bf16_t* VMT = (const bf16_t*)(ws + WS_VMT); const bf16_t* AO = (const bf16_t*)(ws + WS_AO);
    for (int k = tid; k < 1024; k += 512) q[k] = bf2f(XQ[(size_t)r * 1024 + k]);
    for (int h = 0; h < 4; ++h) {
        __syncthreads();
        if (tid < 256) { float a = 0.f; for (int d = 0; d < 256; ++d) a += q[256 * h + d] * bf2f(KM[(size_t)tid * 1024 + 256 * h + d]); sc[tid] = a; }
        __syncthreads();
        float mx = -INFINITY; for (int i = 0; i < 256; ++i) mx = fmaxf(mx, sc[i]); float sm = 0.f; for (int i = 0; i < 256; ++i) sm += exp2f(sc[i] - mx);
        if (tid < 256) { float o = 0.f; for (int key = 0; key < 256; ++key) { const int pos = (key & ~31) + 8 * ((key >> 2) & 3) + 4 * ((key >> 4) & 1) + (key & 3); o += exp2f(sc[key] - mx) * bf2f(VMT[(size_t)(256 * h + tid) * 256 + pos]); }
            dbg_err(dbg, st, bf2f(AO[(size_t)r * 1024 + 256 * h + tid]), o / sm, 0.02f, 0.02f); }
    }
}
__global__ void dbg_encode(unsigned char* ws, float* out, int nstage) {
    const float* dbg = (const float*)(ws + WS_DBG); int first = 0; for (int i = 1; i <= nstage; ++i) if (dbg[i] > 1.0f) { first = i; break; }
#ifdef DBG_PROBE
    { float e = dbg[DBG_PROBE] * 100.0f; first = e > 98.0f ? 98 : (int)(e + 0.5f); }
#endif
    const float c = sqrtf(10.0f * (float)first);
    for (size_t i = (size_t)blockIdx.x * blockDim.x + threadIdx.x; i < (size_t)S_ * D_; i += (size_t)gridDim.x * blockDim.x) out[i] = c;
}
#endif
extern "C" void kernel_launch(void* const* d_in, const int* in_sizes, int n_in, void* d_out, int out_size, void* d_ws, size_t ws_size, hipStream_t stream) {
    static int grid = 0;
    if (grid == 0) {
        if (n_in != 20 || out_size != S_ * D_ || ws_size < WS_END) { fprintf(stderr, "kernel_launch: unexpected shapes (n_in %d out %d ws %zu need %zu)\n", n_in, out_size, ws_size, (size_t)WS_END); grid = -1; return; }
        int dev = 0, cus = 0, per_cu = 0;
        if (hipGetDevice(&dev) != hipSuccess || hipDeviceGetAttribute(&cus, hipDeviceAttributeMultiprocessorCount, dev) != hipSuccess) { grid = -1; return; }
        if (hipFuncSetAttribute((const void*)mk_fwd, hipFuncAttributeMaxDynamicSharedMemorySize, LDS_BYTES) != hipSuccess) { fprintf(stderr, "kernel_launch: hipFuncSetAttribute failed\n"); grid = -1; return; }
        if (hipOccupancyMaxActiveBlocksPerMultiprocessor(&per_cu, (const void*)mk_fwd, NTHREADS, LDS_BYTES) != hipSuccess || per_cu < 1) { fprintf(stderr, "kernel_launch: occupancy query says %d\n", per_cu); }
        (void)hipGetLastError();
        grid = cus;
    }
    if (grid < 0) return;
    (void)hipMemsetAsync((char*)d_ws + WS_CTL, 0, CTL_ZERO_BYTES, stream);
    const float* p[20];
    for (int i = 0; i < 20; ++i) p[i] = (const float*)d_in[i];
#define MK_LAUNCH(LO, HI) hipLaunchKernelGGL(mk_fwd, dim3(grid), dim3(NTHREADS), LDS_BYTES, stream, p[0], p[1], p[2], p[3], p[4], p[5], p[6], p[7], p[8], p[9], p[10], p[11], p[12], p[13], p[14], p[15], p[16], p[17], p[18], p[19], \
        (float*)d_out, (unsigned char*)d_ws, (int)(LO), (int)(HI))
#if DBG_MODE == 1
    if (ws_size < WS_DBGEND3) { fprintf(stderr, "debug build: workspace too small\n"); return; }
    (void)hipMemsetAsync((char*)d_ws + WS_DBG, 0, 65536, stream);
    for (int ph = 0; ph <= 5; ++ph) MK_LAUNCH(ph, ph + 1);
    unsigned char* W8 = (unsigned char*)d_ws;
    hipLaunchKernelGGL(dbg_inproj, dim3(64), dim3(512), 0, stream, p[I_X], p[I_MIXG], p[I_WIN], W8);
    hipLaunchKernelGGL(dbg_sb, dim3(1), dim3(64), 0, stream, W8);
    hipLaunchKernelGGL(dbg_dsa, dim3(16), dim3(512), 0, stream, W8);
    hipLaunchKernelGGL(dbg_gla, dim3(4), dim3(512), 0, stream, p[I_GUP], p[I_GB], p[I_GNG], W8);
    hipLaunchKernelGGL(dbg_kv, dim3(64), dim3(512), 0, stream, p[I_MEM], p[I_MG], p[I_WXKV], W8, 26);
    MK_LAUNCH(6, 7);
    hipLaunchKernelGGL(dbg_merge, dim3(64), dim3(512), 0, stream, p[I_WBA], p[I_WBB], p[I_WBC], W8);
    MK_LAUNCH(7, 8);
    hipLaunchKernelGGL(dbg_resid, dim3(64), dim3(512), 0, stream, p[I_X], 0, p[I_WMIX], 1024, (size_t)WS_MERGED, (const float*)d_out, W8, 22, 0);
    MK_LAUNCH(8, 9);
    hipLaunchKernelGGL(dbg_normproj, dim3(64), dim3(512), 0, stream, (const float*)d_out, p[I_XG], p[I_WXQ], 0, W8, 25);
    hipLaunchKernelGGL(dbg_xattn, dim3(64), dim3(512), 0, stream, W8, 28);
    MK_LAUNCH(9, 10);
    hipLaunchKernelGGL(dbg_resid, dim3(64), dim3(512), 0, stream, (const float*)((char*)d_ws + WS_DBGCK), 1, p[I_WXO], 1024, (size_t)WS_AO, (const float*)d_out, W8, 29, 1);
    MK_LAUNCH(10, 11);
    hipLaunchKernelGGL(dbg_normproj, dim3(64), dim3(512), 0, stream, (const float*)d_out, p[I_FG], p[I_WFI], 1, W8, 32);
    MK_LAUNCH(11, 12);
    hipLaunchKernelGGL(dbg_resid, dim3(64), dim3(512), 0, stream, (const float*)((char*)d_ws + WS_DBGCK) + 64 * 1024, 1, p[I_WFO], DFF, (size_t)WS_HID, (const float*)d_out, W8, 33, 0);
    hipLaunchKernelGGL(dbg_encode, dim3(1024), dim3(256), 0, stream, W8, (float*)d_out, 35);
#elif N_LAUNCH_MODE == 1
    MK_LAUNCH(0, N_PHASES);
#else
    for (int ph = 0; ph < N_PHASES; ++ph) MK_LAUNCH(ph, ph + 1);
#endif
}
```
